# Optimizing an MI355X kernel written in HIP

```python
import jax, jax.numpy as jnp
from jax import lax
import numpy as np

D_MODEL = 1024
BATCH = 8
SEQ = 2048
DEPTH = 1
DEC_BATCH = 128
DEC_SEQ = 4
PAST_LEN = 16384
PAGE_SIZE = 128

N_META = 16
D_MIX = D_MODEL
D_TM = D_MIX // 2
TM_HEAD = 64
TM_HEADS = D_TM // TM_HEAD
DECAY_RANK = 64
AAA_RANK = 64
GATE_RANK = 128
D_TM_PROJ = 3 * D_TM + DECAY_RANK + AAA_RANK + GATE_RANK
D_LRU = D_MIX - D_TM
LRU_BLOCKS = 8
LRU_BLOCK = D_LRU // LRU_BLOCKS
LRU_CONV_W = 4
LRU_C = 8.0
D_IN_PROJ = D_TM_PROJ + 2 * D_LRU
D_FF = 3 * D_MODEL
FFN_CONV_W = 3
EPS = 1e-6
GN_EPS = 64e-5

kernel_name = 'hymba_rwkv7_rglru_convffn_step'


def _rms(x, g):
    xf = x.astype(jnp.float32)
    y = xf * lax.rsqrt(jnp.mean(xf * xf, -1, keepdims=True) + EPS)
    return (y * g.astype(jnp.float32)).astype(x.dtype)


def _causal_dwconv(x, buf, w, b):
    width = w.shape[0]
    seq = x.shape[1]
    xc = jnp.concatenate([buf.astype(x.dtype), x], axis=1)
    y = b + xc[:, 0:seq] * w[0]
    for j in range(1, width):
        y = y + xc[:, j:j + seq] * w[j]
    return y.astype(x.dtype), xc[:, seq:]


def _rwkv7(u, shift_buf, s0, mu, w0, w_up, a0, a_up, g_up, k_k, k_a, r_k, gn_g, gn_b):
    f32 = jnp.float32
    bsz, seq = u.shape[0], u.shape[1]
    prev = jnp.concatenate([shift_buf[:, None].astype(u.dtype), u[:, :-1]], axis=1)
    um = (u + (prev - u) * mu).astype(f32)
    cuts = [D_TM, 2 * D_TM, 3 * D_TM, 3 * D_TM + DECAY_RANK, 3 * D_TM + DECAY_RANK + AAA_RANK]
    r, k, v, xw, xa, xg = jnp.split(um, cuts, axis=-1)
    w_log = -jax.nn.softplus(-(w0 + jnp.tanh(xw) @ w_up)) - 0.5
    decay = jnp.exp(-jnp.exp(w_log))
    a = jax.nn.sigmoid(a0 + xa @ a_up)
    g = jax.nn.sigmoid(xg) @ g_up
    kk = k * k_k
    k = k * (1.0 + (a - 1.0) * k_a)
    heads = lambda t: t.astype(f32).reshape(bsz, seq, TM_HEADS, TM_HEAD)
    rh, kh, vh, dh, ah, kkh = map(heads, (r, k, v, decay, a, kk))
    kkh = kkh * lax.rsqrt(jnp.maximum(jnp.sum(kkh * kkh, -1, keepdims=True), 1e-24))

    def step(s, inp):
        r_t, d_t, k_t, v_t, kk_t, a_t = inp
        s_kk = jnp.einsum('bhvk,bhk->bhv', s, kk_t)
        s = (s * d_t[:, :, None, :]
             - s_kk[..., None] * (kk_t * a_t)[:, :, None, :]
             + v_t[..., None] * k_t[:, :, None, :])
        return s, jnp.einsum('bhvk,bhk->bhv', s, r_t)

    xs = tuple(jnp.moveaxis(t, 1, 0) for t in (rh, dh, kh, vh, kkh, ah))
    s_new, ys = lax.scan(step, s0.astype(f32), xs)
    y = jnp.moveaxis(ys, 0, 1)
    mean = jnp.mean(y, -1, keepdims=True)
    var = jnp.mean(jnp.square(y - mean), -1, keepdims=True)
    y = ((y - mean) * lax.rsqrt(var + GN_EPS)).reshape(bsz, seq, D_TM) * gn_g + gn_b
    bonus = (jnp.sum(rh * kh * r_k, -1, keepdims=True) * vh).reshape(bsz, seq, D_TM)
    out = (y + bonus) * g
    return out.astype(u.dtype), u[:, -1], s_new


def _rglru(xb, gate, conv_buf, h0, pos, conv_w, conv_b, wa, ba, wx, bx, lam, out_g):
    f32 = jnp.float32
    bsz, seq = xb.shape[0], xb.shape[1]
    xc, new_buf = _causal_dwconv(xb, conv_buf, conv_w, conv_b)
    xcf = xc.astype(f32)
    blocks = xcf.reshape(bsz, seq, LRU_BLOCKS, LRU_BLOCK)
    r_g = jax.nn.sigmoid(jnp.einsum('blhi,hij->blhj', blocks, wa).reshape(bsz, seq, D_LRU) + ba)
    i_g = jax.nn.sigmoid(jnp.einsum('blhi,hij->blhj', blocks, wx).reshape(bsz, seq, D_LRU) + bx)
    log_a = -LRU_C * r_g * jax.nn.softplus(-lam.astype(f32))
    a = jnp.exp(log_a)
    mult = jnp.where((pos == 0)[None, :, None], 1.0, jnp.sqrt(-jnp.expm1(2.0 * log_a)))
    b = xcf * i_g * mult
    b = b.at[:, 0].add(a[:, 0] * h0.astype(f32))

    def comb(l, r):
        return (l[0] * r[0], r[0] * l[1] + r[1])

    _, h = lax.associative_scan(comb, (a, b), axis=1)
    y = _rms(h * jax.nn.gelu(gate.astype(f32)), out_g)
    return y.astype(xb.dtype), new_buf, h[:, -1]


def _layer(x, pos, tm_shift, tm_wkv, lru_conv, lru_h, ffn_conv, w):
    (norm1_g, w_in, tm_mu, tm_w0, tm_w_up, tm_a0, tm_a_up, tm_g_up, tm_k_k, tm_k_a, tm_r_k,
     tm_gn_g, tm_gn_b, lru_conv_w, lru_conv_b, lru_wa, lru_ba, lru_wx, lru_bx, lru_lambda,
     lru_out_g, w_out, norm2_g, ffn_w_up, ffn_w_gate, ffn_conv_w, ffn_conv_b, ffn_w_down) = w
    xn = _rms(x, norm1_g)
    u = jnp.einsum('bld,de->ble', xn, w_in)
    u_tm, u_lx, u_lg = jnp.split(u, [D_TM_PROJ, D_TM_PROJ + D_LRU], axis=-1)
    y_tm, new_shift, new_wkv = _rwkv7(u_tm, tm_shift, tm_wkv, tm_mu, tm_w0, tm_w_up, tm_a0, tm_a_up,
                                      tm_g_up, tm_k_k, tm_k_a, tm_r_k, tm_gn_g, tm_gn_b)
    y_lru, new_lconv, new_h = _rglru(u_lx, u_lg, lru_conv, lru_h, pos, lru_conv_w, lru_conv_b,
                                     lru_wa, lru_ba, lru_wx, lru_bx, lru_lambda, lru_out_g)
    x = x + jnp.einsum('ble,ed->bld', jnp.concatenate([y_tm, y_lru], axis=-1), w_out)
    xn = _rms(x, norm2_g)
    up = jnp.einsum('bld,df->blf', xn, ffn_w_up)
    upc, new_fconv = _causal_dwconv(up, ffn_conv, ffn_conv_w, ffn_conv_b)
    hid = jax.nn.gelu(upc) * jnp.einsum('bld,df->blf', xn, ffn_w_gate)
    x = x + jnp.einsum('blf,fd->bld', hid, ffn_w_down)
    return x, (new_shift, new_wkv, new_lconv, new_h, new_fconv)


def setup_inputs(seed: int = 0) -> dict:
    key = jax.random.key(seed)
    ks = iter(jax.random.split(key, 48))
    nrm = lambda shape, scale: scale * jax.random.normal(next(ks), shape, jnp.float32)
    uni = lambda shape, lo, hi: jax.random.uniform(next(ks), shape, jnp.float32, lo, hi)
    a_init = uni((DEPTH, D_LRU), 0.9, 0.999) ** (1.0 / LRU_C)
    lam = jnp.log(a_init) - jnp.log1p(-a_init)
    return {
        'x_prompt': nrm((BATCH, SEQ, D_MODEL), 1.0),
        'x_sample': nrm((DEC_BATCH, DEC_SEQ, D_MODEL), 1.0),
        'state_tm_shift': nrm((DEPTH, DEC_BATCH, D_TM_PROJ), 1.0),
        'state_tm_wkv': nrm((DEPTH, DEC_BATCH, TM_HEADS, TM_HEAD, TM_HEAD), 0.1),
        'state_lru_conv': nrm((DEPTH, DEC_BATCH, LRU_CONV_W - 1, D_LRU), 1.0),
        'state_lru_h': nrm((DEPTH, DEC_BATCH, D_LRU), 0.5),
        'state_ffn_conv': nrm((DEPTH, DEC_BATCH, FFN_CONV_W - 1, D_FF), 1.0),
        'meta_tokens': nrm((N_META, D_MODEL), 1.0),
        'norm1_g': 1.0 + nrm((DEPTH, D_MODEL), 0.01),
        'w_in': nrm((DEPTH, D_MODEL, D_IN_PROJ), D_MODEL ** -0.5),
        'tm_mu': uni((DEPTH, D_TM_PROJ), 0.0, 1.0),
        'tm_w0': uni((DEPTH, D_TM), -6.0, 1.0),
        'tm_w_up': nrm((DEPTH, DECAY_RANK, D_TM), 0.1),
        'tm_a0': nrm((DEPTH, D_TM), 0.1),
        'tm_a_up': nrm((DEPTH, AAA_RANK, D_TM), 0.1),
        'tm_g_up': nrm((DEPTH, GATE_RANK, D_TM), GATE_RANK ** -0.5),
        'tm_k_k': 0.85 + nrm((DEPTH, D_TM), 0.02),
        'tm_k_a': 1.0 + nrm((DEPTH, D_TM), 0.02),
        'tm_r_k': nrm((DEPTH, TM_HEADS, TM_HEAD), 0.1),
        'tm_gn_g': 1.0 + nrm((DEPTH, D_TM), 0.01),
        'tm_gn_b': nrm((DEPTH, D_TM), 0.01),
        'lru_conv_w': nrm((DEPTH, LRU_CONV_W, D_LRU), LRU_CONV_W ** -0.5),
        'lru_conv_b': nrm((DEPTH, D_LRU), 0.01),
        'lru_wa': nrm((DEPTH, LRU_BLOCKS, LRU_BLOCK, LRU_BLOCK), LRU_BLOCK ** -0.5),
        'lru_ba': nrm((DEPTH, D_LRU), 0.1),
        'lru_wx': nrm((DEPTH, LRU_BLOCKS, LRU_BLOCK, LRU_BLOCK), LRU_BLOCK ** -0.5),
        'lru_bx': nrm((DEPTH, D_LRU), 0.1),
        'lru_lambda': lam,
        'lru_out_g': 1.0 + nrm((DEPTH, D_LRU), 0.01),
        'w_out': nrm((DEPTH, D_MIX, D_MODEL), D_MIX ** -0.5),
        'norm2_g': 1.0 + nrm((DEPTH, D_MODEL), 0.01),
        'ffn_w_up': nrm((DEPTH, D_MODEL, D_FF), D_MODEL ** -0.5),
        'ffn_w_gate': nrm((DEPTH, D_MODEL, D_FF), D_MODEL ** -0.5),
        'ffn_conv_w': nrm((DEPTH, FFN_CONV_W, D_FF), FFN_CONV_W ** -0.5),
        'ffn_conv_b': nrm((DEPTH, D_FF), 0.01),
        'ffn_w_down': nrm((DEPTH, D_FF, D_MODEL), D_FF ** -0.5),
        'norm_f_g': 1.0 + nrm((D_MODEL,), 0.01),
    }


def reference(x_prompt, x_sample, state_tm_shift, state_tm_wkv, state_lru_conv, state_lru_h,
              state_ffn_conv, meta_tokens, norm1_g, w_in, tm_mu, tm_w0, tm_w_up, tm_a0, tm_a_up,
              tm_g_up, tm_k_k, tm_k_a, tm_r_k, tm_gn_g, tm_gn_b, lru_conv_w, lru_conv_b, lru_wa,
              lru_ba, lru_wx, lru_bx, lru_lambda, lru_out_g, w_out, norm2_g, ffn_w_up, ffn_w_gate,
              ffn_conv_w, ffn_conv_b, ffn_w_down, norm_f_g):
    f32 = jnp.float32
    bsz = x_prompt.shape[0]
    xp = jnp.concatenate(
        [jnp.broadcast_to(meta_tokens[None].astype(x_prompt.dtype), (bsz, N_META, D_MODEL)), x_prompt],
        axis=1)
    xs = x_sample
    pos_p = jnp.arange(xp.shape[1])
    pos_s = PAST_LEN + jnp.arange(xs.shape[1])
    z_shift = jnp.zeros((bsz, D_TM_PROJ), xp.dtype)
    z_wkv = jnp.zeros((bsz, TM_HEADS, TM_HEAD, TM_HEAD), f32)
    z_lconv = jnp.zeros((bsz, LRU_CONV_W - 1, D_LRU), xp.dtype)
    z_h = jnp.zeros((bsz, D_LRU), f32)
    z_fconv = jnp.zeros((bsz, FFN_CONV_W - 1, D_FF), xp.dtype)
    p_states = [[] for _ in range(5)]
    s_states = [[] for _ in range(5)]
    for l in range(DEPTH):
        w = (norm1_g[l], w_in[l], tm_mu[l], tm_w0[l], tm_w_up[l], tm_a0[l], tm_a_up[l], tm_g_up[l],
             tm_k_k[l], tm_k_a[l], tm_r_k[l], tm_gn_g[l], tm_gn_b[l], lru_conv_w[l], lru_conv_b[l],
             lru_wa[l], lru_ba[l], lru_wx[l], lru_bx[l], lru_lambda[l], lru_out_g[l], w_out[l],
             norm2_g[l], ffn_w_up[l], ffn_w_gate[l], ffn_conv_w[l], ffn_conv_b[l], ffn_w_down[l])
        xp, ps = _layer(xp, pos_p, z_shift, z_wkv, z_lconv, z_h, z_fconv, w)
        xs, ss = _layer(xs, pos_s, state_tm_shift[l], state_tm_wkv[l], state_lru_conv[l],
                        state_lru_h[l], state_ffn_conv[l], w)
        for i in range(5):
            p_states[i].append(ps[i])
            s_states[i].append(ss[i])
    y_prompt = _rms(xp, norm_f_g)[:, N_META:]
    y_sample = _rms(xs, norm_f_g)
    p_tm_shift, p_tm_wkv, p_lru_conv, p_lru_h, p_ffn_conv = [jnp.stack(s) for s in p_states]
    s_tm_shift, s_tm_wkv, s_lru_conv, s_lru_h, s_ffn_conv = [jnp.stack(s) for s in s_states]
    return (y_prompt, y_sample, p_tm_shift, p_tm_wkv, p_lru_conv, p_lru_h, p_ffn_conv,
            s_tm_shift, s_tm_wkv, s_lru_conv, s_lru_h, s_ffn_conv)
```

```cpp
#include <hip/hip_runtime.h>
#include <hip/hip_cooperative_groups.h>
#include <cstdio>
#include <cstdint>
#include <cmath>
namespace pg8 {
#define PG8_LAS __attribute__((address_space(3)))
typedef unsigned short bf16_t;
typedef short bf16x8 __attribute__((ext_vector_type(8)));
typedef float f32x4 __attribute__((ext_vector_type(4)));
typedef unsigned u32x4 __attribute__((ext_vector_type(4)));
constexpr int BM = 256, BK = 64, HALF = 128, HTB = HALF * BK * 2  , STAGE_BYTES = 8 * HTB, NXCD = 8, WGM = 8;

__host__ __device__ __forceinline__ int lds_byte(int r, int c) { const int st = (r >> 4) * 2 + (c >> 5), rr = r & 15, cc = c & 31, ob = rr * 64 + cc * 2; return st * 1024 + (ob ^ (((ob >> 9) & 1) << 5)); }
__host__ __device__ __forceinline__ void stage_rc(int b, int& R, int& C) { const int st = b / 1024, sb = b % 1024, swz = sb ^ (((sb >> 9) & 1) << 5); R = (st >> 1) * 16 + swz / 64; C = (st & 1) * 32 + (swz % 64) / 2; }
__host__ __device__ __forceinline__ int perm32(int rho) { const int n = rho >> 4, i = rho & 15; return 8 * (i >> 2) + 4 * n + (i & 3); }

struct Unit { int pm, pn; };
struct Gemm { const bf16_t* A; const bf16_t* Bt; int M, N, K; };

struct StaticOrder {
    int nM, nN, nwg, G, c;
    __host__ __device__ void init(int M, int N, int G_, int c_) { nM = M / BM; nN = N / BM; nwg = nM * nN; G = G_; c = c_; }
    __host__ __device__ bool next(int i, Unit& u) const {
        const long L = (long)i * G + c; if (L >= nwg) return false;
        int wgid = (int)L; { const int q = nwg / NXCD, r = nwg % NXCD, xcd = wgid % NXCD, off = wgid / NXCD; wgid = (xcd < r ? xcd * (q + 1) : r * (q + 1) + (xcd - r) * q) + off; }
        const int nig = WGM * nN, gid = wgid / nig, fm = gid * WGM, gsz = (nM - fm) < WGM ? (nM - fm) : WGM;
        u.pm = fm + ((wgid % nig) % gsz); u.pn = (wgid % nig) / gsz; return true;
    }
    __device__ __forceinline__ void a_ready(const Unit&) const {}
    __device__ __forceinline__ void done(const Unit&) const {}
};

__device__ __forceinline__ unsigned cvt_pk_bf16(float lo, float hi) { unsigned r; asm volatile("v_cvt_pk_bf16_f32 %0, %1, %2" : "=v"(r) : "v"(lo), "v"(hi)); return r; }
typedef float f32x2 __attribute__((ext_vector_type(2)));
template <class Epi, class Sched, bool ALIGN_EPI = false, bool SP2 = false>
__device__ __forceinline__ void gemm_phase(PG8_LAS unsigned char* lds, const Gemm g, const Sched& S, const Epi& E) {
    const int tid = threadIdx.x, wid = __builtin_amdgcn_readfirstlane(tid >> 6), lane = tid & 63, wr = wid >> 2, wc = wid & 3, fr = lane & 15, fq = lane >> 4;
    const int K = g.K, nt = K / BK;
    unsigned voffA[2], voffB[2];
#pragma unroll
    for (int i = 0; i < 2; ++i) { int R, C; stage_rc(tid * 16 + i * 8192, R, C); const int Rb = Epi::PERM ? ((R & ~31) + perm32(R & 31)) : R;
        voffA[i] = (unsigned)(R * K + C) * 2u; voffB[i] = (unsigned)(Rb * K + C) * 2u; }
    const size_t kstep = (size_t)(BK * 2);
    const size_t hstep = (size_t)HALF * K * 2;
    const size_t tstep = 2 * hstep;
    const unsigned ldsw = (unsigned)wid * 1024u;
    const int aoff = lds_byte(wr * 64 + fr, fq * 8), boff = lds_byte(wc * 32 + fr, fq * 8);
#define PG8_SA(b, h) (((b) * 2 + (h)) * HTB)
#define PG8_SB(b, h) ((4 + (b) * 2 + (h)) * HTB)
#define PG8_STAGE(bufoff, gbase, voff) do { _Pragma("unroll") for (int _i = 0; _i < 2; ++_i) \
        __builtin_amdgcn_global_load_lds((const unsigned*)((const char*)(gbase) + (voff)[_i]), (PG8_LAS unsigned*)(lds + (bufoff) + ldsw + _i * 8192), 16, 0, 0); } while (0)
#define PG8_LDA(dst, b, h) do { _Pragma("unroll") for (int m = 0; m < 4; ++m) _Pragma("unroll") for (int k = 0; k < 2; ++k) dst[m][k] = *(const PG8_LAS bf16x8*)(lds + PG8_SA(b, h) + aoff + m * 2048 + k * 1024); } while (0)
#define PG8_LDB(dst, b, h) do { _Pragma("unroll") for (int n = 0; n < 2; ++n) _Pragma("unroll") for (int k = 0; k < 2; ++k) dst[n][k] = *(const PG8_LAS bf16x8*)(lds + PG8_SB(b, h) + boff + n * 2048 + k * 1024); } while (0)
#define PG8_MMA(ai, bj, At, Bt) do { __builtin_amdgcn_s_setprio(1); _Pragma("unroll") for (int m = 0; m < 4; ++m) _Pragma("unroll") for (int n = 0; n < 2; ++n) _Pragma("unroll") for (int k = 0; k < 2; ++k) \
        acc[ai][bj][m][n] = __builtin_amdgcn_mfma_f32_16x16x32_bf16(Bt[n][k], At[m][k], acc[ai][bj][m][n], 0, 0, 0); __builtin_amdgcn_s_setprio(0); } while (0)
#define PG8_WAIT_V(n) asm volatile("s_waitcnt vmcnt(" #n ")" ::: "memory")
#define PG8_WAIT_L(n) asm volatile("s_waitcnt lgkmcnt(" #n ")" ::: "memory")
#define PG8_BAR __builtin_amdgcn_s_barrier()
#define PG8_SCHED __builtin_amdgcn_sched_barrier(0)
    Unit cur, nxt; int ui = 0;
    if (!S.next(0, cur)) return;
    f32x4 acc[2][2][4][2];
#pragma unroll
    for (int a = 0; a < 2; ++a)
#pragma unroll
        for (int b = 0; b < 2; ++b)
#pragma unroll
            for (int m = 0; m < 4; ++m)
#pragma unroll
                for (int n = 0; n < 2; ++n) acc[a][b][m][n] = (f32x4){0.f, 0.f, 0.f, 0.f};
    bf16x8 At[4][2], B0[2][2], B1[2][2];
    const char* cA = (const char*)g.A + (size_t)cur.pm * tstep; const char* cB = (const char*)g.Bt + (size_t)cur.pn * tstep;
    S.a_ready(cur);
    if constexpr (SP2) {
        PG8_STAGE(PG8_SB(0, 0), cB, voffB); PG8_STAGE(PG8_SB(0, 1), cB + hstep, voffB); PG8_STAGE(PG8_SA(0, 0), cA, voffA); PG8_STAGE(PG8_SA(0, 1), cA + hstep, voffA);
        if (wr == 1) PG8_BAR;
        PG8_WAIT_V(2); PG8_BAR;
        PG8_STAGE(PG8_SB(1, 0), cB + kstep, voffB); PG8_STAGE(PG8_SA(1, 0), cA + kstep, voffA); PG8_STAGE(PG8_SB(1, 1), cB + hstep + kstep, voffB);
        PG8_WAIT_V(6); PG8_BAR;
    } else {
        PG8_STAGE(PG8_SB(0, 0), cB, voffB); PG8_STAGE(PG8_SA(0, 0), cA, voffA); PG8_STAGE(PG8_SB(0, 1), cB + hstep, voffB); PG8_STAGE(PG8_SA(0, 1), cA + hstep, voffA);
        if (wr == 1) PG8_BAR;
        PG8_WAIT_V(4); PG8_BAR;
        PG8_STAGE(PG8_SB(1, 0), cB + kstep, voffB); PG8_STAGE(PG8_SA(1, 0), cA + kstep, voffA); PG8_STAGE(PG8_SB(1, 1), cB + hstep + kstep, voffB);
        PG8_WAIT_V(6); PG8_BAR;
    }
    for (;;) {
        const bool has_next = S.next(ui + 1, nxt);
        const char* nA = has_next ? (const char*)g.A + (size_t)nxt.pm * tstep : cA; const char* nB = has_next ? (const char*)g.Bt + (size_t)nxt.pn * tstep : cB;
        for (int t = 0; t < nt; t += 2) {
            const bool last = (t == nt - 2);
            const char* a1 = cA + (size_t)(t + 1) * kstep;
            const char* a2 = last ? nA : cA + (size_t)(t + 2) * kstep; const char* b2 = last ? nB : cB + (size_t)(t + 2) * kstep;
            const char* a3 = a2 + kstep; const char* b3 = b2 + kstep;
            if (last && has_next) S.a_ready(nxt);
            if constexpr (SP2) {
            PG8_LDB(B0, 0, 0); PG8_LDB(B1, 0, 1); PG8_SCHED; PG8_LDA(At, 0, 0); PG8_STAGE(PG8_SA(1, 1), a1 + hstep, voffA);
            PG8_WAIT_V(8); PG8_WAIT_L(0); PG8_BAR; PG8_MMA(0, 0, At, B0); PG8_MMA(0, 1, At, B1); PG8_BAR; PG8_SCHED;
            PG8_LDA(At, 0, 1); PG8_STAGE(PG8_SB(0, 0), b2, voffB); PG8_STAGE(PG8_SB(0, 1), b2 + hstep, voffB); PG8_STAGE(PG8_SA(0, 0), a2, voffA);
            PG8_WAIT_V(8); PG8_WAIT_L(0); PG8_BAR; PG8_MMA(1, 0, At, B0); PG8_MMA(1, 1, At, B1); PG8_BAR; PG8_SCHED;
            PG8_LDB(B0, 1, 0); PG8_LDB(B1, 1, 1); PG8_SCHED; PG8_LDA(At, 1, 0); PG8_STAGE(PG8_SA(0, 1), a2 + hstep, voffA);
            PG8_WAIT_V(8); PG8_WAIT_L(0); PG8_BAR; PG8_MMA(0, 0, At, B0); PG8_MMA(0, 1, At, B1); PG8_BAR; PG8_SCHED;
            PG8_LDA(At, 1, 1); PG8_STAGE(PG8_SB(1, 0), b3, voffB); PG8_STAGE(PG8_SB(1, 1), b3 + hstep, voffB); PG8_STAGE(PG8_SA(1, 0), a3, voffA);
            PG8_WAIT_V(8); PG8_WAIT_L(0); PG8_BAR; PG8_MMA(1, 0, At, B0); PG8_MMA(1, 1, At, B1); PG8_BAR; PG8_SCHED;
            } else {
            PG8_LDB(B0, 0, 0); PG8_SCHED; PG8_LDA(At, 0, 0); PG8_STAGE(PG8_SA(1, 1), a1 + hstep, voffA);
            PG8_WAIT_L(8); PG8_BAR; PG8_WAIT_L(0); PG8_MMA(0, 0, At, B0); PG8_BAR; PG8_SCHED;
            PG8_LDB(B1, 0, 1); PG8_STAGE(PG8_SB(0, 0), b2, voffB);
            PG8_BAR; PG8_WAIT_L(0); PG8_MMA(0, 1, At, B1); PG8_BAR;
            PG8_LDA(At, 0, 1); PG8_STAGE(PG8_SA(0, 0), a2, voffA);
            PG8_BAR; PG8_WAIT_L(0); PG8_MMA(1, 0, At, B0); PG8_BAR; PG8_SCHED;
            PG8_STAGE(PG8_SB(0, 1), b2 + hstep, voffB);
            PG8_WAIT_V(6); PG8_BAR; PG8_MMA(1, 1, At, B1); PG8_BAR;
            PG8_LDB(B0, 1, 0); PG8_SCHED; PG8_LDA(At, 1, 0); PG8_STAGE(PG8_SA(0, 1), a2 + hstep, voffA);
            PG8_WAIT_L(8); PG8_BAR; PG8_WAIT_L(0); PG8_MMA(0, 0, At, B0); PG8_BAR; PG8_SCHED;
            PG8_LDB(B1, 1, 1); PG8_STAGE(PG8_SB(1, 0), b3, voffB);
            PG8_BAR; PG8_WAIT_L(0); PG8_MMA(0, 1, At, B1); PG8_BAR;
            PG8_LDA(At, 1, 1); PG8_STAGE(PG8_SA(1, 0), a3, voffA);
            PG8_BAR; PG8_WAIT_L(0); PG8_MMA(1, 0, At, B0); PG8_BAR; PG8_SCHED;
            PG8_STAGE(PG8_SB(1, 1), b3 + hstep, voffB);
            PG8_WAIT_V(6); PG8_BAR; PG8_MMA(1, 1, At, B1); PG8_BAR;
            }
        }
        if constexpr (ALIGN_EPI) { if (wr == 0) PG8_BAR; }
        if constexpr (!Epi::AFTER_DRAIN) { E(acc, cur, wr, wc, fr, fq); S.done(cur); }
        if (!has_next) break;
#pragma unroll
        for (int a = 0; a < 2; ++a)
#pragma unroll
            for (int b = 0; b < 2; ++b)
#pragma unroll
                for (int m = 0; m < 4; ++m)
#pragma unroll
                    for (int n = 0; n < 2; ++n) acc[a][b][m][n] = (f32x4){0.f, 0.f, 0.f, 0.f};
        cur = nxt; cA = nA; cB = nB; ++ui;
        if constexpr (ALIGN_EPI) { if (wr == 1) PG8_BAR; }
    }
    PG8_WAIT_V(0);
    if constexpr (!ALIGN_EPI) { if (wr == 0) PG8_BAR; }
    PG8_BAR;
    if constexpr (Epi::AFTER_DRAIN) { E.fused(acc, cur, wr, wc, fr, fq, lds, wid, lane); S.done(cur); }
#undef PG8_SA
#undef PG8_SB
#undef PG8_STAGE
#undef PG8_LDA
#undef PG8_LDB
#undef PG8_MMA
#undef PG8_WAIT_V
#undef PG8_WAIT_L
#undef PG8_BAR
#undef PG8_SCHED
}
}

#ifndef MK_ONE_LAUNCH
#define MK_ONE_LAUNCH 0
#endif
#define LAS __attribute__((address_space(3)))
typedef unsigned short bf16;
typedef float f32x4 __attribute__((ext_vector_type(4)));
typedef unsigned u32x4 __attribute__((ext_vector_type(4)));
typedef unsigned u32x2 __attribute__((ext_vector_type(2)));
constexpr int D = 1024, NB = 8, SEQ = 2048, NMETA = 16, TP = SEQ + NMETA, DB = 128, DS = 4;
constexpr int NH = 8, DTMP = 1792, DIN = 2816, DFF = 3072;
constexpr int R_SAMPLE = NB * SEQ, R_META = R_SAMPLE + DB * DS, R_END = R_META + NMETA, MP = 17152, M_MAIN = 16896;
constexpr float EPS = 1e-6f, GN_EPS = 64e-5f;
constexpr int NPH = 12;
constexpr int LDS_BYTES = 147456;
enum { I_XP = 0, I_XS, I_STS, I_SWKV, I_SLC, I_SLH, I_SFC, I_META, I_N1G, I_WIN, I_MU, I_W0, I_WUP, I_A0, I_AUP, I_GUP, I_KK, I_KA, I_RK,
       I_GNG, I_GNB, I_LCW, I_LCB, I_LWA, I_LBA, I_LWX, I_LBX, I_LAM, I_LOG, I_WOUT, I_N2G, I_FUP, I_FGATE, I_FCW, I_FCB, I_FDOWN, I_NFG, N_IN };
constexpr size_t O_YP = 0, O_YS = 16777216, O_PSHIFT = 17301504, O_PWKV = 17315840, O_PLC = 17577984, O_PLH = 17590272, O_PFC = 17594368,
                 O_SSHIFT = 17643520, O_SWKV = 17872896, O_SLC = 22067200, O_SLH = 22263808, O_SFC = 22329344, O_END = 23115776;
constexpr size_t MiB = 1u << 20;
constexpr size_t WS_CTL = 0, CTL_ZERO_BYTES = 65536;
constexpr size_t WS_SSQ1 = 1 * MiB, WS_SSQ2 = WS_SSQ1 + (size_t)MP * 16 * 4;
constexpr size_t WS_WUP = 4 * MiB, WS_WGATE = 10 * MiB, WS_WDOWN = 16 * MiB;
constexpr size_t WS_X1B = 22 * MiB, WS_UP = WS_X1B + (size_t)MP * D * 2, WS_HID = WS_UP + (size_t)MP * DFF * 2;
constexpr size_t WS_U = 22 * MiB;
constexpr size_t WS_XN = 115 * MiB, WS_WIN = WS_XN + (size_t)MP * D * 2;
constexpr size_t WS_AP = 190 * MiB, WS_XC = 199 * MiB, WS_BA = 216 * MiB, WS_BB = 217 * MiB, WS_GB = 220 * MiB;
constexpr size_t WS_REC = 115 * MiB, WS_LRU = 182 * MiB, WS_Y = 220 * MiB, WS_MIX = 115 * MiB;
static_assert(WS_SSQ2 + (size_t)MP * 16 * 4 <= WS_WUP, "ssq");
static_assert(WS_HID + (size_t)M_MAIN * DFF * 2 <= 256 * MiB, "hid");
static_assert(WS_U + (size_t)MP * DIN * 2 <= WS_XN, "u");
static_assert(WS_WIN + (size_t)DIN * D * 2 <= WS_LRU, "win");
static_assert(WS_AP + (size_t)MP * 256 * 2 <= WS_XC && WS_XC + (size_t)MP * 512 * 2 <= WS_BA, "ap/xc");
static_assert(WS_GB + (size_t)MP * 1024 * 2 <= 256 * MiB, "gb");
static_assert(WS_REC + (size_t)R_END * 4096 <= WS_LRU && WS_LRU + (size_t)R_END * 2048 <= WS_BA, "rec/lru");
static_assert(WS_Y + (size_t)R_END * 2048 <= 256 * MiB, "y");
constexpr size_t DO_GA = 0, DO_LTOT = (size_t)MP * 1536 * 2, DO_CARRY = DO_LTOT + 513 * 2 * 512 * 4, DO_BON = DO_CARRY + 8 * 64 * 512 * 4, DO_WOUT = O_SFC * 4;
static_assert(DO_BON + (size_t)R_END * 8 * 4 <= O_PSHIFT * 4, "d_out scratch");

struct Args { const float* in[N_IN]; float* out; unsigned char* ws; int ph_lo, ph_hi; };

__device__ __forceinline__ float bf2f(bf16 h) { return __uint_as_float(((unsigned)h) << 16); }
__device__ __forceinline__ unsigned f2bf(float f) { unsigned u = __float_as_uint(f); return (u + 0x7fffu + ((u >> 16) & 1u)) >> 16; }
__device__ __forceinline__ unsigned pk2(float lo, float hi) { return f2bf(lo) | (f2bf(hi) << 16); }
__device__ __forceinline__ float lo16(unsigned w) { return __uint_as_float(w << 16); }
__device__ __forceinline__ float hi16(unsigned w) { return __uint_as_float(w & 0xffff0000u); }
__device__ __forceinline__ float sigm(float x) { return 1.f / (1.f + __expf(-x)); }
__device__ __forceinline__ float softplus_(float z) { return fmaxf(z, 0.f) + log1pf(__expf(-fabsf(z))); }
__device__ __forceinline__ float gelu_tanh(float x) { const float u = 1.5957691216057308f * (x + 0.044715f * x * x * x); return x / (1.f + __expf(-u)); }
__device__ __forceinline__ float tanh_(float x) { const float e = __expf(2.f * x); return 1.f - 2.f / (e + 1.f); }
__device__ __forceinline__ float wave_sum(float v) {
#pragma unroll
    for (int o = 1; o < 64; o <<= 1) v += __shfl_xor(v, o);
    return v;
}
template <int CTRL> __device__ __forceinline__ float dpp_f(float x) { return __int_as_float(__builtin_amdgcn_update_dpp(0, __float_as_int(x), CTRL, 0xF, 0xF, true)); }
__device__ __forceinline__ float allsum16(float x) { x += dpp_f<0xB1>(x); x += dpp_f<0x4E>(x); x += dpp_f<0x141>(x); x += dpp_f<0x140>(x); return x; }

struct RowInfo { int kind, b, t; };
__device__ __forceinline__ RowInfo row_info(int row) {
    RowInfo r;
    if (row < R_SAMPLE) { r.kind = 0; r.b = row >> 11; r.t = (row & 2047) + NMETA; }
    else if (row < R_META) { r.kind = 1; r.b = (row - R_SAMPLE) >> 2; r.t = (row - R_SAMPLE) & 3; }
    else if (row < R_END) { r.kind = 2; r.b = 0; r.t = row - R_META; }
    else { r.kind = 3; r.b = 0; r.t = 0; }
    return r;
}
__device__ __forceinline__ int prompt_row(int b, int t) { return t < NMETA ? R_META + t : b * SEQ + t - NMETA; }
__device__ __forceinline__ int row_back(const RowInfo& ri, int row, int j) {
    const int tt = ri.t - j; if (tt < 0) return -1;
    if (ri.kind == 1) return row - j;
    return prompt_row(ri.b, tt);
}
__device__ __forceinline__ void unpack8(const u32x4 w, float (&f)[8]) {
    f[0] = lo16(w.x); f[1] = hi16(w.x); f[2] = lo16(w.y); f[3] = hi16(w.y); f[4] = lo16(w.z); f[5] = hi16(w.z); f[6] = lo16(w.w); f[7] = hi16(w.w);
}
__device__ __forceinline__ float row_rs(const float* ssq, int row) {
    const f32x4* p = (const f32x4*)(ssq + (size_t)row * 16); const f32x4 a = p[0], b = p[1], c = p[2], d = p[3];
    const float s = ((a.x + a.y) + (a.z + a.w)) + ((b.x + b.y) + (b.z + b.w)) + ((c.x + c.y) + (c.z + c.w)) + ((d.x + d.y) + (d.z + d.w));
    return rsqrtf(s * (1.f / 1024.f) + EPS);
}

#define EPI_ROW(ai, m) (u.pm * 256 + (ai) * 128 + wr * 64 + (m) * 16 + fr)
#define EPI_COL(bj) (u.pn * 256 + (bj) * 128 + wc * 32 + 8 * fq)
struct EpiX1 {
    static constexpr bool PERM = true, AFTER_DRAIN = false;
    const float* xp; const float* xs; const float* meta; float* x1; bf16* x1b; float* ssq;
    __device__ __forceinline__ void operator()(const f32x4 (&acc)[2][2][4][2], const pg8::Unit& u, int wr, int wc, int fr, int fq) const {
#pragma unroll
        for (int ai = 0; ai < 2; ++ai)
#pragma unroll
            for (int m = 0; m < 4; ++m) {
                const int row = EPI_ROW(ai, m);
                const float* res = row < R_SAMPLE ? xp + (size_t)row * D : row < R_META ? xs + (size_t)(row - R_SAMPLE) * D : row < R_END ? meta + (size_t)(row - R_META) * D : nullptr;
                float s = 0.f;
#pragma unroll
                for (int bj = 0; bj < 2; ++bj) {
                    const int col = EPI_COL(bj);
                    f32x4 v0 = acc[ai][bj][m][0], v1 = acc[ai][bj][m][1];
                    if (res) { v0 += *(const f32x4*)(res + col); v1 += *(const f32x4*)(res + col + 4); }
                    if (row < M_MAIN) { *(f32x4*)(x1 + (size_t)row * D + col) = v0; *(f32x4*)(x1 + (size_t)row * D + col + 4) = v1; }
                    u32x4 w; w.x = pk2(v0.x, v0.y); w.y = pk2(v0.z, v0.w); w.z = pk2(v1.x, v1.y); w.w = pk2(v1.z, v1.w);
                    *(u32x4*)(x1b + (size_t)row * D + col) = w;
                    s += (v0.x * v0.x + v0.y * v0.y) + (v0.z * v0.z + v0.w * v0.w) + (v1.x * v1.x + v1.y * v1.y) + (v1.z * v1.z + v1.w * v1.w);
                }
                s += __shfl_xor(s, 16); s += __shfl_xor(s, 32);
                if (fq == 0) ssq[(size_t)row * 16 + u.pn * 4 + wc] = s;
            }
    }
};
struct EpiUp {
    static constexpr bool PERM = true, AFTER_DRAIN = false;
    const float* ssq; bf16* up; float* pffn; float* sffn;
    __device__ __forceinline__ void operator()(const f32x4 (&acc)[2][2][4][2], const pg8::Unit& u, int wr, int wc, int fr, int fq) const {
#pragma unroll
        for (int ai = 0; ai < 2; ++ai)
#pragma unroll
            for (int m = 0; m < 4; ++m) {
                const int row = EPI_ROW(ai, m);
                const float rs = row_rs(ssq, row);
                const RowInfo ri = row_info(row);
                float* st = nullptr;
                if (ri.kind == 0 && ri.t >= TP - 2) st = pffn + ((size_t)ri.b * 2 + (ri.t - (TP - 2))) * DFF;
                else if (ri.kind == 1 && ri.t >= 2) st = sffn + ((size_t)ri.b * 2 + (ri.t - 2)) * DFF;
#pragma unroll
                for (int bj = 0; bj < 2; ++bj) {
                    const int col = EPI_COL(bj);
                    const f32x4 v0 = acc[ai][bj][m][0] * rs, v1 = acc[ai][bj][m][1] * rs;
                    u32x4 w; w.x = pk2(v0.x, v0.y); w.y = pk2(v0.z, v0.w); w.z = pk2(v1.x, v1.y); w.w = pk2(v1.z, v1.w);
                    *(u32x4*)(up + (size_t)row * DFF + col) = w;
                    if (st) { *(f32x4*)(st + col) = v0; *(f32x4*)(st + col + 4) = v1; }
                }
            }
    }
};
struct EpiGate {
    static constexpr bool PERM = true, AFTER_DRAIN = false;
    const float* ssq; const bf16* up; const float* stf; const float* cw; const float* cb; bf16* hid;
    __device__ __forceinline__ void operator()(const f32x4 (&acc)[2][2][4][2], const pg8::Unit& u, int wr, int wc, int fr, int fq) const {
#pragma unroll
        for (int ai = 0; ai < 2; ++ai)
#pragma unroll
            for (int m = 0; m < 4; ++m) {
                const int row = EPI_ROW(ai, m);
                const float rs = row_rs(ssq, row);
                const RowInfo ri = row_info(row);
                const int r1 = row_back(ri, row, 1), r2 = row_back(ri, row, 2);
#pragma unroll
                for (int bj = 0; bj < 2; ++bj) {
                    const int col = EPI_COL(bj);
                    float g[8], u0[8], p1[8], p2[8];
                    { const f32x4 v0 = acc[ai][bj][m][0] * rs, v1 = acc[ai][bj][m][1] * rs; g[0] = v0.x; g[1] = v0.y; g[2] = v0.z; g[3] = v0.w; g[4] = v1.x; g[5] = v1.y; g[6] = v1.z; g[7] = v1.w; }
                    unpack8(*(const u32x4*)(up + (size_t)row * DFF + col), u0);
                    if (r1 >= 0) unpack8(*(const u32x4*)(up + (size_t)r1 * DFF + col), p1);
                    else if (ri.kind == 1) { const float* s = stf + ((size_t)ri.b * 2 + (1 + ri.t)) * DFF + col; const f32x4 a = *(const f32x4*)s, b = *(const f32x4*)(s + 4);
                        p1[0] = a.x; p1[1] = a.y; p1[2] = a.z; p1[3] = a.w; p1[4] = b.x; p1[5] = b.y; p1[6] = b.z; p1[7] = b.w; }
                    else {
#pragma unroll
                        for (int i = 0; i < 8; ++i) p1[i] = 0.f; }
                    if (r2 >= 0) unpack8(*(const u32x4*)(up + (size_t)r2 * DFF + col), p2);
                    else if (ri.kind == 1) { const float* s = stf + ((size_t)ri.b * 2 + ri.t) * DFF + col; const f32x4 a = *(const f32x4*)s, b = *(const f32x4*)(s + 4);
                        p2[0] = a.x; p2[1] = a.y; p2[2] = a.z; p2[3] = a.w; p2[4] = b.x; p2[5] = b.y; p2[6] = b.z; p2[7] = b.w; }
                    else {
#pragma unroll
                        for (int i = 0; i < 8; ++i) p2[i] = 0.f; }
                    float o[8];
#pragma unroll
                    for (int h = 0; h < 2; ++h) {
                        const f32x4 w0 = *(const f32x4*)(cw + col + 4 * h), w1 = *(const f32x4*)(cw + DFF + col + 4 * h), w2 = *(const f32x4*)(cw + 2 * DFF + col + 4 * h), bb = *(const f32x4*)(cb + col + 4 * h);
#pragma unroll
                        for (int i = 0; i < 4; ++i) { const int e = 4 * h + i; const float c = bb[i] + w0[i] * p2[e] + w1[i] * p1[e] + w2[i] * u0[e]; o[e] = gelu_tanh(c) * g[e]; }
                    }
                    u32x4 w; w.x = pk2(o[0], o[1]); w.y = pk2(o[2], o[3]); w.z = pk2(o[4], o[5]); w.w = pk2(o[6], o[7]);
                    *(u32x4*)(hid + (size_t)row * DFF + col) = w;
                }
            }
    }
};
struct EpiDown {
    static constexpr bool PERM = true, AFTER_DRAIN = false;
    float* x; float* ssq;
    __device__ __forceinline__ void operator()(const f32x4 (&acc)[2][2][4][2], const pg8::Unit& u, int wr, int wc, int fr, int fq) const {
#pragma unroll
        for (int ai = 0; ai < 2; ++ai)
#pragma unroll
            for (int m = 0; m < 4; ++m) {
                const int row = EPI_ROW(ai, m);
                float s = 0.f;
#pragma unroll
                for (int bj = 0; bj < 2; ++bj) {
                    const int col = EPI_COL(bj);
                    float* p = x + (size_t)row * D + col;
                    const f32x4 v0 = acc[ai][bj][m][0] + *(const f32x4*)p, v1 = acc[ai][bj][m][1] + *(const f32x4*)(p + 4);
                    *(f32x4*)p = v0; *(f32x4*)(p + 4) = v1;
                    s += (v0.x * v0.x + v0.y * v0.y) + (v0.z * v0.z + v0.w * v0.w) + (v1.x * v1.x + v1.y * v1.y) + (v1.z * v1.z + v1.w * v1.w);
                }
                s += __shfl_xor(s, 16); s += __shfl_xor(s, 32);
                if (fq == 0) ssq[(size_t)row * 16 + u.pn * 4 + wc] = s;
            }
    }
};
struct EpiPlain {
    static constexpr bool PERM = true, AFTER_DRAIN = false;
    bf16* O; int ldc;
    __device__ __forceinline__ void operator()(const f32x4 (&acc)[2][2][4][2], const pg8::Unit& u, int wr, int wc, int fr, int fq) const {
#pragma unroll
        for (int ai = 0; ai < 2; ++ai)
#pragma unroll
            for (int m = 0; m < 4; ++m) {
                const int row = EPI_ROW(ai, m);
#pragma unroll
                for (int bj = 0; bj < 2; ++bj) {
                    const int col = EPI_COL(bj);
                    const f32x4 v0 = acc[ai][bj][m][0], v1 = acc[ai][bj][m][1];
                    u32x4 w; w.x = pk2(v0.x, v0.y); w.y = pk2(v0.z, v0.w); w.z = pk2(v1.x, v1.y); w.w = pk2(v1.z, v1.w);
                    *(u32x4*)(O + (size_t)row * ldc + col) = w;
                }
            }
    }
};

#define XB_TMO      128
#define XB_XCNT(j)  (256  + 64 * (j))
#define XB_XSUB(j)  (1280 + 64 * (j))
#define XB_XGEN(j)  (2304 + 64 * (j))
#define XB_TOP      3328
#define XB_TOPGEN   3392
#define XCD_BAR_WORDS 3456
#define XB_SPIN_CAP (1u << 22)
__device__ __forceinline__ unsigned xb_ld(unsigned* p)              { return __hip_atomic_load(p, __ATOMIC_RELAXED, __HIP_MEMORY_SCOPE_AGENT); }
__device__ __forceinline__ unsigned xb_add(unsigned* p, unsigned v) { return __hip_atomic_fetch_add(p, v, __ATOMIC_RELAXED, __HIP_MEMORY_SCOPE_AGENT); }
__device__ __forceinline__ unsigned xb_xcc_id() { return (unsigned)__builtin_amdgcn_s_getreg((3 << 11) | 20) & 0xFu; }
#define XB_SPIN(cond, bar) do { unsigned _sp = 0; while (cond) { __builtin_amdgcn_s_sleep(1); \
    if ((++_sp & 255u) == 0u) { if (xb_ld(&(bar)[XB_TMO])) break; if (_sp > XB_SPIN_CAP) { atomicAdd(&(bar)[XB_TMO], 1u); break; } } } } while (0)
struct XcdBarrier { unsigned* bar; unsigned x; volatile LAS unsigned* st; };
__device__ __forceinline__ XcdBarrier xcd_barrier_post(unsigned* bar, volatile LAS unsigned* st) {
    XcdBarrier b; b.bar = bar; b.x = xb_xcc_id(); b.st = st;
    if (threadIdx.x == 0) (void)xb_add(&bar[XB_XCNT(b.x)], 1u);
    return b;
}
__device__ __forceinline__ void xcd_barrier_complete(unsigned* bar, unsigned x, unsigned& nloc, unsigned& nx) {
    const unsigned G = gridDim.x * gridDim.y * gridDim.z;
    unsigned sum, cnt, mine, sp = 0u;
    for (;;) {
        sum = 0u; cnt = 0u; mine = 0u;
#pragma unroll
        for (unsigned j = 0; j < 16; ++j) { const unsigned c = xb_ld(&bar[XB_XCNT(j)]); sum += c; cnt += (c > 0u) ? 1u : 0u; mine = (j == x) ? c : mine; }
        if (sum == G) break;
        __builtin_amdgcn_s_sleep(1);
        if ((++sp & 255u) == 0u) { if (xb_ld(&bar[XB_TMO])) break; if (sp > XB_SPIN_CAP) { atomicAdd(&bar[XB_TMO], 1u); break; } }
    }
    nloc = mine > 0u ? mine : 1u; nx = cnt > 0u ? cnt : 1u;
}
__device__ __forceinline__ void xcd_barrier(const XcdBarrier& b) {
    asm volatile("s_waitcnt vmcnt(0)" ::: "memory");
    __syncthreads();
    if (threadIdx.x == 0) {
        unsigned* bar = b.bar;
        __builtin_amdgcn_s_waitcnt(0);
        unsigned nloc = b.st[0], nx = b.st[1];
        if (nloc == 0u) { xcd_barrier_complete(bar, b.x, nloc, nx); b.st[0] = nloc; b.st[1] = nx; }
        const unsigned old = xb_add(&bar[XB_XSUB(b.x)], 1u);
        const unsigned gen = old / nloc;
        if (old + 1u == (gen + 1u) * nloc) {
            __builtin_amdgcn_fence(__ATOMIC_RELEASE, "agent");
            asm volatile("s_waitcnt vmcnt(0)" ::: "memory");
            const unsigned og = xb_add(&bar[XB_TOP], 1u);
            const unsigned tg = og / nx;
            if (og + 1u == (tg + 1u) * nx) xb_add(&bar[XB_TOPGEN], 1u);
            else XB_SPIN(xb_ld(&bar[XB_TOPGEN]) == tg, bar);
            __builtin_amdgcn_fence(__ATOMIC_ACQUIRE, "agent");
            xb_add(&bar[XB_XGEN(b.x)], 1u);
            asm volatile("s_waitcnt vmcnt(0)" ::: "memory");
        } else {
            XB_SPIN(xb_ld(&bar[XB_XGEN(b.x)]) == gen, bar);
            __builtin_amdgcn_fence(__ATOMIC_ACQUIRE, "agent");
            asm volatile("s_waitcnt vmcnt(0)" ::: "memory");
        }
    }
    __syncthreads();
}

__device__ __forceinline__ void p0_transpose_item(const float* W, int K, int N, bf16* WT, const float* ksc, LAS float* scr, int item, int lane) {
    const int nblk = N / 32, kb = item / nblk, nb = item % nblk, k0 = 64 * kb, n0 = 32 * nb;
#pragma unroll 8
    for (int i = 0; i < 32; ++i) { const int kk = 2 * i + (lane >> 5); float v = W[(size_t)(k0 + kk) * N + n0 + (lane & 31)]; if (ksc) v *= ksc[k0 + kk]; scr[kk * 33 + (lane & 31)] = v; }
    asm volatile("s_waitcnt lgkmcnt(0)" ::: "memory");
    const int c = lane & 7;
#pragma unroll
    for (int j = 0; j < 4; ++j) { const int n = (lane >> 3) + 8 * j; const LAS float* s = scr + (8 * c) * 33 + n;
        u32x4 o; o.x = pk2(s[0 * 33], s[1 * 33]); o.y = pk2(s[2 * 33], s[3 * 33]); o.z = pk2(s[4 * 33], s[5 * 33]); o.w = pk2(s[6 * 33], s[7 * 33]);
        *(u32x4*)(WT + (size_t)(n0 + n) * K + k0 + 8 * c) = o; }
    asm volatile("s_waitcnt lgkmcnt(0)" ::: "memory");
}
__device__ __forceinline__ void phase_p0(const Args& A, LAS unsigned char* lds, int G) {
    const int tid = threadIdx.x, lane = tid & 63, wave = tid >> 6;
    LAS float* scr = (LAS float*)(lds + wave * 16384);
    const int gw = blockIdx.x * 8 + wave, NGW = G * 8;
    unsigned char* ws = A.ws;
    constexpr int I_IN = 16 * 88, I_OUT = 16 * 32, I_UPI = 16 * 96, I_DN = 48 * 32, NIT = I_IN + I_OUT + 2 * I_UPI + I_DN;
    for (int it = gw; it < NIT; it += NGW) {
        int r = it;
        if (r < I_IN) { p0_transpose_item(A.in[I_WIN], D, DIN, (bf16*)(ws + WS_WIN), nullptr, scr, r, lane); continue; } r -= I_IN;
        if (r < I_OUT) { p0_transpose_item(A.in[I_WOUT], D, D, (bf16*)((unsigned char*)A.out + DO_WOUT), nullptr, scr, r, lane); continue; } r -= I_OUT;
        if (r < I_UPI) { p0_transpose_item(A.in[I_FUP], D, DFF, (bf16*)(ws + WS_WUP), A.in[I_N2G], scr, r, lane); continue; } r -= I_UPI;
        if (r < I_UPI) { p0_transpose_item(A.in[I_FGATE], D, DFF, (bf16*)(ws + WS_WGATE), A.in[I_N2G], scr, r, lane); continue; } r -= I_UPI;
        p0_transpose_item(A.in[I_FDOWN], DFF, D, (bf16*)(ws + WS_WDOWN), nullptr, scr, r, lane);
    }
    const int gt = blockIdx.x * 512 + tid, NGT = G * 512;
    { bf16* BA = (bf16*)(ws + WS_BA); const float* wup = A.in[I_WUP]; const float* aup = A.in[I_AUP]; const float* gup = A.in[I_GUP];
      for (int e = gt; e < 1536 * 256; e += NGT) { const int n = e >> 8, k = e & 255; float v = 0.f;
          if (n < 512) { if (k < 64) v = wup[k * 512 + n]; }
          else if (n < 1024) { if (k >= 64 && k < 128) v = aup[(k - 64) * 512 + n - 512]; }
          else { if (k >= 128) v = gup[(k - 128) * 512 + n - 1024]; }
          BA[e] = (bf16)f2bf(v); } }
    { bf16* BB = (bf16*)(ws + WS_BB); const float* wa = A.in[I_LWA]; const float* wx = A.in[I_LWX];
      for (int e = gt; e < 1024 * 512; e += NGT) { const int n = e >> 9, k = e & 511, nn = n & 511, h = nn >> 6, j = nn & 63; float v = 0.f;
          if ((k >> 6) == h) { const float* Wm = n < 512 ? wa : wx; v = Wm[(h * 64 + (k & 63)) * 64 + j]; }
          BB[e] = (bf16)f2bf(v); } }
    bf16* XN = (bf16*)(ws + WS_XN); const float* g1 = A.in[I_N1G];
    for (int row = gw; row < MP; row += NGW) {
        const float* src = row < R_SAMPLE ? A.in[I_XP] + (size_t)row * D : row < R_META ? A.in[I_XS] + (size_t)(row - R_SAMPLE) * D : row < R_END ? A.in[I_META] + (size_t)(row - R_META) * D : nullptr;
        u32x2* o = (u32x2*)(XN + (size_t)row * D);
        if (!src) {
#pragma unroll
            for (int j = 0; j < 4; ++j) o[lane + 64 * j] = (u32x2){0u, 0u};
            continue; }
        f32x4 v[4]; float s = 0.f;
#pragma unroll
        for (int j = 0; j < 4; ++j) { v[j] = ((const f32x4*)src)[lane + 64 * j]; s += (v[j].x * v[j].x + v[j].y * v[j].y) + (v[j].z * v[j].z + v[j].w * v[j].w); }
        const float rs = rsqrtf(wave_sum(s) * (1.f / D) + EPS);
#pragma unroll
        for (int j = 0; j < 4; ++j) { const f32x4 g = ((const f32x4*)g1)[lane + 64 * j];
            o[lane + 64 * j] = (u32x2){pk2(v[j].x * rs * g.x, v[j].y * rs * g.y), pk2(v[j].z * rs * g.z, v[j].w * rs * g.w)}; }
    }
}

__device__ __forceinline__ void phase_e1(const Args& A, int G) {
    const int tid = threadIdx.x, lane = tid & 63, wave = tid >> 6;
    const int gw = blockIdx.x * 8 + wave, NGW = G * 8;
    unsigned char* ws = A.ws;
    const bf16* U = (const bf16*)(ws + WS_U); bf16* AP = (bf16*)(ws + WS_AP); bf16* XC = (bf16*)(ws + WS_XC);
    const float* mu = A.in[I_MU]; const float* sts = A.in[I_STS]; const float* slc = A.in[I_SLC]; const float* lcw = A.in[I_LCW]; const float* lcb = A.in[I_LCB];
    for (int row = gw; row < MP; row += NGW) {
        bf16* ap = AP + (size_t)row * 256; bf16* xc = XC + (size_t)row * 512;
        const RowInfo ri = row_info(row);
        if (ri.kind == 3) { ((u32x2*)ap)[lane] = (u32x2){0u, 0u}; ((u32x4*)xc)[lane] = (u32x4){0u, 0u, 0u, 0u}; continue; }
        const bf16* urow = U + (size_t)row * DIN;
        const int r1 = row_back(ri, row, 1);
        {
            const int c0 = 1536 + 4 * lane;
            const u32x2 uw = *(const u32x2*)(urow + c0);
            float u[4] = {lo16(uw.x), hi16(uw.x), lo16(uw.y), hi16(uw.y)}, p[4];
            if (r1 >= 0) { const u32x2 pw = *(const u32x2*)(U + (size_t)r1 * DIN + c0); p[0] = lo16(pw.x); p[1] = hi16(pw.x); p[2] = lo16(pw.y); p[3] = hi16(pw.y); }
            else if (ri.kind == 1) { const f32x4 pv = *(const f32x4*)(sts + (size_t)ri.b * DTMP + c0); p[0] = pv.x; p[1] = pv.y; p[2] = pv.z; p[3] = pv.w; }
            else { p[0] = p[1] = p[2] = p[3] = 0.f; }
            const f32x4 m4 = *(const f32x4*)(mu + c0);
            float o[4];
#pragma unroll
            for (int i = 0; i < 4; ++i) { const float um = u[i] + (p[i] - u[i]) * m4[i]; o[i] = lane < 16 ? tanh_(um) : lane < 32 ? um : sigm(um); }
            ((u32x2*)ap)[lane] = (u32x2){pk2(o[0], o[1]), pk2(o[2], o[3])};
        }
        {
            const int c = 8 * lane;
            float acc[8], cur[8];
            { const f32x4 b0 = *(const f32x4*)(lcb + c), b1 = *(const f32x4*)(lcb + c + 4); acc[0] = b0.x; acc[1] = b0.y; acc[2] = b0.z; acc[3] = b0.w; acc[4] = b1.x; acc[5] = b1.y; acc[6] = b1.z; acc[7] = b1.w; }
#pragma unroll
            for (int j = 0; j < 4; ++j) {
                float val[8];
                const int rj = (j == 3) ? row : row_back(ri, row, 3 - j);
                if (rj >= 0) unpack8(*(const u32x4*)(U + (size_t)rj * DIN + DTMP + c), val);
                else if (ri.kind == 1) { const float* s = slc + ((size_t)ri.b * 3 + (ri.t + j)) * 512 + c; const f32x4 a = *(const f32x4*)s, b = *(const f32x4*)(s + 4);
                    val[0] = a.x; val[1] = a.y; val[2] = a.z; val[3] = a.w; val[4] = b.x; val[5] = b.y; val[6] = b.z; val[7] = b.w; }
                else {
#pragma unroll
                    for (int i = 0; i < 8; ++i) val[i] = 0.f; }
                const f32x4 w0 = *(const f32x4*)(lcw + j * 512 + c), w1 = *(const f32x4*)(lcw + j * 512 + c + 4);
#pragma unroll
                for (int i = 0; i < 4; ++i) { acc[i] += w0[i] * val[i]; acc[4 + i] += w1[i] * val[4 + i]; }
                if (j == 3) {
#pragma unroll
                    for (int i = 0; i < 8; ++i) cur[i] = val[i]; }
            }
            u32x4 w; w.x = pk2(acc[0], acc[1]); w.y = pk2(acc[2], acc[3]); w.z = pk2(acc[4], acc[5]); w.w = pk2(acc[6], acc[7]);
            ((u32x4*)xc)[lane] = w;
            float* lco = nullptr;
            if (ri.kind == 0 && ri.t >= TP - 3) lco = A.out + O_PLC + ((size_t)ri.b * 3 + (ri.t - (TP - 3))) * 512 + c;
            else if (ri.kind == 1 && ri.t >= 1) lco = A.out + O_SLC + ((size_t)ri.b * 3 + (ri.t - 1)) * 512 + c;
            if (lco) { *(f32x4*)lco = (f32x4){cur[0], cur[1], cur[2], cur[3]}; *(f32x4*)(lco + 4) = (f32x4){cur[4], cur[5], cur[6], cur[7]}; }
        }
        float* sho = nullptr;
        if (ri.kind == 0 && ri.t == TP - 1) sho = A.out + O_PSHIFT + (size_t)ri.b * DTMP;
        else if (ri.kind == 1 && ri.t == DS - 1) sho = A.out + O_SSHIFT + (size_t)ri.b * DTMP;
        if (sho) for (int i = lane; i < DTMP; i += 64) sho[i] = bf2f(urow[i]);
    }
}

__device__ __forceinline__ void phase_e2(const Args& A, int G) {
    const int tid = threadIdx.x, lane = tid & 63, wave = tid >> 6;
    unsigned char* ws = A.ws;
    const bf16* U = (const bf16*)(ws + WS_U); const bf16* GB = (const bf16*)(ws + WS_GB); const bf16* GA = (const bf16*)((unsigned char*)A.out + DO_GA);
    bf16* REC = (bf16*)(ws + WS_REC); bf16* LRU = (bf16*)(ws + WS_LRU);
    float* LTOT = (float*)((unsigned char*)A.out + DO_LTOT); float* BON = (float*)((unsigned char*)A.out + DO_BON);
    const float* mu = A.in[I_MU]; const float* sts = A.in[I_STS]; const float* slc = A.in[I_SLC]; const float* slh = A.in[I_SLH];
    for (int unit = blockIdx.x; unit < 529; unit += G) {
        int row0, ntok, kind;
        if (unit < 512) { row0 = unit * 32; ntok = 32; kind = 0; } else if (unit == 512) { row0 = R_META; ntok = 16; kind = 2; } else { row0 = R_SAMPLE + (unit - 513) * 32; ntok = 32; kind = 1; }
        {
            const int c = tid;
            const float sp = softplus_(-A.in[I_LAM][c]);
            const float cw0 = A.in[I_LCW][c], cw1 = A.in[I_LCW][512 + c], cw2 = A.in[I_LCW][1024 + c], cw3 = A.in[I_LCW][1536 + c], cbias = A.in[I_LCB][c];
            const float ba_ = A.in[I_LBA][c], bx_ = A.in[I_LBX][c];
            float l1 = 0.f, l2 = 0.f, l3 = 0.f, H = 0.f, P = 1.f;
            if (kind == 0) { const RowInfo ri0 = row_info(row0);
                l1 = bf2f(U[(size_t)row_back(ri0, row0, 1) * DIN + DTMP + c]); l2 = bf2f(U[(size_t)row_back(ri0, row0, 2) * DIN + DTMP + c]); l3 = bf2f(U[(size_t)row_back(ri0, row0, 3) * DIN + DTMP + c]); }
            for (int j = 0; j < ntok; ++j) {
                const int row = row0 + j; const int b = (row - R_SAMPLE) >> 2;
                if (kind == 1 && (j & 3) == 0) { l3 = slc[((size_t)b * 3 + 0) * 512 + c]; l2 = slc[((size_t)b * 3 + 1) * 512 + c]; l1 = slc[((size_t)b * 3 + 2) * 512 + c]; H = slh[(size_t)b * 512 + c]; }
                const float l0 = bf2f(U[(size_t)row * DIN + DTMP + c]);
                const float xc = cbias + cw0 * l3 + cw1 * l2 + cw2 * l1 + cw3 * l0;
                l3 = l2; l2 = l1; l1 = l0;
                const float ra = bf2f(GB[(size_t)row * 1024 + c]) + ba_, ix = bf2f(GB[(size_t)row * 1024 + 512 + c]) + bx_;
                const float rg = sigm(ra), ig = sigm(ix);
                const float la = -8.f * rg * sp, a = __expf(la);
                float mult = sqrtf(-expm1f(2.f * la)); if (kind == 2 && j == 0) mult = 1.f;
                H = a * H + xc * ig * mult; P = P * a;
                LRU[(size_t)row * 1024 + c] = (bf16)f2bf(H); LRU[(size_t)row * 1024 + 512 + c] = (bf16)f2bf(kind == 1 ? 0.f : P);
                if (kind == 1 && (j & 3) == 3) A.out[O_SLH + (size_t)b * 512 + c] = H;
            }
            if (kind != 1) { LTOT[((size_t)unit * 2 + 0) * 512 + c] = P; LTOT[((size_t)unit * 2 + 1) * 512 + c] = H; }
        }
        for (int task = wave; task < ntok * 8; task += 8) {
            const int j = task >> 3, h = task & 7, row = row0 + j, c = h * 64 + lane;
            const RowInfo ri = row_info(row); const int r1 = row_back(ri, row, 1);
            const bf16* ur = U + (size_t)row * DIN;
            const float u_r = bf2f(ur[c]), u_k = bf2f(ur[512 + c]);
            float p_r, p_k;
            if (r1 >= 0) { p_r = bf2f(U[(size_t)r1 * DIN + c]); p_k = bf2f(U[(size_t)r1 * DIN + 512 + c]); }
            else if (ri.kind == 1) { p_r = sts[(size_t)ri.b * DTMP + c]; p_k = sts[(size_t)ri.b * DTMP + 512 + c]; }
            else { p_r = 0.f; p_k = 0.f; }
            const float um_r = u_r + (p_r - u_r) * mu[c], um_k = u_k + (p_k - u_k) * mu[512 + c];
            const float w_pre = bf2f(GA[(size_t)row * 1536 + c]) + A.in[I_W0][c], a_pre = bf2f(GA[(size_t)row * 1536 + 512 + c]) + A.in[I_A0][c];
            const float w_log = -softplus_(-w_pre) - 0.5f, e = __expf(w_log), x = -expm1f(-e);
            const float a = sigm(a_pre);
            const float kk = um_k * A.in[I_KK][c], ss = wave_sum(kk * kk), kkn = kk * rsqrtf(fmaxf(ss, 1e-24f));
            const float kp = um_k * (1.f + (a - 1.f) * A.in[I_KA][c]);
            const float bon = wave_sum(um_r * kp * A.in[I_RK][c]);
            bf16* rec = REC + ((size_t)row * 8 + h) * 256;
            rec[lane] = (bf16)f2bf(a); rec[64 + lane] = (bf16)f2bf(x); rec[128 + lane] = (bf16)f2bf(kkn); rec[192 + lane] = (bf16)f2bf(kp);
            if (lane == 0) BON[(size_t)row * 8 + h] = bon;
        }
    }
}

struct Raw { bf16 a, x, kk, kp, ur, uv, pr, pv; };
__device__ __forceinline__ void m2_load(Raw (&raw)[4], const bf16* REC, const bf16* U, int b, int h, int t0, int ns, int k, int sub) {
#pragma unroll
    for (int i = 0; i < 4; ++i) {
        const int s = sub + 8 * i;
        raw[i].a = 0; raw[i].x = 0; raw[i].kk = 0; raw[i].kp = 0; raw[i].ur = 0; raw[i].uv = 0; raw[i].pr = 0; raw[i].pv = 0;
        if (s < ns) {
            const int t = t0 + s, row = prompt_row(b, t);
            const bf16* rec = REC + ((size_t)row * 8 + h) * 256;
            raw[i].a = rec[k]; raw[i].x = rec[64 + k]; raw[i].kk = rec[128 + k]; raw[i].kp = rec[192 + k];
            const bf16* ur = U + (size_t)row * DIN + h * 64 + k; raw[i].ur = ur[0]; raw[i].uv = ur[1024];
            if (t > 0) { const bf16* pr = U + (size_t)prompt_row(b, t - 1) * DIN + h * 64 + k; raw[i].pr = pr[0]; raw[i].pv = pr[1024]; }
        }
    }
}
__device__ __forceinline__ void m2_store(const Raw (&raw)[4], LAS float* buf, float mu_r, float mu_v, int k, int sub, int ns) {
#pragma unroll
    for (int i = 0; i < 4; ++i) {
        const int s = sub + 8 * i;
        if (s < ns) {
            LAS float* p = buf + s * 384;
            const float a = bf2f(raw[i].a), kk = bf2f(raw[i].kk), ur = bf2f(raw[i].ur), uv = bf2f(raw[i].uv);
            p[k] = kk; p[64 + k] = bf2f(raw[i].x); p[128 + k] = kk * a; p[192 + k] = bf2f(raw[i].kp);
            p[256 + k] = ur + (bf2f(raw[i].pr) - ur) * mu_r; p[320 + k] = uv + (bf2f(raw[i].pv) - uv) * mu_v;
        }
    }
}
__device__ __forceinline__ void phase_m2(const Args& A, LAS unsigned char* lds, int G) {
    const int tid = threadIdx.x, lane = tid & 63, wave = tid >> 6;
    unsigned char* ws = A.ws;
    const bf16* U = (const bf16*)(ws + WS_U); const bf16* REC = (const bf16*)(ws + WS_REC); float* Y = (float*)(ws + WS_Y);
    const float* LTOT = (const float*)((unsigned char*)A.out + DO_LTOT); float* CARRY = (float*)((unsigned char*)A.out + DO_CARRY);
    const float* mu = A.in[I_MU];
    for (int b = blockIdx.x; b < NB; b += G) {
        const int c = tid; float carry = LTOT[((size_t)512 * 2 + 1) * 512 + c];
#pragma unroll 8
        for (int i = 0; i < 64; ++i) { CARRY[((size_t)b * 64 + i) * 512 + c] = carry; const int un = b * 64 + i; carry = LTOT[((size_t)un * 2 + 0) * 512 + c] * carry + LTOT[((size_t)un * 2 + 1) * 512 + c]; }
        A.out[O_PLH + (size_t)b * 512 + c] = carry;
    }
    const int ks = lane & 15, rl = lane >> 4;
    for (int item = blockIdx.x; item < 256; item += G) {
        const int bh = item >> 2, q = item & 3, b = bh >> 3, h = bh & 7;
        const int k = tid & 63, sub = tid >> 6;
        const float mu_r = mu[h * 64 + k], mu_v = mu[1024 + h * 64 + k];
        const int vrow = 16 * q + 4 * (wave & 3) + rl;
        f32x4 S = (f32x4){0.f, 0.f, 0.f, 0.f};
        Raw raw[4];
        LAS float* buf0 = (LAS float*)lds; LAS float* buf1 = (LAS float*)(lds + 49152);
        __syncthreads();
        m2_load(raw, REC, U, b, h, 0, 16, k, sub);
        m2_store(raw, buf0, mu_r, mu_v, k, sub, 16);
        __syncthreads();
        for (int blk = 0; blk < 65; ++blk) {
            const int t0 = blk == 0 ? 0 : 16 + 32 * (blk - 1), ns = blk == 0 ? 16 : 32;
            const int t0n = 16 + 32 * blk;
            if (blk + 1 < 65) m2_load(raw, REC, U, b, h, t0n, 32, k, sub);
            if (wave < 4) {
                const LAS float* buf = (blk & 1) ? buf1 : buf0;
                for (int s = 0; s < ns; ++s) {
                    const LAS float* p = buf + s * 384;
                    const f32x4 kk4 = *(const LAS f32x4*)(p + 4 * ks), x4 = *(const LAS f32x4*)(p + 64 + 4 * ks), ka4 = *(const LAS f32x4*)(p + 128 + 4 * ks),
                                kp4 = *(const LAS f32x4*)(p + 192 + 4 * ks), r4 = *(const LAS f32x4*)(p + 256 + 4 * ks);
                    const float vv = p[320 + vrow];
                    float d = (S.x * kk4.x + S.y * kk4.y) + (S.z * kk4.z + S.w * kk4.w); d = allsum16(d);
                    S = S - S * x4 - d * ka4 + vv * kp4;
                    float y = (S.x * r4.x + S.y * r4.y) + (S.z * r4.z + S.w * r4.w); y = allsum16(y);
                    if (ks == 0) Y[(size_t)prompt_row(b, t0 + s) * 512 + h * 64 + vrow] = y;
                }
            }
            if (blk + 1 < 65) m2_store(raw, (blk & 1) ? buf0 : buf1, mu_r, mu_v, k, sub, 32);
            __syncthreads();
        }
        if (wave < 4) *(f32x4*)(A.out + O_PWKV + ((size_t)(b * 8 + h) * 64 + vrow) * 64 + 4 * ks) = S;
    }
    const float* swkv = A.in[I_SWKV]; const float* sts = A.in[I_STS];
    for (int task = blockIdx.x * 8 + wave; task < DB * NH * 16; task += G * 8) {
        const int bh = task >> 4, rg = task & 15, b = bh >> 3, h = bh & 7, v = 4 * rg + rl;
        f32x4 S = *(const f32x4*)(swkv + ((size_t)bh * 64 + v) * 64 + 4 * ks);
        const f32x4 mr4 = *(const f32x4*)(mu + h * 64 + 4 * ks); const float mv = mu[1024 + h * 64 + v];
#pragma unroll
        for (int t = 0; t < DS; ++t) {
            const int row = R_SAMPLE + 4 * b + t;
            const bf16* rec = REC + ((size_t)row * 8 + h) * 256 + 4 * ks;
            const u32x2 wa = *(const u32x2*)rec, wx = *(const u32x2*)(rec + 64), wk = *(const u32x2*)(rec + 128), wp = *(const u32x2*)(rec + 192);
            const f32x4 a4 = (f32x4){lo16(wa.x), hi16(wa.x), lo16(wa.y), hi16(wa.y)}, x4 = (f32x4){lo16(wx.x), hi16(wx.x), lo16(wx.y), hi16(wx.y)},
                        kk4 = (f32x4){lo16(wk.x), hi16(wk.x), lo16(wk.y), hi16(wk.y)}, kp4 = (f32x4){lo16(wp.x), hi16(wp.x), lo16(wp.y), hi16(wp.y)};
            const u32x2 wr_ = *(const u32x2*)(U + (size_t)row * DIN + h * 64 + 4 * ks);
            const f32x4 ur4 = (f32x4){lo16(wr_.x), hi16(wr_.x), lo16(wr_.y), hi16(wr_.y)};
            const float uv = bf2f(U[(size_t)row * DIN + 1024 + h * 64 + v]);
            f32x4 pr4; float pv;
            if (t > 0) { const u32x2 w = *(const u32x2*)(U + (size_t)(row - 1) * DIN + h * 64 + 4 * ks); pr4 = (f32x4){lo16(w.x), hi16(w.x), lo16(w.y), hi16(w.y)}; pv = bf2f(U[(size_t)(row - 1) * DIN + 1024 + h * 64 + v]); }
            else { pr4 = *(const f32x4*)(sts + (size_t)b * DTMP + h * 64 + 4 * ks); pv = sts[(size_t)b * DTMP + 1024 + h * 64 + v]; }
            const f32x4 r4 = ur4 + (pr4 - ur4) * mr4; const float vv = uv + (pv - uv) * mv;
            const f32x4 ka4 = kk4 * a4;
            float d = (S.x * kk4.x + S.y * kk4.y) + (S.z * kk4.z + S.w * kk4.w); d = allsum16(d);
            S = S - S * x4 - d * ka4 + vv * kp4;
            float y = (S.x * r4.x + S.y * r4.y) + (S.z * r4.z + S.w * r4.w); y = allsum16(y);
            if (ks == 0) Y[(size_t)row * 512 + h * 64 + v] = y;
        }
        *(f32x4*)(A.out + O_SWKV + ((size_t)bh * 64 + v) * 64 + 4 * ks) = S;
    }
}

__device__ __forceinline__ void phase_m3(const Args& A, int G) {
    const int tid = threadIdx.x, lane = tid & 63, wave = tid >> 6;
    const int gw = blockIdx.x * 8 + wave, NGW = G * 8;
    unsigned char* ws = A.ws;
    const bf16* U = (const bf16*)(ws + WS_U); const bf16* GA = (const bf16*)((unsigned char*)A.out + DO_GA); const bf16* LRU = (const bf16*)(ws + WS_LRU);
    const float* Y = (const float*)(ws + WS_Y); const float* CARRY = (const float*)((unsigned char*)A.out + DO_CARRY); const float* BON = (const float*)((unsigned char*)A.out + DO_BON);
    bf16* MIX = (bf16*)(ws + WS_MIX);
    const float* mu = A.in[I_MU]; const float* sts = A.in[I_STS];
    for (int row = gw; row < MP; row += NGW) {
        bf16* mo = MIX + (size_t)row * D;
        const RowInfo ri = row_info(row);
        if (ri.kind == 3) { ((u32x4*)mo)[lane] = (u32x4){0u, 0u, 0u, 0u}; ((u32x4*)mo)[64 + lane] = (u32x4){0u, 0u, 0u, 0u}; continue; }
        const int r1 = row_back(ri, row, 1);
#pragma unroll 2
        for (int h = 0; h < NH; ++h) {
            const int c = h * 64 + lane;
            const float y = Y[(size_t)row * 512 + c];
            const float mean = wave_sum(y) * (1.f / 64.f), dv = y - mean, var = wave_sum(dv * dv) * (1.f / 64.f);
            const float yn = dv * rsqrtf(var + GN_EPS) * A.in[I_GNG][c] + A.in[I_GNB][c];
            const float uv = bf2f(U[(size_t)row * DIN + 1024 + c]);
            float pv; if (r1 >= 0) pv = bf2f(U[(size_t)r1 * DIN + 1024 + c]); else if (ri.kind == 1) pv = sts[(size_t)ri.b * DTMP + 1024 + c]; else pv = 0.f;
            const float vv = uv + (pv - uv) * mu[1024 + c];
            const float g = bf2f(GA[(size_t)row * 1536 + 1024 + c]);
            mo[c] = (bf16)f2bf((yn + BON[(size_t)row * 8 + h] * vv) * g);
        }
        {
            const int c = 8 * lane;
            float hv[8], pp[8], gt[8];
            unpack8(*(const u32x4*)(LRU + (size_t)row * 1024 + c), hv); unpack8(*(const u32x4*)(LRU + (size_t)row * 1024 + 512 + c), pp);
            unpack8(*(const u32x4*)(U + (size_t)row * DIN + DTMP + 512 + c), gt);
            if (ri.kind == 0) { const float* cr = CARRY + ((size_t)ri.b * 64 + ((row & 2047) >> 5)) * 512 + c; const f32x4 c0 = *(const f32x4*)cr, c1 = *(const f32x4*)(cr + 4);
#pragma unroll
                for (int i = 0; i < 4; ++i) { hv[i] += pp[i] * c0[i]; hv[4 + i] += pp[4 + i] * c1[i]; } }
            float z[8], s = 0.f;
#pragma unroll
            for (int i = 0; i < 8; ++i) { z[i] = hv[i] * gelu_tanh(gt[i]); s += z[i] * z[i]; }
            const float rs = rsqrtf(wave_sum(s) * (1.f / 512.f) + EPS);
            const f32x4 g0 = *(const f32x4*)(A.in[I_LOG] + c), g1 = *(const f32x4*)(A.in[I_LOG] + c + 4);
            u32x4 w; w.x = pk2(z[0] * rs * g0.x, z[1] * rs * g0.y); w.y = pk2(z[2] * rs * g0.z, z[3] * rs * g0.w); w.z = pk2(z[4] * rs * g1.x, z[5] * rs * g1.y); w.w = pk2(z[6] * rs * g1.z, z[7] * rs * g1.w);
            *(u32x4*)(mo + 512 + c) = w;
        }
    }
}

__device__ __forceinline__ void phase_final(const Args& A, int G) {
    const int tid = threadIdx.x, lane = tid & 63, wave = tid >> 6;
    const int gw = blockIdx.x * 8 + wave, NGW = G * 8;
    const float* ssq = (const float*)(A.ws + WS_SSQ2); const float* gf = A.in[I_NFG];
    for (int row = gw; row < M_MAIN; row += NGW) {
        const float rs = row_rs(ssq, row);
        f32x4* p = (f32x4*)(A.out + (size_t)row * D);
#pragma unroll
        for (int j = 0; j < 4; ++j) { const f32x4 g = ((const f32x4*)gf)[lane + 64 * j]; f32x4 v = p[lane + 64 * j]; v = v * rs * g; p[lane + 64 * j] = v; }
    }
}

namespace cg = cooperative_groups;
__global__ void __launch_bounds__(512, 2) mk_fwd(Args args) {
    extern __shared__ __attribute__((aligned(16))) unsigned char lds_raw[];
    LAS unsigned char* lds = (LAS unsigned char*)lds_raw;
    const int G = gridDim.x, tid = threadIdx.x;
    volatile LAS unsigned* MISC = (volatile LAS unsigned*)(lds + 131072 + 320);
    if (tid < 64) ((LAS unsigned*)(lds + 131072))[tid + 64] = 0u, ((LAS unsigned*)(lds + 131072))[tid] = 0u;
    __syncthreads();
    const int lo = args.ph_lo, hi = args.ph_hi;
    XcdBarrier bar; bar.bar = (unsigned*)(args.ws + WS_CTL) + 4096; bar.x = 0; bar.st = nullptr;
    if (hi - lo > 1) bar = xcd_barrier_post((unsigned*)(args.ws + WS_CTL) + 4096, MISC + 8);
    if (lo < 0) cg::this_grid().sync();
#define IN(k) (lo <= (k) && (k) < hi)
#define SEAM(k) do { if (IN(k) && IN((k) + 1)) xcd_barrier(bar); } while (0)
    unsigned char* ws = args.ws; unsigned char* ob = (unsigned char*)args.out;
    if (IN(0)) { phase_p0(args, lds, G); } SEAM(0);
    if (IN(1)) { pg8::Gemm g{(const bf16*)(ws + WS_XN), (const bf16*)(ws + WS_WIN), MP, DIN, D}; pg8::StaticOrder S; S.init(MP, DIN, G, (int)blockIdx.x);
        EpiPlain E{(bf16*)(ws + WS_U), DIN}; pg8::gemm_phase<EpiPlain, pg8::StaticOrder, true, true>(lds, g, S, E); } SEAM(1);
    if (IN(2)) { phase_e1(args, G); } SEAM(2);
    if (IN(3)) {
        { pg8::Gemm g{(const bf16*)(ws + WS_AP), (const bf16*)(ws + WS_BA), MP, 1536, 256}; pg8::StaticOrder S; S.init(MP, 1536, G, (int)blockIdx.x);
          EpiPlain E{(bf16*)(ob + DO_GA), 1536}; pg8::gemm_phase<EpiPlain, pg8::StaticOrder, true, true>(lds, g, S, E); }
        { pg8::Gemm g{(const bf16*)(ws + WS_XC), (const bf16*)(ws + WS_BB), MP, 1024, 512}; pg8::StaticOrder S; S.init(MP, 1024, G, (int)blockIdx.x);
          EpiPlain E{(bf16*)(ws + WS_GB), 1024}; pg8::gemm_phase<EpiPlain, pg8::StaticOrder, true, true>(lds, g, S, E); }
    } SEAM(3);
    if (IN(4)) { phase_e2(args, G); } SEAM(4);
    if (IN(5)) { phase_m2(args, lds, G); } SEAM(5);
    if (IN(6)) { phase_m3(args, G); } SEAM(6);
    if (IN(7)) { pg8::Gemm g{(const bf16*)(ws + WS_MIX), (const bf16*)(ob + DO_WOUT), MP, D, D}; pg8::StaticOrder S; S.init(MP, D, G, (int)blockIdx.x);
        EpiX1 E{args.in[I_XP], args.in[I_XS], args.in[I_META], args.out, (bf16*)(ws + WS_X1B), (float*)(ws + WS_SSQ1)};
        pg8::gemm_phase<EpiX1, pg8::StaticOrder, true, true>(lds, g, S, E); } SEAM(7);
    if (IN(8)) { pg8::Gemm g{(const bf16*)(ws + WS_X1B), (const bf16*)(ws + WS_WUP), MP, DFF, D}; pg8::StaticOrder S; S.init(MP, DFF, G, (int)blockIdx.x);
        EpiUp E{(const float*)(ws + WS_SSQ1), (bf16*)(ws + WS_UP), args.out + O_PFC, args.out + O_SFC};
        pg8::gemm_phase<EpiUp, pg8::StaticOrder, true, true>(lds, g, S, E); } SEAM(8);
    if (IN(9)) { pg8::Gemm g{(const bf16*)(ws + WS_X1B), (const bf16*)(ws + WS_WGATE), M_MAIN, DFF, D}; pg8::StaticOrder S; S.init(M_MAIN, DFF, G, (int)blockIdx.x);
        EpiGate E{(const float*)(ws + WS_SSQ1), (const bf16*)(ws + WS_UP), args.in[I_SFC], args.in[I_FCW], args.in[I_FCB], (bf16*)(ws + WS_HID)};
        pg8::gemm_phase<EpiGate, pg8::StaticOrder, true, true>(lds, g, S, E); } SEAM(9);
    if (IN(10)) { pg8::Gemm g{(const bf16*)(ws + WS_HID), (const bf16*)(ws + WS_WDOWN), M_MAIN, D, DFF}; pg8::StaticOrder S; S.init(M_MAIN, D, G, (int)blockIdx.x);
        EpiDown E{args.out, (float*)(ws + WS_SSQ2)};
        pg8::gemm_phase<EpiDown, pg8::StaticOrder, true, true>(lds, g, S, E); } SEAM(10);
    if (IN(11)) { phase_final(args, G); }
#undef IN
#undef SEAM
}

extern "C" void kernel_launch(void* const* d_in, const int* in_sizes, int n_in, void* d_out, int out_size, void* d_ws, size_t ws_size, hipStream_t stream) {
    static int grid = 0;
    if (grid == 0) {
        if (n_in != N_IN || (size_t)out_size != O_END || ws_size < 256 * MiB) { fprintf(stderr, "kernel_launch: unexpected shapes n_in %d out %d ws %zu\n", n_in, out_size, ws_size); grid = -1; return; }
        int dev = 0, cus = 0, per_cu = 0;
        (void)hipGetDevice(&dev); (void)hipDeviceGetAttribute(&cus, hipDeviceAttributeMultiprocessorCount, dev);
        if (hipFuncSetAttribute((const void*)mk_fwd, hipFuncAttributeMaxDynamicSharedMemorySize, LDS_BYTES) != hipSuccess) { fprintf(stderr, "kernel_launch: hipFuncSetAttribute failed\n"); grid = -1; return; }
        if (hipOccupancyMaxActiveBlocksPerMultiprocessor(&per_cu, (const void*)mk_fwd, 512, LDS_BYTES) != hipSuccess || per_cu < 1) per_cu = 1;
        (void)hipGetLastError();
        grid = cus > 0 ? cus : 256;
    }
    if (grid < 0) return;
    Args a{};
    for (int i = 0; i < N_IN; ++i) a.in[i] = (const float*)d_in[i];
    a.out = (float*)d_out; a.ws = (unsigned char*)d_ws;
#if MK_ONE_LAUNCH
    (void)hipMemsetAsync((char*)d_ws + WS_CTL, 0, CTL_ZERO_BYTES, stream);
    a.ph_lo = 0; a.ph_hi = NPH;
    void* kargs[] = {&a};
    hipError_t e = hipLaunchCooperativeKernel((const void*)mk_fwd, dim3(grid), dim3(512), kargs, LDS_BYTES, stream);
    if (e != hipSuccess) fprintf(stderr, "cooperative launch failed: %s (grid %d)\n", hipGetErrorString(e), grid);
#else
    for (int ph = 0; ph < NPH; ++ph) { a.ph_lo = ph; a.ph_hi = ph + 1; hipLaunchKernelGGL(mk_fwd, dim3(grid), dim3(512), LDS_BYTES, stream, a); }
#endif
}
```

```cpp
#include <hip/hip_runtime.h>
#include <hip/hip_cooperative_groups.h>
#include <cstdio>
#include <cstdint>
#include <cmath>
namespace pg8 {
#define PG8_LAS __attribute__((address_space(3)))
typedef unsigned short bf16_t;
typedef short bf16x8 __attribute__((ext_vector_type(8)));
typedef float f32x4 __attribute__((ext_vector_type(4)));
typedef unsigned u32x4 __attribute__((ext_vector_type(4)));
constexpr int BM = 256, BK = 64, HALF = 128, HTB = HALF * BK * 2  , STAGE_BYTES = 8 * HTB, NXCD = 8, WGM = 8;

__host__ __device__ __forceinline__ int lds_byte(int r, int c) { const int st = (r >> 4) * 2 + (c >> 5), rr = r & 15, cc = c & 31, ob = rr * 64 + cc * 2; return st * 1024 + (ob ^ (((ob >> 9) & 1) << 5)); }
__host__ __device__ __forceinline__ void stage_rc(int b, int& R, int& C) { const int st = b / 1024, sb = b % 1024, swz = sb ^ (((sb >> 9) & 1) << 5); R = (st >> 1) * 16 + swz / 64; C = (st & 1) * 32 + (swz % 64) / 2; }
__host__ __device__ __forceinline__ int perm32(int rho) { const int n = rho >> 4, i = rho & 15; return 8 * (i >> 2) + 4 * n + (i & 3); }

struct Unit { int pm, pn; };
struct Gemm { const bf16_t* A; const bf16_t* Bt; int M, N, K; };

struct StaticOrder {
    int nM, nN, nwg, G, c;
    __host__ __device__ void init(int M, int N, int G_, int c_) { nM = M / BM; nN = N / BM; nwg = nM * nN; G = G_; c = c_; }
    __host__ __device__ bool next(int i, Unit& u) const {
        const long L = (long)i * G + c; if (L >= nwg) return false;
        int wgid = (int)L; { const int q = nwg / NXCD, r = nwg % NXCD, xcd = wgid % NXCD, off = wgid / NXCD; wgid = (xcd < r ? xcd * (q + 1) : r * (q + 1) + (xcd - r) * q) + off; }
        const int nig = WGM * nN, gid = wgid / nig, fm = gid * WGM, gsz = (nM - fm) < WGM ? (nM - fm) : WGM;
        u.pm = fm + ((wgid % nig) % gsz); u.pn = (wgid % nig) / gsz; return true;
    }
    __device__ __forceinline__ void a_ready(const Unit&) const {}
    __device__ __forceinline__ void done(const Unit&) const {}
};

__device__ __forceinline__ unsigned cvt_pk_bf16(float lo, float hi) { unsigned r; asm volatile("v_cvt_pk_bf16_f32 %0, %1, %2" : "=v"(r) : "v"(lo), "v"(hi)); return r; }
typedef float f32x2 __attribute__((ext_vector_type(2)));
template <class Epi, class Sched, bool ALIGN_EPI = false, bool SP2 = false>
__device__ __forceinline__ void gemm_phase(PG8_LAS unsigned char* lds, const Gemm g, const Sched& S, const Epi& E) {
    const int tid = threadIdx.x, wid = __builtin_amdgcn_readfirstlane(tid >> 6), lane = tid & 63, wr = wid >> 2, wc = wid & 3, fr = lane & 15, fq = lane >> 4;
    const int K = g.K, nt = K / BK;
    unsigned voffA[2], voffB[2];
#pragma unroll
    for (int i = 0; i < 2; ++i) { int R, C; stage_rc(tid * 16 + i * 8192, R, C); const int Rb = Epi::PERM ? ((R & ~31) + perm32(R & 31)) : R;
        voffA[i] = (unsigned)(R * K + C) * 2u; voffB[i] = (unsigned)(Rb * K + C) * 2u; }
    const size_t kstep = (size_t)(BK * 2);
    const size_t hstep = (size_t)HALF * K * 2;
    const size_t tstep = 2 * hstep;
    const unsigned ldsw = (unsigned)wid * 1024u;
    const int aoff = lds_byte(wr * 64 + fr, fq * 8), boff = lds_byte(wc * 32 + fr, fq * 8);
#define PG8_SA(b, h) (((b) * 2 + (h)) * HTB)
#define PG8_SB(b, h) ((4 + (b) * 2 + (h)) * HTB)
#define PG8_STAGE(bufoff, gbase, voff) do { _Pragma("unroll") for (int _i = 0; _i < 2; ++_i) \
        __builtin_amdgcn_global_load_lds((const unsigned*)((const char*)(gbase) + (voff)[_i]), (PG8_LAS unsigned*)(lds + (bufoff) + ldsw + _i * 8192), 16, 0, 0); } while (0)
#define PG8_LDA(dst, b, h) do { _Pragma("unroll") for (int m = 0; m < 4; ++m) _Pragma("unroll") for (int k = 0; k < 2; ++k) dst[m][k] = *(const PG8_LAS bf16x8*)(lds + PG8_SA(b, h) + aoff + m * 2048 + k * 1024); } while (0)
#define PG8_LDB(dst, b, h) do { _Pragma("unroll") for (int n = 0; n < 2; ++n) _Pragma("unroll") for (int k = 0; k < 2; ++k) dst[n][k] = *(const PG8_LAS bf16x8*)(lds + PG8_SB(b, h) + boff + n * 2048 + k * 1024); } while (0)
#define PG8_MMA(ai, bj, At, Bt) do { __builtin_amdgcn_s_setprio(1); _Pragma("unroll") for (int m = 0; m < 4; ++m) _Pragma("unroll") for (int n = 0; n < 2; ++n) _Pragma("unroll") for (int k = 0; k < 2; ++k) \
        acc[ai][bj][m][n] = __builtin_amdgcn_mfma_f32_16x16x32_bf16(Bt[n][k], At[m][k], acc[ai][bj][m][n], 0, 0, 0); __builtin_amdgcn_s_setprio(0); } while (0)
#define PG8_WAIT_V(n) asm volatile("s_waitcnt vmcnt(" #n ")" ::: "memory")
#define PG8_WAIT_L(n) asm volatile("s_waitcnt lgkmcnt(" #n ")" ::: "memory")
#define PG8_BAR __builtin_amdgcn_s_barrier()
#define PG8_SCHED __builtin_amdgcn_sched_barrier(0)
    Unit cur, nxt; int ui = 0;
    if (!S.next(0, cur)) return;
    f32x4 acc[2][2][4][2];
#pragma unroll
    for (int a = 0; a < 2; ++a)
#pragma unroll
        for (int b = 0; b < 2; ++b)
#pragma unroll
            for (int m = 0; m < 4; ++m)
#pragma unroll
                for (int n = 0; n < 2; ++n) acc[a][b][m][n] = (f32x4){0.f, 0.f, 0.f, 0.f};
    bf16x8 At[4][2], B0[2][2], B1[2][2];
    const char* cA = (const char*)g.A + (size_t)cur.pm * tstep; const char* cB = (const char*)g.Bt + (size_t)cur.pn * tstep;
    S.a_ready(cur);
    if constexpr (SP2) {
        PG8_STAGE(PG8_SB(0, 0), cB, voffB); PG8_STAGE(PG8_SB(0, 1), cB + hstep, voffB); PG8_STAGE(PG8_SA(0, 0), cA, voffA); PG8_STAGE(PG8_SA(0, 1), cA + hstep, voffA);
        if (wr == 1) PG8_BAR;
        PG8_WAIT_V(2); PG8_BAR;
        PG8_STAGE(PG8_SB(1, 0), cB + kstep, voffB); PG8_STAGE(PG8_SA(1, 0), cA + kstep, voffA); PG8_STAGE(PG8_SB(1, 1), cB + hstep + kstep, voffB);
        PG8_WAIT_V(6); PG8_BAR;
    } else {
        PG8_STAGE(PG8_SB(0, 0), cB, voffB); PG8_STAGE(PG8_SA(0, 0), cA, voffA); PG8_STAGE(PG8_SB(0, 1), cB + hstep, voffB); PG8_STAGE(PG8_SA(0, 1), cA + hstep, voffA);
        if (wr == 1) PG8_BAR;
        PG8_WAIT_V(4); PG8_BAR;
        PG8_STAGE(PG8_SB(1, 0), cB + kstep, voffB); PG8_STAGE(PG8_SA(1, 0), cA + kstep, voffA); PG8_STAGE(PG8_SB(1, 1), cB + hstep + kstep, voffB);
        PG8_WAIT_V(6); PG8_BAR;
    }
    for (;;) {
        const bool has_next = S.next(ui + 1, nxt);
        const char* nA = has_next ? (const char*)g.A + (size_t)nxt.pm * tstep : cA; const char* nB = has_next ? (const char*)g.Bt + (size_t)nxt.pn * tstep : cB;
        for (int t = 0; t < nt; t += 2) {
            const bool last = (t == nt - 2);
            const char* a1 = cA + (size_t)(t + 1) * kstep;
            const char* a2 = last ? nA : cA + (size_t)(t + 2) * kstep; const char* b2 = last ? nB : cB + (size_t)(t + 2) * kstep;
            const char* a3 = a2 + kstep; const char* b3 = b2 + kstep;
            if (last && has_next) S.a_ready(nxt);
            if constexpr (SP2) {
            PG8_LDB(B0, 0, 0); PG8_LDB(B1, 0, 1); PG8_SCHED; PG8_LDA(At, 0, 0); PG8_STAGE(PG8_SA(1, 1), a1 + hstep, voffA);
            PG8_WAIT_V(8); PG8_WAIT_L(0); PG8_BAR; PG8_MMA(0, 0, At, B0); PG8_MMA(0, 1, At, B1); PG8_BAR; PG8_SCHED;
            PG8_LDA(At, 0, 1); PG8_STAGE(PG8_SB(0, 0), b2, voffB); PG8_STAGE(PG8_SB(0, 1), b2 + hstep, voffB); PG8_STAGE(PG8_SA(0, 0), a2, voffA);
            PG8_WAIT_V(8); PG8_WAIT_L(0); PG8_BAR; PG8_MMA(1, 0, At, B0); PG8_MMA(1, 1, At, B1); PG8_BAR; PG8_SCHED;
            PG8_LDB(B0, 1, 0); PG8_LDB(B1, 1, 1); PG8_SCHED; PG8_LDA(At, 1, 0); PG8_STAGE(PG8_SA(0, 1), a2 + hstep, voffA);
            PG8_WAIT_V(8); PG8_WAIT_L(0); PG8_BAR; PG8_MMA(0, 0, At, B0); PG8_MMA(0, 1, At, B1); PG8_BAR; PG8_SCHED;
            PG8_LDA(At, 1, 1); PG8_STAGE(PG8_SB(1, 0), b3, voffB); PG8_STAGE(PG8_SB(1, 1), b3 + hstep, voffB); PG8_STAGE(PG8_SA(1, 0), a3, voffA);
            PG8_WAIT_V(8); PG8_WAIT_L(0); PG8_BAR; PG8_MMA(1, 0, At, B0); PG8_MMA(1, 1, At, B1); PG8_BAR; PG8_SCHED;
            } else {
            PG8_LDB(B0, 0, 0); PG8_SCHED; PG8_LDA(At, 0, 0); PG8_STAGE(PG8_SA(1, 1), a1 + hstep, voffA);
            PG8_WAIT_L(8); PG8_BAR; PG8_WAIT_L(0); PG8_MMA(0, 0, At, B0); PG8_BAR; PG8_SCHED;
            PG8_LDB(B1, 0, 1); PG8_STAGE(PG8_SB(0, 0), b2, voffB);
            PG8_BAR; PG8_WAIT_L(0); PG8_MMA(0, 1, At, B1); PG8_BAR;
            PG8_LDA(At, 0, 1); PG8_STAGE(PG8_SA(0, 0), a2, voffA);
            PG8_BAR; PG8_WAIT_L(0); PG8_MMA(1, 0, At, B0); PG8_BAR; PG8_SCHED;
            PG8_STAGE(PG8_SB(0, 1), b2 + hstep, voffB);
            PG8_WAIT_V(6); PG8_BAR; PG8_MMA(1, 1, At, B1); PG8_BAR;
            PG8_LDB(B0, 1, 0); PG8_SCHED; PG8_LDA(At, 1, 0); PG8_STAGE(PG8_SA(0, 1), a2 + hstep, voffA);
            PG8_WAIT_L(8); PG8_BAR; PG8_WAIT_L(0); PG8_MMA(0, 0, At, B0); PG8_BAR; PG8_SCHED;
            PG8_LDB(B1, 1, 1); PG8_STAGE(PG8_SB(1, 0), b3, voffB);
            PG8_BAR; PG8_WAIT_L(0); PG8_MMA(0, 1, At, B1); PG8_BAR;
            PG8_LDA(At, 1, 1); PG8_STAGE(PG8_SA(1, 0), a3, voffA);
            PG8_BAR; PG8_WAIT_L(0); PG8_MMA(1, 0, At, B0); PG8_BAR; PG8_SCHED;
            PG8_STAGE(PG8_SB(1, 1), b3 + hstep, voffB);
            PG8_WAIT_V(6); PG8_BAR; PG8_MMA(1, 1, At, B1); PG8_BAR;
            }
        }
        if constexpr (ALIGN_EPI) { if (wr == 0) PG8_BAR; }
        if constexpr (!Epi::AFTER_DRAIN) { E(acc, cur, wr, wc, fr, fq); S.done(cur); }
        if (!has_next) break;
#pragma unroll
        for (int a = 0; a < 2; ++a)
#pragma unroll
            for (int b = 0; b < 2; ++b)
#pragma unroll
                for (int m = 0; m < 4; ++m)
#pragma unroll
                    for (int n = 0; n < 2; ++n) acc[a][b][m][n] = (f32x4){0.f, 0.f, 0.f, 0.f};
        cur = nxt; cA = nA; cB = nB; ++ui;
        if constexpr (ALIGN_EPI) { if (wr == 1) PG8_BAR; }
    }
    PG8_WAIT_V(0);
    if constexpr (!ALIGN_EPI) { if (wr == 0) PG8_BAR; }
    PG8_BAR;
    if constexpr (Epi::AFTER_DRAIN) { E.fused(acc, cur, wr, wc, fr, fq, lds, wid, lane); S.done(cur); }
#undef PG8_SA
#undef PG8_SB
#undef PG8_STAGE
#undef PG8_LDA
#undef PG8_LDB
#undef PG8_MMA
#undef PG8_WAIT_V
#undef PG8_WAIT_L
#undef PG8_BAR
#undef PG8_SCHED
}
}

#ifndef MK_ONE_LAUNCH
#define MK_ONE_LAUNCH 1
#endif
#define LAS __attribute__((address_space(3)))
typedef unsigned short bf16;
typedef float f32x4 __attribute__((ext_vector_type(4)));
typedef unsigned u32x4 __attribute__((ext_vector_type(4)));
typedef unsigned u32x2 __attribute__((ext_vector_type(2)));
constexpr int D = 1024, NB = 8, SEQ = 2048, NMETA = 16, TP = SEQ + NMETA, DB = 128, DS = 4;
constexpr int NH = 8, DTMP = 1792, DIN = 2816, DFF = 3072;
constexpr int R_SAMPLE = NB * SEQ, R_META = R_SAMPLE + DB * DS, R_END = R_META + NMETA, MP = 17152, M_MAIN = 16896;
constexpr float EPS = 1e-6f, GN_EPS = 64e-5f;
constexpr int NPH = 12;
constexpr int LDS_BYTES = 147456;
enum { I_XP = 0, I_XS, I_STS, I_SWKV, I_SLC, I_SLH, I_SFC, I_META, I_N1G, I_WIN, I_MU, I_W0, I_WUP, I_A0, I_AUP, I_GUP, I_KK, I_KA, I_RK,
       I_GNG, I_GNB, I_LCW, I_LCB, I_LWA, I_LBA, I_LWX, I_LBX, I_LAM, I_LOG, I_WOUT, I_N2G, I_FUP, I_FGATE, I_FCW, I_FCB, I_FDOWN, I_NFG, N_IN };
constexpr size_t O_YP = 0, O_YS = 16777216, O_PSHIFT = 17301504, O_PWKV = 17315840, O_PLC = 17577984, O_PLH = 17590272, O_PFC = 17594368,
                 O_SSHIFT = 17643520, O_SWKV = 17872896, O_SLC = 22067200, O_SLH = 22263808, O_SFC = 22329344, O_END = 23115776;
constexpr size_t MiB = 1u << 20;
constexpr size_t WS_CTL = 0, CTL_ZERO_BYTES = 65536;
constexpr size_t WS_SSQ1 = 1 * MiB, WS_SSQ2 = WS_SSQ1 + (size_t)MP * 16 * 4;
constexpr size_t WS_WUP = 4 * MiB, WS_WGATE = 10 * MiB, WS_WDOWN = 16 * MiB;
constexpr size_t WS_X1B = 22 * MiB, WS_UP = WS_X1B + (size_t)MP * D * 2, WS_HID = WS_UP + (size_t)MP * DFF * 2;
constexpr size_t WS_U = 22 * MiB;
constexpr size_t WS_XN = 115 * MiB, WS_WIN = WS_XN + (size_t)MP * D * 2;
constexpr size_t WS_AP = 190 * MiB, WS_XC = 199 * MiB, WS_BA = 216 * MiB, WS_BB = 217 * MiB, WS_GB = 220 * MiB;
constexpr size_t WS_REC = 115 * MiB, WS_LRU = 182 * MiB, WS_Y = 220 * MiB, WS_MIX = 115 * MiB;
static_assert(WS_SSQ2 + (size_t)MP * 16 * 4 <= WS_WUP, "ssq");
static_assert(WS_HID + (size_t)M_MAIN * DFF * 2 <= 256 * MiB, "hid");
static_assert(WS_U + (size_t)MP * DIN * 2 <= WS_XN, "u");
static_assert(WS_WIN + (size_t)DIN * D * 2 <= WS_LRU, "win");
static_assert(WS_AP + (size_t)MP * 256 * 2 <= WS_XC && WS_XC + (size_t)MP * 512 * 2 <= WS_BA, "ap/xc");
static_assert(WS_GB + (size_t)MP * 1024 * 2 <= 256 * MiB, "gb");
static_assert(WS_REC + (size_t)R_END * 4096 <= WS_LRU && WS_LRU + (size_t)R_END * 2048 <= WS_BA, "rec/lru");
static_assert(WS_Y + (size_t)R_END * 2048 <= 256 * MiB, "y");
constexpr size_t DO_GA = 0, DO_LTOT = (size_t)MP * 1536 * 2, DO_CARRY = DO_LTOT + 513 * 2 * 512 * 4, DO_BON = DO_CARRY + 8 * 64 * 512 * 4, DO_WOUT = O_SFC * 4;
static_assert(DO_BON + (size_t)R_END * 8 * 4 <= O_PSHIFT * 4, "d_out scratch");

struct Args { const float* in[N_IN]; float* out; unsigned char* ws; int ph_lo, ph_hi; };

__device__ __forceinline__ float bf2f(bf16 h) { return __uint_as_float(((unsigned)h) << 16); }
__device__ __forceinline__ unsigned f2bf(float f) { unsigned u = __float_as_uint(f); return (u + 0x7fffu + ((u >> 16) & 1u)) >> 16; }
__device__ __forceinline__ unsigned pk2(float lo, float hi) { return f2bf(lo) | (f2bf(hi) << 16); }
__device__ __forceinline__ float lo16(unsigned w) { return __uint_as_float(w << 16); }
__device__ __forceinline__ float hi16(unsigned w) { return __uint_as_float(w & 0xffff0000u); }
__device__ __forceinline__ float sigm(float x) { return 1.f / (1.f + __expf(-x)); }
__device__ __forceinline__ float softplus_(float z) { return fmaxf(z, 0.f) + log1pf(__expf(-fabsf(z))); }
__device__ __forceinline__ float gelu_tanh(float x) { const float u = 1.5957691216057308f * (x + 0.044715f * x * x * x); return x / (1.f + __expf(-u)); }
__device__ __forceinline__ float tanh_(float x) { const float e = __expf(2.f * x); return 1.f - 2.f / (e + 1.f); }
__device__ __forceinline__ float wave_sum(float v) {
#pragma unroll
    for (int o = 1; o < 64; o <<= 1) v += __shfl_xor(v, o);
    return v;
}
template <int CTRL> __device__ __forceinline__ float dpp_f(float x) { return __int_as_float(__builtin_amdgcn_update_dpp(0, __float_as_int(x), CTRL, 0xF, 0xF, true)); }
__device__ __forceinline__ float allsum16(float x) { x += dpp_f<0xB1>(x); x += dpp_f<0x4E>(x); x += dpp_f<0x141>(x); x += dpp_f<0x140>(x); return x; }

struct RowInfo { int kind, b, t; };
__device__ __forceinline__ RowInfo row_info(int row) {
    RowInfo r;
    if (row < R_SAMPLE) { r.kind = 0; r.b = row >> 11; r.t = (row & 2047) + NMETA; }
    else if (row < R_META) { r.kind = 1; r.b = (row - R_SAMPLE) >> 2; r.t = (row - R_SAMPLE) & 3; }
    else if (row < R_END) { r.kind = 2; r.b = 0; r.t = row - R_META; }
    else { r.kind = 3; r.b = 0; r.t = 0; }
    return r;
}
__device__ __forceinline__ int prompt_row(int b, int t) { return t < NMETA ? R_META + t : b * SEQ + t - NMETA; }
__device__ __forceinline__ int row_back(const RowInfo& ri, int row, int j) {
    const int tt = ri.t - j; if (tt < 0) return -1;
    if (ri.kind == 1) return row - j;
    return prompt_row(ri.b, tt);
}
__device__ __forceinline__ void unpack8(const u32x4 w, float (&f)[8]) {
    f[0] = lo16(w.x); f[1] = hi16(w.x); f[2] = lo16(w.y); f[3] = hi16(w.y); f[4] = lo16(w.z); f[5] = hi16(w.z); f[6] = lo16(w.w); f[7] = hi16(w.w);
}
__device__ __forceinline__ float row_rs(const float* ssq, int row) {
    const f32x4* p = (const f32x4*)(ssq + (size_t)row * 16); const f32x4 a = p[0], b = p[1], c = p[2], d = p[3];
    const float s = ((a.x + a.y) + (a.z + a.w)) + ((b.x + b.y) + (b.z + b.w)) + ((c.x + c.y) + (c.z + c.w)) + ((d.x + d.y) + (d.z + d.w));
    return rsqrtf(s * (1.f / 1024.f) + EPS);
}

#define EPI_ROW(ai, m) (u.pm * 256 + (ai) * 128 + wr * 64 + (m) * 16 + fr)
#define EPI_COL(bj) (u.pn * 256 + (bj) * 128 + wc * 32 + 8 * fq)
struct EpiX1 {
    static constexpr bool PERM = true, AFTER_DRAIN = false;
    const float* xp; const float* xs; const float* meta; float* x1; bf16* x1b; float* ssq;
    __device__ __forceinline__ void operator()(const f32x4 (&acc)[2][2][4][2], const pg8::Unit& u, int wr, int wc, int fr, int fq) const {
#pragma unroll
        for (int ai = 0; ai < 2; ++ai)
#pragma unroll
            for (int m = 0; m < 4; ++m) {
                const int row = EPI_ROW(ai, m);
                const float* res = row < R_SAMPLE ? xp + (size_t)row * D : row < R_META ? xs + (size_t)(row - R_SAMPLE) * D : row < R_END ? meta + (size_t)(row - R_META) * D : nullptr;
                float s = 0.f;
#pragma unroll
                for (int bj = 0; bj < 2; ++bj) {
                    const int col = EPI_COL(bj);
                    f32x4 v0 = acc[ai][bj][m][0], v1 = acc[ai][bj][m][1];
                    if (res) { v0 += *(const f32x4*)(res + col); v1 += *(const f32x4*)(res + col + 4); }
                    if (row < M_MAIN) { *(f32x4*)(x1 + (size_t)row * D + col) = v0; *(f32x4*)(x1 + (size_t)row * D + col + 4) = v1; }
                    u32x4 w; w.x = pk2(v0.x, v0.y); w.y = pk2(v0.z, v0.w); w.z = pk2(v1.x, v1.y); w.w = pk2(v1.z, v1.w);
                    *(u32x4*)(x1b + (size_t)row * D + col) = w;
                    s += (v0.x * v0.x + v0.y * v0.y) + (v0.z * v0.z + v0.w * v0.w) + (v1.x * v1.x + v1.y * v1.y) + (v1.z * v1.z + v1.w * v1.w);
                }
                s += __shfl_xor(s, 16); s += __shfl_xor(s, 32);
                if (fq == 0) ssq[(size_t)row * 16 + u.pn * 4 + wc] = s;
            }
    }
};
struct EpiUp {
    static constexpr bool PERM = true, AFTER_DRAIN = false;
    const float* ssq; bf16* up; float* pffn; float* sffn;
    __device__ __forceinline__ void operator()(const f32x4 (&acc)[2][2][4][2], const pg8::Unit& u, int wr, int wc, int fr, int fq) const {
#pragma unroll
        for (int ai = 0; ai < 2; ++ai)
#pragma unroll
            for (int m = 0; m < 4; ++m) {
                const int row = EPI_ROW(ai, m);
                const float rs = row_rs(ssq, row);
                const RowInfo ri = row_info(row);
                float* st = nullptr;
                if (ri.kind == 0 && ri.t >= TP - 2) st = pffn + ((size_t)ri.b * 2 + (ri.t - (TP - 2))) * DFF;
                else if (ri.kind == 1 && ri.t >= 2) st = sffn + ((size_t)ri.b * 2 + (ri.t - 2)) * DFF;
#pragma unroll
                for (int bj = 0; bj < 2; ++bj) {
                    const int col = EPI_COL(bj);
                    const f32x4 v0 = acc[ai][bj][m][0] * rs, v1 = acc[ai][bj][m][1] * rs;
                    u32x4 w; w.x = pk2(v0.x, v0.y); w.y = pk2(v0.z, v0.w); w.z = pk2(v1.x, v1.y); w.w = pk2(v1.z, v1.w);
                    *(u32x4*)(up + (size_t)row * DFF + col) = w;
                    if (st) { *(f32x4*)(st + col) = v0; *(f32x4*)(st + col + 4) = v1; }
                }
            }
    }
};
struct EpiGate {
    static constexpr bool PERM = true, AFTER_DRAIN = false;
    const float* ssq; const bf16* up; const float* stf; const float* cw; const float* cb; bf16* hid;
    __device__ __forceinline__ void operator()(const f32x4 (&acc)[2][2][4][2], const pg8::Unit& u, int wr, int wc, int fr, int fq) const {
#pragma unroll
        for (int ai = 0; ai < 2; ++ai)
#pragma unroll
            for (int m = 0; m < 4; ++m) {
                const int row = EPI_ROW(ai, m);
                const float rs = row_rs(ssq, row);
                const RowInfo ri = row_info(row);
                const int r1 = row_back(ri, row, 1), r2 = row_back(ri, row, 2);
#pragma unroll
                for (int bj = 0; bj < 2; ++bj) {
                    const int col = EPI_COL(bj);
                    float g[8], u0[8], p1[8], p2[8];
                    { const f32x4 v0 = acc[ai][bj][m][0] * rs, v1 = acc[ai][bj][m][1] * rs; g[0] = v0.x; g[1] = v0.y; g[2] = v0.z; g[3] = v0.w; g[4] = v1.x; g[5] = v1.y; g[6] = v1.z; g[7] = v1.w; }
                    unpack8(*(const u32x4*)(up + (size_t)row * DFF + col), u0);
                    if (r1 >= 0) unpack8(*(const u32x4*)(up + (size_t)r1 * DFF + col), p1);
                    else if (ri.kind == 1) { const float* s = stf + ((size_t)ri.b * 2 + (1 + ri.t)) * DFF + col; const f32x4 a = *(const f32x4*)s, b = *(const f32x4*)(s + 4);
                        p1[0] = a.x; p1[1] = a.y; p1[2] = a.z; p1[3] = a.w; p1[4] = b.x; p1[5] = b.y; p1[6] = b.z; p1[7] = b.w; }
                    else {
#pragma unroll
                        for (int i = 0; i < 8; ++i) p1[i] = 0.f; }
                    if (r2 >= 0) unpack8(*(const u32x4*)(up + (size_t)r2 * DFF + col), p2);
                    else if (ri.kind == 1) { const float* s = stf + ((size_t)ri.b * 2 + ri.t) * DFF + col; const f32x4 a = *(const f32x4*)s, b = *(const f32x4*)(s + 4);
                        p2[0] = a.x; p2[1] = a.y; p2[2] = a.z; p2[3] = a.w; p2[4] = b.x; p2[5] = b.y; p2[6] = b.z; p2[7] = b.w; }
                    else {
#pragma unroll
                        for (int i = 0; i < 8; ++i) p2[i] = 0.f; }
                    float o[8];
#pragma unroll
                    for (int h = 0; h < 2; ++h) {
                        const f32x4 w0 = *(const f32x4*)(cw + col + 4 * h), w1 = *(const f32x4*)(cw + DFF + col + 4 * h), w2 = *(const f32x4*)(cw + 2 * DFF + col + 4 * h), bb = *(const f32x4*)(cb + col + 4 * h);
#pragma unroll
                        for (int i = 0; i < 4; ++i) { const int e = 4 * h + i; const float c = bb[i] + w0[i] * p2[e] + w1[i] * p1[e] + w2[i] * u0[e]; o[e] = gelu_tanh(c) * g[e]; }
                    }
                    u32x4 w; w.x = pk2(o[0], o[1]); w.y = pk2(o[2], o[3]); w.z = pk2(o[4], o[5]); w.w = pk2(o[6], o[7]);
                    *(u32x4*)(hid + (size_t)row * DFF + col) = w;
                }
            }
    }
};
struct EpiDown {
    static constexpr bool PERM = true, AFTER_DRAIN = false;
    float* x; float* ssq;
    __device__ __forceinline__ void operator()(const f32x4 (&acc)[2][2][4][2], const pg8::Unit& u, int wr, int wc, int fr, int fq) const {
#pragma unroll
        for (int ai = 0; ai < 2; ++ai)
#pragma unroll
            for (int m = 0; m < 4; ++m) {
                const int row = EPI_ROW(ai, m);
                float s = 0.f;
#pragma unroll
                for (int bj = 0; bj < 2; ++bj) {
                    const int col = EPI_COL(bj);
                    float* p = x + (size_t)row * D + col;
                    const f32x4 v0 = acc[ai][bj][m][0] + *(const f32x4*)p, v1 = acc[ai][bj][m][1] + *(const f32x4*)(p + 4);
                    *(f32x4*)p = v0; *(f32x4*)(p + 4) = v1;
                    s += (v0.x * v0.x + v0.y * v0.y) + (v0.z * v0.z + v0.w * v0.w) + (v1.x * v1.x + v1.y * v1.y) + (v1.z * v1.z + v1.w * v1.w);
                }
                s += __shfl_xor(s, 16); s += __shfl_xor(s, 32);
                if (fq == 0) ssq[(size_t)row * 16 + u.pn * 4 + wc] = s;
            }
    }
};
struct EpiPlain {
    static constexpr bool PERM = true, AFTER_DRAIN = false;
    bf16* O; int ldc;
    __device__ __forceinline__ void operator()(const f32x4 (&acc)[2][2][4][2], const pg8::Unit& u, int wr, int wc, int fr, int fq) const {
#pragma unroll
        for (int ai = 0; ai < 2; ++ai)
#pragma unroll
            for (int m = 0; m < 4; ++m) {
                const int row = EPI_ROW(ai, m);
#pragma unroll
                for (int bj = 0; bj < 2; ++bj) {
                    const int col = EPI_COL(bj);
                    const f32x4 v0 = acc[ai][bj][m][0], v1 = acc[ai][bj][m][1];
                    u32x4 w; w.x = pk2(v0.x, v0.y); w.y = pk2(v0.z, v0.w); w.z = pk2(v1.x, v1.y); w.w = pk2(v1.z, v1.w);
                    *(u32x4*)(O + (size_t)row * ldc + col) = w;
                }
            }
    }
};

#define XB_TMO      128
#define XB_XCNT(j)  (256  + 64 * (j))
#define XB_XSUB(j)  (1280 + 64 * (j))
#define XB_XGEN(j)  (2304 + 64 * (j))
#define XB_TOP      3328
#define XB_TOPGEN   3392
#define XCD_BAR_WORDS 3456
#define XB_SPIN_CAP (1u << 22)
__device__ __forceinline__ unsigned xb_ld(unsigned* p)              { return __hip_atomic_load(p, __ATOMIC_RELAXED, __HIP_MEMORY_SCOPE_AGENT); }
__device__ __forceinline__ unsigned xb_add(unsigned* p, unsigned v) { return __hip_atomic_fetch_add(p, v, __ATOMIC_RELAXED, __HIP_MEMORY_SCOPE_AGENT); }
__device__ __forceinline__ unsigned xb_xcc_id() { return (unsigned)__builtin_amdgcn_s_getreg((3 << 11) | 20) & 0xFu; }
#define XB_SPIN(cond, bar) do { unsigned _sp = 0; while (cond) { __builtin_amdgcn_s_sleep(1); \
    if ((++_sp & 255u) == 0u) { if (xb_ld(&(bar)[XB_TMO])) break; if (_sp > XB_SPIN_CAP) { atomicAdd(&(bar)[XB_TMO], 1u); break; } } } } while (0)
struct XcdBarrier { unsigned* bar; unsigned x; volatile LAS unsigned* st; };
__device__ __forceinline__ XcdBarrier xcd_barrier_post(unsigned* bar, volatile LAS unsigned* st) {
    XcdBarrier b; b.bar = bar; b.x = xb_xcc_id(); b.st = st;
    if (threadIdx.x == 0) (void)xb_add(&bar[XB_XCNT(b.x)], 1u);
    return b;
}
__device__ __forceinline__ void xcd_barrier_complete(unsigned* bar, unsigned x, unsigned& nloc, unsigned& nx) {
    const unsigned G = gridDim.x * gridDim.y * gridDim.z;
    unsigned sum, cnt, mine, sp = 0u;
    for (;;) {
        sum = 0u; cnt = 0u; mine = 0u;
#pragma unroll
        for (unsigned j = 0; j < 16; ++j) { const unsigned c = xb_ld(&bar[XB_XCNT(j)]); sum += c; cnt += (c > 0u) ? 1u : 0u; mine = (j == x) ? c : mine; }
        if (sum == G) break;
        __builtin_amdgcn_s_sleep(1);
        if ((++sp & 255u) == 0u) { if (xb_ld(&bar[XB_TMO])) break; if (sp > XB_SPIN_CAP) { atomicAdd(&bar[XB_TMO], 1u); break; } }
    }
    nloc = mine > 0u ? mine : 1u; nx = cnt > 0u ? cnt : 1u;
}
__device__ __forceinline__ void xcd_barrier(const XcdBarrier& b) {
    asm volatile("s_waitcnt vmcnt(0)" ::: "memory");
    __syncthreads();
    if (threadIdx.x == 0) {
        unsigned* bar = b.bar;
        __builtin_amdgcn_s_waitcnt(0);
        unsigned nloc = b.st[0], nx = b.st[1];
        if (nloc == 0u) { xcd_barrier_complete(bar, b.x, nloc, nx); b.st[0] = nloc; b.st[1] = nx; }
        const unsigned old = xb_add(&bar[XB_XSUB(b.x)], 1u);
        const unsigned gen = old / nloc;
        if (old + 1u == (gen + 1u) * nloc) {
            __builtin_amdgcn_fence(__ATOMIC_RELEASE, "agent");
            asm volatile("s_waitcnt vmcnt(0)" ::: "memory");
            const unsigned og = xb_add(&bar[XB_TOP], 1u);
            const unsigned tg = og / nx;
            if (og + 1u == (tg + 1u) * nx) xb_add(&bar[XB_TOPGEN], 1u);
            else XB_SPIN(xb_ld(&bar[XB_TOPGEN]) == tg, bar);
            __builtin_amdgcn_fence(__ATOMIC_ACQUIRE, "agent");
            xb_add(&bar[XB_XGEN(b.x)], 1u);
            asm volatile("s_waitcnt vmcnt(0)" ::: "memory");
        } else {
            XB_SPIN(xb_ld(&bar[XB_XGEN(b.x)]) == gen, bar);
            __builtin_amdgcn_fence(__ATOMIC_ACQUIRE, "agent");
            asm volatile("s_waitcnt vmcnt(0)" ::: "memory");
        }
    }
    __syncthreads();
}

__device__ __forceinline__ void p0_transpose_item(const float* W, int K, int N, bf16* WT, const float* ksc, LAS float* scr, int item, int lane) {
    const int nblk = N / 32, kb = item / nblk, nb = item % nblk, k0 = 64 * kb, n0 = 32 * nb;
#pragma unroll 8
    for (int i = 0; i < 32; ++i) { const int kk = 2 * i + (lane >> 5); float v = W[(size_t)(k0 + kk) * N + n0 + (lane & 31)]; if (ksc) v *= ksc[k0 + kk]; scr[kk * 33 + (lane & 31)] = v; }
    asm volatile("s_waitcnt lgkmcnt(0)" ::: "memory");
    const int c = lane & 7;
#pragma unroll
    for (int j = 0; j < 4; ++j) { const int n = (lane >> 3) + 8 * j; const LAS float* s = scr + (8 * c) * 33 + n;
        u32x4 o; o.x = pk2(s[0 * 33], s[1 * 33]); o.y = pk2(s[2 * 33], s[3 * 33]); o.z = pk2(s[4 * 33], s[5 * 33]); o.w = pk2(s[6 * 33], s[7 * 33]);
        *(u32x4*)(WT + (size_t)(n0 + n) * K + k0 + 8 * c) = o; }
    asm volatile("s_waitcnt lgkmcnt(0)" ::: "memory");
}
__device__ __forceinline__ void phase_p0(const Args& A, LAS unsigned char* lds, int G) {
    const int tid = threadIdx.x, lane = tid & 63, wave = tid >> 6;
    LAS float* scr = (LAS float*)(lds + wave * 16384);
    const int gw = blockIdx.x * 8 + wave, NGW = G * 8;
    unsigned char* ws = A.ws;
    constexpr int I_IN = 16 * 88, I_OUT = 16 * 32, I_UPI = 16 * 96, I_DN = 48 * 32, NIT = I_IN + I_OUT + 2 * I_UPI + I_DN;
    for (int it = gw; it < NIT; it += NGW) {
        int r = it;
        if (r < I_IN) { p0_transpose_item(A.in[I_WIN], D, DIN, (bf16*)(ws + WS_WIN), nullptr, scr, r, lane); continue; } r -= I_IN;
        if (r < I_OUT) { p0_transpose_item(A.in[I_WOUT], D, D, (bf16*)((unsigned char*)A.out + DO_WOUT), nullptr, scr, r, lane); continue; } r -= I_OUT;
        if (r < I_UPI) { p0_transpose_item(A.in[I_FUP], D, DFF, (bf16*)(ws + WS_WUP), A.in[I_N2G], scr, r, lane); continue; } r -= I_UPI;
        if (r < I_UPI) { p0_transpose_item(A.in[I_FGATE], D, DFF, (bf16*)(ws + WS_WGATE), A.in[I_N2G], scr, r, lane); continue; } r -= I_UPI;
        p0_transpose_item(A.in[I_FDOWN], DFF, D, (bf16*)(ws + WS_WDOWN), nullptr, scr, r, lane);
    }
    const int gt = blockIdx.x * 512 + tid, NGT = G * 512;
    { bf16* BA = (bf16*)(ws + WS_BA); const float* wup = A.in[I_WUP]; const float* aup = A.in[I_AUP]; const float* gup = A.in[I_GUP];
      for (int e = gt; e < 1536 * 256; e += NGT) { const int n = e >> 8, k = e & 255; float v = 0.f;
          if (n < 512) { if (k < 64) v = wup[k * 512 + n]; }
          else if (n < 1024) { if (k >= 64 && k < 128) v = aup[(k - 64) * 512 + n - 512]; }
          else { if (k >= 128) v = gup[(k - 128) * 512 + n - 1024]; }
          BA[e] = (bf16)f2bf(v); } }
    { bf16* BB = (bf16*)(ws + WS_BB); const float* wa = A.in[I_LWA]; const float* wx = A.in[I_LWX];
      for (int e = gt; e < 1024 * 512; e += NGT) { const int n = e >> 9, k = e & 511, nn = n & 511, h = nn >> 6, j = nn & 63; float v = 0.f;
          if ((k >> 6) == h) { const float* Wm = n < 512 ? wa : wx; v = Wm[(h * 64 + (k & 63)) * 64 + j]; }
          BB[e] = (bf16)f2bf(v); } }
    bf16* XN = (bf16*)(ws + WS_XN); const float* g1 = A.in[I_N1G];
    for (int row = gw; row < MP; row += NGW) {
        const float* src = row < R_SAMPLE ? A.in[I_XP] + (size_t)row * D : row < R_META ? A.in[I_XS] + (size_t)(row - R_SAMPLE) * D : row < R_END ? A.in[I_META] + (size_t)(row - R_META) * D : nullptr;
        u32x2* o = (u32x2*)(XN + (size_t)row * D);
        if (!src) {
#pragma unroll
            for (int j = 0; j < 4; ++j) o[lane + 64 * j] = (u32x2){0u, 0u};
            continue; }
        f32x4 v[4]; float s = 0.f;
#pragma unroll
        for (int j = 0; j < 4; ++j) { v[j] = ((const f32x4*)src)[lane + 64 * j]; s += (v[j].x * v[j].x + v[j].y * v[j].y) + (v[j].z * v[j].z + v[j].w * v[j].w); }
        const float rs = rsqrtf(wave_sum(s) * (1.f / D) + EPS);
#pragma unroll
        for (int j = 0; j < 4; ++j) { const f32x4 g = ((const f32x4*)g1)[lane + 64 * j];
            o[lane + 64 * j] = (u32x2){pk2(v[j].x * rs * g.x, v[j].y * rs * g.y), pk2(v[j].z * rs * g.z, v[j].w * rs * g.w)}; }
    }
}

__device__ __forceinline__ void phase_e1(const Args& A, int G) {
    const int tid = threadIdx.x, lane = tid & 63, wave = tid >> 6;
    const int gw = blockIdx.x * 8 + wave, NGW = G * 8;
    unsigned char* ws = A.ws;
    const bf16* U = (const bf16*)(ws + WS_U); bf16* AP = (bf16*)(ws + WS_AP); bf16* XC = (bf16*)(ws + WS_XC);
    const float* mu = A.in[I_MU]; const float* sts = A.in[I_STS]; const float* slc = A.in[I_SLC]; const float* lcw = A.in[I_LCW]; const float* lcb = A.in[I_LCB];
    for (int row = gw; row < MP; row += NGW) {
        bf16* ap = AP + (size_t)row * 256; bf16* xc = XC + (size_t)row * 512;
        const RowInfo ri = row_info(row);
        if (ri.kind == 3) { ((u32x2*)ap)[lane] = (u32x2){0u, 0u}; ((u32x4*)xc)[lane] = (u32x4){0u, 0u, 0u, 0u}; continue; }
        const bf16* urow = U + (size_t)row * DIN;
        const int r1 = row_back(ri, row, 1);
        {
            const int c0 = 1536 + 4 * lane;
            const u32x2 uw = *(const u32x2*)(urow + c0);
            float u[4] = {lo16(uw.x), hi16(uw.x), lo16(uw.y), hi16(uw.y)}, p[4];
            if (r1 >= 0) { const u32x2 pw = *(const u32x2*)(U + (size_t)r1 * DIN + c0); p[0] = lo16(pw.x); p[1] = hi16(pw.x); p[2] = lo16(pw.y); p[3] = hi16(pw.y); }
            else if (ri.kind == 1) { const f32x4 pv = *(const f32x4*)(sts + (size_t)ri.b * DTMP + c0); p[0] = pv.x; p[1] = pv.y; p[2] = pv.z; p[3] = pv.w; }
            else { p[0] = p[1] = p[2] = p[3] = 0.f; }
            const f32x4 m4 = *(const f32x4*)(mu + c0);
            float o[4];
#pragma unroll
            for (int i = 0; i < 4; ++i) { const float um = u[i] + (p[i] - u[i]) * m4[i]; o[i] = lane < 16 ? tanh_(um) : lane < 32 ? um : sigm(um); }
            ((u32x2*)ap)[lane] = (u32x2){pk2(o[0], o[1]), pk2(o[2], o[3])};
        }
        {
            const int c = 8 * lane;
            float acc[8], cur[8];
            { const f32x4 b0 = *(const f32x4*)(lcb + c), b1 = *(const f32x4*)(lcb + c + 4); acc[0] = b0.x; acc[1] = b0.y; acc[2] = b0.z; acc[3] = b0.w; acc[4] = b1.x; acc[5] = b1.y; acc[6] = b1.z; acc[7] = b1.w; }
#pragma unroll
            for (int j = 0; j < 4; ++j) {
                float val[8];
                const int rj = (j == 3) ? row : row_back(ri, row, 3 - j);
                if (rj >= 0) unpack8(*(const u32x4*)(U + (size_t)rj * DIN + DTMP + c), val);
                else if (ri.kind == 1) { const float* s = slc + ((size_t)ri.b * 3 + (ri.t + j)) * 512 + c; const f32x4 a = *(const f32x4*)s, b = *(const f32x4*)(s + 4);
                    val[0] = a.x; val[1] = a.y; val[2] = a.z; val[3] = a.w; val[4] = b.x; val[5] = b.y; val[6] = b.z; val[7] = b.w; }
                else {
#pragma unroll
                    for (int i = 0; i < 8; ++i) val[i] = 0.f; }
                const f32x4 w0 = *(const f32x4*)(lcw + j * 512 + c), w1 = *(const f32x4*)(lcw + j * 512 + c + 4);
#pragma unroll
                for (int i = 0; i < 4; ++i) { acc[i] += w0[i] * val[i]; acc[4 + i] += w1[i] * val[4 + i]; }
                if (j == 3) {
#pragma unroll
                    for (int i = 0; i < 8; ++i) cur[i] = val[i]; }
            }
            u32x4 w; w.x = pk2(acc[0], acc[1]); w.y = pk2(acc[2], acc[3]); w.z = pk2(acc[4], acc[5]); w.w = pk2(acc[6], acc[7]);
            ((u32x4*)xc)[lane] = w;
            float* lco = nullptr;
            if (ri.kind == 0 && ri.t >= TP - 3) lco = A.out + O_PLC + ((size_t)ri.b * 3 + (ri.t - (TP - 3))) * 512 + c;
            else if (ri.kind == 1 && ri.t >= 1) lco = A.out + O_SLC + ((size_t)ri.b * 3 + (ri.t - 1)) * 512 + c;
            if (lco) { *(f32x4*)lco = (f32x4){cur[0], cur[1], cur[2], cur[3]}; *(f32x4*)(lco + 4) = (f32x4){cur[4], cur[5], cur[6], cur[7]}; }
        }
        float* sho = nullptr;
        if (ri.kind == 0 && ri.t == TP - 1) sho = A.out + O_PSHIFT + (size_t)ri.b * DTMP;
        else if (ri.kind == 1 && ri.t == DS - 1) sho = A.out + O_SSHIFT + (size_t)ri.b * DTMP;
        if (sho) for (int i = lane; i < DTMP; i += 64) sho[i] = bf2f(urow[i]);
    }
}

__device__ __forceinline__ void phase_e2(const Args& A, int G) {
    const int tid = threadIdx.x, lane = tid & 63, wave = tid >> 6;
    unsigned char* ws = A.ws;
    const bf16* U = (const bf16*)(ws + WS_U); const bf16* GB = (const bf16*)(ws + WS_GB); const bf16* GA = (const bf16*)((unsigned char*)A.out + DO_GA);
    bf16* REC = (bf16*)(ws + WS_REC); bf16* LRU = (bf16*)(ws + WS_LRU);
    float* LTOT = (float*)((unsigned char*)A.out + DO_LTOT); float* BON = (float*)((unsigned char*)A.out + DO_BON);
    const float* mu = A.in[I_MU]; const float* sts = A.in[I_STS]; const float* slc = A.in[I_SLC]; const float* slh = A.in[I_SLH];
    for (int unit = blockIdx.x; unit < 529; unit += G) {
        int row0, ntok, kind;
        if (unit < 512) { row0 = unit * 32; ntok = 32; kind = 0; } else if (unit == 512) { row0 = R_META; ntok = 16; kind = 2; } else { row0 = R_SAMPLE + (unit - 513) * 32; ntok = 32; kind = 1; }
        {
            const int c = tid;
            const float sp = softplus_(-A.in[I_LAM][c]);
            const float cw0 = A.in[I_LCW][c], cw1 = A.in[I_LCW][512 + c], cw2 = A.in[I_LCW][1024 + c], cw3 = A.in[I_LCW][1536 + c], cbias = A.in[I_LCB][c];
            const float ba_ = A.in[I_LBA][c], bx_ = A.in[I_LBX][c];
            float l1 = 0.f, l2 = 0.f, l3 = 0.f, H = 0.f, P = 1.f;
            if (kind == 0) { const RowInfo ri0 = row_info(row0);
                l1 = bf2f(U[(size_t)row_back(ri0, row0, 1) * DIN + DTMP + c]); l2 = bf2f(U[(size_t)row_back(ri0, row0, 2) * DIN + DTMP + c]); l3 = bf2f(U[(size_t)row_back(ri0, row0, 3) * DIN + DTMP + c]); }
            for (int j = 0; j < ntok; ++j) {
                const int row = row0 + j; const int b = (row - R_SAMPLE) >> 2;
                if (kind == 1 && (j & 3) == 0) { l3 = slc[((size_t)b * 3 + 0) * 512 + c]; l2 = slc[((size_t)b * 3 + 1) * 512 + c]; l1 = slc[((size_t)b * 3 + 2) * 512 + c]; H = slh[(size_t)b * 512 + c]; }
                const float l0 = bf2f(U[(size_t)row * DIN + DTMP + c]);
                const float xc = cbias + cw0 * l3 + cw1 * l2 + cw2 * l1 + cw3 * l0;
                l3 = l2; l2 = l1; l1 = l0;
                const float ra = bf2f(GB[(size_t)row * 1024 + c]) + ba_, ix = bf2f(GB[(size_t)row * 1024 + 512 + c]) + bx_;
                const float rg = sigm(ra), ig = sigm(ix);
                const float la = -8.f * rg * sp, a = __expf(la);
                float mult = sqrtf(-expm1f(2.f * la)); if (kind == 2 && j == 0) mult = 1.f;
                H = a * H + xc * ig * mult; P = P * a;
                LRU[(size_t)row * 1024 + c] = (bf16)f2bf(H); LRU[(size_t)row * 1024 + 512 + c] = (bf16)f2bf(kind == 1 ? 0.f : P);
                if (kind == 1 && (j & 3) == 3) A.out[O_SLH + (size_t)b * 512 + c] = H;
            }
            if (kind != 1) { LTOT[((size_t)unit * 2 + 0) * 512 + c] = P; LTOT[((size_t)unit * 2 + 1) * 512 + c] = H; }
        }
        for (int task = wave; task < ntok * 8; task += 8) {
            const int j = task >> 3, h = task & 7, row = row0 + j, c = h * 64 + lane;
            const RowInfo ri = row_info(row); const int r1 = row_back(ri, row, 1);
            const bf16* ur = U + (size_t)row * DIN;
            const float u_r = bf2f(ur[c]), u_k = bf2f(ur[512 + c]);
            float p_r, p_k;
            if (r1 >= 0) { p_r = bf2f(U[(size_t)r1 * DIN + c]); p_k = bf2f(U[(size_t)r1 * DIN + 512 + c]); }
            else if (ri.kind == 1) { p_r = sts[(size_t)ri.b * DTMP + c]; p_k = sts[(size_t)ri.b * DTMP + 512 + c]; }
            else { p_r = 0.f; p_k = 0.f; }
            const float um_r = u_r + (p_r - u_r) * mu[c], um_k = u_k + (p_k - u_k) * mu[512 + c];
            const float w_pre = bf2f(GA[(size_t)row * 1536 + c]) + A.in[I_W0][c], a_pre = bf2f(GA[(size_t)row * 1536 + 512 + c]) + A.in[I_A0][c];
            const float w_log = -softplus_(-w_pre) - 0.5f, e = __expf(w_log), x = -expm1f(-e);
            const float a = sigm(a_pre);
            const float kk = um_k * A.in[I_KK][c], ss = wave_sum(kk * kk), kkn = kk * rsqrtf(fmaxf(ss, 1e-24f));
            const float kp = um_k * (1.f + (a - 1.f) * A.in[I_KA][c]);
            const float bon = wave_sum(um_r * kp * A.in[I_RK][c]);
            bf16* rec = REC + ((size_t)row * 8 + h) * 256;
            rec[lane] = (bf16)f2bf(a); rec[64 + lane] = (bf16)f2bf(x); rec[128 + lane] = (bf16)f2bf(kkn); rec[192 + lane] = (bf16)f2bf(kp);
            if (lane == 0) BON[(size_t)row * 8 + h] = bon;
        }
    }
}

struct Raw { bf16 a, x, kk, kp, ur, uv, pr, pv; };
__device__ __forceinline__ void m2_load(Raw (&raw)[4], const bf16* REC, const bf16* U, int b, int h, int t0, int ns, int k, int sub) {
#pragma unroll
    for (int i = 0; i < 4; ++i) {
        const int s = sub + 8 * i;
        raw[i].a = 0; raw[i].x = 0; raw[i].kk = 0; raw[i].kp = 0; raw[i].ur = 0; raw[i].uv = 0; raw[i].pr = 0; raw[i].pv = 0;
        if (s < ns) {
            const int t = t0 + s, row = prompt_row(b, t);
            const bf16* rec = REC + ((size_t)row * 8 + h) * 256;
            raw[i].a = rec[k]; raw[i].x = rec[64 + k]; raw[i].kk = rec[128 + k]; raw[i].kp = rec[192 + k];
            const bf16* ur = U + (size_t)row * DIN + h * 64 + k; raw[i].ur = ur[0]; raw[i].uv = ur[1024];
            if (t > 0) { const bf16* pr = U + (size_t)prompt_row(b, t - 1) * DIN + h * 64 + k; raw[i].pr = pr[0]; raw[i].pv = pr[1024]; }
        }
    }
}
__device__ __forceinline__ void m2_store(const Raw (&raw)[4], LAS float* buf, float mu_r, float mu_v, int k, int sub, int ns) {
#pragma unroll
    for (int i = 0; i < 4; ++i) {
        const int s = sub + 8 * i;
        if (s < ns) {
            LAS float* p = buf + s * 384;
            const float a = bf2f(raw[i].a), kk = bf2f(raw[i].kk), ur = bf2f(raw[i].ur), uv = bf2f(raw[i].uv);
            p[k] = kk; p[64 + k] = bf2f(raw[i].x); p[128 + k] = kk * a; p[192 + k] = bf2f(raw[i].kp);
            p[256 + k] = ur + (bf2f(raw[i].pr) - ur) * mu_r; p[320 + k] = uv + (bf2f(raw[i].pv) - uv) * mu_v;
        }
    }
}
__device__ __forceinline__ void phase_m2(const Args& A, LAS unsigned char* lds, int G) {
    const int tid = threadIdx.x, lane = tid & 63, wave = tid >> 6;
    unsigned char* ws = A.ws;
    const bf16* U = (const bf16*)(ws + WS_U); const bf16* REC = (const bf16*)(ws + WS_REC); float* Y = (float*)(ws + WS_Y);
    const float* LTOT = (const float*)((unsigned char*)A.out + DO_LTOT); float* CARRY = (float*)((unsigned char*)A.out + DO_CARRY);
    const float* mu = A.in[I_MU];
    for (int b = blockIdx.x; b < NB; b += G) {
        const int c = tid; float carry = LTOT[((size_t)512 * 2 + 1) * 512 + c];
#pragma unroll 8
        for (int i = 0; i < 64; ++i) { CARRY[((size_t)b * 64 + i) * 512 + c] = carry; const int un = b * 64 + i; carry = LTOT[((size_t)un * 2 + 0) * 512 + c] * carry + LTOT[((size_t)un * 2 + 1) * 512 + c]; }
        A.out[O_PLH + (size_t)b * 512 + c] = carry;
    }
    const int ks = lane & 15, rl = lane >> 4;
    for (int item = blockIdx.x; item < 256; item += G) {
        const int bh = item >> 2, q = item & 3, b = bh >> 3, h = bh & 7;
        const int k = tid & 63, sub = tid >> 6;
        const float mu_r = mu[h * 64 + k], mu_v = mu[1024 + h * 64 + k];
        const int vrow = 16 * q + 4 * (wave & 3) + rl;
        f32x4 S = (f32x4){0.f, 0.f, 0.f, 0.f};
        Raw raw[4];
        LAS float* buf0 = (LAS float*)lds; LAS float* buf1 = (LAS float*)(lds + 49152);
        __syncthreads();
        m2_load(raw, REC, U, b, h, 0, 16, k, sub);
        m2_store(raw, buf0, mu_r, mu_v, k, sub, 16);
        __syncthreads();
        for (int blk = 0; blk < 65; ++blk) {
            const int t0 = blk == 0 ? 0 : 16 + 32 * (blk - 1), ns = blk == 0 ? 16 : 32;
            const int t0n = 16 + 32 * blk;
            if (blk + 1 < 65) m2_load(raw, REC, U, b, h, t0n, 32, k, sub);
            if (wave < 4) {
                const LAS float* buf = (blk & 1) ? buf1 : buf0;
                for (int s = 0; s < ns; ++s) {
                    const LAS float* p = buf + s * 384;
                    const f32x4 kk4 = *(const LAS f32x4*)(p + 4 * ks), x4 = *(const LAS f32x4*)(p + 64 + 4 * ks), ka4 = *(const LAS f32x4*)(p + 128 + 4 * ks),
                                kp4 = *(const LAS f32x4*)(p + 192 + 4 * ks), r4 = *(const LAS f32x4*)(p + 256 + 4 * ks);
                    const float vv = p[320 + vrow];
                    float d = (S.x * kk4.x + S.y * kk4.y) + (S.z * kk4.z + S.w * kk4.w); d = allsum16(d);
                    S = S - S * x4 - d * ka4 + vv * kp4;
                    float y = (S.x * r4.x + S.y * r4.y) + (S.z * r4.z + S.w * r4.w); y = allsum16(y);
                    if (ks == 0) Y[(size_t)prompt_row(b, t0 + s) * 512 + h * 64 + vrow] = y;
                }
            }
            if (blk + 1 < 65) m2_store(raw, (blk & 1) ? buf0 : buf1, mu_r, mu_v, k, sub, 32);
            __syncthreads();
        }
        if (wave < 4) *(f32x4*)(A.out + O_PWKV + ((size_t)(b * 8 + h) * 64 + vrow) * 64 + 4 * ks) = S;
    }
    const float* swkv = A.in[I_SWKV]; const float* sts = A.in[I_STS];
    for (int task = blockIdx.x * 8 + wave; task < DB * NH * 16; task += G * 8) {
        const int bh = task >> 4, rg = task & 15, b = bh >> 3, h = bh & 7, v = 4 * rg + rl;
        f32x4 S = *(const f32x4*)(swkv + ((size_t)bh * 64 + v) * 64 + 4 * ks);
        const f32x4 mr4 = *(const f32x4*)(mu + h * 64 + 4 * ks); const float mv = mu[1024 + h * 64 + v];
#pragma unroll
        for (int t = 0; t < DS; ++t) {
            const int row = R_SAMPLE + 4 * b + t;
            const bf16* rec = REC + ((size_t)row * 8 + h) * 256 + 4 * ks;
            const u32x2 wa = *(const u32x2*)rec, wx = *(const u32x2*)(rec + 64), wk = *(const u32x2*)(rec + 128), wp = *(const u32x2*)(rec + 192);
            const f32x4 a4 = (f32x4){lo16(wa.x), hi16(wa.x), lo16(wa.y), hi16(wa.y)}, x4 = (f32x4){lo16(wx.x), hi16(wx.x), lo16(wx.y), hi16(wx.y)},
                        kk4 = (f32x4){lo16(wk.x), hi16(wk.x), lo16(wk.y), hi16(wk.y)}, kp4 = (f32x4){lo16(wp.x), hi16(wp.x), lo16(wp.y), hi16(wp.y)};
            const u32x2 wr_ = *(const u32x2*)(U + (size_t)row * DIN + h * 64 + 4 * ks);
            const f32x4 ur4 = (f32x4){lo16(wr_.x), hi16(wr_.x), lo16(wr_.y), hi16(wr_.y)};
            const float uv = bf2f(U[(size_t)row * DIN + 1024 + h * 64 + v]);
            f32x4 pr4; float pv;
            if (t > 0) { const u32x2 w = *(const u32x2*)(U + (size_t)(row - 1) * DIN + h * 64 + 4 * ks); pr4 = (f32x4){lo16(w.x), hi16(w.x), lo16(w.y), hi16(w.y)}; pv = bf2f(U[(size_t)(row - 1) * DIN + 1024 + h * 64 + v]); }
            else { pr4 = *(const f32x4*)(sts + (size_t)b * DTMP + h * 64 + 4 * ks); pv = sts[(size_t)b * DTMP + 1024 + h * 64 + v]; }
            const f32x4 r4 = ur4 + (pr4 - ur4) * mr4; const float vv = uv + (pv - uv) * mv;
            const f32x4 ka4 = kk4 * a4;
            float d = (S.x * kk4.x + S.y * kk4.y) + (S.z * kk4.z + S.w * kk4.w); d = allsum16(d);
            S = S - S * x4 - d * ka4 + vv * kp4;
            float y = (S.x * r4.x + S.y * r4.y) + (S.z * r4.z + S.w * r4.w); y = allsum16(y);
            if (ks == 0) Y[(size_t)row * 512 + h * 64 + v] = y;
        }
        *(f32x4*)(A.out + O_SWKV + ((size_t)bh * 64 + v) * 64 + 4 * ks) = S;
    }
}

__device__ __forceinline__ void phase_m3(const Args& A, int G) {
    const int tid = threadIdx.x, lane = tid & 63, wave = tid >> 6;
    const int gw = blockIdx.x * 8 + wave, NGW = G * 8;
    unsigned char* ws = A.ws;
    const bf16* U = (const bf16*)(ws + WS_U); const bf16* GA = (const bf16*)((unsigned char*)A.out + DO_GA); const bf16* LRU = (const bf16*)(ws + WS_LRU);
    const float* Y = (const float*)(ws + WS_Y); const float* CARRY = (const float*)((unsigned char*)A.out + DO_CARRY); const float* BON = (const float*)((unsigned char*)A.out + DO_BON);
    bf16* MIX = (bf16*)(ws + WS_MIX);
    const float* mu = A.in[I_MU]; const float* sts = A.in[I_STS];
    for (int row = gw; row < MP; row += NGW) {
        bf16* mo = MIX + (size_t)row * D;
        const RowInfo ri = row_info(row);
        if (ri.kind == 3) { ((u32x4*)mo)[lane] = (u32x4){0u, 0u, 0u, 0u}; ((u32x4*)mo)[64 + lane] = (u32x4){0u, 0u, 0u, 0u}; continue; }
        const int r1 = row_back(ri, row, 1);
#pragma unroll 2
        for (int h = 0; h < NH; ++h) {
            const int c = h * 64 + lane;
            const float y = Y[(size_t)row * 512 + c];
            const float mean = wave_sum(y) * (1.f / 64.f), dv = y - mean, var = wave_sum(dv * dv) * (1.f / 64.f);
            const float yn = dv * rsqrtf(var + GN_EPS) * A.in[I_GNG][c] + A.in[I_GNB][c];
            const float uv = bf2f(U[(size_t)row * DIN + 1024 + c]);
            float pv; if (r1 >= 0) pv = bf2f(U[(size_t)r1 * DIN + 1024 + c]); else if (ri.kind == 1) pv = sts[(size_t)ri.b * DTMP + 1024 + c]; else pv = 0.f;
            const float vv = uv + (pv - uv) * mu[1024 + c];
            const float g = bf2f(GA[(size_t)row * 1536 + 1024 + c]);
            mo[c] = (bf16)f2bf((yn + BON[(size_t)row * 8 + h] * vv) * g);
        }
        {
            const int c = 8 * lane;
            float hv[8], pp[8], gt[8];
            unpack8(*(const u32x4*)(LRU + (size_t)row * 1024 + c), hv); unpack8(*(const u32x4*)(LRU + (size_t)row * 1024 + 512 + c), pp);
            unpack8(*(const u32x4*)(U + (size_t)row * DIN + DTMP + 512 + c), gt);
            if (ri.kind == 0) { const float* cr = CARRY + ((size_t)ri.b * 64 + ((row & 2047) >> 5)) * 512 + c; const f32x4 c0 = *(const f32x4*)cr, c1 = *(const f32x4*)(cr + 4);
#pragma unroll
                for (int i = 0; i < 4; ++i) { hv[i] += pp[i] * c0[i]; hv[4 + i] += pp[4 + i] * c1[i]; } }
            float z[8], s = 0.f;
#pragma unroll
            for (int i = 0; i < 8; ++i) { z[i] = hv[i] * gelu_tanh(gt[i]); s += z[i] * z[i]; }
            const float rs = rsqrtf(wave_sum(s) * (1.f / 512.f) + EPS);
            const f32x4 g0 = *(const f32x4*)(A.in[I_LOG] + c), g1 = *(const f32x4*)(A.in[I_LOG] + c + 4);
            u32x4 w; w.x = pk2(z[0] * rs * g0.x, z[1] * rs * g0.y); w.y = pk2(z[2] * rs * g0.z, z[3] * rs * g0.w); w.z = pk2(z[4] * rs * g1.x, z[5] * rs * g1.y); w.w = pk2(z[6] * rs * g1.z, z[7] * rs * g1.w);
            *(u32x4*)(mo + 512 + c) = w;
        }
    }
}

__device__ __forceinline__ void phase_final(const Args& A, int G) {
    const int tid = threadIdx.x, lane = tid & 63, wave = tid >> 6;
    const int gw = blockIdx.x * 8 + wave, NGW = G * 8;
    const float* ssq = (const float*)(A.ws + WS_SSQ2); const float* gf = A.in[I_NFG];
    for (int row = gw; row < M_MAIN; row += NGW) {
        const float rs = row_rs(ssq, row);
        f32x4* p = (f32x4*)(A.out + (size_t)row * D);
#pragma unroll
        for (int j = 0; j < 4; ++j) { const f32x4 g = ((const f32x4*)gf)[lane + 64 * j]; f32x4 v = p[lane + 64 * j]; v = v * rs * g; p[lane + 64 * j] = v; }
    }
}

namespace cg = cooperative_groups;
__global__ void __launch_bounds__(512, 2) mk_fwd(Args args) {
    extern __shared__ __attribute__((aligned(16))) unsigned char lds_raw[];
    LAS unsigned char* lds = (LAS unsigned char*)lds_raw;
    const int G = gridDim.x, tid = threadIdx.x;
    volatile LAS unsigned* MISC = (volatile LAS unsigned*)(lds + 131072 + 320);
    if (tid < 64) ((LAS unsigned*)(lds + 131072))[tid + 64] = 0u, ((LAS unsigned*)(lds + 131072))[tid] = 0u;
    __syncthreads();
    const int lo = args.ph_lo, hi = args.ph_hi;
    XcdBarrier bar; bar.bar = (unsigned*)(args.ws + WS_CTL) + 4096; bar.x = 0; bar.st = nullptr;
    if (hi - lo > 1) bar = xcd_barrier_post((unsigned*)(args.ws + WS_CTL) + 4096, MISC + 8);
    if (lo < 0) cg::this_grid().sync();
#define IN(k) (lo <= (k) && (k) < hi)
#define SEAM(k) do { if (IN(k) && IN((k) + 1)) xcd_barrier(bar); } while (0)
    unsigned char* ws = args.ws; unsigned char* ob = (unsigned char*)args.out;
    if (IN(0)) { phase_p0(args, lds, G); } SEAM(0);
    if (IN(1)) { pg8::Gemm g{(const bf16*)(ws + WS_XN), (const bf16*)(ws + WS_WIN), MP, DIN, D}; pg8::StaticOrder S; S.init(MP, DIN, G, (int)blockIdx.x);
        EpiPlain E{(bf16*)(ws + WS_U), DIN}; pg8::gemm_phase<EpiPlain, pg8::StaticOrder, true, true>(lds, g, S, E); } SEAM(1);
    if (IN(2)) { phase_e1(args, G); } SEAM(2);
    if (IN(3)) {
        { pg8::Gemm g{(const bf16*)(ws + WS_AP), (const bf16*)(ws + WS_BA), MP, 1536, 256}; pg8::StaticOrder S; S.init(MP, 1536, G, (int)blockIdx.x);
          EpiPlain E{(bf16*)(ob + DO_GA), 1536}; pg8::gemm_phase<EpiPlain, pg8::StaticOrder, true, true>(lds, g, S, E); }
        { pg8::Gemm g{(const bf16*)(ws + WS_XC), (const bf16*)(ws + WS_BB), MP, 1024, 512}; pg8::StaticOrder S; S.init(MP, 1024, G, (int)blockIdx.x);
          EpiPlain E{(bf16*)(ws + WS_GB), 1024}; pg8::gemm_phase<EpiPlain, pg8::StaticOrder, true, true>(lds, g, S, E); }
    } SEAM(3);
    if (IN(4)) { phase_e2(args, G); } SEAM(4);
    if (IN(5)) { phase_m2(args, lds, G); } SEAM(5);
    if (IN(6)) { phase_m3(args, G); } SEAM(6);
    if (IN(7)) { pg8::Gemm g{(const bf16*)(ws + WS_MIX), (const bf16*)(ob + DO_WOUT), MP, D, D}; pg8::StaticOrder S; S.init(MP, D, G, (int)blockIdx.x);
        EpiX1 E{args.in[I_XP], args.in[I_XS], args.in[I_META], args.out, (bf16*)(ws + WS_X1B), (float*)(ws + WS_SSQ1)};
        pg8::gemm_phase<EpiX1, pg8::StaticOrder, true, true>(lds, g, S, E); } SEAM(7);
    if (IN(8)) { pg8::Gemm g{(const bf16*)(ws + WS_X1B), (const bf16*)(ws + WS_WUP), MP, DFF, D}; pg8::StaticOrder S; S.init(MP, DFF, G, (int)blockIdx.x);
        EpiUp E{(const float*)(ws + WS_SSQ1), (bf16*)(ws + WS_UP), args.out + O_PFC, args.out + O_SFC};
        pg8::gemm_phase<EpiUp, pg8::StaticOrder, true, true>(lds, g, S, E); } SEAM(8);
    if (IN(9)) { pg8::Gemm g{(const bf16*)(ws + WS_X1B), (const bf16*)(ws + WS_WGATE), M_MAIN, DFF, D}; pg8::StaticOrder S; S.init(M_MAIN, DFF, G, (int)blockIdx.x);
        EpiGate E{(const float*)(ws + WS_SSQ1), (const bf16*)(ws + WS_UP), args.in[I_SFC], args.in[I_FCW], args.in[I_FCB], (bf16*)(ws + WS_HID)};
        pg8::gemm_phase<EpiGate, pg8::StaticOrder, true, true>(lds, g, S, E); } SEAM(9);
    if (IN(10)) { pg8::Gemm g{(const bf16*)(ws + WS_HID), (const bf16*)(ws + WS_WDOWN), M_MAIN, D, DFF}; pg8::StaticOrder S; S.init(M_MAIN, D, G, (int)blockIdx.x);
        EpiDown E{args.out, (float*)(ws + WS_SSQ2)};
        pg8::gemm_phase<EpiDown, pg8::StaticOrder, true, true>(lds, g, S, E); } SEAM(10);
    if (IN(11)) { phase_final(args, G); }
#undef IN
#undef SEAM
}

extern "C" void kernel_launch(void* const* d_in, const int* in_sizes, int n_in, void* d_out, int out_size, void* d_ws, size_t ws_size, hipStream_t stream) {
    static int grid = 0;
    if (grid == 0) {
        if (n_in != N_IN || (size_t)out_size != O_END || ws_size < 256 * MiB) { fprintf(stderr, "kernel_launch: unexpected shapes n_in %d out %d ws %zu\n", n_in, out_size, ws_size); grid = -1; return; }
        int dev = 0, cus = 0, per_cu = 0;
        (void)hipGetDevice(&dev); (void)hipDeviceGetAttribute(&cus, hipDeviceAttributeMultiprocessorCount, dev);
        if (hipFuncSetAttribute((const void*)mk_fwd, hipFuncAttributeMaxDynamicSharedMemorySize, LDS_BYTES) != hipSuccess) { fprintf(stderr, "kernel_launch: hipFuncSetAttribute failed\n"); grid = -1; return; }
        if (hipOccupancyMaxActiveBlocksPerMultiprocessor(&per_cu, (const void*)mk_fwd, 512, LDS_BYTES) != hipSuccess || per_cu < 1) per_cu = 1;
        (void)hipGetLastError();
        grid = cus > 0 ? cus : 256;
    }
    if (grid < 0) return;
    Args a{};
    for (int i = 0; i < N_IN; ++i) a.in[i] = (const float*)d_in[i];
    a.out = (float*)d_out; a.ws = (unsigned char*)d_ws;
#if MK_ONE_LAUNCH
    (void)hipMemsetAsync((char*)d_ws + WS_CTL, 0, CTL_ZERO_BYTES, stream);
    a.ph_lo = 0; a.ph_hi = NPH;
    void* kargs[] = {&a};
    hipError_t e = hipLaunchCooperativeKernel((const void*)mk_fwd, dim3(grid), dim3(512), kargs, LDS_BYTES, stream);
    if (e != hipSuccess) fprintf(stderr, "cooperative launch failed: %s (grid %d)\n", hipGetErrorString(e), grid);
#else
    for (int ph = 0; ph < NPH; ++ph) { a.ph_lo = ph; a.ph_hi = ph + 1; hipLaunchKernelGGL(mk_fwd, dim3(grid), dim3(512), LDS_BYTES, stream, a); }
#endif
}
```

```cpp
#include <hip/hip_runtime.h>
#include <hip/hip_cooperative_groups.h>
#include <cstdio>
#include <cstdint>
#include <cmath>
namespace pg8 {
#define PG8_LAS __attribute__((address_space(3)))
typedef unsigned short bf16_t;
typedef short bf16x8 __attribute__((ext_vector_type(8)));
typedef float f32x4 __attribute__((ext_vector_type(4)));
typedef unsigned u32x4 __attribute__((ext_vector_type(4)));
constexpr int BM = 256, BK = 64, HALF = 128, HTB = HALF * BK * 2  , STAGE_BYTES = 8 * HTB, NXCD = 8, WGM = 8;

__host__ __device__ __forceinline__ int lds_byte(int r, int c) { const int st = (r >> 4) * 2 + (c >> 5), rr = r & 15, cc = c & 31, ob = rr * 64 + cc * 2; return st * 1024 + (ob ^ (((ob >> 9) & 1) << 5)); }
__host__ __device__ __forceinline__ void stage_rc(int b, int& R, int& C) { const int st = b / 1024, sb = b % 1024, swz = sb ^ (((sb >> 9) & 1) << 5); R = (st >> 1) * 16 + swz / 64; C = (st & 1) * 32 + (swz % 64) / 2; }
__host__ __device__ __forceinline__ int perm32(int rho) { const int n = rho >> 4, i = rho & 15; return 8 * (i >> 2) + 4 * n + (i & 3); }

struct Unit { int pm, pn; };
struct Gemm { const bf16_t* A; const bf16_t* Bt; int M, N, K; };

struct StaticOrder {
    int nM, nN, nwg, G, c;
    __host__ __device__ void init(int M, int N, int G_, int c_) { nM = M / BM; nN = N / BM; nwg = nM * nN; G = G_; c = c_; }
    __host__ __device__ bool next(int i, Unit& u) const {
        const long L = (long)i * G + c; if (L >= nwg) return false;
        int wgid = (int)L; { const int q = nwg / NXCD, r = nwg % NXCD, xcd = wgid % NXCD, off = wgid / NXCD; wgid = (xcd < r ? xcd * (q + 1) : r * (q + 1) + (xcd - r) * q) + off; }
        const int nig = WGM * nN, gid = wgid / nig, fm = gid * WGM, gsz = (nM - fm) < WGM ? (nM - fm) : WGM;
        u.pm = fm + ((wgid % nig) % gsz); u.pn = (wgid % nig) / gsz; return true;
    }
    __device__ __forceinline__ void a_ready(const Unit&) const {}
    __device__ __forceinline__ void done(const Unit&) const {}
};

__device__ __forceinline__ unsigned cvt_pk_bf16(float lo, float hi) { unsigned r; asm volatile("v_cvt_pk_bf16_f32 %0, %1, %2" : "=v"(r) : "v"(lo), "v"(hi)); return r; }
typedef float f32x2 __attribute__((ext_vector_type(2)));
template <class Epi, class Sched, bool ALIGN_EPI = false, bool SP2 = false>
__device__ __forceinline__ void gemm_phase(PG8_LAS unsigned char* lds, const Gemm g, const Sched& S, const Epi& E) {
    const int tid = threadIdx.x, wid = __builtin_amdgcn_readfirstlane(tid >> 6), lane = tid & 63, wr = wid >> 2, wc = wid & 3, fr = lane & 15, fq = lane >> 4;
    const int K = g.K, nt = K / BK;
    unsigned voffA[2], voffB[2];
#pragma unroll
    for (int i = 0; i < 2; ++i) { int R, C; stage_rc(tid * 16 + i * 8192, R, C); const int Rb = Epi::PERM ? ((R & ~31) + perm32(R & 31)) : R;
        voffA[i] = (unsigned)(R * K + C) * 2u; voffB[i] = (unsigned)(Rb * K + C) * 2u; }
    const size_t kstep = (size_t)(BK * 2);
    const size_t hstep = (size_t)HALF * K * 2;
    const size_t tstep = 2 * hstep;
    const unsigned ldsw = (unsigned)wid * 1024u;
    const int aoff = lds_byte(wr * 64 + fr, fq * 8), boff = lds_byte(wc * 32 + fr, fq * 8);
#define PG8_SA(b, h) (((b) * 2 + (h)) * HTB)
#define PG8_SB(b, h) ((4 + (b) * 2 + (h)) * HTB)
#define PG8_STAGE(bufoff, gbase, voff) do { _Pragma("unroll") for (int _i = 0; _i < 2; ++_i) \
        __builtin_amdgcn_global_load_lds((const unsigned*)((const char*)(gbase) + (voff)[_i]), (PG8_LAS unsigned*)(lds + (bufoff) + ldsw + _i * 8192), 16, 0, 0); } while (0)
#define PG8_LDA(dst, b, h) do { _Pragma("unroll") for (int m = 0; m < 4; ++m) _Pragma("unroll") for (int k = 0; k < 2; ++k) dst[m][k] = *(const PG8_LAS bf16x8*)(lds + PG8_SA(b, h) + aoff + m * 2048 + k * 1024); } while (0)
#define PG8_LDB(dst, b, h) do { _Pragma("unroll") for (int n = 0; n < 2; ++n) _Pragma("unroll") for (int k = 0; k < 2; ++k) dst[n][k] = *(const PG8_LAS bf16x8*)(lds + PG8_SB(b, h) + boff + n * 2048 + k * 1024); } while (0)
#define PG8_MMA(ai, bj, At, Bt) do { __builtin_amdgcn_s_setprio(1); _Pragma("unroll") for (int m = 0; m < 4; ++m) _Pragma("unroll") for (int n = 0; n < 2; ++n) _Pragma("unroll") for (int k = 0; k < 2; ++k) \
        acc[ai][bj][m][n] = __builtin_amdgcn_mfma_f32_16x16x32_bf16(Bt[n][k], At[m][k], acc[ai][bj][m][n], 0, 0, 0); __builtin_amdgcn_s_setprio(0); } while (0)
#define PG8_WAIT_V(n) asm volatile("s_waitcnt vmcnt(" #n ")" ::: "memory")
#define PG8_WAIT_L(n) asm volatile("s_waitcnt lgkmcnt(" #n ")" ::: "memory")
#define PG8_BAR __builtin_amdgcn_s_barrier()
#define PG8_SCHED __builtin_amdgcn_sched_barrier(0)
    Unit cur, nxt; int ui = 0;
    if (!S.next(0, cur)) return;
    f32x4 acc[2][2][4][2];
#pragma unroll
    for (int a = 0; a < 2; ++a)
#pragma unroll
        for (int b = 0; b < 2; ++b)
#pragma unroll
            for (int m = 0; m < 4; ++m)
#pragma unroll
                for (int n = 0; n < 2; ++n) acc[a][b][m][n] = (f32x4){0.f, 0.f, 0.f, 0.f};
    bf16x8 At[4][2], B0[2][2], B1[2][2];
    const char* cA = (const char*)g.A + (size_t)cur.pm * tstep; const char* cB = (const char*)g.Bt + (size_t)cur.pn * tstep;
    S.a_ready(cur);
    if constexpr (SP2) {
        PG8_STAGE(PG8_SB(0, 0), cB, voffB); PG8_STAGE(PG8_SB(0, 1), cB + hstep, voffB); PG8_STAGE(PG8_SA(0, 0), cA, voffA); PG8_STAGE(PG8_SA(0, 1), cA + hstep, voffA);
        if (wr == 1) PG8_BAR;
        PG8_WAIT_V(2); PG8_BAR;
        PG8_STAGE(PG8_SB(1, 0), cB + kstep, voffB); PG8_STAGE(PG8_SA(1, 0), cA + kstep, voffA); PG8_STAGE(PG8_SB(1, 1), cB + hstep + kstep, voffB);
        PG8_WAIT_V(6); PG8_BAR;
    } else {
        PG8_STAGE(PG8_SB(0, 0), cB, voffB); PG8_STAGE(PG8_SA(0, 0), cA, voffA); PG8_STAGE(PG8_SB(0, 1), cB + hstep, voffB); PG8_STAGE(PG8_SA(0, 1), cA + hstep, voffA);
        if (wr == 1) PG8_BAR;
        PG8_WAIT_V(4); PG8_BAR;
        PG8_STAGE(PG8_SB(1, 0), cB + kstep, voffB); PG8_STAGE(PG8_SA(1, 0), cA + kstep, voffA); PG8_STAGE(PG8_SB(1, 1), cB + hstep + kstep, voffB);
        PG8_WAIT_V(6); PG8_BAR;
    }
    for (;;) {
        const bool has_next = S.next(ui + 1, nxt);
        const char* nA = has_next ? (const char*)g.A + (size_t)nxt.pm * tstep : cA; const char* nB = has_next ? (const char*)g.Bt + (size_t)nxt.pn * tstep : cB;
        for (int t = 0; t < nt; t += 2) {
            const bool last = (t == nt - 2);
            const char* a1 = cA + (size_t)(t + 1) * kstep;
            const char* a2 = last ? nA : cA + (size_t)(t + 2) * kstep; const char* b2 = last ? nB : cB + (size_t)(t + 2) * kstep;
            const char* a3 = a2 + kstep; const char* b3 = b2 + kstep;
            if (last && has_next) S.a_ready(nxt);
            if constexpr (SP2) {
            PG8_LDB(B0, 0, 0); PG8_LDB(B1, 0, 1); PG8_SCHED; PG8_LDA(At, 0, 0); PG8_STAGE(PG8_SA(1, 1), a1 + hstep, voffA);
            PG8_WAIT_V(8); PG8_WAIT_L(0); PG8_BAR; PG8_MMA(0, 0, At, B0); PG8_MMA(0, 1, At, B1); PG8_BAR; PG8_SCHED;
            PG8_LDA(At, 0, 1); PG8_STAGE(PG8_SB(0, 0), b2, voffB); PG8_STAGE(PG8_SB(0, 1), b2 + hstep, voffB); PG8_STAGE(PG8_SA(0, 0), a2, voffA);
            PG8_WAIT_V(8); PG8_WAIT_L(0); PG8_BAR; PG8_MMA(1, 0, At, B0); PG8_MMA(1, 1, At, B1); PG8_BAR; PG8_SCHED;
            PG8_LDB(B0, 1, 0); PG8_LDB(B1, 1, 1); PG8_SCHED; PG8_LDA(At, 1, 0); PG8_STAGE(PG8_SA(0, 1), a2 + hstep, voffA);
            PG8_WAIT_V(8); PG8_WAIT_L(0); PG8_BAR; PG8_MMA(0, 0, At, B0); PG8_MMA(0, 1, At, B1); PG8_BAR; PG8_SCHED;
            PG8_LDA(At, 1, 1); PG8_STAGE(PG8_SB(1, 0), b3, voffB); PG8_STAGE(PG8_SB(1, 1), b3 + hstep, voffB); PG8_STAGE(PG8_SA(1, 0), a3, voffA);
            PG8_WAIT_V(8); PG8_WAIT_L(0); PG8_BAR; PG8_MMA(1, 0, At, B0); PG8_MMA(1, 1, At, B1); PG8_BAR; PG8_SCHED;
            } else {
            PG8_LDB(B0, 0, 0); PG8_SCHED; PG8_LDA(At, 0, 0); PG8_STAGE(PG8_SA(1, 1), a1 + hstep, voffA);
            PG8_WAIT_L(8); PG8_BAR; PG8_WAIT_L(0); PG8_MMA(0, 0, At, B0); PG8_BAR; PG8_SCHED;
            PG8_LDB(B1, 0, 1); PG8_STAGE(PG8_SB(0, 0), b2, voffB);
            PG8_BAR; PG8_WAIT_L(0); PG8_MMA(0, 1, At, B1); PG8_BAR;
            PG8_LDA(At, 0, 1); PG8_STAGE(PG8_SA(0, 0), a2, voffA);
            PG8_BAR; PG8_WAIT_L(0); PG8_MMA(1, 0, At, B0); PG8_BAR; PG8_SCHED;
            PG8_STAGE(PG8_SB(0, 1), b2 + hstep, voffB);
            PG8_WAIT_V(6); PG8_BAR; PG8_MMA(1, 1, At, B1); PG8_BAR;
            PG8_LDB(B0, 1, 0); PG8_SCHED; PG8_LDA(At, 1, 0); PG8_STAGE(PG8_SA(0, 1), a2 + hstep, voffA);
            PG8_WAIT_L(8); PG8_BAR; PG8_WAIT_L(0); PG8_MMA(0, 0, At, B0); PG8_BAR; PG8_SCHED;
            PG8_LDB(B1, 1, 1); PG8_STAGE(PG8_SB(1, 0), b3, voffB);
            PG8_BAR; PG8_WAIT_L(0); PG8_MMA(0, 1, At, B1); PG8_BAR;
            PG8_LDA(At, 1, 1); PG8_STAGE(PG8_SA(1, 0), a3, voffA);
            PG8_BAR; PG8_WAIT_L(0); PG8_MMA(1, 0, At, B0); PG8_BAR; PG8_SCHED;
            PG8_STAGE(PG8_SB(1, 1), b3 + hstep, voffB);
            PG8_WAIT_V(6); PG8_BAR; PG8_MMA(1, 1, At, B1); PG8_BAR;
            }
        }
        if constexpr (ALIGN_EPI) { if (wr == 0) PG8_BAR; }
        if constexpr (!Epi::AFTER_DRAIN) { E(acc, cur, wr, wc, fr, fq); S.done(cur); }
        if (!has_next) break;
#pragma unroll
        for (int a = 0; a < 2; ++a)
#pragma unroll
            for (int b = 0; b < 2; ++b)
#pragma unroll
                for (int m = 0; m < 4; ++m)
#pragma unroll
                    for (int n = 0; n < 2; ++n) acc[a][b][m][n] = (f32x4){0.f, 0.f, 0.f, 0.f};
        cur = nxt; cA = nA; cB = nB; ++ui;
        if constexpr (ALIGN_EPI) { if (wr == 1) PG8_BAR; }
    }
    PG8_WAIT_V(0);
    if constexpr (!ALIGN_EPI) { if (wr == 0) PG8_BAR; }
    PG8_BAR;
    if constexpr (Epi::AFTER_DRAIN) { E.fused(acc, cur, wr, wc, fr, fq, lds, wid, lane); S.done(cur); }
#undef PG8_SA
#undef PG8_SB
#undef PG8_STAGE
#undef PG8_LDA
#undef PG8_LDB
#undef PG8_MMA
#undef PG8_WAIT_V
#undef PG8_WAIT_L
#undef PG8_BAR
#undef PG8_SCHED
}
}

#ifndef MK_REP_MASK
#define MK_REP_MASK 0
#endif
#ifndef MK_ONE_LAUNCH
#define MK_ONE_LAUNCH 1
#endif
#define LAS __attribute__((address_space(3)))
typedef unsigned short bf16;
typedef float f32x4 __attribute__((ext_vector_type(4)));
typedef unsigned u32x4 __attribute__((ext_vector_type(4)));
typedef unsigned u32x2 __attribute__((ext_vector_type(2)));
constexpr int D = 1024, NB = 8, SEQ = 2048, NMETA = 16, TP = SEQ + NMETA, DB = 128, DS = 4;
constexpr int NH = 8, DTMP = 1792, DIN = 2816, DFF = 3072;
constexpr int R_SAMPLE = NB * SEQ, R_META = R_SAMPLE + DB * DS, R_END = R_META + NMETA, MP = 17152, M_MAIN = 16896;
constexpr float EPS = 1e-6f, GN_EPS = 64e-5f;
constexpr int NPH = 12;
constexpr int LDS_BYTES = 147456;
enum { I_XP = 0, I_XS, I_STS, I_SWKV, I_SLC, I_SLH, I_SFC, I_META, I_N1G, I_WIN, I_MU, I_W0, I_WUP, I_A0, I_AUP, I_GUP, I_KK, I_KA, I_RK,
       I_GNG, I_GNB, I_LCW, I_LCB, I_LWA, I_LBA, I_LWX, I_LBX, I_LAM, I_LOG, I_WOUT, I_N2G, I_FUP, I_FGATE, I_FCW, I_FCB, I_FDOWN, I_NFG, N_IN };
constexpr size_t O_YP = 0, O_YS = 16777216, O_PSHIFT = 17301504, O_PWKV = 17315840, O_PLC = 17577984, O_PLH = 17590272, O_PFC = 17594368,
                 O_SSHIFT = 17643520, O_SWKV = 17872896, O_SLC = 22067200, O_SLH = 22263808, O_SFC = 22329344, O_END = 23115776;
constexpr size_t MiB = 1u << 20;
constexpr size_t WS_CTL = 0, CTL_ZERO_BYTES = 65536;
constexpr size_t WS_SSQ1 = 1 * MiB, WS_SSQ2 = WS_SSQ1 + (size_t)MP * 16 * 4;
constexpr size_t WS_WUP = 4 * MiB, WS_WGATE = 10 * MiB, WS_WDOWN = 16 * MiB;
constexpr size_t WS_X1B = 22 * MiB, WS_UP = WS_X1B + (size_t)MP * D * 2, WS_HID = WS_UP + (size_t)MP * DFF * 2;
constexpr size_t WS_U = 22 * MiB;
constexpr size_t WS_XN = 115 * MiB, WS_WIN = WS_XN + (size_t)MP * D * 2;
constexpr size_t WS_AP = 190 * MiB, WS_XC = 199 * MiB, WS_BA = 216 * MiB, WS_BB = 217 * MiB, WS_GB = 220 * MiB;
constexpr size_t WS_REC = 115 * MiB, WS_LRU = 182 * MiB, WS_Y = 220 * MiB, WS_MIX = 115 * MiB;
static_assert(WS_SSQ2 + (size_t)MP * 16 * 4 <= WS_WUP, "ssq");
static_assert(WS_HID + (size_t)M_MAIN * DFF * 2 <= 256 * MiB, "hid");
static_assert(WS_U + (size_t)MP * DIN * 2 <= WS_XN, "u");
static_assert(WS_WIN + (size_t)DIN * D * 2 <= WS_LRU, "win");
static_assert(WS_AP + (size_t)MP * 256 * 2 <= WS_XC && WS_XC + (size_t)MP * 512 * 2 <= WS_BA, "ap/xc");
static_assert(WS_GB + (size_t)MP * 1024 * 2 <= 256 * MiB, "gb");
static_assert(WS_REC + (size_t)R_END * 4096 <= WS_LRU && WS_LRU + (size_t)R_END * 2048 <= WS_BA, "rec/lru");
static_assert(WS_Y + (size_t)R_END * 2048 <= 256 * MiB, "y");
constexpr size_t DO_GA = 0, DO_LTOT = (size_t)MP * 1536 * 2, DO_CARRY = DO_LTOT + 513 * 2 * 512 * 4, DO_BON = DO_CARRY + 8 * 64 * 512 * 4, DO_WOUT = O_SFC * 4;
static_assert(DO_BON + (size_t)R_END * 8 * 4 <= O_PSHIFT * 4, "d_out scratch");

struct Args { const float* in[N_IN]; float* out; unsigned char* ws; int ph_lo, ph_hi; };

__device__ __forceinline__ float bf2f(bf16 h) { return __uint_as_float(((unsigned)h) << 16); }
__device__ __forceinline__ unsigned f2bf(float f) { unsigned u = __float_as_uint(f); return (u + 0x7fffu + ((u >> 16) & 1u)) >> 16; }
__device__ __forceinline__ unsigned pk2(float lo, float hi) { return f2bf(lo) | (f2bf(hi) << 16); }
__device__ __forceinline__ float lo16(unsigned w) { return __uint_as_float(w << 16); }
__device__ __forceinline__ float hi16(unsigned w) { return __uint_as_float(w & 0xffff0000u); }
__device__ __forceinline__ float sigm(float x) { return 1.f / (1.f + __expf(-x)); }
__device__ __forceinline__ float softplus_(float z) { return fmaxf(z, 0.f) + log1pf(__expf(-fabsf(z))); }
__device__ __forceinline__ float gelu_tanh(float x) { const float u = 1.5957691216057308f * (x + 0.044715f * x * x * x); return x / (1.f + __expf(-u)); }
__device__ __forceinline__ float tanh_(float x) { const float e = __expf(2.f * x); return 1.f - 2.f / (e + 1.f); }
__device__ __forceinline__ float wave_sum(float v) {
#pragma unroll
    for (int o = 1; o < 64; o <<= 1) v += __shfl_xor(v, o);
    return v;
}
template <int CTRL> __device__ __forceinline__ float dpp_f(float x) { return __int_as_float(__builtin_amdgcn_update_dpp(0, __float_as_int(x), CTRL, 0xF, 0xF, true)); }
__device__ __forceinline__ float allsum16(float x) { x += dpp_f<0xB1>(x); x += dpp_f<0x4E>(x); x += dpp_f<0x141>(x); x += dpp_f<0x140>(x); return x; }

struct RowInfo { int kind, b, t; };
__device__ __forceinline__ RowInfo row_info(int row) {
    RowInfo r;
    if (row < R_SAMPLE) { r.kind = 0; r.b = row >> 11; r.t = (row & 2047) + NMETA; }
    else if (row < R_META) { r.kind = 1; r.b = (row - R_SAMPLE) >> 2; r.t = (row - R_SAMPLE) & 3; }
    else if (row < R_END) { r.kind = 2; r.b = 0; r.t = row - R_META; }
    else { r.kind = 3; r.b = 0; r.t = 0; }
    return r;
}
__device__ __forceinline__ int prompt_row(int b, int t) { return t < NMETA ? R_META + t : b * SEQ + t - NMETA; }
__device__ __forceinline__ int row_back(const RowInfo& ri, int row, int j) {
    const int tt = ri.t - j; if (tt < 0) return -1;
    if (ri.kind == 1) return row - j;
    return prompt_row(ri.b, tt);
}
__device__ __forceinline__ void unpack8(const u32x4 w, float (&f)[8]) {
    f[0] = lo16(w.x); f[1] = hi16(w.x); f[2] = lo16(w.y); f[3] = hi16(w.y); f[4] = lo16(w.z); f[5] = hi16(w.z); f[6] = lo16(w.w); f[7] = hi16(w.w);
}
__device__ __forceinline__ float row_rs(const float* ssq, int row) {
    const f32x4* p = (const f32x4*)(ssq + (size_t)row * 16); const f32x4 a = p[0], b = p[1], c = p[2], d = p[3];
    const float s = ((a.x + a.y) + (a.z + a.w)) + ((b.x + b.y) + (b.z + b.w)) + ((c.x + c.y) + (c.z + c.w)) + ((d.x + d.y) + (d.z + d.w));
    return rsqrtf(s * (1.f / 1024.f) + EPS);
}

#define EPI_ROW(ai, m) (u.pm * 256 + (ai) * 128 + wr * 64 + (m) * 16 + fr)
#define EPI_COL(bj) (u.pn * 256 + (bj) * 128 + wc * 32 + 8 * fq)
struct EpiX1 {
    static constexpr bool PERM = true, AFTER_DRAIN = false;
    const float* xp; const float* xs; const float* meta; float* x1; bf16* x1b; float* ssq;
    __device__ __forceinline__ void operator()(const f32x4 (&acc)[2][2][4][2], const pg8::Unit& u, int wr, int wc, int fr, int fq) const {
#pragma unroll
        for (int ai = 0; ai < 2; ++ai)
#pragma unroll
            for (int m = 0; m < 4; ++m) {
                const int row = EPI_ROW(ai, m);
                const float* res = row < R_SAMPLE ? xp + (size_t)row * D : row < R_META ? xs + (size_t)(row - R_SAMPLE) * D : row < R_END ? meta + (size_t)(row - R_META) * D : nullptr;
                float s = 0.f;
#pragma unroll
                for (int bj = 0; bj < 2; ++bj) {
                    const int col = EPI_COL(bj);
                    f32x4 v0 = acc[ai][bj][m][0], v1 = acc[ai][bj][m][1];
                    if (res) { v0 += *(const f32x4*)(res + col); v1 += *(const f32x4*)(res + col + 4); }
                    if (row < M_MAIN) { *(f32x4*)(x1 + (size_t)row * D + col) = v0; *(f32x4*)(x1 + (size_t)row * D + col + 4) = v1; }
                    u32x4 w; w.x = pk2(v0.x, v0.y); w.y = pk2(v0.z, v0.w); w.z = pk2(v1.x, v1.y); w.w = pk2(v1.z, v1.w);
                    *(u32x4*)(x1b + (size_t)row * D + col) = w;
                    s += (v0.x * v0.x + v0.y * v0.y) + (v0.z * v0.z + v0.w * v0.w) + (v1.x * v1.x + v1.y * v1.y) + (v1.z * v1.z + v1.w * v1.w);
                }
                s += __shfl_xor(s, 16); s += __shfl_xor(s, 32);
                if (fq == 0) ssq[(size_t)row * 16 + u.pn * 4 + wc] = s;
            }
    }
};
struct EpiUp {
    static constexpr bool PERM = true, AFTER_DRAIN = false;
    const float* ssq; bf16* up; float* pffn; float* sffn;
    __device__ __forceinline__ void operator()(const f32x4 (&acc)[2][2][4][2], const pg8::Unit& u, int wr, int wc, int fr, int fq) const {
#pragma unroll
        for (int ai = 0; ai < 2; ++ai)
#pragma unroll
            for (int m = 0; m < 4; ++m) {
                const int row = EPI_ROW(ai, m);
                const float rs = row_rs(ssq, row);
                const RowInfo ri = row_info(row);
                float* st = nullptr;
                if (ri.kind == 0 && ri.t >= TP - 2) st = pffn + ((size_t)ri.b * 2 + (ri.t - (TP - 2))) * DFF;
                else if (ri.kind == 1 && ri.t >= 2) st = sffn + ((size_t)ri.b * 2 + (ri.t - 2)) * DFF;
#pragma unroll
                for (int bj = 0; bj < 2; ++bj) {
                    const int col = EPI_COL(bj);
                    const f32x4 v0 = acc[ai][bj][m][0] * rs, v1 = acc[ai][bj][m][1] * rs;
                    u32x4 w; w.x = pk2(v0.x, v0.y); w.y = pk2(v0.z, v0.w); w.z = pk2(v1.x, v1.y); w.w = pk2(v1.z, v1.w);
                    *(u32x4*)(up + (size_t)row * DFF + col) = w;
                    if (st) { *(f32x4*)(st + col) = v0; *(f32x4*)(st + col + 4) = v1; }
                }
            }
    }
};
struct EpiGate {
    static constexpr bool PERM = true, AFTER_DRAIN = false;
    const float* ssq; const bf16* up; const float* stf; const float* cw; const float* cb; bf16* hid;
    __device__ __forceinline__ void operator()(const f32x4 (&acc)[2][2][4][2], const pg8::Unit& u, int wr, int wc, int fr, int fq) const {
#pragma unroll
        for (int ai = 0; ai < 2; ++ai)
#pragma unroll
            for (int m = 0; m < 4; ++m) {
                const int row = EPI_ROW(ai, m);
                const float rs = row_rs(ssq, row);
                const RowInfo ri = row_info(row);
                const int r1 = row_back(ri, row, 1), r2 = row_back(ri, row, 2);
#pragma unroll
                for (int bj = 0; bj < 2; ++bj) {
                    const int col = EPI_COL(bj);
                    float g[8], u0[8], p1[8], p2[8];
                    { const f32x4 v0 = acc[ai][bj][m][0] * rs, v1 = acc[ai][bj][m][1] * rs; g[0] = v0.x; g[1] = v0.y; g[2] = v0.z; g[3] = v0.w; g[4] = v1.x; g[5] = v1.y; g[6] = v1.z; g[7] = v1.w; }
                    unpack8(*(const u32x4*)(up + (size_t)row * DFF + col), u0);
                    if (r1 >= 0) unpack8(*(const u32x4*)(up + (size_t)r1 * DFF + col), p1);
                    else if (ri.kind == 1) { const float* s = stf + ((size_t)ri.b * 2 + (1 + ri.t)) * DFF + col; const f32x4 a = *(const f32x4*)s, b = *(const f32x4*)(s + 4);
                        p1[0] = a.x; p1[1] = a.y; p1[2] = a.z; p1[3] = a.w; p1[4] = b.x; p1[5] = b.y; p1[6] = b.z; p1[7] = b.w; }
                    else {
#pragma unroll
                        for (int i = 0; i < 8; ++i) p1[i] = 0.f; }
                    if (r2 >= 0) unpack8(*(const u32x4*)(up + (size_t)r2 * DFF + col), p2);
                    else if (ri.kind == 1) { const float* s = stf + ((size_t)ri.b * 2 + ri.t) * DFF + col; const f32x4 a = *(const f32x4*)s, b = *(const f32x4*)(s + 4);
                        p2[0] = a.x; p2[1] = a.y; p2[2] = a.z; p2[3] = a.w; p2[4] = b.x; p2[5] = b.y; p2[6] = b.z; p2[7] = b.w; }
                    else {
#pragma unroll
                        for (int i = 0; i < 8; ++i) p2[i] = 0.f; }
                    float o[8];
#pragma unroll
                    for (int h = 0; h < 2; ++h) {
                        const f32x4 w0 = *(const f32x4*)(cw + col + 4 * h), w1 = *(const f32x4*)(cw + DFF + col + 4 * h), w2 = *(const f32x4*)(cw + 2 * DFF + col + 4 * h), bb = *(const f32x4*)(cb + col + 4 * h);
#pragma unroll
                        for (int i = 0; i < 4; ++i) { const int e = 4 * h + i; const float c = bb[i] + w0[i] * p2[e] + w1[i] * p1[e] + w2[i] * u0[e]; o[e] = gelu_tanh(c) * g[e]; }
                    }
                    u32x4 w; w.x = pk2(o[0], o[1]); w.y = pk2(o[2], o[3]); w.z = pk2(o[4], o[5]); w.w = pk2(o[6], o[7]);
                    *(u32x4*)(hid + (size_t)row * DFF + col) = w;
                }
            }
    }
};
struct EpiDown {
    static constexpr bool PERM = true, AFTER_DRAIN = false;
    float* x; float* ssq;
    __device__ __forceinline__ void operator()(const f32x4 (&acc)[2][2][4][2], const pg8::Unit& u, int wr, int wc, int fr, int fq) const {
#pragma unroll
        for (int ai = 0; ai < 2; ++ai)
#pragma unroll
            for (int m = 0; m < 4; ++m) {
                const int row = EPI_ROW(ai, m);
                float s = 0.f;
#pragma unroll
                for (int bj = 0; bj < 2; ++bj) {
                    const int col = EPI_COL(bj);
                    float* p = x + (size_t)row * D + col;
                    const f32x4 v0 = acc[ai][bj][m][0] + *(const f32x4*)p, v1 = acc[ai][bj][m][1] + *(const f32x4*)(p + 4);
                    *(f32x4*)p = v0; *(f32x4*)(p + 4) = v1;
                    s += (v0.x * v0.x + v0.y * v0.y) + (v0.z * v0.z + v0.w * v0.w) + (v1.x * v1.x + v1.y * v1.y) + (v1.z * v1.z + v1.w * v1.w);
                }
                s += __shfl_xor(s, 16); s += __shfl_xor(s, 32);
                if (fq == 0) ssq[(size_t)row * 16 + u.pn * 4 + wc] = s;
            }
    }
};
struct EpiPlain {
    static constexpr bool PERM = true, AFTER_DRAIN = false;
    bf16* O; int ldc;
    __device__ __forceinline__ void operator()(const f32x4 (&acc)[2][2][4][2], const pg8::Unit& u, int wr, int wc, int fr, int fq) const {
#pragma unroll
        for (int ai = 0; ai < 2; ++ai)
#pragma unroll
            for (int m = 0; m < 4; ++m) {
                const int row = EPI_ROW(ai, m);
#pragma unroll
                for (int bj = 0; bj < 2; ++bj) {
                    const int col = EPI_COL(bj);
                    const f32x4 v0 = acc[ai][bj][m][0], v1 = acc[ai][bj][m][1];
                    u32x4 w; w.x = pk2(v0.x, v0.y); w.y = pk2(v0.z, v0.w); w.z = pk2(v1.x, v1.y); w.w = pk2(v1.z, v1.w);
                    *(u32x4*)(O + (size_t)row * ldc + col) = w;
                }
            }
    }
};

#define XB_TMO      128
#define XB_XCNT(j)  (256  + 64 * (j))
#define XB_XSUB(j)  (1280 + 64 * (j))
#define XB_XGEN(j)  (2304 + 64 * (j))
#define XB_TOP      3328
#define XB_TOPGEN   3392
#define XCD_BAR_WORDS 3456
#define XB_SPIN_CAP (1u << 22)
__device__ __forceinline__ unsigned xb_ld(unsigned* p)              { return __hip_atomic_load(p, __ATOMIC_RELAXED, __HIP_MEMORY_SCOPE_AGENT); }
__device__ __forceinline__ unsigned xb_add(unsigned* p, unsigned v) { return __hip_atomic_fetch_add(p, v, __ATOMIC_RELAXED, __HIP_MEMORY_SCOPE_AGENT); }
__device__ __forceinline__ unsigned xb_xcc_id() { return (unsigned)__builtin_amdgcn_s_getreg((3 << 11) | 20) & 0xFu; }
#define XB_SPIN(cond, bar) do { unsigned _sp = 0; while (cond) { __builtin_amdgcn_s_sleep(1); \
    if ((++_sp & 255u) == 0u) { if (xb_ld(&(bar)[XB_TMO])) break; if (_sp > XB_SPIN_CAP) { atomicAdd(&(bar)[XB_TMO], 1u); break; } } } } while (0)
struct XcdBarrier { unsigned* bar; unsigned x; volatile LAS unsigned* st; };
__device__ __forceinline__ XcdBarrier xcd_barrier_post(unsigned* bar, volatile LAS unsigned* st) {
    XcdBarrier b; b.bar = bar; b.x = xb_xcc_id(); b.st = st;
    if (threadIdx.x == 0) (void)xb_add(&bar[XB_XCNT(b.x)], 1u);
    return b;
}
__device__ __forceinline__ void xcd_barrier_complete(unsigned* bar, unsigned x, unsigned& nloc, unsigned& nx) {
    const unsigned G = gridDim.x * gridDim.y * gridDim.z;
    unsigned sum, cnt, mine, sp = 0u;
    for (;;) {
        sum = 0u; cnt = 0u; mine = 0u;
#pragma unroll
        for (unsigned j = 0; j < 16; ++j) { const unsigned c = xb_ld(&bar[XB_XCNT(j)]); sum += c; cnt += (c > 0u) ? 1u : 0u; mine = (j == x) ? c : mine; }
        if (sum == G) break;
        __builtin_amdgcn_s_sleep(1);
        if ((++sp & 255u) == 0u) { if (xb_ld(&bar[XB_TMO])) break; if (sp > XB_SPIN_CAP) { atomicAdd(&bar[XB_TMO], 1u); break; } }
    }
    nloc = mine > 0u ? mine : 1u; nx = cnt > 0u ? cnt : 1u;
}
__device__ __forceinline__ void xcd_barrier(const XcdBarrier& b) {
    asm volatile("s_waitcnt vmcnt(0)" ::: "memory");
    __syncthreads();
    if (threadIdx.x == 0) {
        unsigned* bar = b.bar;
        __builtin_amdgcn_s_waitcnt(0);
        unsigned nloc = b.st[0], nx = b.st[1];
        if (nloc == 0u) { xcd_barrier_complete(bar, b.x, nloc, nx); b.st[0] = nloc; b.st[1] = nx; }
        const unsigned old = xb_add(&bar[XB_XSUB(b.x)], 1u);
        const unsigned gen = old / nloc;
        if (old + 1u == (gen + 1u) * nloc) {
            __builtin_amdgcn_fence(__ATOMIC_RELEASE, "agent");
            asm volatile("s_waitcnt vmcnt(0)" ::: "memory");
            const unsigned og = xb_add(&bar[XB_TOP], 1u);
            const unsigned tg = og / nx;
            if (og + 1u == (tg + 1u) * nx) xb_add(&bar[XB_TOPGEN], 1u);
            else XB_SPIN(xb_ld(&bar[XB_TOPGEN]) == tg, bar);
            __builtin_amdgcn_fence(__ATOMIC_ACQUIRE, "agent");
            xb_add(&bar[XB_XGEN(b.x)], 1u);
            asm volatile("s_waitcnt vmcnt(0)" ::: "memory");
        } else {
            XB_SPIN(xb_ld(&bar[XB_XGEN(b.x)]) == gen, bar);
            __builtin_amdgcn_fence(__ATOMIC_ACQUIRE, "agent");
            asm volatile("s_waitcnt vmcnt(0)" ::: "memory");
        }
    }
    __syncthreads();
}

__device__ __forceinline__ void p0_transpose_item(const float* W, int K, int N, bf16* WT, const float* ksc, LAS float* scr, int item, int lane) {
    const int nblk = N / 32, kb = item / nblk, nb = item % nblk, k0 = 64 * kb, n0 = 32 * nb;
#pragma unroll 8
    for (int i = 0; i < 32; ++i) { const int kk = 2 * i + (lane >> 5); float v = W[(size_t)(k0 + kk) * N + n0 + (lane & 31)]; if (ksc) v *= ksc[k0 + kk]; scr[kk * 33 + (lane & 31)] = v; }
    asm volatile("s_waitcnt lgkmcnt(0)" ::: "memory");
    const int c = lane & 7;
#pragma unroll
    for (int j = 0; j < 4; ++j) { const int n = (lane >> 3) + 8 * j; const LAS float* s = scr + (8 * c) * 33 + n;
        u32x4 o; o.x = pk2(s[0 * 33], s[1 * 33]); o.y = pk2(s[2 * 33], s[3 * 33]); o.z = pk2(s[4 * 33], s[5 * 33]); o.w = pk2(s[6 * 33], s[7 * 33]);
        *(u32x4*)(WT + (size_t)(n0 + n) * K + k0 + 8 * c) = o; }
    asm volatile("s_waitcnt lgkmcnt(0)" ::: "memory");
}
__device__ __forceinline__ void phase_p0(const Args& A, LAS unsigned char* lds, int G) {
    const int tid = threadIdx.x, lane = tid & 63, wave = tid >> 6;
    LAS float* scr = (LAS float*)(lds + wave * 16384);
    const int gw = blockIdx.x * 8 + wave, NGW = G * 8;
    unsigned char* ws = A.ws;
    constexpr int I_IN = 16 * 88, I_OUT = 16 * 32, I_UPI = 16 * 96, I_DN = 48 * 32, NIT = I_IN + I_OUT + 2 * I_UPI + I_DN;
    for (int it = gw; it < NIT; it += NGW) {
        int r = it;
        if (r < I_IN) { p0_transpose_item(A.in[I_WIN], D, DIN, (bf16*)(ws + WS_WIN), nullptr, scr, r, lane); continue; } r -= I_IN;
        if (r < I_OUT) { p0_transpose_item(A.in[I_WOUT], D, D, (bf16*)((unsigned char*)A.out + DO_WOUT), nullptr, scr, r, lane); continue; } r -= I_OUT;
        if (r < I_UPI) { p0_transpose_item(A.in[I_FUP], D, DFF, (bf16*)(ws + WS_WUP), A.in[I_N2G], scr, r, lane); continue; } r -= I_UPI;
        if (r < I_UPI) { p0_transpose_item(A.in[I_FGATE], D, DFF, (bf16*)(ws + WS_WGATE), A.in[I_N2G], scr, r, lane); continue; } r -= I_UPI;
        p0_transpose_item(A.in[I_FDOWN], DFF, D, (bf16*)(ws + WS_WDOWN), nullptr, scr, r, lane);
    }
    const int gt = blockIdx.x * 512 + tid, NGT = G * 512;
    { bf16* BA = (bf16*)(ws + WS_BA); const float* wup = A.in[I_WUP]; const float* aup = A.in[I_AUP]; const float* gup = A.in[I_GUP];
      for (int e = gt; e < 1536 * 256; e += NGT) { const int n = e >> 8, k = e & 255; float v = 0.f;
          if (n < 512) { if (k < 64) v = wup[k * 512 + n]; }
          else if (n < 1024) { if (k >= 64 && k < 128) v = aup[(k - 64) * 512 + n - 512]; }
          else { if (k >= 128) v = gup[(k - 128) * 512 + n - 1024]; }
          BA[e] = (bf16)f2bf(v); } }
    { bf16* BB = (bf16*)(ws + WS_BB); const float* wa = A.in[I_LWA]; const float* wx = A.in[I_LWX];
      for (int e = gt; e < 1024 * 512; e += NGT) { const int n = e >> 9, k = e & 511, nn = n & 511, h = nn >> 6, j = nn & 63; float v = 0.f;
          if ((k >> 6) == h) { const float* Wm = n < 512 ? wa : wx; v = Wm[(h * 64 + (k & 63)) * 64 + j]; }
          BB[e] = (bf16)f2bf(v); } }
    bf16* XN = (bf16*)(ws + WS_XN); const float* g1 = A.in[I_N1G];
    for (int row = gw; row < MP; row += NGW) {
        const float* src = row < R_SAMPLE ? A.in[I_XP] + (size_t)row * D : row < R_META ? A.in[I_XS] + (size_t)(row - R_SAMPLE) * D : row < R_END ? A.in[I_META] + (size_t)(row - R_META) * D : nullptr;
        u32x2* o = (u32x2*)(XN + (size_t)row * D);
        if (!src) {
#pragma unroll
            for (int j = 0; j < 4; ++j) o[lane + 64 * j] = (u32x2){0u, 0u};
            continue; }
        f32x4 v[4]; float s = 0.f;
#pragma unroll
        for (int j = 0; j < 4; ++j) { v[j] = ((const f32x4*)src)[lane + 64 * j]; s += (v[j].x * v[j].x + v[j].y * v[j].y) + (v[j].z * v[j].z + v[j].w * v[j].w); }
        const float rs = rsqrtf(wave_sum(s) * (1.f / D) + EPS);
#pragma unroll
        for (int j = 0; j < 4; ++j) { const f32x4 g = ((const f32x4*)g1)[lane + 64 * j];
            o[lane + 64 * j] = (u32x2){pk2(v[j].x * rs * g.x, v[j].y * rs * g.y), pk2(v[j].z * rs * g.z, v[j].w * rs * g.w)}; }
    }
}

__device__ __forceinline__ void phase_e1(const Args& A, int G) {
    const int tid = threadIdx.x, lane = tid & 63, wave = tid >> 6;
    const int gw = blockIdx.x * 8 + wave, NGW = G * 8;
    unsigned char* ws = A.ws;
    const bf16* U = (const bf16*)(ws + WS_U); bf16* AP = (bf16*)(ws + WS_AP); bf16* XC = (bf16*)(ws + WS_XC);
    const float* mu = A.in[I_MU]; const float* sts = A.in[I_STS]; const float* slc = A.in[I_SLC]; const float* lcw = A.in[I_LCW]; const float* lcb = A.in[I_LCB];
    for (int row = gw; row < MP; row += NGW) {
        bf16* ap = AP + (size_t)row * 256; bf16* xc = XC + (size_t)row * 512;
        const RowInfo ri = row_info(row);
        if (ri.kind == 3) { ((u32x2*)ap)[lane] = (u32x2){0u, 0u}; ((u32x4*)xc)[lane] = (u32x4){0u, 0u, 0u, 0u}; continue; }
        const bf16* urow = U + (size_t)row * DIN;
        const int r1 = row_back(ri, row, 1);
        {
            const int c0 = 1536 + 4 * lane;
            const u32x2 uw = *(const u32x2*)(urow + c0);
            float u[4] = {lo16(uw.x), hi16(uw.x), lo16(uw.y), hi16(uw.y)}, p[4];
            if (r1 >= 0) { const u32x2 pw = *(const u32x2*)(U + (size_t)r1 * DIN + c0); p[0] = lo16(pw.x); p[1] = hi16(pw.x); p[2] = lo16(pw.y); p[3] = hi16(pw.y); }
            else if (ri.kind == 1) { const f32x4 pv = *(const f32x4*)(sts + (size_t)ri.b * DTMP + c0); p[0] = pv.x; p[1] = pv.y; p[2] = pv.z; p[3] = pv.w; }
            else { p[0] = p[1] = p[2] = p[3] = 0.f; }
            const f32x4 m4 = *(const f32x4*)(mu + c0);
            float o[4];
#pragma unroll
            for (int i = 0; i < 4; ++i) { const float um = u[i] + (p[i] - u[i]) * m4[i]; o[i] = lane < 16 ? tanh_(um) : lane < 32 ? um : sigm(um); }
            ((u32x2*)ap)[lane] = (u32x2){pk2(o[0], o[1]), pk2(o[2], o[3])};
        }
        {
            const int c = 8 * lane;
            float acc[8], cur[8];
            { const f32x4 b0 = *(const f32x4*)(lcb + c), b1 = *(const f32x4*)(lcb + c + 4); acc[0] = b0.x; acc[1] = b0.y; acc[2] = b0.z; acc[3] = b0.w; acc[4] = b1.x; acc[5] = b1.y; acc[6] = b1.z; acc[7] = b1.w; }
#pragma unroll
            for (int j = 0; j < 4; ++j) {
                float val[8];
                const int rj = (j == 3) ? row : row_back(ri, row, 3 - j);
                if (rj >= 0) unpack8(*(const u32x4*)(U + (size_t)rj * DIN + DTMP + c), val);
                else if (ri.kind == 1) { const float* s = slc + ((size_t)ri.b * 3 + (ri.t + j)) * 512 + c; const f32x4 a = *(const f32x4*)s, b = *(const f32x4*)(s + 4);
                    val[0] = a.x; val[1] = a.y; val[2] = a.z; val[3] = a.w; val[4] = b.x; val[5] = b.y; val[6] = b.z; val[7] = b.w; }
                else {
#pragma unroll
                    for (int i = 0; i < 8; ++i) val[i] = 0.f; }
                const f32x4 w0 = *(const f32x4*)(lcw + j * 512 + c), w1 = *(const f32x4*)(lcw + j * 512 + c + 4);
#pragma unroll
                for (int i = 0; i < 4; ++i) { acc[i] += w0[i] * val[i]; acc[4 + i] += w1[i] * val[4 + i]; }
                if (j == 3) {
#pragma unroll
                    for (int i = 0; i < 8; ++i) cur[i] = val[i]; }
            }
            u32x4 w; w.x = pk2(acc[0], acc[1]); w.y = pk2(acc[2], acc[3]); w.z = pk2(acc[4], acc[5]); w.w = pk2(acc[6], acc[7]);
            ((u32x4*)xc)[lane] = w;
            float* lco = nullptr;
            if (ri.kind == 0 && ri.t >= TP - 3) lco = A.out + O_PLC + ((size_t)ri.b * 3 + (ri.t - (TP - 3))) * 512 + c;
            else if (ri.kind == 1 && ri.t >= 1) lco = A.out + O_SLC + ((size_t)ri.b * 3 + (ri.t - 1)) * 512 + c;
            if (lco) { *(f32x4*)lco = (f32x4){cur[0], cur[1], cur[2], cur[3]}; *(f32x4*)(lco + 4) = (f32x4){cur[4], cur[5], cur[6], cur[7]}; }
        }
        float* sho = nullptr;
        if (ri.kind == 0 && ri.t == TP - 1) sho = A.out + O_PSHIFT + (size_t)ri.b * DTMP;
        else if (ri.kind == 1 && ri.t == DS - 1) sho = A.out + O_SSHIFT + (size_t)ri.b * DTMP;
        if (sho) for (int i = lane; i < DTMP; i += 64) sho[i] = bf2f(urow[i]);
    }
}

__device__ __forceinline__ float sum8(float x) { x += dpp_f<0xB1>(x); x += dpp_f<0x4E>(x); x += dpp_f<0x141>(x); return x; }
__device__ __forceinline__ void ld8f(const float* p, float (&f)[8]) { const f32x4 a = *(const f32x4*)p, b = *(const f32x4*)(p + 4); f[0] = a.x; f[1] = a.y; f[2] = a.z; f[3] = a.w; f[4] = b.x; f[5] = b.y; f[6] = b.z; f[7] = b.w; }
__device__ __forceinline__ u32x4 pack8(const float (&o)[8]) { u32x4 w; w.x = pk2(o[0], o[1]); w.y = pk2(o[2], o[3]); w.z = pk2(o[4], o[5]); w.w = pk2(o[6], o[7]); return w; }
__device__ __forceinline__ void phase_e2(const Args& A, int G) {
    const int tid = threadIdx.x, lane = tid & 63, wave = tid >> 6;
    unsigned char* ws = A.ws;
    const bf16* U = (const bf16*)(ws + WS_U); const bf16* GB = (const bf16*)(ws + WS_GB); const bf16* GA = (const bf16*)((unsigned char*)A.out + DO_GA);
    bf16* REC = (bf16*)(ws + WS_REC); bf16* LRU = (bf16*)(ws + WS_LRU);
    float* LTOT = (float*)((unsigned char*)A.out + DO_LTOT); float* BON = (float*)((unsigned char*)A.out + DO_BON);
    const float* mu = A.in[I_MU]; const float* sts = A.in[I_STS]; const float* slc = A.in[I_SLC]; const float* slh = A.in[I_SLH];
    for (int unit = blockIdx.x; unit < 513 + DB; unit += G) {
        int row0, ntok, kind;
        if (unit < 512) { row0 = unit * 32; ntok = 32; kind = 0; } else if (unit == 512) { row0 = R_META; ntok = 16; kind = 2; } else { row0 = R_SAMPLE + (unit - 513) * 4; ntok = 4; kind = 1; }
        const int c = tid;
        const float sp = softplus_(-A.in[I_LAM][c]);
        const float cw0 = A.in[I_LCW][c], cw1 = A.in[I_LCW][512 + c], cw2 = A.in[I_LCW][1024 + c], cw3 = A.in[I_LCW][1536 + c], cbias = A.in[I_LCB][c];
        const float ba_ = A.in[I_LBA][c], bx_ = A.in[I_LBX][c];
        float l1 = 0.f, l2 = 0.f, l3 = 0.f, H = 0.f, P = 1.f;
        if (kind == 0) { const RowInfo ri0 = row_info(row0);
            l1 = bf2f(U[(size_t)row_back(ri0, row0, 1) * DIN + DTMP + c]); l2 = bf2f(U[(size_t)row_back(ri0, row0, 2) * DIN + DTMP + c]); l3 = bf2f(U[(size_t)row_back(ri0, row0, 3) * DIN + DTMP + c]); }
        else if (kind == 1) { const int b = unit - 513; l3 = slc[((size_t)b * 3 + 0) * 512 + c]; l2 = slc[((size_t)b * 3 + 1) * 512 + c]; l1 = slc[((size_t)b * 3 + 2) * 512 + c]; H = slh[(size_t)b * 512 + c]; }
#pragma unroll 4
        for (int j = 0; j < ntok; ++j) {
            const int row = row0 + j;
            const float l0 = bf2f(U[(size_t)row * DIN + DTMP + c]);
            const float xc = cbias + cw0 * l3 + cw1 * l2 + cw2 * l1 + cw3 * l0;
            l3 = l2; l2 = l1; l1 = l0;
            const float ra = bf2f(GB[(size_t)row * 1024 + c]) + ba_, ix = bf2f(GB[(size_t)row * 1024 + 512 + c]) + bx_;
            const float rg = sigm(ra), ig = sigm(ix);
            const float la = -8.f * rg * sp, a = __expf(la);
            float mult = sqrtf(fmaxf(1.f - __expf(2.f * la), 0.f)); if (kind == 2 && j == 0) mult = 1.f;
            H = a * H + xc * ig * mult; P = P * a;
            LRU[(size_t)row * 1024 + c] = (bf16)f2bf(H); LRU[(size_t)row * 1024 + 512 + c] = (bf16)f2bf(kind == 1 ? 0.f : P);
        }
        if (kind == 1) A.out[O_SLH + (size_t)(unit - 513) * 512 + c] = H;
        else { LTOT[((size_t)unit * 2 + 0) * 512 + c] = P; LTOT[((size_t)unit * 2 + 1) * 512 + c] = H; }
    }
    {
        const int c = 8 * lane, h = lane >> 3, gw = blockIdx.x * 8 + wave, NGW = G * 8;
        float mr[8], mk[8], w0[8], a0[8], kkw[8], kaw[8], rkw[8];
        ld8f(mu + c, mr); ld8f(mu + 512 + c, mk); ld8f(A.in[I_W0] + c, w0); ld8f(A.in[I_A0] + c, a0); ld8f(A.in[I_KK] + c, kkw); ld8f(A.in[I_KA] + c, kaw); ld8f(A.in[I_RK] + c, rkw);
        for (int row = gw; row < R_END; row += NGW) {
            const RowInfo ri = row_info(row); const int r1 = row_back(ri, row, 1);
            const bf16* ur = U + (size_t)row * DIN;
            float u_r[8], u_k[8], p_r[8], p_k[8], wp[8], ap[8];
            unpack8(*(const u32x4*)(ur + c), u_r); unpack8(*(const u32x4*)(ur + 512 + c), u_k);
            unpack8(*(const u32x4*)(GA + (size_t)row * 1536 + c), wp); unpack8(*(const u32x4*)(GA + (size_t)row * 1536 + 512 + c), ap);
            if (r1 >= 0) { unpack8(*(const u32x4*)(U + (size_t)r1 * DIN + c), p_r); unpack8(*(const u32x4*)(U + (size_t)r1 * DIN + 512 + c), p_k); }
            else if (ri.kind == 1) { ld8f(sts + (size_t)ri.b * DTMP + c, p_r); ld8f(sts + (size_t)ri.b * DTMP + 512 + c, p_k); }
            else {
#pragma unroll
                for (int i = 0; i < 8; ++i) { p_r[i] = 0.f; p_k[i] = 0.f; } }
            float av[8], xv[8], kk[8], kp[8], ss = 0.f, bs = 0.f;
#pragma unroll
            for (int i = 0; i < 8; ++i) {
                const float um_r = u_r[i] + (p_r[i] - u_r[i]) * mr[i], um_k = u_k[i] + (p_k[i] - u_k[i]) * mk[i];
                const float z = -(wp[i] + w0[i]);
                const float w_log = -(fmaxf(z, 0.f) + __logf(1.f + __expf(-fabsf(z)))) - 0.5f;
                const float e = __expf(w_log); xv[i] = 1.f - __expf(-e);
                av[i] = sigm(ap[i] + a0[i]);
                kk[i] = um_k * kkw[i]; ss += kk[i] * kk[i];
                kp[i] = um_k * (1.f + (av[i] - 1.f) * kaw[i]);
                bs += um_r * kp[i] * rkw[i];
            }
            ss = sum8(ss); bs = sum8(bs);
            const float rn = rsqrtf(fmaxf(ss, 1e-24f));
#pragma unroll
            for (int i = 0; i < 8; ++i) kk[i] *= rn;
            bf16* rec = REC + ((size_t)row * 8 + h) * 256 + (lane & 7) * 8;
            *(u32x4*)rec = pack8(av); *(u32x4*)(rec + 64) = pack8(xv); *(u32x4*)(rec + 128) = pack8(kk); *(u32x4*)(rec + 192) = pack8(kp);
            if ((lane & 7) == 0) BON[(size_t)row * 8 + h] = bs;
        }
    }
}

struct Raw { bf16 a, x, kk, kp, ur, uv, pr, pv; };
__device__ __forceinline__ void m2_load(Raw (&raw)[4], const bf16* REC, const bf16* U, int b, int h, int t0, int ns, int k, int sub) {
#pragma unroll
    for (int i = 0; i < 4; ++i) {
        const int s = sub + 8 * i;
        raw[i].a = 0; raw[i].x = 0; raw[i].kk = 0; raw[i].kp = 0; raw[i].ur = 0; raw[i].uv = 0; raw[i].pr = 0; raw[i].pv = 0;
        if (s < ns) {
            const int t = t0 + s, row = prompt_row(b, t);
            const bf16* rec = REC + ((size_t)row * 8 + h) * 256;
            raw[i].a = rec[k]; raw[i].x = rec[64 + k]; raw[i].kk = rec[128 + k]; raw[i].kp = rec[192 + k];
            const bf16* ur = U + (size_t)row * DIN + h * 64 + k; raw[i].ur = ur[0]; raw[i].uv = ur[1024];
            if (t > 0) { const bf16* pr = U + (size_t)prompt_row(b, t - 1) * DIN + h * 64 + k; raw[i].pr = pr[0]; raw[i].pv = pr[1024]; }
        }
    }
}
__device__ __forceinline__ void m2_store(const Raw (&raw)[4], LAS float* buf, float mu_r, float mu_v, int k, int sub, int ns) {
#pragma unroll
    for (int i = 0; i < 4; ++i) {
        const int s = sub + 8 * i;
        if (s < ns) {
            LAS float* p = buf + s * 384;
            const float a = bf2f(raw[i].a), kk = bf2f(raw[i].kk), ur = bf2f(raw[i].ur), uv = bf2f(raw[i].uv);
            p[k] = kk; p[64 + k] = bf2f(raw[i].x); p[128 + k] = kk * a; p[192 + k] = bf2f(raw[i].kp);
            p[256 + k] = ur + (bf2f(raw[i].pr) - ur) * mu_r; p[320 + k] = uv + (bf2f(raw[i].pv) - uv) * mu_v;
        }
    }
}
struct StepOps { f32x4 kk, x, ka, kp, r; float v; };
__device__ __forceinline__ void ops_load(StepOps& o, const LAS float* p, int ks, int vrow) {
    o.kk = *(const LAS f32x4*)(p + 4 * ks); o.x = *(const LAS f32x4*)(p + 64 + 4 * ks); o.ka = *(const LAS f32x4*)(p + 128 + 4 * ks);
    o.kp = *(const LAS f32x4*)(p + 192 + 4 * ks); o.r = *(const LAS f32x4*)(p + 256 + 4 * ks); o.v = p[320 + vrow];
}
__device__ __forceinline__ float scan_step(f32x4& S, const StepOps& o) {
    float d = (S.x * o.kk.x + S.y * o.kk.y) + (S.z * o.kk.z + S.w * o.kk.w); d = allsum16(d);
    S = S - S * o.x - d * o.ka + o.v * o.kp;
    float y = (S.x * o.r.x + S.y * o.r.y) + (S.z * o.r.z + S.w * o.r.w); return allsum16(y);
}
__device__ __forceinline__ void phase_m2(const Args& A, LAS unsigned char* lds, int G) {
    const int tid = threadIdx.x, lane = tid & 63, wave = tid >> 6;
    unsigned char* ws = A.ws;
    const bf16* U = (const bf16*)(ws + WS_U); const bf16* REC = (const bf16*)(ws + WS_REC); float* Y = (float*)(ws + WS_Y);
    const float* LTOT = (const float*)((unsigned char*)A.out + DO_LTOT); float* CARRY = (float*)((unsigned char*)A.out + DO_CARRY);
    const float* mu = A.in[I_MU];
    for (int b = blockIdx.x; b < NB; b += G) {
        const int c = tid; float carry = LTOT[((size_t)512 * 2 + 1) * 512 + c];
        float Pv[64], Hv[64];
#pragma unroll
        for (int i = 0; i < 64; ++i) { const int un = b * 64 + i; Pv[i] = LTOT[((size_t)un * 2 + 0) * 512 + c]; Hv[i] = LTOT[((size_t)un * 2 + 1) * 512 + c]; }
#pragma unroll
        for (int i = 0; i < 64; ++i) { CARRY[((size_t)b * 64 + i) * 512 + c] = carry; carry = Pv[i] * carry + Hv[i]; }
        A.out[O_PLH + (size_t)b * 512 + c] = carry;
    }
    const int ks = lane & 15, rl = lane >> 4;
    for (int item = blockIdx.x; item < 256; item += G) {
        const int bh = item >> 2, q = item & 3, b = bh >> 3, h = bh & 7;
        const int k = tid & 63, sub = tid >> 6;
        const float mu_r = mu[h * 64 + k], mu_v = mu[1024 + h * 64 + k];
        const int wv = wave & 3, vrow = 16 * q + 4 * wv + rl;
        f32x4 S = (f32x4){0.f, 0.f, 0.f, 0.f};
        Raw raw[4];
        LAS float* buf0 = (LAS float*)lds; LAS float* buf1 = (LAS float*)(lds + 49152); LAS float* ybuf = (LAS float*)(lds + 98304) + wv * 128;
        __syncthreads();
        m2_load(raw, REC, U, b, h, 0, 16, k, sub);
        m2_store(raw, buf0, mu_r, mu_v, k, sub, 16);
        __syncthreads();
        for (int blk = 0; blk < 65; ++blk) {
            const int t0 = blk == 0 ? 0 : 16 + 32 * (blk - 1), ns = blk == 0 ? 16 : 32;
            if (blk + 1 < 65) m2_load(raw, REC, U, b, h, 16 + 32 * blk, 32, k, sub);
            if (wave < 4) {
                const LAS float* buf = (blk & 1) ? buf1 : buf0;
                StepOps oa, ob; ops_load(oa, buf, ks, vrow);
                for (int s = 0; s < ns; s += 2) {
                    ops_load(ob, buf + (s + 1) * 384, ks, vrow);
                    const float y0 = scan_step(S, oa);
                    if (ks == 0) ybuf[s * 4 + rl] = y0;
                    if (s + 2 < ns) ops_load(oa, buf + (s + 2) * 384, ks, vrow);
                    const float y1 = scan_step(S, ob);
                    if (ks == 0) ybuf[(s + 1) * 4 + rl] = y1;
                }
                if (ks < ns) Y[(size_t)prompt_row(b, t0 + ks) * 512 + h * 64 + vrow] = ybuf[ks * 4 + rl];
                if (ks + 16 < ns) Y[(size_t)prompt_row(b, t0 + ks + 16) * 512 + h * 64 + vrow] = ybuf[(ks + 16) * 4 + rl];
            }
            if (blk + 1 < 65) m2_store(raw, (blk & 1) ? buf0 : buf1, mu_r, mu_v, k, sub, 32);
            __syncthreads();
        }
        if (wave < 4) *(f32x4*)(A.out + O_PWKV + ((size_t)(b * 8 + h) * 64 + vrow) * 64 + 4 * ks) = S;
    }
    const float* swkv = A.in[I_SWKV]; const float* sts = A.in[I_STS];
#pragma unroll 2
    for (int task = blockIdx.x * 8 + wave; task < DB * NH * 16; task += G * 8) {
        const int bh = task >> 4, rg = task & 15, b = bh >> 3, h = bh & 7, v = 4 * rg + rl;
        f32x4 S = *(const f32x4*)(swkv + ((size_t)bh * 64 + v) * 64 + 4 * ks);
        const f32x4 mr4 = *(const f32x4*)(mu + h * 64 + 4 * ks); const float mv = mu[1024 + h * 64 + v];
        StepOps o[DS];
#pragma unroll
        for (int t = 0; t < DS; ++t) {
            const int row = R_SAMPLE + 4 * b + t;
            const bf16* rec = REC + ((size_t)row * 8 + h) * 256 + 4 * ks;
            const u32x2 wa = *(const u32x2*)rec, wx = *(const u32x2*)(rec + 64), wk = *(const u32x2*)(rec + 128), wp = *(const u32x2*)(rec + 192);
            const f32x4 a4 = (f32x4){lo16(wa.x), hi16(wa.x), lo16(wa.y), hi16(wa.y)};
            o[t].x = (f32x4){lo16(wx.x), hi16(wx.x), lo16(wx.y), hi16(wx.y)};
            o[t].kk = (f32x4){lo16(wk.x), hi16(wk.x), lo16(wk.y), hi16(wk.y)}; o[t].kp = (f32x4){lo16(wp.x), hi16(wp.x), lo16(wp.y), hi16(wp.y)};
            const u32x2 wr_ = *(const u32x2*)(U + (size_t)row * DIN + h * 64 + 4 * ks);
            const f32x4 ur4 = (f32x4){lo16(wr_.x), hi16(wr_.x), lo16(wr_.y), hi16(wr_.y)};
            const float uv = bf2f(U[(size_t)row * DIN + 1024 + h * 64 + v]);
            f32x4 pr4; float pv;
            if (t > 0) { const u32x2 w = *(const u32x2*)(U + (size_t)(row - 1) * DIN + h * 64 + 4 * ks); pr4 = (f32x4){lo16(w.x), hi16(w.x), lo16(w.y), hi16(w.y)}; pv = bf2f(U[(size_t)(row - 1) * DIN + 1024 + h * 64 + v]); }
            else { pr4 = *(const f32x4*)(sts + (size_t)b * DTMP + h * 64 + 4 * ks); pv = sts[(size_t)b * DTMP + 1024 + h * 64 + v]; }
            o[t].r = ur4 + (pr4 - ur4) * mr4; o[t].v = uv + (pv - uv) * mv; o[t].ka = o[t].kk * a4;
        }
#pragma unroll
        for (int t = 0; t < DS; ++t) { const float y = scan_step(S, o[t]); if (ks == 0) Y[(size_t)(R_SAMPLE + 4 * b + t) * 512 + h * 64 + v] = y; }
        *(f32x4*)(A.out + O_SWKV + ((size_t)bh * 64 + v) * 64 + 4 * ks) = S;
    }
}

__device__ __forceinline__ void phase_m3(const Args& A, int G) {
    const int tid = threadIdx.x, lane = tid & 63, wave = tid >> 6;
    const int gw = blockIdx.x * 8 + wave, NGW = G * 8;
    unsigned char* ws = A.ws;
    const bf16* U = (const bf16*)(ws + WS_U); const bf16* GA = (const bf16*)((unsigned char*)A.out + DO_GA); const bf16* LRU = (const bf16*)(ws + WS_LRU);
    const float* Y = (const float*)(ws + WS_Y); const float* CARRY = (const float*)((unsigned char*)A.out + DO_CARRY); const float* BON = (const float*)((unsigned char*)A.out + DO_BON);
    bf16* MIX = (bf16*)(ws + WS_MIX);
    const float* sts = A.in[I_STS];
    const int c = 8 * lane, h = lane >> 3;
    float mv[8], gg[8], gb[8], og[8];
    ld8f(A.in[I_MU] + 1024 + c, mv); ld8f(A.in[I_GNG] + c, gg); ld8f(A.in[I_GNB] + c, gb); ld8f(A.in[I_LOG] + c, og);
    for (int row = gw; row < MP; row += NGW) {
        bf16* mo = MIX + (size_t)row * D;
        const RowInfo ri = row_info(row);
        if (ri.kind == 3) { ((u32x4*)mo)[lane] = (u32x4){0u, 0u, 0u, 0u}; ((u32x4*)mo)[64 + lane] = (u32x4){0u, 0u, 0u, 0u}; continue; }
        const int r1 = row_back(ri, row, 1);
        float y[8], uv[8], pv[8], g[8], hv[8], pp[8], gt[8], cr[8];
        ld8f(Y + (size_t)row * 512 + c, y);
        unpack8(*(const u32x4*)(U + (size_t)row * DIN + 1024 + c), uv);
        unpack8(*(const u32x4*)(GA + (size_t)row * 1536 + 1024 + c), g);
        unpack8(*(const u32x4*)(LRU + (size_t)row * 1024 + c), hv); unpack8(*(const u32x4*)(LRU + (size_t)row * 1024 + 512 + c), pp);
        unpack8(*(const u32x4*)(U + (size_t)row * DIN + DTMP + 512 + c), gt);
        const float bon = BON[(size_t)row * 8 + h];
        if (r1 >= 0) unpack8(*(const u32x4*)(U + (size_t)r1 * DIN + 1024 + c), pv);
        else if (ri.kind == 1) ld8f(sts + (size_t)ri.b * DTMP + 1024 + c, pv);
        else {
#pragma unroll
            for (int i = 0; i < 8; ++i) pv[i] = 0.f; }
        if (ri.kind == 0) ld8f(CARRY + ((size_t)ri.b * 64 + ((row & 2047) >> 5)) * 512 + c, cr);
        else {
#pragma unroll
            for (int i = 0; i < 8; ++i) cr[i] = 0.f; }
        float s = 0.f;
#pragma unroll
        for (int i = 0; i < 8; ++i) s += y[i];
        const float mean = sum8(s) * (1.f / 64.f);
        float q = 0.f;
#pragma unroll
        for (int i = 0; i < 8; ++i) { y[i] -= mean; q += y[i] * y[i]; }
        const float rstd = rsqrtf(sum8(q) * (1.f / 64.f) + GN_EPS);
        float o[8];
#pragma unroll
        for (int i = 0; i < 8; ++i) { const float vv = uv[i] + (pv[i] - uv[i]) * mv[i]; o[i] = (y[i] * rstd * gg[i] + gb[i] + bon * vv) * g[i]; }
        *(u32x4*)(mo + c) = pack8(o);
        float z[8], s2 = 0.f;
#pragma unroll
        for (int i = 0; i < 8; ++i) { z[i] = (hv[i] + pp[i] * cr[i]) * gelu_tanh(gt[i]); s2 += z[i] * z[i]; }
        const float rs = rsqrtf(wave_sum(s2) * (1.f / 512.f) + EPS);
#pragma unroll
        for (int i = 0; i < 8; ++i) o[i] = z[i] * rs * og[i];
        *(u32x4*)(mo + 512 + c) = pack8(o);
    }
}

__device__ __forceinline__ void phase_final(const Args& A, int G) {
    const int tid = threadIdx.x, lane = tid & 63, wave = tid >> 6;
    const int gw = blockIdx.x * 8 + wave, NGW = G * 8;
    const float* ssq = (const float*)(A.ws + WS_SSQ2); const float* gf = A.in[I_NFG];
    for (int row = gw; row < M_MAIN; row += NGW) {
        const float rs = row_rs(ssq, row);
        f32x4* p = (f32x4*)(A.out + (size_t)row * D);
#pragma unroll
        for (int j = 0; j < 4; ++j) { const f32x4 g = ((const f32x4*)gf)[lane + 64 * j]; f32x4 v = p[lane + 64 * j]; v = v * rs * g; p[lane + 64 * j] = v; }
    }
}

namespace cg = cooperative_groups;
__global__ void __launch_bounds__(512, 2) mk_fwd(Args args) {
    extern __shared__ __attribute__((aligned(16))) unsigned char lds_raw[];
    LAS unsigned char* lds = (LAS unsigned char*)lds_raw;
    const int G = gridDim.x, tid = threadIdx.x;
    volatile LAS unsigned* MISC = (volatile LAS unsigned*)(lds + 131072 + 320);
    if (tid < 64) ((LAS unsigned*)(lds + 131072))[tid + 64] = 0u, ((LAS unsigned*)(lds + 131072))[tid] = 0u;
    __syncthreads();
    const int lo = args.ph_lo, hi = args.ph_hi;
    XcdBarrier bar; bar.bar = (unsigned*)(args.ws + WS_CTL) + 4096; bar.x = 0; bar.st = nullptr;
    if (hi - lo > 1) bar = xcd_barrier_post((unsigned*)(args.ws + WS_CTL) + 4096, MISC + 8);
    if (lo < 0) cg::this_grid().sync();
#define IN(k) (lo <= (k) && (k) < hi)
#define SEAM(k) do { if (IN(k) && IN((k) + 1)) xcd_barrier(bar); } while (0)
    unsigned char* ws = args.ws; unsigned char* ob = (unsigned char*)args.out;
    if (IN(0)) { phase_p0(args, lds, G); } SEAM(0);
    if (IN(1)) { pg8::Gemm g{(const bf16*)(ws + WS_XN), (const bf16*)(ws + WS_WIN), MP, DIN, D}; pg8::StaticOrder S; S.init(MP, DIN, G, (int)blockIdx.x);
        EpiPlain E{(bf16*)(ws + WS_U), DIN}; pg8::gemm_phase<EpiPlain, pg8::StaticOrder, true, true>(lds, g, S, E); } SEAM(1);
    if (IN(2)) { phase_e1(args, G); } SEAM(2);
    if (IN(3)) {
        { pg8::Gemm g{(const bf16*)(ws + WS_AP), (const bf16*)(ws + WS_BA), MP, 1536, 256}; pg8::StaticOrder S; S.init(MP, 1536, G, (int)blockIdx.x);
          EpiPlain E{(bf16*)(ob + DO_GA), 1536}; pg8::gemm_phase<EpiPlain, pg8::StaticOrder, true, true>(lds, g, S, E); }
        { pg8::Gemm g{(const bf16*)(ws + WS_XC), (const bf16*)(ws + WS_BB), MP, 1024, 512}; pg8::StaticOrder S; S.init(MP, 1024, G, (int)blockIdx.x);
          EpiPlain E{(bf16*)(ws + WS_GB), 1024}; pg8::gemm_phase<EpiPlain, pg8::StaticOrder, true, true>(lds, g, S, E); }
    } SEAM(3);
    if (IN(4)) { phase_e2(args, G); } SEAM(4);
    if (IN(5)) { phase_m2(args, lds, G); } SEAM(5);
    if (IN(6)) { phase_m3(args, G); } SEAM(6);
    if (IN(7)) { pg8::Gemm g{(const bf16*)(ws + WS_MIX), (const bf16*)(ob + DO_WOUT), MP, D, D}; pg8::StaticOrder S; S.init(MP, D, G, (int)blockIdx.x);
        EpiX1 E{args.in[I_XP], args.in[I_XS], args.in[I_META], args.out, (bf16*)(ws + WS_X1B), (float*)(ws + WS_SSQ1)};
        pg8::gemm_phase<EpiX1, pg8::StaticOrder, true, true>(lds, g, S, E); } SEAM(7);
    if (IN(8)) { pg8::Gemm g{(const bf16*)(ws + WS_X1B), (const bf16*)(ws + WS_WUP), MP, DFF, D}; pg8::StaticOrder S; S.init(MP, DFF, G, (int)blockIdx.x);
        EpiUp E{(const float*)(ws + WS_SSQ1), (bf16*)(ws + WS_UP), args.out + O_PFC, args.out + O_SFC};
        pg8::gemm_phase<EpiUp, pg8::StaticOrder, true, true>(lds, g, S, E); } SEAM(8);
    if (IN(9)) { pg8::Gemm g{(const bf16*)(ws + WS_X1B), (const bf16*)(ws + WS_WGATE), M_MAIN, DFF, D}; pg8::StaticOrder S; S.init(M_MAIN, DFF, G, (int)blockIdx.x);
        EpiGate E{(const float*)(ws + WS_SSQ1), (const bf16*)(ws + WS_UP), args.in[I_SFC], args.in[I_FCW], args.in[I_FCB], (bf16*)(ws + WS_HID)};
        pg8::gemm_phase<EpiGate, pg8::StaticOrder, true, true>(lds, g, S, E); } SEAM(9);
    if (IN(10)) { pg8::Gemm g{(const bf16*)(ws + WS_HID), (const bf16*)(ws + WS_WDOWN), M_MAIN, D, DFF}; pg8::StaticOrder S; S.init(M_MAIN, D, G, (int)blockIdx.x);
        EpiDown E{args.out, (float*)(ws + WS_SSQ2)};
        pg8::gemm_phase<EpiDown, pg8::StaticOrder, true, true>(lds, g, S, E); } SEAM(10);
    if (IN(11)) { phase_final(args, G); }
#undef IN
#undef SEAM
}

extern "C" void kernel_launch(void* const* d_in, const int* in_sizes, int n_in, void* d_out, int out_size, void* d_ws, size_t ws_size, hipStream_t stream) {
    static int grid = 0;
    if (grid == 0) {
        if (n_in != N_IN || (size_t)out_size != O_END || ws_size < 256 * MiB) { fprintf(stderr, "kernel_launch: unexpected shapes n_in %d out %d ws %zu\n", n_in, out_size, ws_size); grid = -1; return; }
        int dev = 0, cus = 0, per_cu = 0;
        (void)hipGetDevice(&dev); (void)hipDeviceGetAttribute(&cus, hipDeviceAttributeMultiprocessorCount, dev);
        if (hipFuncSetAttribute((const void*)mk_fwd, hipFuncAttributeMaxDynamicSharedMemorySize, LDS_BYTES) != hipSuccess) { fprintf(stderr, "kernel_launch: hipFuncSetAttribute failed\n"); grid = -1; return; }
        if (hipOccupancyMaxActiveBlocksPerMultiprocessor(&per_cu, (const void*)mk_fwd, 512, LDS_BYTES) != hipSuccess || per_cu < 1) per_cu = 1;
        (void)hipGetLastError();
        grid = cus > 0 ? cus : 256;
    }
    if (grid < 0) return;
    Args a{};
    for (int i = 0; i < N_IN; ++i) a.in[i] = (const float*)d_in[i];
    a.out = (float*)d_out; a.ws = (unsigned char*)d_ws;
#if MK_ONE_LAUNCH
    (void)hipMemsetAsync((char*)d_ws + WS_CTL, 0, CTL_ZERO_BYTES, stream);
    a.ph_lo = 0; a.ph_hi = NPH;
    void* kargs[] = {&a};
    hipError_t e = hipLaunchCooperativeKernel((const void*)mk_fwd, dim3(grid), dim3(512), kargs, LDS_BYTES, stream);
    if (e != hipSuccess) fprintf(stderr, "cooperative launch failed: %s (grid %d)\n", hipGetErrorString(e), grid);
#else
    for (int ph = 0; ph < NPH; ++ph) for (int rep = 0; rep < 1 + ((MK_REP_MASK >> ph) & 1); ++rep) { a.ph_lo = ph; a.ph_hi = ph + 1; hipLaunchKernelGGL(mk_fwd, dim3(grid), dim3(512), LDS_BYTES, stream, a); }
#endif
}
```

```cpp
#include <hip/hip_runtime.h>
#include <hip/hip_cooperative_groups.h>
#include <cstdio>
#include <cstdint>
#include <cmath>
namespace pg8 {
#define PG8_LAS __attribute__((address_space(3)))
typedef unsigned short bf16_t;
typedef short bf16x8 __attribute__((ext_vector_type(8)));
typedef float f32x4 __attribute__((ext_vector_type(4)));
typedef unsigned u32x4 __attribute__((ext_vector_type(4)));
constexpr int BM = 256, BK = 64, HALF = 128, HTB = HALF * BK * 2  , STAGE_BYTES = 8 * HTB, NXCD = 8, WGM = 8;

__host__ __device__ __forceinline__ int lds_byte(int r, int c) { const int st = (r >> 4) * 2 + (c >> 5), rr = r & 15, cc = c & 31, ob = rr * 64 + cc * 2; return st * 1024 + (ob ^ (((ob >> 9) & 1) << 5)); }
__host__ __device__ __forceinline__ void stage_rc(int b, int& R, int& C) { const int st = b / 1024, sb = b % 1024, swz = sb ^ (((sb >> 9) & 1) << 5); R = (st >> 1) * 16 + swz / 64; C = (st & 1) * 32 + (swz % 64) / 2; }
__host__ __device__ __forceinline__ int perm32(int rho) { const int n = rho >> 4, i = rho & 15; return 8 * (i >> 2) + 4 * n + (i & 3); }

struct Unit { int pm, pn; };
struct Gemm { const bf16_t* A; const bf16_t* Bt; int M, N, K; };

struct StaticOrder {
    int nM, nN, nwg, G, c;
    __host__ __device__ void init(int M, int N, int G_, int c_) { nM = M / BM; nN = N / BM; nwg = nM * nN; G = G_; c = c_; }
    __host__ __device__ bool next(int i, Unit& u) const {
        const long L = (long)i * G + c; if (L >= nwg) return false;
        int wgid = (int)L; { const int q = nwg / NXCD, r = nwg % NXCD, xcd = wgid % NXCD, off = wgid / NXCD; wgid = (xcd < r ? xcd * (q + 1) : r * (q + 1) + (xcd - r) * q) + off; }
        const int nig = WGM * nN, gid = wgid / nig, fm = gid * WGM, gsz = (nM - fm) < WGM ? (nM - fm) : WGM;
        u.pm = fm + ((wgid % nig) % gsz); u.pn = (wgid % nig) / gsz; return true;
    }
    __device__ __forceinline__ void a_ready(const Unit&) const {}
    __device__ __forceinline__ void done(const Unit&) const {}
};

__device__ __forceinline__ unsigned cvt_pk_bf16(float lo, float hi) { unsigned r; asm volatile("v_cvt_pk_bf16_f32 %0, %1, %2" : "=v"(r) : "v"(lo), "v"(hi)); return r; }
typedef float f32x2 __attribute__((ext_vector_type(2)));
template <class Epi, class Sched, bool ALIGN_EPI = false, bool SP2 = false>
__device__ __forceinline__ void gemm_phase(PG8_LAS unsigned char* lds, const Gemm g, const Sched& S, const Epi& E) {
    const int tid = threadIdx.x, wid = __builtin_amdgcn_readfirstlane(tid >> 6), lane = tid & 63, wr = wid >> 2, wc = wid & 3, fr = lane & 15, fq = lane >> 4;
    const int K = g.K, nt = K / BK;
    unsigned voffA[2], voffB[2];
#pragma unroll
    for (int i = 0; i < 2; ++i) { int R, C; stage_rc(tid * 16 + i * 8192, R, C); const int Rb = Epi::PERM ? ((R & ~31) + perm32(R & 31)) : R;
        voffA[i] = (unsigned)(R * K + C) * 2u; voffB[i] = (unsigned)(Rb * K + C) * 2u; }
    const size_t kstep = (size_t)(BK * 2);
    const size_t hstep = (size_t)HALF * K * 2;
    const size_t tstep = 2 * hstep;
    const unsigned ldsw = (unsigned)wid * 1024u;
    const int aoff = lds_byte(wr * 64 + fr, fq * 8), boff = lds_byte(wc * 32 + fr, fq * 8);
#define PG8_SA(b, h) (((b) * 2 + (h)) * HTB)
#define PG8_SB(b, h) ((4 + (b) * 2 + (h)) * HTB)
#define PG8_STAGE(bufoff, gbase, voff) do { _Pragma("unroll") for (int _i = 0; _i < 2; ++_i) \
        __builtin_amdgcn_global_load_lds((const unsigned*)((const char*)(gbase) + (voff)[_i]), (PG8_LAS unsigned*)(lds + (bufoff) + ldsw + _i * 8192), 16, 0, 0); } while (0)
#define PG8_LDA(dst, b, h) do { _Pragma("unroll") for (int m = 0; m < 4; ++m) _Pragma("unroll") for (int k = 0; k < 2; ++k) dst[m][k] = *(const PG8_LAS bf16x8*)(lds + PG8_SA(b, h) + aoff + m * 2048 + k * 1024); } while (0)
#define PG8_LDB(dst, b, h) do { _Pragma("unroll") for (int n = 0; n < 2; ++n) _Pragma("unroll") for (int k = 0; k < 2; ++k) dst[n][k] = *(const PG8_LAS bf16x8*)(lds + PG8_SB(b, h) + boff + n * 2048 + k * 1024); } while (0)
#define PG8_MMA(ai, bj, At, Bt) do { __builtin_amdgcn_s_setprio(1); _Pragma("unroll") for (int m = 0; m < 4; ++m) _Pragma("unroll") for (int n = 0; n < 2; ++n) _Pragma("unroll") for (int k = 0; k < 2; ++k) \
        acc[ai][bj][m][n] = __builtin_amdgcn_mfma_f32_16x16x32_bf16(Bt[n][k], At[m][k], acc[ai][bj][m][n], 0, 0, 0); __builtin_amdgcn_s_setprio(0); } while (0)
#define PG8_WAIT_V(n) asm volatile("s_waitcnt vmcnt(" #n ")" ::: "memory")
#define PG8_WAIT_L(n) asm volatile("s_waitcnt lgkmcnt(" #n ")" ::: "memory")
#define PG8_BAR __builtin_amdgcn_s_barrier()
#define PG8_SCHED __builtin_amdgcn_sched_barrier(0)
    Unit cur, nxt; int ui = 0;
    if (!S.next(0, cur)) return;
    f32x4 acc[2][2][4][2];
#pragma unroll
    for (int a = 0; a < 2; ++a)
#pragma unroll
        for (int b = 0; b < 2; ++b)
#pragma unroll
            for (int m = 0; m < 4; ++m)
#pragma unroll
                for (int n = 0; n < 2; ++n) acc[a][b][m][n] = (f32x4){0.f, 0.f, 0.f, 0.f};
    bf16x8 At[4][2], B0[2][2], B1[2][2];
    const char* cA = (const char*)g.A + (size_t)cur.pm * tstep; const char* cB = (const char*)g.Bt + (size_t)cur.pn * tstep;
    S.a_ready(cur);
    if constexpr (SP2) {
        PG8_STAGE(PG8_SB(0, 0), cB, voffB); PG8_STAGE(PG8_SB(0, 1), cB + hstep, voffB); PG8_STAGE(PG8_SA(0, 0), cA, voffA); PG8_STAGE(PG8_SA(0, 1), cA + hstep, voffA);
        if (wr == 1) PG8_BAR;
        PG8_WAIT_V(2); PG8_BAR;
        PG8_STAGE(PG8_SB(1, 0), cB + kstep, voffB); PG8_STAGE(PG8_SA(1, 0), cA + kstep, voffA); PG8_STAGE(PG8_SB(1, 1), cB + hstep + kstep, voffB);
        PG8_WAIT_V(6); PG8_BAR;
    } else {
        PG8_STAGE(PG8_SB(0, 0), cB, voffB); PG8_STAGE(PG8_SA(0, 0), cA, voffA); PG8_STAGE(PG8_SB(0, 1), cB + hstep, voffB); PG8_STAGE(PG8_SA(0, 1), cA + hstep, voffA);
        if (wr == 1) PG8_BAR;
        PG8_WAIT_V(4); PG8_BAR;
        PG8_STAGE(PG8_SB(1, 0), cB + kstep, voffB); PG8_STAGE(PG8_SA(1, 0), cA + kstep, voffA); PG8_STAGE(PG8_SB(1, 1), cB + hstep + kstep, voffB);
        PG8_WAIT_V(6); PG8_BAR;
    }
    for (;;) {
        const bool has_next = S.next(ui + 1, nxt);
        const char* nA = has_next ? (const char*)g.A + (size_t)nxt.pm * tstep : cA; const char* nB = has_next ? (const char*)g.Bt + (size_t)nxt.pn * tstep : cB;
        for (int t = 0; t < nt; t += 2) {
            const bool last = (t == nt - 2);
            const char* a1 = cA + (size_t)(t + 1) * kstep;
            const char* a2 = last ? nA : cA + (size_t)(t + 2) * kstep; const char* b2 = last ? nB : cB + (size_t)(t + 2) * kstep;
            const char* a3 = a2 + kstep; const char* b3 = b2 + kstep;
            if (last && has_next) S.a_ready(nxt);
            if constexpr (SP2) {
            PG8_LDB(B0, 0, 0); PG8_LDB(B1, 0, 1); PG8_SCHED; PG8_LDA(At, 0, 0); PG8_STAGE(PG8_SA(1, 1), a1 + hstep, voffA);
            PG8_WAIT_V(8); PG8_WAIT_L(0); PG8_BAR; PG8_MMA(0, 0, At, B0); PG8_MMA(0, 1, At, B1); PG8_BAR; PG8_SCHED;
            PG8_LDA(At, 0, 1); PG8_STAGE(PG8_SB(0, 0), b2, voffB); PG8_STAGE(PG8_SB(0, 1), b2 + hstep, voffB); PG8_STAGE(PG8_SA(0, 0), a2, voffA);
            PG8_WAIT_V(8); PG8_WAIT_L(0); PG8_BAR; PG8_MMA(1, 0, At, B0); PG8_MMA(1, 1, At, B1); PG8_BAR; PG8_SCHED;
            PG8_LDB(B0, 1, 0); PG8_LDB(B1, 1, 1); PG8_SCHED; PG8_LDA(At, 1, 0); PG8_STAGE(PG8_SA(0, 1), a2 + hstep, voffA);
            PG8_WAIT_V(8); PG8_WAIT_L(0); PG8_BAR; PG8_MMA(0, 0, At, B0); PG8_MMA(0, 1, At, B1); PG8_BAR; PG8_SCHED;
            PG8_LDA(At, 1, 1); PG8_STAGE(PG8_SB(1, 0), b3, voffB); PG8_STAGE(PG8_SB(1, 1), b3 + hstep, voffB); PG8_STAGE(PG8_SA(1, 0), a3, voffA);
            PG8_WAIT_V(8); PG8_WAIT_L(0); PG8_BAR; PG8_MMA(1, 0, At, B0); PG8_MMA(1, 1, At, B1); PG8_BAR; PG8_SCHED;
            } else {
            PG8_LDB(B0, 0, 0); PG8_SCHED; PG8_LDA(At, 0, 0); PG8_STAGE(PG8_SA(1, 1), a1 + hstep, voffA);
            PG8_WAIT_L(8); PG8_BAR; PG8_WAIT_L(0); PG8_MMA(0, 0, At, B0); PG8_BAR; PG8_SCHED;
            PG8_LDB(B1, 0, 1); PG8_STAGE(PG8_SB(0, 0), b2, voffB);
            PG8_BAR; PG8_WAIT_L(0); PG8_MMA(0, 1, At, B1); PG8_BAR;
            PG8_LDA(At, 0, 1); PG8_STAGE(PG8_SA(0, 0), a2, voffA);
            PG8_BAR; PG8_WAIT_L(0); PG8_MMA(1, 0, At, B0); PG8_BAR; PG8_SCHED;
            PG8_STAGE(PG8_SB(0, 1), b2 + hstep, voffB);
            PG8_WAIT_V(6); PG8_BAR; PG8_MMA(1, 1, At, B1); PG8_BAR;
            PG8_LDB(B0, 1, 0); PG8_SCHED; PG8_LDA(At, 1, 0); PG8_STAGE(PG8_SA(0, 1), a2 + hstep, voffA);
            PG8_WAIT_L(8); PG8_BAR; PG8_WAIT_L(0); PG8_MMA(0, 0, At, B0); PG8_BAR; PG8_SCHED;
            PG8_LDB(B1, 1, 1); PG8_STAGE(PG8_SB(1, 0), b3, voffB);
            PG8_BAR; PG8_WAIT_L(0); PG8_MMA(0, 1, At, B1); PG8_BAR;
            PG8_LDA(At, 1, 1); PG8_STAGE(PG8_SA(1, 0), a3, voffA);
            PG8_BAR; PG8_WAIT_L(0); PG8_MMA(1, 0, At, B0); PG8_BAR; PG8_SCHED;
            PG8_STAGE(PG8_SB(1, 1), b3 + hstep, voffB);
            PG8_WAIT_V(6); PG8_BAR; PG8_MMA(1, 1, At, B1); PG8_BAR;
            }
        }
        if constexpr (ALIGN_EPI) { if (wr == 0) PG8_BAR; }
        if constexpr (!Epi::AFTER_DRAIN) { E(acc, cur, wr, wc, fr, fq); S.done(cur); }
        if (!has_next) break;
#pragma unroll
        for (int a = 0; a < 2; ++a)
#pragma unroll
            for (int b = 0; b < 2; ++b)
#pragma unroll
                for (int m = 0; m < 4; ++m)
#pragma unroll
                    for (int n = 0; n < 2; ++n) acc[a][b][m][n] = (f32x4){0.f, 0.f, 0.f, 0.f};
        cur = nxt; cA = nA; cB = nB; ++ui;
        if constexpr (ALIGN_EPI) { if (wr == 1) PG8_BAR; }
    }
    PG8_WAIT_V(0);
    if constexpr (!ALIGN_EPI) { if (wr == 0) PG8_BAR; }
    PG8_BAR;
    if constexpr (Epi::AFTER_DRAIN) { E.fused(acc, cur, wr, wc, fr, fq, lds, wid, lane); S.done(cur); }
#undef PG8_SA
#undef PG8_SB
#undef PG8_STAGE
#undef PG8_LDA
#undef PG8_LDB
#undef PG8_MMA
#undef PG8_WAIT_V
#undef PG8_WAIT_L
#undef PG8_BAR
#undef PG8_SCHED
}
}

#ifndef MK_REP_MASK
#define MK_REP_MASK 0
#endif
#ifndef MK_ONE_LAUNCH
#define MK_ONE_LAUNCH 1
#endif
#define LAS __attribute__((address_space(3)))
typedef unsigned short bf16;
typedef float f32x4 __attribute__((ext_vector_type(4)));
typedef unsigned u32x4 __attribute__((ext_vector_type(4)));
typedef unsigned u32x2 __attribute__((ext_vector_type(2)));
constexpr int D = 1024, NB = 8, SEQ = 2048, NMETA = 16, TP = SEQ + NMETA, DB = 128, DS = 4;
constexpr int NH = 8, DTMP = 1792, DIN = 2816, DFF = 3072;
constexpr int R_SAMPLE = NB * SEQ, R_META = R_SAMPLE + DB * DS, R_END = R_META + NMETA, MP = 17152, M_MAIN = 16896;
constexpr float EPS = 1e-6f, GN_EPS = 64e-5f;
constexpr int NPH = 12;
constexpr int LDS_BYTES = 147456;
enum { I_XP = 0, I_XS, I_STS, I_SWKV, I_SLC, I_SLH, I_SFC, I_META, I_N1G, I_WIN, I_MU, I_W0, I_WUP, I_A0, I_AUP, I_GUP, I_KK, I_KA, I_RK,
       I_GNG, I_GNB, I_LCW, I_LCB, I_LWA, I_LBA, I_LWX, I_LBX, I_LAM, I_LOG, I_WOUT, I_N2G, I_FUP, I_FGATE, I_FCW, I_FCB, I_FDOWN, I_NFG, N_IN };
constexpr size_t O_YP = 0, O_YS = 16777216, O_PSHIFT = 17301504, O_PWKV = 17315840, O_PLC = 17577984, O_PLH = 17590272, O_PFC = 17594368,
                 O_SSHIFT = 17643520, O_SWKV = 17872896, O_SLC = 22067200, O_SLH = 22263808, O_SFC = 22329344, O_END = 23115776;
constexpr size_t MiB = 1u << 20;
constexpr size_t WS_CTL = 0, CTL_ZERO_BYTES = 65536;
constexpr size_t WS_SSQ1 = 1 * MiB, WS_SSQ2 = WS_SSQ1 + (size_t)MP * 16 * 4;
constexpr size_t WS_WUP = 4 * MiB, WS_WGATE = 10 * MiB, WS_WDOWN = 16 * MiB;
constexpr size_t WS_X1B = 22 * MiB, WS_UP = WS_X1B + (size_t)MP * D * 2, WS_HID = WS_UP + (size_t)MP * DFF * 2;
constexpr size_t WS_U = 22 * MiB;
constexpr size_t WS_XN = 115 * MiB, WS_WIN = WS_XN + (size_t)MP * D * 2;
constexpr size_t WS_AP = 190 * MiB, WS_XC = 199 * MiB, WS_BA = 216 * MiB, WS_BB = 217 * MiB, WS_GB = 220 * MiB;
constexpr size_t WS_REC = 115 * MiB, WS_LRU = 182 * MiB, WS_Y = 220 * MiB, WS_MIX = 115 * MiB;
static_assert(WS_SSQ2 + (size_t)MP * 16 * 4 <= WS_WUP, "ssq");
static_assert(WS_HID + (size_t)M_MAIN * DFF * 2 <= 256 * MiB, "hid");
static_assert(WS_U + (size_t)MP * DIN * 2 <= WS_XN, "u");
static_assert(WS_WIN + (size_t)DIN * D * 2 <= WS_LRU, "win");
static_assert(WS_AP + (size_t)MP * 256 * 2 <= WS_XC && WS_XC + (size_t)MP * 512 * 2 <= WS_BA, "ap/xc");
static_assert(WS_GB + (size_t)MP * 1024 * 2 <= 256 * MiB, "gb");
static_assert(WS_REC + (size_t)R_END * 4096 <= WS_LRU && WS_LRU + (size_t)R_END * 2048 <= WS_BA, "rec/lru");
static_assert(WS_Y + (size_t)R_END * 2048 <= 256 * MiB, "y");
constexpr size_t DO_GA = 0, DO_LTOT = (size_t)MP * 1536 * 2, DO_CARRY = DO_LTOT + 513 * 2 * 512 * 4, DO_BON = DO_CARRY + 8 * 64 * 512 * 4, DO_WOUT = O_SFC * 4;
static_assert(DO_BON + (size_t)R_END * 8 * 4 <= O_PSHIFT * 4, "d_out scratch");

struct Args { const float* in[N_IN]; float* out; unsigned char* ws; int ph_lo, ph_hi; };

__device__ __forceinline__ float bf2f(bf16 h) { return __uint_as_float(((unsigned)h) << 16); }
__device__ __forceinline__ unsigned f2bf(float f) { unsigned u = __float_as_uint(f); return (u + 0x7fffu + ((u >> 16) & 1u)) >> 16; }
__device__ __forceinline__ unsigned pk2(float lo, float hi) { return f2bf(lo) | (f2bf(hi) << 16); }
__device__ __forceinline__ float lo16(unsigned w) { return __uint_as_float(w << 16); }
__device__ __forceinline__ float hi16(unsigned w) { return __uint_as_float(w & 0xffff0000u); }
__device__ __forceinline__ float sigm(float x) { return 1.f / (1.f + __expf(-x)); }
__device__ __forceinline__ float softplus_(float z) { return fmaxf(z, 0.f) + log1pf(__expf(-fabsf(z))); }
__device__ __forceinline__ float gelu_tanh(float x) { const float u = 1.5957691216057308f * (x + 0.044715f * x * x * x); return x / (1.f + __expf(-u)); }
__device__ __forceinline__ float tanh_(float x) { const float e = __expf(2.f * x); return 1.f - 2.f / (e + 1.f); }
__device__ __forceinline__ float wave_sum(float v) {
#pragma unroll
    for (int o = 1; o < 64; o <<= 1) v += __shfl_xor(v, o);
    return v;
}
template <int CTRL> __device__ __forceinline__ float dpp_f(float x) { return __int_as_float(__builtin_amdgcn_update_dpp(0, __float_as_int(x), CTRL, 0xF, 0xF, true)); }
__device__ __forceinline__ float allsum16(float x) { x += dpp_f<0xB1>(x); x += dpp_f<0x4E>(x); x += dpp_f<0x141>(x); x += dpp_f<0x140>(x); return x; }

struct RowInfo { int kind, b, t; };
__device__ __forceinline__ RowInfo row_info(int row) {
    RowInfo r;
    if (row < R_SAMPLE) { r.kind = 0; r.b = row >> 11; r.t = (row & 2047) + NMETA; }
    else if (row < R_META) { r.kind = 1; r.b = (row - R_SAMPLE) >> 2; r.t = (row - R_SAMPLE) & 3; }
    else if (row < R_END) { r.kind = 2; r.b = 0; r.t = row - R_META; }
    else { r.kind = 3; r.b = 0; r.t = 0; }
    return r;
}
__device__ __forceinline__ int prompt_row(int b, int t) { return t < NMETA ? R_META + t : b * SEQ + t - NMETA; }
__device__ __forceinline__ int row_back(const RowInfo& ri, int row, int j) {
    const int tt = ri.t - j; if (tt < 0) return -1;
    if (ri.kind == 1) return row - j;
    return prompt_row(ri.b, tt);
}
__device__ __forceinline__ void unpack8(const u32x4 w, float (&f)[8]) {
    f[0] = lo16(w.x); f[1] = hi16(w.x); f[2] = lo16(w.y); f[3] = hi16(w.y); f[4] = lo16(w.z); f[5] = hi16(w.z); f[6] = lo16(w.w); f[7] = hi16(w.w);
}
__device__ __forceinline__ float row_rs(const float* ssq, int row) {
    const f32x4* p = (const f32x4*)(ssq + (size_t)row * 16); const f32x4 a = p[0], b = p[1], c = p[2], d = p[3];
    const float s = ((a.x + a.y) + (a.z + a.w)) + ((b.x + b.y) + (b.z + b.w)) + ((c.x + c.y) + (c.z + c.w)) + ((d.x + d.y) + (d.z + d.w));
    return rsqrtf(s * (1.f / 1024.f) + EPS);
}

#define EPI_ROW(ai, m) (u.pm * 256 + (ai) * 128 + wr * 64 + (m) * 16 + fr)
#define EPI_COL(bj) (u.pn * 256 + (bj) * 128 + wc * 32 + 8 * fq)
struct EpiX1 {
    static constexpr bool PERM = true, AFTER_DRAIN = false;
    const float* xp; const float* xs; const float* meta; float* x1; bf16* x1b; float* ssq;
    __device__ __forceinline__ void operator()(const f32x4 (&acc)[2][2][4][2], const pg8::Unit& u, int wr, int wc, int fr, int fq) const {
#pragma unroll
        for (int ai = 0; ai < 2; ++ai)
#pragma unroll
            for (int m = 0; m < 4; ++m) {
                const int row = EPI_ROW(ai, m);
                const float* res = row < R_SAMPLE ? xp + (size_t)row * D : row < R_META ? xs + (size_t)(row - R_SAMPLE) * D : row < R_END ? meta + (size_t)(row - R_META) * D : nullptr;
                float s = 0.f;
#pragma unroll
                for (int bj = 0; bj < 2; ++bj) {
                    const int col = EPI_COL(bj);
                    f32x4 v0 = acc[ai][bj][m][0], v1 = acc[ai][bj][m][1];
                    if (res) { v0 += *(const f32x4*)(res + col); v1 += *(const f32x4*)(res + col + 4); }
                    if (row < M_MAIN) { *(f32x4*)(x1 + (size_t)row * D + col) = v0; *(f32x4*)(x1 + (size_t)row * D + col + 4) = v1; }
                    u32x4 w; w.x = pk2(v0.x, v0.y); w.y = pk2(v0.z, v0.w); w.z = pk2(v1.x, v1.y); w.w = pk2(v1.z, v1.w);
                    *(u32x4*)(x1b + (size_t)row * D + col) = w;
                    s += (v0.x * v0.x + v0.y * v0.y) + (v0.z * v0.z + v0.w * v0.w) + (v1.x * v1.x + v1.y * v1.y) + (v1.z * v1.z + v1.w * v1.w);
                }
                s += __shfl_xor(s, 16); s += __shfl_xor(s, 32);
                if (fq == 0) ssq[(size_t)row * 16 + u.pn * 4 + wc] = s;
            }
    }
};
struct EpiUp {
    static constexpr bool PERM = true, AFTER_DRAIN = false;
    const float* ssq; bf16* up; float* pffn; float* sffn;
    __device__ __forceinline__ void operator()(const f32x4 (&acc)[2][2][4][2], const pg8::Unit& u, int wr, int wc, int fr, int fq) const {
#pragma unroll
        for (int ai = 0; ai < 2; ++ai)
#pragma unroll
            for (int m = 0; m < 4; ++m) {
                const int row = EPI_ROW(ai, m);
                const float rs = row_rs(ssq, row);
                const RowInfo ri = row_info(row);
                float* st = nullptr;
                if (ri.kind == 0 && ri.t >= TP - 2) st = pffn + ((size_t)ri.b * 2 + (ri.t - (TP - 2))) * DFF;
                else if (ri.kind == 1 && ri.t >= 2) st = sffn + ((size_t)ri.b * 2 + (ri.t - 2)) * DFF;
#pragma unroll
                for (int bj = 0; bj < 2; ++bj) {
                    const int col = EPI_COL(bj);
                    const f32x4 v0 = acc[ai][bj][m][0] * rs, v1 = acc[ai][bj][m][1] * rs;
                    u32x4 w; w.x = pk2(v0.x, v0.y); w.y = pk2(v0.z, v0.w); w.z = pk2(v1.x, v1.y); w.w = pk2(v1.z, v1.w);
                    *(u32x4*)(up + (size_t)row * DFF + col) = w;
                    if (st) { *(f32x4*)(st + col) = v0; *(f32x4*)(st + col + 4) = v1; }
                }
            }
    }
};
struct EpiGate {
    static constexpr bool PERM = true, AFTER_DRAIN = false;
    const float* ssq; const bf16* up; const float* stf; const float* cw; const float* cb; bf16* hid;
    __device__ __forceinline__ void operator()(const f32x4 (&acc)[2][2][4][2], const pg8::Unit& u, int wr, int wc, int fr, int fq) const {
#pragma unroll
        for (int ai = 0; ai < 2; ++ai)
#pragma unroll
            for (int m = 0; m < 4; ++m) {
                const int row = EPI_ROW(ai, m);
                const float rs = row_rs(ssq, row);
                const RowInfo ri = row_info(row);
                const int r1 = row_back(ri, row, 1), r2 = row_back(ri, row, 2);
#pragma unroll
                for (int bj = 0; bj < 2; ++bj) {
                    const int col = EPI_COL(bj);
                    float g[8], u0[8], p1[8], p2[8];
                    { const f32x4 v0 = acc[ai][bj][m][0] * rs, v1 = acc[ai][bj][m][1] * rs; g[0] = v0.x; g[1] = v0.y; g[2] = v0.z; g[3] = v0.w; g[4] = v1.x; g[5] = v1.y; g[6] = v1.z; g[7] = v1.w; }
                    unpack8(*(const u32x4*)(up + (size_t)row * DFF + col), u0);
                    if (r1 >= 0) unpack8(*(const u32x4*)(up + (size_t)r1 * DFF + col), p1);
                    else if (ri.kind == 1) { const float* s = stf + ((size_t)ri.b * 2 + (1 + ri.t)) * DFF + col; const f32x4 a = *(const f32x4*)s, b = *(const f32x4*)(s + 4);
                        p1[0] = a.x; p1[1] = a.y; p1[2] = a.z; p1[3] = a.w; p1[4] = b.x; p1[5] = b.y; p1[6] = b.z; p1[7] = b.w; }
                    else {
#pragma unroll
                        for (int i = 0; i < 8; ++i) p1[i] = 0.f; }
                    if (r2 >= 0) unpack8(*(const u32x4*)(up + (size_t)r2 * DFF + col), p2);
                    else if (ri.kind == 1) { const float* s = stf + ((size_t)ri.b * 2 + ri.t) * DFF + col; const f32x4 a = *(const f32x4*)s, b = *(const f32x4*)(s + 4);
                        p2[0] = a.x; p2[1] = a.y; p2[2] = a.z; p2[3] = a.w; p2[4] = b.x; p2[5] = b.y; p2[6] = b.z; p2[7] = b.w; }
                    else {
#pragma unroll
                        for (int i = 0; i < 8; ++i) p2[i] = 0.f; }
                    float o[8];
#pragma unroll
                    for (int h = 0; h < 2; ++h) {
                        const f32x4 w0 = *(const f32x4*)(cw + col + 4 * h), w1 = *(const f32x4*)(cw + DFF + col + 4 * h), w2 = *(const f32x4*)(cw + 2 * DFF + col + 4 * h), bb = *(const f32x4*)(cb + col + 4 * h);
#pragma unroll
                        for (int i = 0; i < 4; ++i) { const int e = 4 * h + i; const float c = bb[i] + w0[i] * p2[e] + w1[i] * p1[e] + w2[i] * u0[e]; o[e] = gelu_tanh(c) * g[e]; }
                    }
                    u32x4 w; w.x = pk2(o[0], o[1]); w.y = pk2(o[2], o[3]); w.z = pk2(o[4], o[5]); w.w = pk2(o[6], o[7]);
                    *(u32x4*)(hid + (size_t)row * DFF + col) = w;
                }
            }
    }
};
struct EpiDown {
    static constexpr bool PERM = true, AFTER_DRAIN = false;
    float* x; float* ssq;
    __device__ __forceinline__ void operator()(const f32x4 (&acc)[2][2][4][2], const pg8::Unit& u, int wr, int wc, int fr, int fq) const {
#pragma unroll
        for (int ai = 0; ai < 2; ++ai)
#pragma unroll
            for (int m = 0; m < 4; ++m) {
                const int row = EPI_ROW(ai, m);
                float s = 0.f;
#pragma unroll
                for (int bj = 0; bj < 2; ++bj) {
                    const int col = EPI_COL(bj);
                    float* p = x + (size_t)row * D + col;
                    const f32x4 v0 = acc[ai][bj][m][0] + *(const f32x4*)p, v1 = acc[ai][bj][m][1] + *(const f32x4*)(p + 4);
                    *(f32x4*)p = v0; *(f32x4*)(p + 4) = v1;
                    s += (v0.x * v0.x + v0.y * v0.y) + (v0.z * v0.z + v0.w * v0.w) + (v1.x * v1.x + v1.y * v1.y) + (v1.z * v1.z + v1.w * v1.w);
                }
                s += __shfl_xor(s, 16); s += __shfl_xor(s, 32);
                if (fq == 0) ssq[(size_t)row * 16 + u.pn * 4 + wc] = s;
            }
    }
};
struct EpiPlain {
    static constexpr bool PERM = true, AFTER_DRAIN = false;
    bf16* O; int ldc;
    __device__ __forceinline__ void operator()(const f32x4 (&acc)[2][2][4][2], const pg8::Unit& u, int wr, int wc, int fr, int fq) const {
#pragma unroll
        for (int ai = 0; ai < 2; ++ai)
#pragma unroll
            for (int m = 0; m < 4; ++m) {
                const int row = EPI_ROW(ai, m);
#pragma unroll
                for (int bj = 0; bj < 2; ++bj) {
                    const int col = EPI_COL(bj);
                    const f32x4 v0 = acc[ai][bj][m][0], v1 = acc[ai][bj][m][1];
                    u32x4 w; w.x = pk2(v0.x, v0.y); w.y = pk2(v0.z, v0.w); w.z = pk2(v1.x, v1.y); w.w = pk2(v1.z, v1.w);
                    *(u32x4*)(O + (size_t)row * ldc + col) = w;
                }
            }
    }
};

#define XB_TMO      128
#define XB_XCNT(j)  (256  + 64 * (j))
#define XB_XSUB(j)  (1280 + 64 * (j))
#define XB_XGEN(j)  (2304 + 64 * (j))
#define XB_TOP      3328
#define XB_TOPGEN   3392
#define XCD_BAR_WORDS 3456
#define XB_SPIN_CAP (1u << 22)
__device__ __forceinline__ unsigned xb_ld(unsigned* p)              { return __hip_atomic_load(p, __ATOMIC_RELAXED, __HIP_MEMORY_SCOPE_AGENT); }
__device__ __forceinline__ unsigned xb_add(unsigned* p, unsigned v) { return __hip_atomic_fetch_add(p, v, __ATOMIC_RELAXED, __HIP_MEMORY_SCOPE_AGENT); }
__device__ __forceinline__ unsigned xb_xcc_id() { return (unsigned)__builtin_amdgcn_s_getreg((3 << 11) | 20) & 0xFu; }
#define XB_SPIN(cond, bar) do { unsigned _sp = 0; while (cond) { __builtin_amdgcn_s_sleep(1); \
    if ((++_sp & 255u) == 0u) { if (xb_ld(&(bar)[XB_TMO])) break; if (_sp > XB_SPIN_CAP) { atomicAdd(&(bar)[XB_TMO], 1u); break; } } } } while (0)
struct XcdBarrier { unsigned* bar; unsigned x; volatile LAS unsigned* st; };
__device__ __forceinline__ XcdBarrier xcd_barrier_post(unsigned* bar, volatile LAS unsigned* st) {
    XcdBarrier b; b.bar = bar; b.x = xb_xcc_id(); b.st = st;
    if (threadIdx.x == 0) (void)xb_add(&bar[XB_XCNT(b.x)], 1u);
    return b;
}
__device__ __forceinline__ void xcd_barrier_complete(unsigned* bar, unsigned x, unsigned& nloc, unsigned& nx) {
    const unsigned G = gridDim.x * gridDim.y * gridDim.z;
    unsigned sum, cnt, mine, sp = 0u;
    for (;;) {
        sum = 0u; cnt = 0u; mine = 0u;
#pragma unroll
        for (unsigned j = 0; j < 16; ++j) { const unsigned c = xb_ld(&bar[XB_XCNT(j)]); sum += c; cnt += (c > 0u) ? 1u : 0u; mine = (j == x) ? c : mine; }
        if (sum == G) break;
        __builtin_amdgcn_s_sleep(1);
        if ((++sp & 255u) == 0u) { if (xb_ld(&bar[XB_TMO])) break; if (sp > XB_SPIN_CAP) { atomicAdd(&bar[XB_TMO], 1u); break; } }
    }
    nloc = mine > 0u ? mine : 1u; nx = cnt > 0u ? cnt : 1u;
}
__device__ __forceinline__ void xcd_barrier(const XcdBarrier& b) {
    asm volatile("s_waitcnt vmcnt(0)" ::: "memory");
    __syncthreads();
    if (threadIdx.x == 0) {
        unsigned* bar = b.bar;
        __builtin_amdgcn_s_waitcnt(0);
        unsigned nloc = b.st[0], nx = b.st[1];
        if (nloc == 0u) { xcd_barrier_complete(bar, b.x, nloc, nx); b.st[0] = nloc; b.st[1] = nx; }
        const unsigned old = xb_add(&bar[XB_XSUB(b.x)], 1u);
        const unsigned gen = old / nloc;
        if (old + 1u == (gen + 1u) * nloc) {
            __builtin_amdgcn_fence(__ATOMIC_RELEASE, "agent");
            asm volatile("s_waitcnt vmcnt(0)" ::: "memory");
            const unsigned og = xb_add(&bar[XB_TOP], 1u);
            const unsigned tg = og / nx;
            if (og + 1u == (tg + 1u) * nx) xb_add(&bar[XB_TOPGEN], 1u);
            else XB_SPIN(xb_ld(&bar[XB_TOPGEN]) == tg, bar);
            __builtin_amdgcn_fence(__ATOMIC_ACQUIRE, "agent");
            xb_add(&bar[XB_XGEN(b.x)], 1u);
            asm volatile("s_waitcnt vmcnt(0)" ::: "memory");
        } else {
            XB_SPIN(xb_ld(&bar[XB_XGEN(b.x)]) == gen, bar);
            __builtin_amdgcn_fence(__ATOMIC_ACQUIRE, "agent");
            asm volatile("s_waitcnt vmcnt(0)" ::: "memory");
        }
    }
    __syncthreads();
}

__device__ __forceinline__ void p0_transpose_item(const float* W, int K, int N, bf16* WT, const float* ksc, LAS float* scr, int item, int lane) {
    const int nblk = N / 32, kb = item / nblk, nb = item % nblk, k0 = 64 * kb, n0 = 32 * nb;
#pragma unroll 8
    for (int i = 0; i < 32; ++i) { const int kk = 2 * i + (lane >> 5); float v = W[(size_t)(k0 + kk) * N + n0 + (lane & 31)]; if (ksc) v *= ksc[k0 + kk]; scr[kk * 33 + (lane & 31)] = v; }
    asm volatile("s_waitcnt lgkmcnt(0)" ::: "memory");
    const int c = lane & 7;
#pragma unroll
    for (int j = 0; j < 4; ++j) { const int n = (lane >> 3) + 8 * j; const LAS float* s = scr + (8 * c) * 33 + n;
        u32x4 o; o.x = pk2(s[0 * 33], s[1 * 33]); o.y = pk2(s[2 * 33], s[3 * 33]); o.z = pk2(s[4 * 33], s[5 * 33]); o.w = pk2(s[6 * 33], s[7 * 33]);
        *(u32x4*)(WT + (size_t)(n0 + n) * K + k0 + 8 * c) = o; }
    asm volatile("s_waitcnt lgkmcnt(0)" ::: "memory");
}
__device__ __forceinline__ void phase_p0(const Args& A, LAS unsigned char* lds, int G) {
    const int tid = threadIdx.x, lane = tid & 63, wave = tid >> 6;
    LAS float* scr = (LAS float*)(lds + wave * 16384);
    const int gw = blockIdx.x * 8 + wave, NGW = G * 8;
    unsigned char* ws = A.ws;
    constexpr int I_IN = 16 * 88, I_OUT = 16 * 32, I_UPI = 16 * 96, I_DN = 48 * 32, NIT = I_IN + I_OUT + 2 * I_UPI + I_DN;
    for (int it = gw; it < NIT; it += NGW) {
        int r = it;
        if (r < I_IN) { p0_transpose_item(A.in[I_WIN], D, DIN, (bf16*)(ws + WS_WIN), nullptr, scr, r, lane); continue; } r -= I_IN;
        if (r < I_OUT) { p0_transpose_item(A.in[I_WOUT], D, D, (bf16*)((unsigned char*)A.out + DO_WOUT), nullptr, scr, r, lane); continue; } r -= I_OUT;
        if (r < I_UPI) { p0_transpose_item(A.in[I_FUP], D, DFF, (bf16*)(ws + WS_WUP), A.in[I_N2G], scr, r, lane); continue; } r -= I_UPI;
        if (r < I_UPI) { p0_transpose_item(A.in[I_FGATE], D, DFF, (bf16*)(ws + WS_WGATE), A.in[I_N2G], scr, r, lane); continue; } r -= I_UPI;
        p0_transpose_item(A.in[I_FDOWN], DFF, D, (bf16*)(ws + WS_WDOWN), nullptr, scr, r, lane);
    }
    const int gt = blockIdx.x * 512 + tid, NGT = G * 512;
    { bf16* BA = (bf16*)(ws + WS_BA); const float* wup = A.in[I_WUP]; const float* aup = A.in[I_AUP]; const float* gup = A.in[I_GUP];
      for (int e = gt; e < 1536 * 256; e += NGT) { const int n = e >> 8, k = e & 255; float v = 0.f;
          if (n < 512) { if (k < 64) v = wup[k * 512 + n]; }
          else if (n < 1024) { if (k >= 64 && k < 128) v = aup[(k - 64) * 512 + n - 512]; }
          else { if (k >= 128) v = gup[(k - 128) * 512 + n - 1024]; }
          BA[e] = (bf16)f2bf(v); } }
    { bf16* BB = (bf16*)(ws + WS_BB); const float* wa = A.in[I_LWA]; const float* wx = A.in[I_LWX];
      for (int e = gt; e < 1024 * 512; e += NGT) { const int n = e >> 9, k = e & 511, nn = n & 511, h = nn >> 6, j = nn & 63; float v = 0.f;
          if ((k >> 6) == h) { const float* Wm = n < 512 ? wa : wx; v = Wm[(h * 64 + (k & 63)) * 64 + j]; }
          BB[e] = (bf16)f2bf(v); } }
    bf16* XN = (bf16*)(ws + WS_XN); const float* g1 = A.in[I_N1G];
    for (int row = gw; row < MP; row += NGW) {
        const float* src = row < R_SAMPLE ? A.in[I_XP] + (size_t)row * D : row < R_META ? A.in[I_XS] + (size_t)(row - R_SAMPLE) * D : row < R_END ? A.in[I_META] + (size_t)(row - R_META) * D : nullptr;
        u32x2* o = (u32x2*)(XN + (size_t)row * D);
        if (!src) {
#pragma unroll
            for (int j = 0; j < 4; ++j) o[lane + 64 * j] = (u32x2){0u, 0u};
            continue; }
        f32x4 v[4]; float s = 0.f;
#pragma unroll
        for (int j = 0; j < 4; ++j) { v[j] = ((const f32x4*)src)[lane + 64 * j]; s += (v[j].x * v[j].x + v[j].y * v[j].y) + (v[j].z * v[j].z + v[j].w * v[j].w); }
        const float rs = rsqrtf(wave_sum(s) * (1.f / D) + EPS);
#pragma unroll
        for (int j = 0; j < 4; ++j) { const f32x4 g = ((const f32x4*)g1)[lane + 64 * j];
            o[lane + 64 * j] = (u32x2){pk2(v[j].x * rs * g.x, v[j].y * rs * g.y), pk2(v[j].z * rs * g.z, v[j].w * rs * g.w)}; }
    }
}

__device__ __forceinline__ void phase_e1(const Args& A, int G) {
    const int tid = threadIdx.x, lane = tid & 63, wave = tid >> 6;
    const int gw = blockIdx.x * 8 + wave, NGW = G * 8;
    unsigned char* ws = A.ws;
    const bf16* U = (const bf16*)(ws + WS_U); bf16* AP = (bf16*)(ws + WS_AP); bf16* XC = (bf16*)(ws + WS_XC);
    const float* mu = A.in[I_MU]; const float* sts = A.in[I_STS]; const float* slc = A.in[I_SLC]; const float* lcw = A.in[I_LCW]; const float* lcb = A.in[I_LCB];
    for (int row = gw; row < MP; row += NGW) {
        bf16* ap = AP + (size_t)row * 256; bf16* xc = XC + (size_t)row * 512;
        const RowInfo ri = row_info(row);
        if (ri.kind == 3) { ((u32x2*)ap)[lane] = (u32x2){0u, 0u}; ((u32x4*)xc)[lane] = (u32x4){0u, 0u, 0u, 0u}; continue; }
        const bf16* urow = U + (size_t)row * DIN;
        const int r1 = row_back(ri, row, 1);
        {
            const int c0 = 1536 + 4 * lane;
            const u32x2 uw = *(const u32x2*)(urow + c0);
            float u[4] = {lo16(uw.x), hi16(uw.x), lo16(uw.y), hi16(uw.y)}, p[4];
            if (r1 >= 0) { const u32x2 pw = *(const u32x2*)(U + (size_t)r1 * DIN + c0); p[0] = lo16(pw.x); p[1] = hi16(pw.x); p[2] = lo16(pw.y); p[3] = hi16(pw.y); }
            else if (ri.kind == 1) { const f32x4 pv = *(const f32x4*)(sts + (size_t)ri.b * DTMP + c0); p[0] = pv.x; p[1] = pv.y; p[2] = pv.z; p[3] = pv.w; }
            else { p[0] = p[1] = p[2] = p[3] = 0.f; }
            const f32x4 m4 = *(const f32x4*)(mu + c0);
            float o[4];
#pragma unroll
            for (int i = 0; i < 4; ++i) { const float um = u[i] + (p[i] - u[i]) * m4[i]; o[i] = lane < 16 ? tanh_(um) : lane < 32 ? um : sigm(um); }
            ((u32x2*)ap)[lane] = (u32x2){pk2(o[0], o[1]), pk2(o[2], o[3])};
        }
        {
            const int c = 8 * lane;
            float acc[8], cur[8];
            { const f32x4 b0 = *(const f32x4*)(lcb + c), b1 = *(const f32x4*)(lcb + c + 4); acc[0] = b0.x; acc[1] = b0.y; acc[2] = b0.z; acc[3] = b0.w; acc[4] = b1.x; acc[5] = b1.y; acc[6] = b1.z; acc[7] = b1.w; }
#pragma unroll
            for (int j = 0; j < 4; ++j) {
                float val[8];
                const int rj = (j == 3) ? row : row_back(ri, row, 3 - j);
                if (rj >= 0) unpack8(*(const u32x4*)(U + (size_t)rj * DIN + DTMP + c), val);
                else if (ri.kind == 1) { const float* s = slc + ((size_t)ri.b * 3 + (ri.t + j)) * 512 + c; const f32x4 a = *(const f32x4*)s, b = *(const f32x4*)(s + 4);
                    val[0] = a.x; val[1] = a.y; val[2] = a.z; val[3] = a.w; val[4] = b.x; val[5] = b.y; val[6] = b.z; val[7] = b.w; }
                else {
#pragma unroll
                    for (int i = 0; i < 8; ++i) val[i] = 0.f; }
                const f32x4 w0 = *(const f32x4*)(lcw + j * 512 + c), w1 = *(const f32x4*)(lcw + j * 512 + c + 4);
#pragma unroll
                for (int i = 0; i < 4; ++i) { acc[i] += w0[i] * val[i]; acc[4 + i] += w1[i] * val[4 + i]; }
                if (j == 3) {
#pragma unroll
                    for (int i = 0; i < 8; ++i) cur[i] = val[i]; }
            }
            u32x4 w; w.x = pk2(acc[0], acc[1]); w.y = pk2(acc[2], acc[3]); w.z = pk2(acc[4], acc[5]); w.w = pk2(acc[6], acc[7]);
            ((u32x4*)xc)[lane] = w;
            float* lco = nullptr;
            if (ri.kind == 0 && ri.t >= TP - 3) lco = A.out + O_PLC + ((size_t)ri.b * 3 + (ri.t - (TP - 3))) * 512 + c;
            else if (ri.kind == 1 && ri.t >= 1) lco = A.out + O_SLC + ((size_t)ri.b * 3 + (ri.t - 1)) * 512 + c;
            if (lco) { *(f32x4*)lco = (f32x4){cur[0], cur[1], cur[2], cur[3]}; *(f32x4*)(lco + 4) = (f32x4){cur[4], cur[5], cur[6], cur[7]}; }
        }
        float* sho = nullptr;
        if (ri.kind == 0 && ri.t == TP - 1) sho = A.out + O_PSHIFT + (size_t)ri.b * DTMP;
        else if (ri.kind == 1 && ri.t == DS - 1) sho = A.out + O_SSHIFT + (size_t)ri.b * DTMP;
        if (sho) for (int i = lane; i < DTMP; i += 64) sho[i] = bf2f(urow[i]);
    }
}

__device__ __forceinline__ float sum8(float x) { x += dpp_f<0xB1>(x); x += dpp_f<0x4E>(x); x += dpp_f<0x141>(x); return x; }
__device__ __forceinline__ void ld8f(const float* p, float (&f)[8]) { const f32x4 a = *(const f32x4*)p, b = *(const f32x4*)(p + 4); f[0] = a.x; f[1] = a.y; f[2] = a.z; f[3] = a.w; f[4] = b.x; f[5] = b.y; f[6] = b.z; f[7] = b.w; }
__device__ __forceinline__ u32x4 pack8(const float (&o)[8]) { u32x4 w; w.x = pk2(o[0], o[1]); w.y = pk2(o[2], o[3]); w.z = pk2(o[4], o[5]); w.w = pk2(o[6], o[7]); return w; }
__device__ __forceinline__ void phase_e2(const Args& A, int G) {
    const int tid = threadIdx.x, lane = tid & 63, wave = tid >> 6;
    unsigned char* ws = A.ws;
    const bf16* U = (const bf16*)(ws + WS_U); const bf16* GB = (const bf16*)(ws + WS_GB); const bf16* GA = (const bf16*)((unsigned char*)A.out + DO_GA);
    bf16* REC = (bf16*)(ws + WS_REC); bf16* LRU = (bf16*)(ws + WS_LRU);
    float* LTOT = (float*)((unsigned char*)A.out + DO_LTOT); float* BON = (float*)((unsigned char*)A.out + DO_BON);
    const float* mu = A.in[I_MU]; const float* sts = A.in[I_STS]; const float* slc = A.in[I_SLC]; const float* slh = A.in[I_SLH];
    for (int unit = blockIdx.x; unit < 513 + DB; unit += G) {
        int row0, ntok, kind;
        if (unit < 512) { row0 = unit * 32; ntok = 32; kind = 0; } else if (unit == 512) { row0 = R_META; ntok = 16; kind = 2; } else { row0 = R_SAMPLE + (unit - 513) * 4; ntok = 4; kind = 1; }
        const int c = tid;
        const float sp = softplus_(-A.in[I_LAM][c]);
        const float cw0 = A.in[I_LCW][c], cw1 = A.in[I_LCW][512 + c], cw2 = A.in[I_LCW][1024 + c], cw3 = A.in[I_LCW][1536 + c], cbias = A.in[I_LCB][c];
        const float ba_ = A.in[I_LBA][c], bx_ = A.in[I_LBX][c];
        float l1 = 0.f, l2 = 0.f, l3 = 0.f, H = 0.f, P = 1.f;
        if (kind == 0) { const RowInfo ri0 = row_info(row0);
            l1 = bf2f(U[(size_t)row_back(ri0, row0, 1) * DIN + DTMP + c]); l2 = bf2f(U[(size_t)row_back(ri0, row0, 2) * DIN + DTMP + c]); l3 = bf2f(U[(size_t)row_back(ri0, row0, 3) * DIN + DTMP + c]); }
        else if (kind == 1) { const int b = unit - 513; l3 = slc[((size_t)b * 3 + 0) * 512 + c]; l2 = slc[((size_t)b * 3 + 1) * 512 + c]; l1 = slc[((size_t)b * 3 + 2) * 512 + c]; H = slh[(size_t)b * 512 + c]; }
#pragma unroll 4
        for (int j = 0; j < ntok; ++j) {
            const int row = row0 + j;
            const float l0 = bf2f(U[(size_t)row * DIN + DTMP + c]);
            const float xc = cbias + cw0 * l3 + cw1 * l2 + cw2 * l1 + cw3 * l0;
            l3 = l2; l2 = l1; l1 = l0;
            const float ra = bf2f(GB[(size_t)row * 1024 + c]) + ba_, ix = bf2f(GB[(size_t)row * 1024 + 512 + c]) + bx_;
            const float rg = sigm(ra), ig = sigm(ix);
            const float la = -8.f * rg * sp, a = __expf(la);
            float mult = sqrtf(fmaxf(1.f - __expf(2.f * la), 0.f)); if (kind == 2 && j == 0) mult = 1.f;
            H = a * H + xc * ig * mult; P = P * a;
            LRU[(size_t)row * 1024 + c] = (bf16)f2bf(H); LRU[(size_t)row * 1024 + 512 + c] = (bf16)f2bf(kind == 1 ? 0.f : P);
        }
        if (kind == 1) A.out[O_SLH + (size_t)(unit - 513) * 512 + c] = H;
        else { LTOT[((size_t)unit * 2 + 0) * 512 + c] = P; LTOT[((size_t)unit * 2 + 1) * 512 + c] = H; }
    }
    {
        const int c = 8 * lane, h = lane >> 3, gw = blockIdx.x * 8 + wave, NGW = G * 8;
        float mr[8], mk[8], w0[8], a0[8], kkw[8], kaw[8], rkw[8];
        ld8f(mu + c, mr); ld8f(mu + 512 + c, mk); ld8f(A.in[I_W0] + c, w0); ld8f(A.in[I_A0] + c, a0); ld8f(A.in[I_KK] + c, kkw); ld8f(A.in[I_KA] + c, kaw); ld8f(A.in[I_RK] + c, rkw);
        for (int row = gw; row < R_END; row += NGW) {
            const RowInfo ri = row_info(row); const int r1 = row_back(ri, row, 1);
            const bf16* ur = U + (size_t)row * DIN;
            float u_r[8], u_k[8], p_r[8], p_k[8], wp[8], ap[8];
            unpack8(*(const u32x4*)(ur + c), u_r); unpack8(*(const u32x4*)(ur + 512 + c), u_k);
            unpack8(*(const u32x4*)(GA + (size_t)row * 1536 + c), wp); unpack8(*(const u32x4*)(GA + (size_t)row * 1536 + 512 + c), ap);
            if (r1 >= 0) { unpack8(*(const u32x4*)(U + (size_t)r1 * DIN + c), p_r); unpack8(*(const u32x4*)(U + (size_t)r1 * DIN + 512 + c), p_k); }
            else if (ri.kind == 1) { ld8f(sts + (size_t)ri.b * DTMP + c, p_r); ld8f(sts + (size_t)ri.b * DTMP + 512 + c, p_k); }
            else {
#pragma unroll
                for (int i = 0; i < 8; ++i) { p_r[i] = 0.f; p_k[i] = 0.f; } }
            float av[8], xv[8], kk[8], kp[8], ss = 0.f, bs = 0.f;
#pragma unroll
            for (int i = 0; i < 8; ++i) {
                const float um_r = u_r[i] + (p_r[i] - u_r[i]) * mr[i], um_k = u_k[i] + (p_k[i] - u_k[i]) * mk[i];
                const float z = -(wp[i] + w0[i]);
                const float w_log = -(fmaxf(z, 0.f) + __logf(1.f + __expf(-fabsf(z)))) - 0.5f;
                const float e = __expf(w_log); xv[i] = 1.f - __expf(-e);
                av[i] = sigm(ap[i] + a0[i]);
                kk[i] = um_k * kkw[i]; ss += kk[i] * kk[i];
                kp[i] = um_k * (1.f + (av[i] - 1.f) * kaw[i]);
                bs += um_r * kp[i] * rkw[i];
            }
            ss = sum8(ss); bs = sum8(bs);
            const float rn = rsqrtf(fmaxf(ss, 1e-24f));
#pragma unroll
            for (int i = 0; i < 8; ++i) kk[i] *= rn;
            bf16* rec = REC + ((size_t)row * 8 + h) * 256 + (lane & 7) * 8;
            *(u32x4*)rec = pack8(av); *(u32x4*)(rec + 64) = pack8(xv); *(u32x4*)(rec + 128) = pack8(kk); *(u32x4*)(rec + 192) = pack8(kp);
            if ((lane & 7) == 0) BON[(size_t)row * 8 + h] = bs;
        }
    }
}

struct Raw { bf16 a, x, kk, kp, ur, uv, pr, pv; };
__device__ __forceinline__ void m2_load(Raw (&raw)[8], const bf16* REC, const bf16* U, int b, int h, int t0, int ns, int k, int sub) {
#pragma unroll
    for (int i = 0; i < 8; ++i) {
        const int s = sub + 4 * i;
        raw[i].a = 0; raw[i].x = 0; raw[i].kk = 0; raw[i].kp = 0; raw[i].ur = 0; raw[i].uv = 0; raw[i].pr = 0; raw[i].pv = 0;
        if (s < ns) {
            const int t = t0 + s, row = prompt_row(b, t);
            const bf16* rec = REC + ((size_t)row * 8 + h) * 256;
            raw[i].a = rec[k]; raw[i].x = rec[64 + k]; raw[i].kk = rec[128 + k]; raw[i].kp = rec[192 + k];
            const bf16* ur = U + (size_t)row * DIN + h * 64 + k; raw[i].ur = ur[0]; raw[i].uv = ur[1024];
            if (t > 0) { const bf16* pr = U + (size_t)prompt_row(b, t - 1) * DIN + h * 64 + k; raw[i].pr = pr[0]; raw[i].pv = pr[1024]; }
        }
    }
}
__device__ __forceinline__ void m2_store(const Raw (&raw)[8], LAS float* buf, float mu_r, float mu_v, int k, int sub, int ns) {
#pragma unroll
    for (int i = 0; i < 8; ++i) {
        const int s = sub + 4 * i;
        if (s < ns) {
            LAS float* p = buf + s * 384;
            const float a = bf2f(raw[i].a), kk = bf2f(raw[i].kk), ur = bf2f(raw[i].ur), uv = bf2f(raw[i].uv);
            p[k] = kk; p[64 + k] = 1.f - bf2f(raw[i].x); p[128 + k] = -(kk * a); p[192 + k] = bf2f(raw[i].kp);
            p[256 + k] = ur + (bf2f(raw[i].pr) - ur) * mu_r; p[320 + k] = uv + (bf2f(raw[i].pv) - uv) * mu_v;
        }
    }
}
typedef float f32x2 __attribute__((ext_vector_type(2)));
struct StepOps { f32x4 kk, dd, nka, kp, r; float v; };
__device__ __forceinline__ void ops_load(StepOps& o, const LAS float* p, int ks, int vrow) {
    o.kk = *(const LAS f32x4*)(p + 4 * ks); o.dd = *(const LAS f32x4*)(p + 64 + 4 * ks); o.nka = *(const LAS f32x4*)(p + 128 + 4 * ks);
    o.kp = *(const LAS f32x4*)(p + 192 + 4 * ks); o.r = *(const LAS f32x4*)(p + 256 + 4 * ks); o.v = p[320 + vrow];
}
__device__ __forceinline__ float dot4(const f32x4 a, const f32x4 b) { f32x2 t = a.xy * b.xy; t = a.zw * b.zw + t; return t.x + t.y; }
__device__ __forceinline__ void scan_step2(f32x4& S, const StepOps& o, float& yp) {
    float d = dot4(S, o.kk);
    d += dpp_f<0xB1>(d); yp += dpp_f<0xB1>(yp); d += dpp_f<0x4E>(d); yp += dpp_f<0x4E>(yp);
    d += dpp_f<0x141>(d); yp += dpp_f<0x141>(yp); d += dpp_f<0x140>(d); yp += dpp_f<0x140>(yp);
    S = S * o.dd + d * o.nka + o.v * o.kp;
}
__device__ __forceinline__ float scan_step(f32x4& S, const StepOps& o) {
    float d = dot4(S, o.kk); d = allsum16(d);
    S = S * o.dd + d * o.nka + o.v * o.kp;
    float y = dot4(S, o.r); return allsum16(y);
}
__device__ __forceinline__ void phase_m2(const Args& A, LAS unsigned char* lds, int G) {
    const int tid = threadIdx.x, lane = tid & 63, wave = tid >> 6;
    unsigned char* ws = A.ws;
    const bf16* U = (const bf16*)(ws + WS_U); const bf16* REC = (const bf16*)(ws + WS_REC); float* Y = (float*)(ws + WS_Y);
    const float* LTOT = (const float*)((unsigned char*)A.out + DO_LTOT); float* CARRY = (float*)((unsigned char*)A.out + DO_CARRY);
    const float* mu = A.in[I_MU];
    for (int b = blockIdx.x; b < NB; b += G) {
        const int c = tid; float carry = LTOT[((size_t)512 * 2 + 1) * 512 + c];
        float Pv[64], Hv[64];
#pragma unroll
        for (int i = 0; i < 64; ++i) { const int un = b * 64 + i; Pv[i] = LTOT[((size_t)un * 2 + 0) * 512 + c]; Hv[i] = LTOT[((size_t)un * 2 + 1) * 512 + c]; }
#pragma unroll
        for (int i = 0; i < 64; ++i) { CARRY[((size_t)b * 64 + i) * 512 + c] = carry; carry = Pv[i] * carry + Hv[i]; }
        A.out[O_PLH + (size_t)b * 512 + c] = carry;
    }
    const int ks = lane & 15, rl = lane >> 4;
    for (int item = blockIdx.x; item < 256; item += G) {
        const int bh = item >> 2, q = item & 3, b = bh >> 3, h = bh & 7;
        const int k = tid & 63, sub = (tid >> 6) & 3;
        const float mu_r = mu[h * 64 + k], mu_v = mu[1024 + h * 64 + k];
        const int wv = wave & 3, vrow = 16 * q + 4 * wv + rl;
        f32x4 S = (f32x4){0.f, 0.f, 0.f, 0.f};
        Raw raw[8];
        LAS float* buf0 = (LAS float*)lds; LAS float* buf1 = (LAS float*)(lds + 49152); LAS float* ybuf = (LAS float*)(lds + 98304) + wv * 132;
        __syncthreads();
        if (wave >= 4) { m2_load(raw, REC, U, b, h, 0, 16, k, sub); m2_store(raw, buf0, mu_r, mu_v, k, sub, 16); m2_load(raw, REC, U, b, h, 16, 32, k, sub); }
        __syncthreads();
        for (int blk = 0; blk < 65; ++blk) {
            const int t0 = blk == 0 ? 0 : 16 + 32 * (blk - 1), ns = blk == 0 ? 16 : 32;
            if (wave >= 4) {
                if (blk + 1 < 65) m2_store(raw, (blk & 1) ? buf0 : buf1, mu_r, mu_v, k, sub, 32);
                if (blk + 2 < 65) m2_load(raw, REC, U, b, h, 16 + 32 * (blk + 1), 32, k, sub);
            } else {
                const LAS float* buf = (blk & 1) ? buf1 : buf0;
                StepOps oa, ob; ops_load(oa, buf, ks, vrow);
                float yp = 0.f;
                for (int s = 0; s < ns; s += 2) {
                    ops_load(ob, buf + (s + 1) * 384, ks, vrow);
                    scan_step2(S, oa, yp); ybuf[s * 4 + rl] = yp; yp = dot4(S, oa.r);
                    if (s + 2 < ns) ops_load(oa, buf + (s + 2) * 384, ks, vrow);
                    scan_step2(S, ob, yp); ybuf[(s + 1) * 4 + rl] = yp; yp = dot4(S, ob.r);
                }
                yp = allsum16(yp); ybuf[ns * 4 + rl] = yp;
                if (ks < ns) Y[(size_t)prompt_row(b, t0 + ks) * 512 + h * 64 + vrow] = ybuf[(ks + 1) * 4 + rl];
                if (ks + 16 < ns) Y[(size_t)prompt_row(b, t0 + ks + 16) * 512 + h * 64 + vrow] = ybuf[(ks + 17) * 4 + rl];
            }
            __syncthreads();
        }
        if (wave < 4) *(f32x4*)(A.out + O_PWKV + ((size_t)(b * 8 + h) * 64 + vrow) * 64 + 4 * ks) = S;
    }
    const float* swkv = A.in[I_SWKV]; const float* sts = A.in[I_STS];
#pragma unroll 2
    for (int task = blockIdx.x * 8 + wave; task < DB * NH * 16; task += G * 8) {
        const int bh = task >> 4, rg = task & 15, b = bh >> 3, h = bh & 7, v = 4 * rg + rl;
        f32x4 S = *(const f32x4*)(swkv + ((size_t)bh * 64 + v) * 64 + 4 * ks);
        const f32x4 mr4 = *(const f32x4*)(mu + h * 64 + 4 * ks); const float mv = mu[1024 + h * 64 + v];
        StepOps o[DS];
#pragma unroll
        for (int t = 0; t < DS; ++t) {
            const int row = R_SAMPLE + 4 * b + t;
            const bf16* rec = REC + ((size_t)row * 8 + h) * 256 + 4 * ks;
            const u32x2 wa = *(const u32x2*)rec, wx = *(const u32x2*)(rec + 64), wk = *(const u32x2*)(rec + 128), wp = *(const u32x2*)(rec + 192);
            const f32x4 a4 = (f32x4){lo16(wa.x), hi16(wa.x), lo16(wa.y), hi16(wa.y)};
            o[t].dd = 1.f - (f32x4){lo16(wx.x), hi16(wx.x), lo16(wx.y), hi16(wx.y)};
            o[t].kk = (f32x4){lo16(wk.x), hi16(wk.x), lo16(wk.y), hi16(wk.y)}; o[t].kp = (f32x4){lo16(wp.x), hi16(wp.x), lo16(wp.y), hi16(wp.y)};
            const u32x2 wr_ = *(const u32x2*)(U + (size_t)row * DIN + h * 64 + 4 * ks);
            const f32x4 ur4 = (f32x4){lo16(wr_.x), hi16(wr_.x), lo16(wr_.y), hi16(wr_.y)};
            const float uv = bf2f(U[(size_t)row * DIN + 1024 + h * 64 + v]);
            f32x4 pr4; float pv;
            if (t > 0) { const u32x2 w = *(const u32x2*)(U + (size_t)(row - 1) * DIN + h * 64 + 4 * ks); pr4 = (f32x4){lo16(w.x), hi16(w.x), lo16(w.y), hi16(w.y)}; pv = bf2f(U[(size_t)(row - 1) * DIN + 1024 + h * 64 + v]); }
            else { pr4 = *(const f32x4*)(sts + (size_t)b * DTMP + h * 64 + 4 * ks); pv = sts[(size_t)b * DTMP + 1024 + h * 64 + v]; }
            o[t].r = ur4 + (pr4 - ur4) * mr4; o[t].v = uv + (pv - uv) * mv; o[t].nka = -(o[t].kk * a4);
        }
#pragma unroll
        for (int t = 0; t < DS; ++t) { const float y = scan_step(S, o[t]); if (ks == 0) Y[(size_t)(R_SAMPLE + 4 * b + t) * 512 + h * 64 + v] = y; }
        *(f32x4*)(A.out + O_SWKV + ((size_t)bh * 64 + v) * 64 + 4 * ks) = S;
    }
}

__device__ __forceinline__ void phase_m3(const Args& A, int G) {
    const int tid = threadIdx.x, lane = tid & 63, wave = tid >> 6;
    const int gw = blockIdx.x * 8 + wave, NGW = G * 8;
    unsigned char* ws = A.ws;
    const bf16* U = (const bf16*)(ws + WS_U); const bf16* GA = (const bf16*)((unsigned char*)A.out + DO_GA); const bf16* LRU = (const bf16*)(ws + WS_LRU);
    const float* Y = (const float*)(ws + WS_Y); const float* CARRY = (const float*)((unsigned char*)A.out + DO_CARRY); const float* BON = (const float*)((unsigned char*)A.out + DO_BON);
    bf16* MIX = (bf16*)(ws + WS_MIX);
    const float* sts = A.in[I_STS];
    const int c = 8 * lane, h = lane >> 3;
    float mv[8], gg[8], gb[8], og[8];
    ld8f(A.in[I_MU] + 1024 + c, mv); ld8f(A.in[I_GNG] + c, gg); ld8f(A.in[I_GNB] + c, gb); ld8f(A.in[I_LOG] + c, og);
    for (int row = gw; row < MP; row += NGW) {
        bf16* mo = MIX + (size_t)row * D;
        const RowInfo ri = row_info(row);
        if (ri.kind == 3) { ((u32x4*)mo)[lane] = (u32x4){0u, 0u, 0u, 0u}; ((u32x4*)mo)[64 + lane] = (u32x4){0u, 0u, 0u, 0u}; continue; }
        const int r1 = row_back(ri, row, 1);
        float y[8], uv[8], pv[8], g[8], hv[8], pp[8], gt[8], cr[8];
        ld8f(Y + (size_t)row * 512 + c, y);
        unpack8(*(const u32x4*)(U + (size_t)row * DIN + 1024 + c), uv);
        unpack8(*(const u32x4*)(GA + (size_t)row * 1536 + 1024 + c), g);
        unpack8(*(const u32x4*)(LRU + (size_t)row * 1024 + c), hv); unpack8(*(const u32x4*)(LRU + (size_t)row * 1024 + 512 + c), pp);
        unpack8(*(const u32x4*)(U + (size_t)row * DIN + DTMP + 512 + c), gt);
        const float bon = BON[(size_t)row * 8 + h];
        if (r1 >= 0) unpack8(*(const u32x4*)(U + (size_t)r1 * DIN + 1024 + c), pv);
        else if (ri.kind == 1) ld8f(sts + (size_t)ri.b * DTMP + 1024 + c, pv);
        else {
#pragma unroll
            for (int i = 0; i < 8; ++i) pv[i] = 0.f; }
        if (ri.kind == 0) ld8f(CARRY + ((size_t)ri.b * 64 + ((row & 2047) >> 5)) * 512 + c, cr);
        else {
#pragma unroll
            for (int i = 0; i < 8; ++i) cr[i] = 0.f; }
        float s = 0.f;
#pragma unroll
        for (int i = 0; i < 8; ++i) s += y[i];
        const float mean = sum8(s) * (1.f / 64.f);
        float q = 0.f;
#pragma unroll
        for (int i = 0; i < 8; ++i) { y[i] -= mean; q += y[i] * y[i]; }
        const float rstd = rsqrtf(sum8(q) * (1.f / 64.f) + GN_EPS);
        float o[8];
#pragma unroll
        for (int i = 0; i < 8; ++i) { const float vv = uv[i] + (pv[i] - uv[i]) * mv[i]; o[i] = (y[i] * rstd * gg[i] + gb[i] + bon * vv) * g[i]; }
        *(u32x4*)(mo + c) = pack8(o);
        float z[8], s2 = 0.f;
#pragma unroll
        for (int i = 0; i < 8; ++i) { z[i] = (hv[i] + pp[i] * cr[i]) * gelu_tanh(gt[i]); s2 += z[i] * z[i]; }
        const float rs = rsqrtf(wave_sum(s2) * (1.f / 512.f) + EPS);
#pragma unroll
        for (int i = 0; i < 8; ++i) o[i] = z[i] * rs * og[i];
        *(u32x4*)(mo + 512 + c) = pack8(o);
    }
}

__device__ __forceinline__ void phase_final(const Args& A, int G) {
    const int tid = threadIdx.x, lane = tid & 63, wave = tid >> 6;
    const int gw = blockIdx.x * 8 + wave, NGW = G * 8;
    const float* ssq = (const float*)(A.ws + WS_SSQ2); const float* gf = A.in[I_NFG];
    for (int row = gw; row < M_MAIN; row += NGW) {
        const float rs = row_rs(ssq, row);
        f32x4* p = (f32x4*)(A.out + (size_t)row * D);
#pragma unroll
        for (int j = 0; j < 4; ++j) { const f32x4 g = ((const f32x4*)gf)[lane + 64 * j]; f32x4 v = p[lane + 64 * j]; v = v * rs * g; p[lane + 64 * j] = v; }
    }
}

namespace cg = cooperative_groups;
__global__ void __launch_bounds__(512, 2) mk_fwd(Args args) {
    extern __shared__ __attribute__((aligned(16))) unsigned char lds_raw[];
    LAS unsigned char* lds = (LAS unsigned char*)lds_raw;
    const int G = gridDim.x, tid = threadIdx.x;
    volatile LAS unsigned* MISC = (volatile LAS unsigned*)(lds + 131072 + 320);
    if (tid < 64) ((LAS unsigned*)(lds + 131072))[tid + 64] = 0u, ((LAS unsigned*)(lds + 131072))[tid] = 0u;
    __syncthreads();
    const int lo = args.ph_lo, hi = args.ph_hi;
    XcdBarrier bar; bar.bar = (unsigned*)(args.ws + WS_CTL) + 4096; bar.x = 0; bar.st = nullptr;
    if (hi - lo > 1) bar = xcd_barrier_post((unsigned*)(args.ws + WS_CTL) + 4096, MISC + 8);
    if (lo < 0) cg::this_grid().sync();
#define IN(k) (lo <= (k) && (k) < hi)
#define SEAM(k) do { if (IN(k) && IN((k) + 1)) xcd_barrier(bar); } while (0)
    unsigned char* ws = args.ws; unsigned char* ob = (unsigned char*)args.out;
    if (IN(0)) { phase_p0(args, lds, G); } SEAM(0);
    if (IN(1)) { pg8::Gemm g{(const bf16*)(ws + WS_XN), (const bf16*)(ws + WS_WIN), MP, DIN, D}; pg8::StaticOrder S; S.init(MP, DIN, G, (int)blockIdx.x);
        EpiPlain E{(bf16*)(ws + WS_U), DIN}; pg8::gemm_phase<EpiPlain, pg8::StaticOrder, true, true>(lds, g, S, E); } SEAM(1);
    if (IN(2)) { phase_e1(args, G); } SEAM(2);
    if (IN(3)) {
        { pg8::Gemm g{(const bf16*)(ws + WS_AP), (const bf16*)(ws + WS_BA), MP, 1536, 256}; pg8::StaticOrder S; S.init(MP, 1536, G, (int)blockIdx.x);
          EpiPlain E{(bf16*)(ob + DO_GA), 1536}; pg8::gemm_phase<EpiPlain, pg8::StaticOrder, true, true>(lds, g, S, E); }
        { pg8::Gemm g{(const bf16*)(ws + WS_XC), (const bf16*)(ws + WS_BB), MP, 1024, 512}; pg8::StaticOrder S; S.init(MP, 1024, G, (int)blockIdx.x);
          EpiPlain E{(bf16*)(ws + WS_GB), 1024}; pg8::gemm_phase<EpiPlain, pg8::StaticOrder, true, true>(lds, g, S, E); }
    } SEAM(3);
    if (IN(4)) { phase_e2(args, G); } SEAM(4);
    if (IN(5)) { phase_m2(args, lds, G); } SEAM(5);
    if (IN(6)) { phase_m3(args, G); } SEAM(6);
    if (IN(7)) { pg8::Gemm g{(const bf16*)(ws + WS_MIX), (const bf16*)(ob + DO_WOUT), MP, D, D}; pg8::StaticOrder S; S.init(MP, D, G, (int)blockIdx.x);
        EpiX1 E{args.in[I_XP], args.in[I_XS], args.in[I_META], args.out, (bf16*)(ws + WS_X1B), (float*)(ws + WS_SSQ1)};
        pg8::gemm_phase<EpiX1, pg8::StaticOrder, true, true>(lds, g, S, E); } SEAM(7);
    if (IN(8)) { pg8::Gemm g{(const bf16*)(ws + WS_X1B), (const bf16*)(ws + WS_WUP), MP, DFF, D}; pg8::StaticOrder S; S.init(MP, DFF, G, (int)blockIdx.x);
        EpiUp E{(const float*)(ws + WS_SSQ1), (bf16*)(ws + WS_UP), args.out + O_PFC, args.out + O_SFC};
        pg8::gemm_phase<EpiUp, pg8::StaticOrder, true, true>(lds, g, S, E); } SEAM(8);
    if (IN(9)) { pg8::Gemm g{(const bf16*)(ws + WS_X1B), (const bf16*)(ws + WS_WGATE), M_MAIN, DFF, D}; pg8::StaticOrder S; S.init(M_MAIN, DFF, G, (int)blockIdx.x);
        EpiGate E{(const float*)(ws + WS_SSQ1), (const bf16*)(ws + WS_UP), args.in[I_SFC], args.in[I_FCW], args.in[I_FCB], (bf16*)(ws + WS_HID)};
        pg8::gemm_phase<EpiGate, pg8::StaticOrder, true, true>(lds, g, S, E); } SEAM(9);
    if (IN(10)) { pg8::Gemm g{(const bf16*)(ws + WS_HID), (const bf16*)(ws + WS_WDOWN), M_MAIN, D, DFF}; pg8::StaticOrder S; S.init(M_MAIN, D, G, (int)blockIdx.x);
        EpiDown E{args.out, (float*)(ws + WS_SSQ2)};
        pg8::gemm_phase<EpiDown, pg8::StaticOrder, true, true>(lds, g, S, E); } SEAM(10);
    if (IN(11)) { phase_final(args, G); }
#undef IN
#undef SEAM
}

extern "C" void kernel_launch(void* const* d_in, const int* in_sizes, int n_in, void* d_out, int out_size, void* d_ws, size_t ws_size, hipStream_t stream) {
    static int grid = 0;
    if (grid == 0) {
        if (n_in != N_IN || (size_t)out_size != O_END || ws_size < 256 * MiB) { fprintf(stderr, "kernel_launch: unexpected shapes n_in %d out %d ws %zu\n", n_in, out_size, ws_size); grid = -1; return; }
        int dev = 0, cus = 0, per_cu = 0;
        (void)hipGetDevice(&dev); (void)hipDeviceGetAttribute(&cus, hipDeviceAttributeMultiprocessorCount, dev);
        if (hipFuncSetAttribute((const void*)mk_fwd, hipFuncAttributeMaxDynamicSharedMemorySize, LDS_BYTES) != hipSuccess) { fprintf(stderr, "kernel_launch: hipFuncSetAttribute failed\n"); grid = -1; return; }
        if (hipOccupancyMaxActiveBlocksPerMultiprocessor(&per_cu, (const void*)mk_fwd, 512, LDS_BYTES) != hipSuccess || per_cu < 1) per_cu = 1;
        (void)hipGetLastError();
        grid = cus > 0 ? cus : 256;
    }
    if (grid < 0) return;
    Args a{};
    for (int i = 0; i < N_IN; ++i) a.in[i] = (const float*)d_in[i];
    a.out = (float*)d_out; a.ws = (unsigned char*)d_ws;
#if MK_ONE_LAUNCH
    (void)hipMemsetAsync((char*)d_ws + WS_CTL, 0, CTL_ZERO_BYTES, stream);
    a.ph_lo = 0; a.ph_hi = NPH;
    void* kargs[] = {&a};
    hipError_t e = hipLaunchCooperativeKernel((const void*)mk_fwd, dim3(grid), dim3(512), kargs, LDS_BYTES, stream);
    if (e != hipSuccess) fprintf(stderr, "cooperative launch failed: %s (grid %d)\n", hipGetErrorString(e), grid);
#else
    for (int ph = 0; ph < NPH; ++ph) for (int rep = 0; rep < 1 + ((MK_REP_MASK >> ph) & 1); ++rep) { a.ph_lo = ph; a.ph_hi = ph + 1; hipLaunchKernelGGL(mk_fwd, dim3(grid), dim3(512), LDS_BYTES, stream, a); }
#endif
}
```

```cpp
#include <hip/hip_runtime.h>
#include <hip/hip_cooperative_groups.h>
#include <cstdio>
#include <cstdint>
#include <cmath>
namespace pg8 {
#define PG8_LAS __attribute__((address_space(3)))
typedef unsigned short bf16_t;
typedef short bf16x8 __attribute__((ext_vector_type(8)));
typedef float f32x4 __attribute__((ext_vector_type(4)));
typedef unsigned u32x4 __attribute__((ext_vector_type(4)));
constexpr int BM = 256, BK = 64, HALF = 128, HTB = HALF * BK * 2  , STAGE_BYTES = 8 * HTB, NXCD = 8, WGM = 8;

__host__ __device__ __forceinline__ int lds_byte(int r, int c) { const int st = (r >> 4) * 2 + (c >> 5), rr = r & 15, cc = c & 31, ob = rr * 64 + cc * 2; return st * 1024 + (ob ^ (((ob >> 9) & 1) << 5)); }
__host__ __device__ __forceinline__ void stage_rc(int b, int& R, int& C) { const int st = b / 1024, sb = b % 1024, swz = sb ^ (((sb >> 9) & 1) << 5); R = (st >> 1) * 16 + swz / 64; C = (st & 1) * 32 + (swz % 64) / 2; }
__host__ __device__ __forceinline__ int perm32(int rho) { const int n = rho >> 4, i = rho & 15; return 8 * (i >> 2) + 4 * n + (i & 3); }

struct Unit { int pm, pn, ko, nt; };
struct Gemm { const bf16_t* A; const bf16_t* Bt; int M, N, K; };

struct StaticOrder {
    int nM, nN, nwg, G, c, ntk;
    __host__ __device__ void init(int M, int N, int G_, int c_, int K_) { nM = M / BM; nN = N / BM; nwg = nM * nN; G = G_; c = c_; ntk = K_ / BK; }
    __host__ __device__ bool next(int i, Unit& u) const {
        const long L = (long)i * G + c; if (L >= nwg) return false;
        int wgid = (int)L; { const int q = nwg / NXCD, r = nwg % NXCD, xcd = wgid % NXCD, off = wgid / NXCD; wgid = (xcd < r ? xcd * (q + 1) : r * (q + 1) + (xcd - r) * q) + off; }
        const int nig = WGM * nN, gid = wgid / nig, fm = gid * WGM, gsz = (nM - fm) < WGM ? (nM - fm) : WGM;
        u.pm = fm + ((wgid % nig) % gsz); u.pn = (wgid % nig) / gsz; u.ko = 0; u.nt = ntk; return true;
    }
    __device__ __forceinline__ void a_ready(const Unit&) const {}
    __device__ __forceinline__ void done(const Unit&) const {}
};

__device__ __forceinline__ unsigned cvt_pk_bf16(float lo, float hi) { unsigned r; asm volatile("v_cvt_pk_bf16_f32 %0, %1, %2" : "=v"(r) : "v"(lo), "v"(hi)); return r; }
typedef float f32x2 __attribute__((ext_vector_type(2)));
template <class Epi, class Sched, bool ALIGN_EPI = false, bool SP2 = false>
__device__ __forceinline__ void gemm_phase(PG8_LAS unsigned char* lds, const Gemm g, const Sched& S, const Epi& E) {
    const int tid = threadIdx.x, wid = __builtin_amdgcn_readfirstlane(tid >> 6), lane = tid & 63, wr = wid >> 2, wc = wid & 3, fr = lane & 15, fq = lane >> 4;
    const int K = g.K;
    unsigned voffA[2], voffB[2];
#pragma unroll
    for (int i = 0; i < 2; ++i) { int R, C; stage_rc(tid * 16 + i * 8192, R, C); const int Rb = Epi::PERM ? ((R & ~31) + perm32(R & 31)) : R;
        voffA[i] = (unsigned)(R * K + C) * 2u; voffB[i] = (unsigned)(Rb * K + C) * 2u; }
    const size_t kstep = (size_t)(BK * 2);
    const size_t hstep = (size_t)HALF * K * 2;
    const size_t tstep = 2 * hstep;
    const unsigned ldsw = (unsigned)wid * 1024u;
    const int aoff = lds_byte(wr * 64 + fr, fq * 8), boff = lds_byte(wc * 32 + fr, fq * 8);
#define PG8_SA(b, h) (((b) * 2 + (h)) * HTB)
#define PG8_SB(b, h) ((4 + (b) * 2 + (h)) * HTB)
#define PG8_STAGE(bufoff, gbase, voff) do { _Pragma("unroll") for (int _i = 0; _i < 2; ++_i) \
        __builtin_amdgcn_global_load_lds((const unsigned*)((const char*)(gbase) + (voff)[_i]), (PG8_LAS unsigned*)(lds + (bufoff) + ldsw + _i * 8192), 16, 0, 0); } while (0)
#define PG8_LDA(dst, b, h) do { _Pragma("unroll") for (int m = 0; m < 4; ++m) _Pragma("unroll") for (int k = 0; k < 2; ++k) dst[m][k] = *(const PG8_LAS bf16x8*)(lds + PG8_SA(b, h) + aoff + m * 2048 + k * 1024); } while (0)
#define PG8_LDB(dst, b, h) do { _Pragma("unroll") for (int n = 0; n < 2; ++n) _Pragma("unroll") for (int k = 0; k < 2; ++k) dst[n][k] = *(const PG8_LAS bf16x8*)(lds + PG8_SB(b, h) + boff + n * 2048 + k * 1024); } while (0)
#define PG8_MMA(ai, bj, At, Bt) do { __builtin_amdgcn_s_setprio(1); _Pragma("unroll") for (int m = 0; m < 4; ++m) _Pragma("unroll") for (int n = 0; n < 2; ++n) _Pragma("unroll") for (int k = 0; k < 2; ++k) \
        acc[ai][bj][m][n] = __builtin_amdgcn_mfma_f32_16x16x32_bf16(Bt[n][k], At[m][k], acc[ai][bj][m][n], 0, 0, 0); __builtin_amdgcn_s_setprio(0); } while (0)
#define PG8_WAIT_V(n) asm volatile("s_waitcnt vmcnt(" #n ")" ::: "memory")
#define PG8_WAIT_L(n) asm volatile("s_waitcnt lgkmcnt(" #n ")" ::: "memory")
#define PG8_BAR __builtin_amdgcn_s_barrier()
#define PG8_SCHED __builtin_amdgcn_sched_barrier(0)
    Unit cur, nxt; int ui = 0;
    if (!S.next(0, cur)) return;
    f32x4 acc[2][2][4][2];
#pragma unroll
    for (int a = 0; a < 2; ++a)
#pragma unroll
        for (int b = 0; b < 2; ++b)
#pragma unroll
            for (int m = 0; m < 4; ++m)
#pragma unroll
                for (int n = 0; n < 2; ++n) acc[a][b][m][n] = (f32x4){0.f, 0.f, 0.f, 0.f};
    bf16x8 At[4][2], B0[2][2], B1[2][2];
    const char* cA = (const char*)g.A + (size_t)cur.pm * tstep + (size_t)cur.ko * 2; const char* cB = (const char*)g.Bt + (size_t)cur.pn * tstep + (size_t)cur.ko * 2;
    S.a_ready(cur);
    if constexpr (SP2) {
        PG8_STAGE(PG8_SB(0, 0), cB, voffB); PG8_STAGE(PG8_SB(0, 1), cB + hstep, voffB); PG8_STAGE(PG8_SA(0, 0), cA, voffA); PG8_STAGE(PG8_SA(0, 1), cA + hstep, voffA);
        if (wr == 1) PG8_BAR;
        PG8_WAIT_V(2); PG8_BAR;
        PG8_STAGE(PG8_SB(1, 0), cB + kstep, voffB); PG8_STAGE(PG8_SA(1, 0), cA + kstep, voffA); PG8_STAGE(PG8_SB(1, 1), cB + hstep + kstep, voffB);
        PG8_WAIT_V(6); PG8_BAR;
    } else {
        PG8_STAGE(PG8_SB(0, 0), cB, voffB); PG8_STAGE(PG8_SA(0, 0), cA, voffA); PG8_STAGE(PG8_SB(0, 1), cB + hstep, voffB); PG8_STAGE(PG8_SA(0, 1), cA + hstep, voffA);
        if (wr == 1) PG8_BAR;
        PG8_WAIT_V(4); PG8_BAR;
        PG8_STAGE(PG8_SB(1, 0), cB + kstep, voffB); PG8_STAGE(PG8_SA(1, 0), cA + kstep, voffA); PG8_STAGE(PG8_SB(1, 1), cB + hstep + kstep, voffB);
        PG8_WAIT_V(6); PG8_BAR;
    }
    for (;;) {
        const bool has_next = S.next(ui + 1, nxt);
        const char* nA = has_next ? (const char*)g.A + (size_t)nxt.pm * tstep + (size_t)nxt.ko * 2 : cA; const char* nB = has_next ? (const char*)g.Bt + (size_t)nxt.pn * tstep + (size_t)nxt.ko * 2 : cB;
        const int nt = cur.nt;
        for (int t = 0; t < nt; t += 2) {
            const bool last = (t == nt - 2);
            const char* a1 = cA + (size_t)(t + 1) * kstep;
            const char* a2 = last ? nA : cA + (size_t)(t + 2) * kstep; const char* b2 = last ? nB : cB + (size_t)(t + 2) * kstep;
            const char* a3 = a2 + kstep; const char* b3 = b2 + kstep;
            if (last && has_next) S.a_ready(nxt);
            if constexpr (SP2) {
            PG8_LDB(B0, 0, 0); PG8_LDB(B1, 0, 1); PG8_SCHED; PG8_LDA(At, 0, 0); PG8_STAGE(PG8_SA(1, 1), a1 + hstep, voffA);
            PG8_WAIT_V(8); PG8_WAIT_L(0); PG8_BAR; PG8_MMA(0, 0, At, B0); PG8_MMA(0, 1, At, B1); PG8_BAR; PG8_SCHED;
            PG8_LDA(At, 0, 1); PG8_STAGE(PG8_SB(0, 0), b2, voffB); PG8_STAGE(PG8_SB(0, 1), b2 + hstep, voffB); PG8_STAGE(PG8_SA(0, 0), a2, voffA);
            PG8_WAIT_V(8); PG8_WAIT_L(0); PG8_BAR; PG8_MMA(1, 0, At, B0); PG8_MMA(1, 1, At, B1); PG8_BAR; PG8_SCHED;
            PG8_LDB(B0, 1, 0); PG8_LDB(B1, 1, 1); PG8_SCHED; PG8_LDA(At, 1, 0); PG8_STAGE(PG8_SA(0, 1), a2 + hstep, voffA);
            PG8_WAIT_V(8); PG8_WAIT_L(0); PG8_BAR; PG8_MMA(0, 0, At, B0); PG8_MMA(0, 1, At, B1); PG8_BAR; PG8_SCHED;
            PG8_LDA(At, 1, 1); PG8_STAGE(PG8_SB(1, 0), b3, voffB); PG8_STAGE(PG8_SB(1, 1), b3 + hstep, voffB); PG8_STAGE(PG8_SA(1, 0), a3, voffA);
            PG8_WAIT_V(8); PG8_WAIT_L(0); PG8_BAR; PG8_MMA(1, 0, At, B0); PG8_MMA(1, 1, At, B1); PG8_BAR; PG8_SCHED;
            } else {
            PG8_LDB(B0, 0, 0); PG8_SCHED; PG8_LDA(At, 0, 0); PG8_STAGE(PG8_SA(1, 1), a1 + hstep, voffA);
            PG8_WAIT_L(8); PG8_BAR; PG8_WAIT_L(0); PG8_MMA(0, 0, At, B0); PG8_BAR; PG8_SCHED;
            PG8_LDB(B1, 0, 1); PG8_STAGE(PG8_SB(0, 0), b2, voffB);
            PG8_BAR; PG8_WAIT_L(0); PG8_MMA(0, 1, At, B1); PG8_BAR;
            PG8_LDA(At, 0, 1); PG8_STAGE(PG8_SA(0, 0), a2, voffA);
            PG8_BAR; PG8_WAIT_L(0); PG8_MMA(1, 0, At, B0); PG8_BAR; PG8_SCHED;
            PG8_STAGE(PG8_SB(0, 1), b2 + hstep, voffB);
            PG8_WAIT_V(6); PG8_BAR; PG8_MMA(1, 1, At, B1); PG8_BAR;
            PG8_LDB(B0, 1, 0); PG8_SCHED; PG8_LDA(At, 1, 0); PG8_STAGE(PG8_SA(0, 1), a2 + hstep, voffA);
            PG8_WAIT_L(8); PG8_BAR; PG8_WAIT_L(0); PG8_MMA(0, 0, At, B0); PG8_BAR; PG8_SCHED;
            PG8_LDB(B1, 1, 1); PG8_STAGE(PG8_SB(1, 0), b3, voffB);
            PG8_BAR; PG8_WAIT_L(0); PG8_MMA(0, 1, At, B1); PG8_BAR;
            PG8_LDA(At, 1, 1); PG8_STAGE(PG8_SA(1, 0), a3, voffA);
            PG8_BAR; PG8_WAIT_L(0); PG8_MMA(1, 0, At, B0); PG8_BAR; PG8_SCHED;
            PG8_STAGE(PG8_SB(1, 1), b3 + hstep, voffB);
            PG8_WAIT_V(6); PG8_BAR; PG8_MMA(1, 1, At, B1); PG8_BAR;
            }
        }
        if constexpr (ALIGN_EPI) { if (wr == 0) PG8_BAR; }
        if constexpr (!Epi::AFTER_DRAIN) { E(acc, cur, wr, wc, fr, fq); S.done(cur); }
        if (!has_next) break;
#pragma unroll
        for (int a = 0; a < 2; ++a)
#pragma unroll
            for (int b = 0; b < 2; ++b)
#pragma unroll
                for (int m = 0; m < 4; ++m)
#pragma unroll
                    for (int n = 0; n < 2; ++n) acc[a][b][m][n] = (f32x4){0.f, 0.f, 0.f, 0.f};
        cur = nxt; cA = nA; cB = nB; ++ui;
        if constexpr (ALIGN_EPI) { if (wr == 1) PG8_BAR; }
    }
    PG8_WAIT_V(0);
    if constexpr (!ALIGN_EPI) { if (wr == 0) PG8_BAR; }
    PG8_BAR;
    if constexpr (Epi::AFTER_DRAIN) { E.fused(acc, cur, wr, wc, fr, fq, lds, wid, lane); S.done(cur); }
#undef PG8_SA
#undef PG8_SB
#undef PG8_STAGE
#undef PG8_LDA
#undef PG8_LDB
#undef PG8_MMA
#undef PG8_WAIT_V
#undef PG8_WAIT_L
#undef PG8_BAR
#undef PG8_SCHED
}
}

#ifndef MK_REP_MASK
#define MK_REP_MASK 0
#endif
#ifndef MK_ONE_LAUNCH
#define MK_ONE_LAUNCH 1
#endif
#define LAS __attribute__((address_space(3)))
typedef unsigned short bf16;
typedef float f32x4 __attribute__((ext_vector_type(4)));
typedef unsigned u32x4 __attribute__((ext_vector_type(4)));
typedef unsigned u32x2 __attribute__((ext_vector_type(2)));
constexpr int D = 1024, NB = 8, SEQ = 2048, NMETA = 16, TP = SEQ + NMETA, DB = 128, DS = 4;
constexpr int NH = 8, DTMP = 1792, DIN = 2816, DFF = 3072;
constexpr int R_SAMPLE = NB * SEQ, R_META = R_SAMPLE + DB * DS, R_END = R_META + NMETA, MP = 17152, M_MAIN = 16896;
constexpr float EPS = 1e-6f, GN_EPS = 64e-5f;
constexpr int NPH = 12;
constexpr int LDS_BYTES = 147456;
enum { I_XP = 0, I_XS, I_STS, I_SWKV, I_SLC, I_SLH, I_SFC, I_META, I_N1G, I_WIN, I_MU, I_W0, I_WUP, I_A0, I_AUP, I_GUP, I_KK, I_KA, I_RK,
       I_GNG, I_GNB, I_LCW, I_LCB, I_LWA, I_LBA, I_LWX, I_LBX, I_LAM, I_LOG, I_WOUT, I_N2G, I_FUP, I_FGATE, I_FCW, I_FCB, I_FDOWN, I_NFG, N_IN };
constexpr size_t O_YP = 0, O_YS = 16777216, O_PSHIFT = 17301504, O_PWKV = 17315840, O_PLC = 17577984, O_PLH = 17590272, O_PFC = 17594368,
                 O_SSHIFT = 17643520, O_SWKV = 17872896, O_SLC = 22067200, O_SLH = 22263808, O_SFC = 22329344, O_END = 23115776;
constexpr size_t MiB = 1u << 20;
constexpr size_t WS_CTL = 0, CTL_ZERO_BYTES = 65536;
constexpr size_t WS_SSQ1 = 1 * MiB, WS_SSQ2 = WS_SSQ1 + (size_t)MP * 16 * 4;
constexpr size_t WS_WUP = 4 * MiB, WS_WGATE = 10 * MiB, WS_WDOWN = 16 * MiB;
constexpr size_t WS_X1B = 22 * MiB, WS_UP = WS_X1B + (size_t)MP * D * 2, WS_HID = WS_UP + (size_t)MP * DFF * 2;
constexpr size_t WS_U = 22 * MiB;
constexpr size_t WS_XN = 115 * MiB, WS_WIN = WS_XN + (size_t)MP * D * 2;
constexpr size_t WS_AP = 190 * MiB, WS_XC = 199 * MiB, WS_BA = 216 * MiB, WS_BB = 217 * MiB, WS_GB = 220 * MiB;
constexpr size_t WS_REC = 115 * MiB, WS_LRU = 182 * MiB, WS_Y = 220 * MiB, WS_MIX = 115 * MiB;
static_assert(WS_SSQ2 + (size_t)MP * 16 * 4 <= WS_WUP, "ssq");
static_assert(WS_HID + (size_t)M_MAIN * DFF * 2 <= 256 * MiB, "hid");
static_assert(WS_U + (size_t)MP * DIN * 2 <= WS_XN, "u");
static_assert(WS_WIN + (size_t)DIN * D * 2 <= WS_LRU, "win");
static_assert(WS_AP + (size_t)MP * 256 * 2 <= WS_XC && WS_XC + (size_t)MP * 512 * 2 <= WS_BA, "ap/xc");
static_assert(WS_GB + (size_t)MP * 1024 * 2 <= 256 * MiB, "gb");
static_assert(WS_REC + (size_t)R_END * 4096 <= WS_LRU && WS_LRU + (size_t)R_END * 2048 <= WS_BA, "rec/lru");
static_assert(WS_Y + (size_t)R_END * 2048 <= 256 * MiB, "y");
constexpr size_t DO_GA = 0, DO_LTOT = (size_t)MP * 1536 * 2, DO_CARRY = DO_LTOT + 513 * 2 * 512 * 4, DO_BON = DO_CARRY + 8 * 64 * 512 * 4, DO_WOUT = O_SFC * 4;
static_assert(DO_BON + (size_t)R_END * 8 * 4 <= O_PSHIFT * 4, "d_out scratch");

struct Args { const float* in[N_IN]; float* out; unsigned char* ws; int ph_lo, ph_hi; };

__device__ __forceinline__ float bf2f(bf16 h) { return __uint_as_float(((unsigned)h) << 16); }
__device__ __forceinline__ unsigned f2bf(float f) { unsigned u = __float_as_uint(f); return (u + 0x7fffu + ((u >> 16) & 1u)) >> 16; }
__device__ __forceinline__ unsigned pk2(float lo, float hi) { return f2bf(lo) | (f2bf(hi) << 16); }
__device__ __forceinline__ float lo16(unsigned w) { return __uint_as_float(w << 16); }
__device__ __forceinline__ float hi16(unsigned w) { return __uint_as_float(w & 0xffff0000u); }
__device__ __forceinline__ float sigm(float x) { return 1.f / (1.f + __expf(-x)); }
__device__ __forceinline__ float softplus_(float z) { return fmaxf(z, 0.f) + log1pf(__expf(-fabsf(z))); }
__device__ __forceinline__ float gelu_tanh(float x) { const float u = 1.5957691216057308f * (x + 0.044715f * x * x * x); return x / (1.f + __expf(-u)); }
__device__ __forceinline__ float tanh_(float x) { const float e = __expf(2.f * x); return 1.f - 2.f / (e + 1.f); }
__device__ __forceinline__ float wave_sum(float v) {
#pragma unroll
    for (int o = 1; o < 64; o <<= 1) v += __shfl_xor(v, o);
    return v;
}
template <int CTRL> __device__ __forceinline__ float dpp_f(float x) { return __int_as_float(__builtin_amdgcn_update_dpp(0, __float_as_int(x), CTRL, 0xF, 0xF, true)); }
__device__ __forceinline__ float allsum16(float x) { x += dpp_f<0xB1>(x); x += dpp_f<0x4E>(x); x += dpp_f<0x141>(x); x += dpp_f<0x140>(x); return x; }

struct RowInfo { int kind, b, t; };
__device__ __forceinline__ RowInfo row_info(int row) {
    RowInfo r;
    if (row < R_SAMPLE) { r.kind = 0; r.b = row >> 11; r.t = (row & 2047) + NMETA; }
    else if (row < R_META) { r.kind = 1; r.b = (row - R_SAMPLE) >> 2; r.t = (row - R_SAMPLE) & 3; }
    else if (row < R_END) { r.kind = 2; r.b = 0; r.t = row - R_META; }
    else { r.kind = 3; r.b = 0; r.t = 0; }
    return r;
}
__device__ __forceinline__ int prompt_row(int b, int t) { return t < NMETA ? R_META + t : b * SEQ + t - NMETA; }
__device__ __forceinline__ int row_back(const RowInfo& ri, int row, int j) {
    const int tt = ri.t - j; if (tt < 0) return -1;
    if (ri.kind == 1) return row - j;
    return prompt_row(ri.b, tt);
}
__device__ __forceinline__ void unpack8(const u32x4 w, float (&f)[8]) {
    f[0] = lo16(w.x); f[1] = hi16(w.x); f[2] = lo16(w.y); f[3] = hi16(w.y); f[4] = lo16(w.z); f[5] = hi16(w.z); f[6] = lo16(w.w); f[7] = hi16(w.w);
}
__device__ __forceinline__ float row_rs(const float* ssq, int row) {
    const f32x4* p = (const f32x4*)(ssq + (size_t)row * 16); const f32x4 a = p[0], b = p[1], c = p[2], d = p[3];
    const float s = ((a.x + a.y) + (a.z + a.w)) + ((b.x + b.y) + (b.z + b.w)) + ((c.x + c.y) + (c.z + c.w)) + ((d.x + d.y) + (d.z + d.w));
    return rsqrtf(s * (1.f / 1024.f) + EPS);
}

#define EPI_ROW(ai, m) (u.pm * 256 + (ai) * 128 + wr * 64 + (m) * 16 + fr)
#define EPI_COL(bj) (u.pn * 256 + (bj) * 128 + wc * 32 + 8 * fq)
struct EpiX1 {
    static constexpr bool PERM = true, AFTER_DRAIN = false;
    const float* xp; const float* xs; const float* meta; float* x1; bf16* x1b; float* ssq;
    __device__ __forceinline__ void operator()(const f32x4 (&acc)[2][2][4][2], const pg8::Unit& u, int wr, int wc, int fr, int fq) const {
#pragma unroll
        for (int ai = 0; ai < 2; ++ai)
#pragma unroll
            for (int m = 0; m < 4; ++m) {
                const int row = EPI_ROW(ai, m);
                const float* res = row < R_SAMPLE ? xp + (size_t)row * D : row < R_META ? xs + (size_t)(row - R_SAMPLE) * D : row < R_END ? meta + (size_t)(row - R_META) * D : nullptr;
                float s = 0.f;
#pragma unroll
                for (int bj = 0; bj < 2; ++bj) {
                    const int col = EPI_COL(bj);
                    f32x4 v0 = acc[ai][bj][m][0], v1 = acc[ai][bj][m][1];
                    if (res) { v0 += *(const f32x4*)(res + col); v1 += *(const f32x4*)(res + col + 4); }
                    if (row < M_MAIN) { *(f32x4*)(x1 + (size_t)row * D + col) = v0; *(f32x4*)(x1 + (size_t)row * D + col + 4) = v1; }
                    u32x4 w; w.x = pk2(v0.x, v0.y); w.y = pk2(v0.z, v0.w); w.z = pk2(v1.x, v1.y); w.w = pk2(v1.z, v1.w);
                    *(u32x4*)(x1b + (size_t)row * D + col) = w;
                    s += (v0.x * v0.x + v0.y * v0.y) + (v0.z * v0.z + v0.w * v0.w) + (v1.x * v1.x + v1.y * v1.y) + (v1.z * v1.z + v1.w * v1.w);
                }
                s += __shfl_xor(s, 16); s += __shfl_xor(s, 32);
                if (fq == 0) ssq[(size_t)row * 16 + u.pn * 4 + wc] = s;
            }
    }
};
struct EpiUp {
    static constexpr bool PERM = true, AFTER_DRAIN = false;
    const float* ssq; bf16* up; float* pffn; float* sffn;
    __device__ __forceinline__ void operator()(const f32x4 (&acc)[2][2][4][2], const pg8::Unit& u, int wr, int wc, int fr, int fq) const {
#pragma unroll
        for (int ai = 0; ai < 2; ++ai)
#pragma unroll
            for (int m = 0; m < 4; ++m) {
                const int row = EPI_ROW(ai, m);
                const float rs = row_rs(ssq, row);
                const RowInfo ri = row_info(row);
                float* st = nullptr;
                if (ri.kind == 0 && ri.t >= TP - 2) st = pffn + ((size_t)ri.b * 2 + (ri.t - (TP - 2))) * DFF;
                else if (ri.kind == 1 && ri.t >= 2) st = sffn + ((size_t)ri.b * 2 + (ri.t - 2)) * DFF;
#pragma unroll
                for (int bj = 0; bj < 2; ++bj) {
                    const int col = EPI_COL(bj);
                    const f32x4 v0 = acc[ai][bj][m][0] * rs, v1 = acc[ai][bj][m][1] * rs;
                    u32x4 w; w.x = pk2(v0.x, v0.y); w.y = pk2(v0.z, v0.w); w.z = pk2(v1.x, v1.y); w.w = pk2(v1.z, v1.w);
                    *(u32x4*)(up + (size_t)row * DFF + col) = w;
                    if (st) { *(f32x4*)(st + col) = v0; *(f32x4*)(st + col + 4) = v1; }
                }
            }
    }
};
struct EpiGate {
    static constexpr bool PERM = true, AFTER_DRAIN = false;
    const float* ssq; const bf16* up; const float* stf; const float* cw; const float* cb; bf16* hid;
    __device__ __forceinline__ void operator()(const f32x4 (&acc)[2][2][4][2], const pg8::Unit& u, int wr, int wc, int fr, int fq) const {
#pragma unroll
        for (int ai = 0; ai < 2; ++ai)
#pragma unroll
            for (int m = 0; m < 4; ++m) {
                const int row = EPI_ROW(ai, m);
                const float rs = row_rs(ssq, row);
                const RowInfo ri = row_info(row);
                const int r1 = row_back(ri, row, 1), r2 = row_back(ri, row, 2);
#pragma unroll
                for (int bj = 0; bj < 2; ++bj) {
                    const int col = EPI_COL(bj);
                    float g[8], u0[8], p1[8], p2[8];
                    { const f32x4 v0 = acc[ai][bj][m][0] * rs, v1 = acc[ai][bj][m][1] * rs; g[0] = v0.x; g[1] = v0.y; g[2] = v0.z; g[3] = v0.w; g[4] = v1.x; g[5] = v1.y; g[6] = v1.z; g[7] = v1.w; }
                    unpack8(*(const u32x4*)(up + (size_t)row * DFF + col), u0);
                    if (r1 >= 0) unpack8(*(const u32x4*)(up + (size_t)r1 * DFF + col), p1);
                    else if (ri.kind == 1) { const float* s = stf + ((size_t)ri.b * 2 + (1 + ri.t)) * DFF + col; const f32x4 a = *(const f32x4*)s, b = *(const f32x4*)(s + 4);
                        p1[0] = a.x; p1[1] = a.y; p1[2] = a.z; p1[3] = a.w; p1[4] = b.x; p1[5] = b.y; p1[6] = b.z; p1[7] = b.w; }
                    else {
#pragma unroll
                        for (int i = 0; i < 8; ++i) p1[i] = 0.f; }
                    if (r2 >= 0) unpack8(*(const u32x4*)(up + (size_t)r2 * DFF + col), p2);
                    else if (ri.kind == 1) { const float* s = stf + ((size_t)ri.b * 2 + ri.t) * DFF + col; const f32x4 a = *(const f32x4*)s, b = *(const f32x4*)(s + 4);
                        p2[0] = a.x; p2[1] = a.y; p2[2] = a.z; p2[3] = a.w; p2[4] = b.x; p2[5] = b.y; p2[6] = b.z; p2[7] = b.w; }
                    else {
#pragma unroll
                        for (int i = 0; i < 8; ++i) p2[i] = 0.f; }
                    float o[8];
#pragma unroll
                    for (int h = 0; h < 2; ++h) {
                        const f32x4 w0 = *(const f32x4*)(cw + col + 4 * h), w1 = *(const f32x4*)(cw + DFF + col + 4 * h), w2 = *(const f32x4*)(cw + 2 * DFF + col + 4 * h), bb = *(const f32x4*)(cb + col + 4 * h);
#pragma unroll
                        for (int i = 0; i < 4; ++i) { const int e = 4 * h + i; const float c = bb[i] + w0[i] * p2[e] + w1[i] * p1[e] + w2[i] * u0[e]; o[e] = gelu_tanh(c) * g[e]; }
                    }
                    u32x4 w; w.x = pk2(o[0], o[1]); w.y = pk2(o[2], o[3]); w.z = pk2(o[4], o[5]); w.w = pk2(o[6], o[7]);
                    *(u32x4*)(hid + (size_t)row * DFF + col) = w;
                }
            }
    }
};
struct EpiDown {
    static constexpr bool PERM = true, AFTER_DRAIN = false;
    float* x;
    __device__ __forceinline__ void operator()(const f32x4 (&acc)[2][2][4][2], const pg8::Unit& u, int wr, int wc, int fr, int fq) const {
        const bool part = u.nt != DFF / 64;
#pragma unroll
        for (int ai = 0; ai < 2; ++ai)
#pragma unroll
            for (int m = 0; m < 4; ++m) {
                const int row = EPI_ROW(ai, m);
#pragma unroll
                for (int bj = 0; bj < 2; ++bj) {
                    const int col = EPI_COL(bj);
                    float* p = x + (size_t)row * D + col;
                    if (part) {
#pragma unroll
                        for (int i = 0; i < 4; ++i) { unsafeAtomicAdd(p + i, acc[ai][bj][m][0][i]); unsafeAtomicAdd(p + 4 + i, acc[ai][bj][m][1][i]); }
                    } else {
                        const f32x4 v0 = acc[ai][bj][m][0] + *(const f32x4*)p, v1 = acc[ai][bj][m][1] + *(const f32x4*)(p + 4);
                        *(f32x4*)p = v0; *(f32x4*)(p + 4) = v1;
                    }
                }
            }
    }
};
struct DownOrder {
    pg8::StaticOrder base; int G, c;
    __device__ void init(int G_, int c_) { base.init(R_SAMPLE, D, G_, c_, DFF); G = G_; c = c_; }
    __device__ bool next(int i, pg8::Unit& u) const {
        const int nb = (256 - c + G - 1) / G;
        if (i < nb) return base.next(i, u);
        const int j = (i - nb) * G + c; if (j >= 48) return false;
        u.pm = 64 + j / 24; u.pn = (j / 6) % 4; u.ko = (j % 6) * 512; u.nt = 8; return true;
    }
    __device__ __forceinline__ void a_ready(const pg8::Unit&) const {}
    __device__ __forceinline__ void done(const pg8::Unit&) const {}
};
struct EpiPlain {
    static constexpr bool PERM = true, AFTER_DRAIN = false;
    bf16* O; int ldc;
    __device__ __forceinline__ void operator()(const f32x4 (&acc)[2][2][4][2], const pg8::Unit& u, int wr, int wc, int fr, int fq) const {
#pragma unroll
        for (int ai = 0; ai < 2; ++ai)
#pragma unroll
            for (int m = 0; m < 4; ++m) {
                const int row = EPI_ROW(ai, m);
#pragma unroll
                for (int bj = 0; bj < 2; ++bj) {
                    const int col = EPI_COL(bj);
                    const f32x4 v0 = acc[ai][bj][m][0], v1 = acc[ai][bj][m][1];
                    u32x4 w; w.x = pk2(v0.x, v0.y); w.y = pk2(v0.z, v0.w); w.z = pk2(v1.x, v1.y); w.w = pk2(v1.z, v1.w);
                    *(u32x4*)(O + (size_t)row * ldc + col) = w;
                }
            }
    }
};

#define XB_TMO      128
#define XB_XCNT(j)  (256  + 64 * (j))
#define XB_XSUB(j)  (1280 + 64 * (j))
#define XB_XGEN(j)  (2304 + 64 * (j))
#define XB_TOP      3328
#define XB_TOPGEN   3392
#define XCD_BAR_WORDS 3456
#define XB_SPIN_CAP (1u << 22)
__device__ __forceinline__ unsigned xb_ld(unsigned* p)              { return __hip_atomic_load(p, __ATOMIC_RELAXED, __HIP_MEMORY_SCOPE_AGENT); }
__device__ __forceinline__ unsigned xb_add(unsigned* p, unsigned v) { return __hip_atomic_fetch_add(p, v, __ATOMIC_RELAXED, __HIP_MEMORY_SCOPE_AGENT); }
__device__ __forceinline__ unsigned xb_xcc_id() { return (unsigned)__builtin_amdgcn_s_getreg((3 << 11) | 20) & 0xFu; }
#define XB_SPIN(cond, bar) do { unsigned _sp = 0; while (cond) { __builtin_amdgcn_s_sleep(1); \
    if ((++_sp & 255u) == 0u) { if (xb_ld(&(bar)[XB_TMO])) break; if (_sp > XB_SPIN_CAP) { atomicAdd(&(bar)[XB_TMO], 1u); break; } } } } while (0)
struct XcdBarrier { unsigned* bar; unsigned x; volatile LAS unsigned* st; };
__device__ __forceinline__ XcdBarrier xcd_barrier_post(unsigned* bar, volatile LAS unsigned* st) {
    XcdBarrier b; b.bar = bar; b.x = xb_xcc_id(); b.st = st;
    if (threadIdx.x == 0) (void)xb_add(&bar[XB_XCNT(b.x)], 1u);
    return b;
}
__device__ __forceinline__ void xcd_barrier_complete(unsigned* bar, unsigned x, unsigned& nloc, unsigned& nx) {
    const unsigned G = gridDim.x * gridDim.y * gridDim.z;
    unsigned sum, cnt, mine, sp = 0u;
    for (;;) {
        sum = 0u; cnt = 0u; mine = 0u;
#pragma unroll
        for (unsigned j = 0; j < 16; ++j) { const unsigned c = xb_ld(&bar[XB_XCNT(j)]); sum += c; cnt += (c > 0u) ? 1u : 0u; mine = (j == x) ? c : mine; }
        if (sum == G) break;
        __builtin_amdgcn_s_sleep(1);
        if ((++sp & 255u) == 0u) { if (xb_ld(&bar[XB_TMO])) break; if (sp > XB_SPIN_CAP) { atomicAdd(&bar[XB_TMO], 1u); break; } }
    }
    nloc = mine > 0u ? mine : 1u; nx = cnt > 0u ? cnt : 1u;
}
__device__ __forceinline__ void xcd_barrier(const XcdBarrier& b) {
    asm volatile("s_waitcnt vmcnt(0)" ::: "memory");
    __syncthreads();
    if (threadIdx.x == 0) {
        unsigned* bar = b.bar;
        __builtin_amdgcn_s_waitcnt(0);
        unsigned nloc = b.st[0], nx = b.st[1];
        if (nloc == 0u) { xcd_barrier_complete(bar, b.x, nloc, nx); b.st[0] = nloc; b.st[1] = nx; }
        const unsigned old = xb_add(&bar[XB_XSUB(b.x)], 1u);
        const unsigned gen = old / nloc;
        if (old + 1u == (gen + 1u) * nloc) {
            __builtin_amdgcn_fence(__ATOMIC_RELEASE, "agent");
            asm volatile("s_waitcnt vmcnt(0)" ::: "memory");
            const unsigned og = xb_add(&bar[XB_TOP], 1u);
            const unsigned tg = og / nx;
            if (og + 1u == (tg + 1u) * nx) xb_add(&bar[XB_TOPGEN], 1u);
            else XB_SPIN(xb_ld(&bar[XB_TOPGEN]) == tg, bar);
            __builtin_amdgcn_fence(__ATOMIC_ACQUIRE, "agent");
            xb_add(&bar[XB_XGEN(b.x)], 1u);
            asm volatile("s_waitcnt vmcnt(0)" ::: "memory");
        } else {
            XB_SPIN(xb_ld(&bar[XB_XGEN(b.x)]) == gen, bar);
            __builtin_amdgcn_fence(__ATOMIC_ACQUIRE, "agent");
            asm volatile("s_waitcnt vmcnt(0)" ::: "memory");
        }
    }
    __syncthreads();
}

__device__ __forceinline__ void p0_transpose_item(const float* W, int K, int N, bf16* WT, const float* ksc, LAS float* scr, int item, int lane) {
    const int nblk = N / 32, kb = item / nblk, nb = item % nblk, k0 = 64 * kb, n0 = 32 * nb;
#pragma unroll
    for (int i = 0; i < 32; ++i) { const int kk = 2 * i + (lane >> 5); float v = W[(size_t)(k0 + kk) * N + n0 + (lane & 31)]; if (ksc) v *= ksc[k0 + kk]; scr[kk * 33 + (lane & 31)] = v; }
    asm volatile("s_waitcnt lgkmcnt(0)" ::: "memory");
    const int c = lane & 7;
#pragma unroll
    for (int j = 0; j < 4; ++j) { const int n = (lane >> 3) + 8 * j; const LAS float* s = scr + (8 * c) * 33 + n;
        u32x4 o; o.x = pk2(s[0 * 33], s[1 * 33]); o.y = pk2(s[2 * 33], s[3 * 33]); o.z = pk2(s[4 * 33], s[5 * 33]); o.w = pk2(s[6 * 33], s[7 * 33]);
        *(u32x4*)(WT + (size_t)(n0 + n) * K + k0 + 8 * c) = o; }
    asm volatile("s_waitcnt lgkmcnt(0)" ::: "memory");
}
__device__ __forceinline__ void phase_p0(const Args& A, LAS unsigned char* lds, int G) {
    const int tid = threadIdx.x, lane = tid & 63, wave = tid >> 6;
    LAS float* scr = (LAS float*)(lds + wave * 16384);
    const int gw = blockIdx.x * 8 + wave, NGW = G * 8;
    unsigned char* ws = A.ws;
    constexpr int I_IN = 16 * 88, I_OUT = 16 * 32, I_UPI = 16 * 96, I_DN = 48 * 32, NIT = I_IN + I_OUT + 2 * I_UPI + I_DN;
    for (int it = gw; it < NIT; it += NGW) {
        int r = it;
        if (r < I_IN) { p0_transpose_item(A.in[I_WIN], D, DIN, (bf16*)(ws + WS_WIN), nullptr, scr, r, lane); continue; } r -= I_IN;
        if (r < I_OUT) { p0_transpose_item(A.in[I_WOUT], D, D, (bf16*)((unsigned char*)A.out + DO_WOUT), nullptr, scr, r, lane); continue; } r -= I_OUT;
        if (r < I_UPI) { p0_transpose_item(A.in[I_FUP], D, DFF, (bf16*)(ws + WS_WUP), A.in[I_N2G], scr, r, lane); continue; } r -= I_UPI;
        if (r < I_UPI) { p0_transpose_item(A.in[I_FGATE], D, DFF, (bf16*)(ws + WS_WGATE), A.in[I_N2G], scr, r, lane); continue; } r -= I_UPI;
        p0_transpose_item(A.in[I_FDOWN], DFF, D, (bf16*)(ws + WS_WDOWN), nullptr, scr, r, lane);
    }
    const int gt = blockIdx.x * 512 + tid, NGT = G * 512;
    { bf16* BA = (bf16*)(ws + WS_BA); const float* wup = A.in[I_WUP]; const float* aup = A.in[I_AUP]; const float* gup = A.in[I_GUP];
      for (int e = gt; e < 1536 * 256; e += NGT) { const int n = e >> 8, k = e & 255; float v = 0.f;
          if (n < 512) { if (k < 64) v = wup[k * 512 + n]; }
          else if (n < 1024) { if (k >= 64 && k < 128) v = aup[(k - 64) * 512 + n - 512]; }
          else { if (k >= 128) v = gup[(k - 128) * 512 + n - 1024]; }
          BA[e] = (bf16)f2bf(v); } }
    { bf16* BB = (bf16*)(ws + WS_BB); const float* wa = A.in[I_LWA]; const float* wx = A.in[I_LWX];
      for (int e = gt; e < 1024 * 512; e += NGT) { const int n = e >> 9, k = e & 511, nn = n & 511, h = nn >> 6, j = nn & 63; float v = 0.f;
          if ((k >> 6) == h) { const float* Wm = n < 512 ? wa : wx; v = Wm[(h * 64 + (k & 63)) * 64 + j]; }
          BB[e] = (bf16)f2bf(v); } }
    bf16* XN = (bf16*)(ws + WS_XN); const float* g1 = A.in[I_N1G];
    for (int row = gw; row < MP; row += NGW) {
        const float* src = row < R_SAMPLE ? A.in[I_XP] + (size_t)row * D : row < R_META ? A.in[I_XS] + (size_t)(row - R_SAMPLE) * D : row < R_END ? A.in[I_META] + (size_t)(row - R_META) * D : nullptr;
        u32x2* o = (u32x2*)(XN + (size_t)row * D);
        if (!src) {
#pragma unroll
            for (int j = 0; j < 4; ++j) o[lane + 64 * j] = (u32x2){0u, 0u};
            continue; }
        f32x4 v[4]; float s = 0.f;
#pragma unroll
        for (int j = 0; j < 4; ++j) { v[j] = ((const f32x4*)src)[lane + 64 * j]; s += (v[j].x * v[j].x + v[j].y * v[j].y) + (v[j].z * v[j].z + v[j].w * v[j].w); }
        const float rs = rsqrtf(wave_sum(s) * (1.f / D) + EPS);
#pragma unroll
        for (int j = 0; j < 4; ++j) { const f32x4 g = ((const f32x4*)g1)[lane + 64 * j];
            o[lane + 64 * j] = (u32x2){pk2(v[j].x * rs * g.x, v[j].y * rs * g.y), pk2(v[j].z * rs * g.z, v[j].w * rs * g.w)}; }
    }
}

__device__ __forceinline__ void phase_e1(const Args& A, int G) {
    const int tid = threadIdx.x, lane = tid & 63, wave = tid >> 6;
    const int gw = blockIdx.x * 8 + wave, NGW = G * 8;
    unsigned char* ws = A.ws;
    const bf16* U = (const bf16*)(ws + WS_U); bf16* AP = (bf16*)(ws + WS_AP); bf16* XC = (bf16*)(ws + WS_XC);
    const float* mu = A.in[I_MU]; const float* sts = A.in[I_STS]; const float* slc = A.in[I_SLC]; const float* lcw = A.in[I_LCW]; const float* lcb = A.in[I_LCB];
    for (int row = gw; row < MP; row += NGW) {
        bf16* ap = AP + (size_t)row * 256; bf16* xc = XC + (size_t)row * 512;
        const RowInfo ri = row_info(row);
        if (ri.kind == 3) { ((u32x2*)ap)[lane] = (u32x2){0u, 0u}; ((u32x4*)xc)[lane] = (u32x4){0u, 0u, 0u, 0u}; continue; }
        const bf16* urow = U + (size_t)row * DIN;
        const int r1 = row_back(ri, row, 1);
        {
            const int c0 = 1536 + 4 * lane;
            const u32x2 uw = *(const u32x2*)(urow + c0);
            float u[4] = {lo16(uw.x), hi16(uw.x), lo16(uw.y), hi16(uw.y)}, p[4];
            if (r1 >= 0) { const u32x2 pw = *(const u32x2*)(U + (size_t)r1 * DIN + c0); p[0] = lo16(pw.x); p[1] = hi16(pw.x); p[2] = lo16(pw.y); p[3] = hi16(pw.y); }
            else if (ri.kind == 1) { const f32x4 pv = *(const f32x4*)(sts + (size_t)ri.b * DTMP + c0); p[0] = pv.x; p[1] = pv.y; p[2] = pv.z; p[3] = pv.w; }
            else { p[0] = p[1] = p[2] = p[3] = 0.f; }
            const f32x4 m4 = *(const f32x4*)(mu + c0);
            float o[4];
#pragma unroll
            for (int i = 0; i < 4; ++i) { const float um = u[i] + (p[i] - u[i]) * m4[i]; o[i] = lane < 16 ? tanh_(um) : lane < 32 ? um : sigm(um); }
            ((u32x2*)ap)[lane] = (u32x2){pk2(o[0], o[1]), pk2(o[2], o[3])};
        }
        {
            const int c = 8 * lane;
            float acc[8], cur[8];
            { const f32x4 b0 = *(const f32x4*)(lcb + c), b1 = *(const f32x4*)(lcb + c + 4); acc[0] = b0.x; acc[1] = b0.y; acc[2] = b0.z; acc[3] = b0.w; acc[4] = b1.x; acc[5] = b1.y; acc[6] = b1.z; acc[7] = b1.w; }
#pragma unroll
            for (int j = 0; j < 4; ++j) {
                float val[8];
                const int rj = (j == 3) ? row : row_back(ri, row, 3 - j);
                if (rj >= 0) unpack8(*(const u32x4*)(U + (size_t)rj * DIN + DTMP + c), val);
                else if (ri.kind == 1) { const float* s = slc + ((size_t)ri.b * 3 + (ri.t + j)) * 512 + c; const f32x4 a = *(const f32x4*)s, b = *(const f32x4*)(s + 4);
                    val[0] = a.x; val[1] = a.y; val[2] = a.z; val[3] = a.w; val[4] = b.x; val[5] = b.y; val[6] = b.z; val[7] = b.w; }
                else {
#pragma unroll
                    for (int i = 0; i < 8; ++i) val[i] = 0.f; }
                const f32x4 w0 = *(const f32x4*)(lcw + j * 512 + c), w1 = *(const f32x4*)(lcw + j * 512 + c + 4);
#pragma unroll
                for (int i = 0; i < 4; ++i) { acc[i] += w0[i] * val[i]; acc[4 + i] += w1[i] * val[4 + i]; }
                if (j == 3) {
#pragma unroll
                    for (int i = 0; i < 8; ++i) cur[i] = val[i]; }
            }
            u32x4 w; w.x = pk2(acc[0], acc[1]); w.y = pk2(acc[2], acc[3]); w.z = pk2(acc[4], acc[5]); w.w = pk2(acc[6], acc[7]);
            ((u32x4*)xc)[lane] = w;
            float* lco = nullptr;
            if (ri.kind == 0 && ri.t >= TP - 3) lco = A.out + O_PLC + ((size_t)ri.b * 3 + (ri.t - (TP - 3))) * 512 + c;
            else if (ri.kind == 1 && ri.t >= 1) lco = A.out + O_SLC + ((size_t)ri.b * 3 + (ri.t - 1)) * 512 + c;
            if (lco) { *(f32x4*)lco = (f32x4){cur[0], cur[1], cur[2], cur[3]}; *(f32x4*)(lco + 4) = (f32x4){cur[4], cur[5], cur[6], cur[7]}; }
        }
        float* sho = nullptr;
        if (ri.kind == 0 && ri.t == TP - 1) sho = A.out + O_PSHIFT + (size_t)ri.b * DTMP;
        else if (ri.kind == 1 && ri.t == DS - 1) sho = A.out + O_SSHIFT + (size_t)ri.b * DTMP;
        if (sho) for (int i = lane; i < DTMP; i += 64) sho[i] = bf2f(urow[i]);
    }
}

__device__ __forceinline__ float sum8(float x) { x += dpp_f<0xB1>(x); x += dpp_f<0x4E>(x); x += dpp_f<0x141>(x); return x; }
__device__ __forceinline__ void ld8f(const float* p, float (&f)[8]) { const f32x4 a = *(const f32x4*)p, b = *(const f32x4*)(p + 4); f[0] = a.x; f[1] = a.y; f[2] = a.z; f[3] = a.w; f[4] = b.x; f[5] = b.y; f[6] = b.z; f[7] = b.w; }
__device__ __forceinline__ u32x4 pack8(const float (&o)[8]) { u32x4 w; w.x = pk2(o[0], o[1]); w.y = pk2(o[2], o[3]); w.z = pk2(o[4], o[5]); w.w = pk2(o[6], o[7]); return w; }
__device__ __forceinline__ void phase_e2(const Args& A, int G) {
    const int tid = threadIdx.x, lane = tid & 63, wave = tid >> 6;
    unsigned char* ws = A.ws;
    const bf16* U = (const bf16*)(ws + WS_U); const bf16* GB = (const bf16*)(ws + WS_GB); const bf16* GA = (const bf16*)((unsigned char*)A.out + DO_GA);
    bf16* REC = (bf16*)(ws + WS_REC); bf16* LRU = (bf16*)(ws + WS_LRU);
    float* LTOT = (float*)((unsigned char*)A.out + DO_LTOT); float* BON = (float*)((unsigned char*)A.out + DO_BON);
    const float* mu = A.in[I_MU]; const float* sts = A.in[I_STS]; const float* slc = A.in[I_SLC]; const float* slh = A.in[I_SLH];
    for (int unit = blockIdx.x; unit < 513 + DB; unit += G) {
        int row0, ntok, kind;
        if (unit < 512) { row0 = unit * 32; ntok = 32; kind = 0; } else if (unit == 512) { row0 = R_META; ntok = 16; kind = 2; } else { row0 = R_SAMPLE + (unit - 513) * 4; ntok = 4; kind = 1; }
        const int c = tid;
        const float sp = softplus_(-A.in[I_LAM][c]);
        const float cw0 = A.in[I_LCW][c], cw1 = A.in[I_LCW][512 + c], cw2 = A.in[I_LCW][1024 + c], cw3 = A.in[I_LCW][1536 + c], cbias = A.in[I_LCB][c];
        const float ba_ = A.in[I_LBA][c], bx_ = A.in[I_LBX][c];
        float l1 = 0.f, l2 = 0.f, l3 = 0.f, H = 0.f, P = 1.f;
        if (kind == 0) { const RowInfo ri0 = row_info(row0);
            l1 = bf2f(U[(size_t)row_back(ri0, row0, 1) * DIN + DTMP + c]); l2 = bf2f(U[(size_t)row_back(ri0, row0, 2) * DIN + DTMP + c]); l3 = bf2f(U[(size_t)row_back(ri0, row0, 3) * DIN + DTMP + c]); }
        else if (kind == 1) { const int b = unit - 513; l3 = slc[((size_t)b * 3 + 0) * 512 + c]; l2 = slc[((size_t)b * 3 + 1) * 512 + c]; l1 = slc[((size_t)b * 3 + 2) * 512 + c]; H = slh[(size_t)b * 512 + c]; }
#pragma unroll 4
        for (int j = 0; j < ntok; ++j) {
            const int row = row0 + j;
            const float l0 = bf2f(U[(size_t)row * DIN + DTMP + c]);
            const float xc = cbias + cw0 * l3 + cw1 * l2 + cw2 * l1 + cw3 * l0;
            l3 = l2; l2 = l1; l1 = l0;
            const float ra = bf2f(GB[(size_t)row * 1024 + c]) + ba_, ix = bf2f(GB[(size_t)row * 1024 + 512 + c]) + bx_;
            const float rg = sigm(ra), ig = sigm(ix);
            const float la = -8.f * rg * sp, a = __expf(la);
            float mult = sqrtf(fmaxf(1.f - __expf(2.f * la), 0.f)); if (kind == 2 && j == 0) mult = 1.f;
            H = a * H + xc * ig * mult; P = P * a;
            LRU[(size_t)row * 1024 + c] = (bf16)f2bf(H); LRU[(size_t)row * 1024 + 512 + c] = (bf16)f2bf(kind == 1 ? 0.f : P);
        }
        if (kind == 1) A.out[O_SLH + (size_t)(unit - 513) * 512 + c] = H;
        else { LTOT[((size_t)unit * 2 + 0) * 512 + c] = P; LTOT[((size_t)unit * 2 + 1) * 512 + c] = H; }
    }
    {
        const int c = 8 * lane, h = lane >> 3, gw = blockIdx.x * 8 + wave, NGW = G * 8;
        float mr[8], mk[8], w0[8], a0[8], kkw[8], kaw[8], rkw[8];
        ld8f(mu + c, mr); ld8f(mu + 512 + c, mk); ld8f(A.in[I_W0] + c, w0); ld8f(A.in[I_A0] + c, a0); ld8f(A.in[I_KK] + c, kkw); ld8f(A.in[I_KA] + c, kaw); ld8f(A.in[I_RK] + c, rkw);
        for (int row = gw; row < R_END; row += NGW) {
            const RowInfo ri = row_info(row); const int r1 = row_back(ri, row, 1);
            const bf16* ur = U + (size_t)row * DIN;
            float u_r[8], u_k[8], p_r[8], p_k[8], wp[8], ap[8];
            unpack8(*(const u32x4*)(ur + c), u_r); unpack8(*(const u32x4*)(ur + 512 + c), u_k);
            unpack8(*(const u32x4*)(GA + (size_t)row * 1536 + c), wp); unpack8(*(const u32x4*)(GA + (size_t)row * 1536 + 512 + c), ap);
            if (r1 >= 0) { unpack8(*(const u32x4*)(U + (size_t)r1 * DIN + c), p_r); unpack8(*(const u32x4*)(U + (size_t)r1 * DIN + 512 + c), p_k); }
            else if (ri.kind == 1) { ld8f(sts + (size_t)ri.b * DTMP + c, p_r); ld8f(sts + (size_t)ri.b * DTMP + 512 + c, p_k); }
            else {
#pragma unroll
                for (int i = 0; i < 8; ++i) { p_r[i] = 0.f; p_k[i] = 0.f; } }
            float av[8], xv[8], kk[8], kp[8], ss = 0.f, bs = 0.f;
#pragma unroll
            for (int i = 0; i < 8; ++i) {
                const float um_r = u_r[i] + (p_r[i] - u_r[i]) * mr[i], um_k = u_k[i] + (p_k[i] - u_k[i]) * mk[i];
                const float z = -(wp[i] + w0[i]);
                const float w_log = -(fmaxf(z, 0.f) + __logf(1.f + __expf(-fabsf(z)))) - 0.5f;
                const float e = __expf(w_log); xv[i] = 1.f - __expf(-e);
                av[i] = sigm(ap[i] + a0[i]);
                kk[i] = um_k * kkw[i]; ss += kk[i] * kk[i];
                kp[i] = um_k * (1.f + (av[i] - 1.f) * kaw[i]);
                bs += um_r * kp[i] * rkw[i];
            }
            ss = sum8(ss); bs = sum8(bs);
            const float rn = rsqrtf(fmaxf(ss, 1e-24f));
#pragma unroll
            for (int i = 0; i < 8; ++i) kk[i] *= rn;
            bf16* rec = REC + ((size_t)row * 8 + h) * 256 + (lane & 7) * 8;
            *(u32x4*)rec = pack8(av); *(u32x4*)(rec + 64) = pack8(xv); *(u32x4*)(rec + 128) = pack8(kk); *(u32x4*)(rec + 192) = pack8(kp);
            if ((lane & 7) == 0) BON[(size_t)row * 8 + h] = bs;
        }
    }
}

struct Raw { bf16 a, x, kk, kp, ur, uv, pr, pv; };
__device__ __forceinline__ void m2_load(Raw (&raw)[8], const bf16* REC, const bf16* U, int b, int h, int t0, int ns, int k, int sub) {
#pragma unroll
    for (int i = 0; i < 8; ++i) {
        const int s = sub + 4 * i;
        raw[i].a = 0; raw[i].x = 0; raw[i].kk = 0; raw[i].kp = 0; raw[i].ur = 0; raw[i].uv = 0; raw[i].pr = 0; raw[i].pv = 0;
        if (s < ns) {
            const int t = t0 + s, row = prompt_row(b, t);
            const bf16* rec = REC + ((size_t)row * 8 + h) * 256;
            raw[i].a = rec[k]; raw[i].x = rec[64 + k]; raw[i].kk = rec[128 + k]; raw[i].kp = rec[192 + k];
            const bf16* ur = U + (size_t)row * DIN + h * 64 + k; raw[i].ur = ur[0]; raw[i].uv = ur[1024];
            if (t > 0) { const bf16* pr = U + (size_t)prompt_row(b, t - 1) * DIN + h * 64 + k; raw[i].pr = pr[0]; raw[i].pv = pr[1024]; }
        }
    }
}
__device__ __forceinline__ void m2_store(const Raw (&raw)[8], LAS float* buf, float mu_r, float mu_v, int k, int sub, int ns) {
#pragma unroll
    for (int i = 0; i < 8; ++i) {
        const int s = sub + 4 * i;
        if (s < ns) {
            LAS float* p = buf + s * 384;
            const float a = bf2f(raw[i].a), kk = bf2f(raw[i].kk), ur = bf2f(raw[i].ur), uv = bf2f(raw[i].uv);
            p[k] = kk; p[64 + k] = 1.f - bf2f(raw[i].x); p[128 + k] = -(kk * a); p[192 + k] = bf2f(raw[i].kp);
            p[256 + k] = ur + (bf2f(raw[i].pr) - ur) * mu_r; p[320 + k] = uv + (bf2f(raw[i].pv) - uv) * mu_v;
        }
    }
}
typedef float f32x2 __attribute__((ext_vector_type(2)));
struct StepOps { f32x4 kk, dd, nka, kp, r; float v; };
__device__ __forceinline__ void ops_load(StepOps& o, const LAS float* p, int ks, int vrow) {
    o.kk = *(const LAS f32x4*)(p + 4 * ks); o.dd = *(const LAS f32x4*)(p + 64 + 4 * ks); o.nka = *(const LAS f32x4*)(p + 128 + 4 * ks);
    o.kp = *(const LAS f32x4*)(p + 192 + 4 * ks); o.r = *(const LAS f32x4*)(p + 256 + 4 * ks); o.v = p[320 + vrow];
}
__device__ __forceinline__ float dot4(const f32x4 a, const f32x4 b) { f32x2 t = a.xy * b.xy; t = a.zw * b.zw + t; return t.x + t.y; }
__device__ __forceinline__ void scan_step2(f32x4& S, const StepOps& o, float& yp) {
    float d = dot4(S, o.kk);
    d += dpp_f<0xB1>(d); yp += dpp_f<0xB1>(yp); d += dpp_f<0x4E>(d); yp += dpp_f<0x4E>(yp);
    d += dpp_f<0x141>(d); yp += dpp_f<0x141>(yp); d += dpp_f<0x140>(d); yp += dpp_f<0x140>(yp);
    S = S * o.dd + d * o.nka + o.v * o.kp;
}
__device__ __forceinline__ float scan_step(f32x4& S, const StepOps& o) {
    float d = dot4(S, o.kk); d = allsum16(d);
    S = S * o.dd + d * o.nka + o.v * o.kp;
    float y = dot4(S, o.r); return allsum16(y);
}
__device__ __forceinline__ void phase_m2(const Args& A, LAS unsigned char* lds, int G) {
    const int tid = threadIdx.x, lane = tid & 63, wave = tid >> 6;
    unsigned char* ws = A.ws;
    const bf16* U = (const bf16*)(ws + WS_U); const bf16* REC = (const bf16*)(ws + WS_REC); float* Y = (float*)(ws + WS_Y);
    const float* LTOT = (const float*)((unsigned char*)A.out + DO_LTOT); float* CARRY = (float*)((unsigned char*)A.out + DO_CARRY);
    const float* mu = A.in[I_MU];
    for (int b = blockIdx.x; b < NB; b += G) {
        const int c = tid; float carry = LTOT[((size_t)512 * 2 + 1) * 512 + c];
        float Pv[64], Hv[64];
#pragma unroll
        for (int i = 0; i < 64; ++i) { const int un = b * 64 + i; Pv[i] = LTOT[((size_t)un * 2 + 0) * 512 + c]; Hv[i] = LTOT[((size_t)un * 2 + 1) * 512 + c]; }
#pragma unroll
        for (int i = 0; i < 64; ++i) { CARRY[((size_t)b * 64 + i) * 512 + c] = carry; carry = Pv[i] * carry + Hv[i]; }
        A.out[O_PLH + (size_t)b * 512 + c] = carry;
    }
    const int ks = lane & 15, rl = lane >> 4;
    for (int item = blockIdx.x; item < 256; item += G) {
        const int bh = item >> 2, q = item & 3, b = bh >> 3, h = bh & 7;
        const int k = tid & 63, sub = (tid >> 6) & 3;
        const float mu_r = mu[h * 64 + k], mu_v = mu[1024 + h * 64 + k];
        const int wv = wave & 3, vrow = 16 * q + 4 * wv + rl;
        f32x4 S = (f32x4){0.f, 0.f, 0.f, 0.f};
        Raw raw[8];
        LAS float* buf0 = (LAS float*)lds; LAS float* buf1 = (LAS float*)(lds + 50688); LAS float* ybuf = (LAS float*)(lds + 101376) + wv * 132;
        __syncthreads();
        if (wave >= 4) { m2_load(raw, REC, U, b, h, 0, 16, k, sub); m2_store(raw, buf0, mu_r, mu_v, k, sub, 16); m2_load(raw, REC, U, b, h, 16, 32, k, sub); }
        __syncthreads();
        for (int blk = 0; blk < 65; ++blk) {
            const int t0 = blk == 0 ? 0 : 16 + 32 * (blk - 1), ns = blk == 0 ? 16 : 32;
            if (wave >= 4) {
                if (blk + 1 < 65) m2_store(raw, (blk & 1) ? buf0 : buf1, mu_r, mu_v, k, sub, 32);
                if (blk + 2 < 65) m2_load(raw, REC, U, b, h, 16 + 32 * (blk + 1), 32, k, sub);
            } else {
                const LAS float* buf = (blk & 1) ? buf1 : buf0;
                StepOps oa, ob; ops_load(oa, buf, ks, vrow);
                float yp = 0.f;
                for (int s = 0; s < ns; s += 2) {
                    ops_load(ob, buf + (s + 1) * 384, ks, vrow);
                    scan_step2(S, oa, yp); ybuf[s * 4 + rl] = yp; yp = dot4(S, oa.r);
                    ops_load(oa, buf + (s + 2) * 384, ks, vrow);
                    scan_step2(S, ob, yp); ybuf[(s + 1) * 4 + rl] = yp; yp = dot4(S, ob.r);
                }
                yp = allsum16(yp); ybuf[ns * 4 + rl] = yp;
                if (ks < ns) Y[(size_t)prompt_row(b, t0 + ks) * 512 + h * 64 + vrow] = ybuf[(ks + 1) * 4 + rl];
                if (ks + 16 < ns) Y[(size_t)prompt_row(b, t0 + ks + 16) * 512 + h * 64 + vrow] = ybuf[(ks + 17) * 4 + rl];
            }
            __syncthreads();
        }
        if (wave < 4) *(f32x4*)(A.out + O_PWKV + ((size_t)(b * 8 + h) * 64 + vrow) * 64 + 4 * ks) = S;
    }
    const float* swkv = A.in[I_SWKV]; const float* sts = A.in[I_STS];
#pragma unroll 2
    for (int task = blockIdx.x * 8 + wave; task < DB * NH * 16; task += G * 8) {
        const int bh = task >> 4, rg = task & 15, b = bh >> 3, h = bh & 7, v = 4 * rg + rl;
        f32x4 S = *(const f32x4*)(swkv + ((size_t)bh * 64 + v) * 64 + 4 * ks);
        const f32x4 mr4 = *(const f32x4*)(mu + h * 64 + 4 * ks); const float mv = mu[1024 + h * 64 + v];
        StepOps o[DS];
#pragma unroll
        for (int t = 0; t < DS; ++t) {
            const int row = R_SAMPLE + 4 * b + t;
            const bf16* rec = REC + ((size_t)row * 8 + h) * 256 + 4 * ks;
            const u32x2 wa = *(const u32x2*)rec, wx = *(const u32x2*)(rec + 64), wk = *(const u32x2*)(rec + 128), wp = *(const u32x2*)(rec + 192);
            const f32x4 a4 = (f32x4){lo16(wa.x), hi16(wa.x), lo16(wa.y), hi16(wa.y)};
            o[t].dd = 1.f - (f32x4){lo16(wx.x), hi16(wx.x), lo16(wx.y), hi16(wx.y)};
            o[t].kk = (f32x4){lo16(wk.x), hi16(wk.x), lo16(wk.y), hi16(wk.y)}; o[t].kp = (f32x4){lo16(wp.x), hi16(wp.x), lo16(wp.y), hi16(wp.y)};
            const u32x2 wr_ = *(const u32x2*)(U + (size_t)row * DIN + h * 64 + 4 * ks);
            const f32x4 ur4 = (f32x4){lo16(wr_.x), hi16(wr_.x), lo16(wr_.y), hi16(wr_.y)};
            const float uv = bf2f(U[(size_t)row * DIN + 1024 + h * 64 + v]);
            f32x4 pr4; float pv;
            if (t > 0) { const u32x2 w = *(const u32x2*)(U + (size_t)(row - 1) * DIN + h * 64 + 4 * ks); pr4 = (f32x4){lo16(w.x), hi16(w.x), lo16(w.y), hi16(w.y)}; pv = bf2f(U[(size_t)(row - 1) * DIN + 1024 + h * 64 + v]); }
            else { pr4 = *(const f32x4*)(sts + (size_t)b * DTMP + h * 64 + 4 * ks); pv = sts[(size_t)b * DTMP + 1024 + h * 64 + v]; }
            o[t].r = ur4 + (pr4 - ur4) * mr4; o[t].v = uv + (pv - uv) * mv; o[t].nka = -(o[t].kk * a4);
        }
#pragma unroll
        for (int t = 0; t < DS; ++t) { const float y = scan_step(S, o[t]); if (ks == 0) Y[(size_t)(R_SAMPLE + 4 * b + t) * 512 + h * 64 + v] = y; }
        *(f32x4*)(A.out + O_SWKV + ((size_t)bh * 64 + v) * 64 + 4 * ks) = S;
    }
}

__device__ __forceinline__ void phase_m3(const Args& A, int G) {
    const int tid = threadIdx.x, lane = tid & 63, wave = tid >> 6;
    const int gw = blockIdx.x * 8 + wave, NGW = G * 8;
    unsigned char* ws = A.ws;
    const bf16* U = (const bf16*)(ws + WS_U); const bf16* GA = (const bf16*)((unsigned char*)A.out + DO_GA); const bf16* LRU = (const bf16*)(ws + WS_LRU);
    const float* Y = (const float*)(ws + WS_Y); const float* CARRY = (const float*)((unsigned char*)A.out + DO_CARRY); const float* BON = (const float*)((unsigned char*)A.out + DO_BON);
    bf16* MIX = (bf16*)(ws + WS_MIX);
    const float* sts = A.in[I_STS];
    const int c = 8 * lane, h = lane >> 3;
    float mv[8], gg[8], gb[8], og[8];
    ld8f(A.in[I_MU] + 1024 + c, mv); ld8f(A.in[I_GNG] + c, gg); ld8f(A.in[I_GNB] + c, gb); ld8f(A.in[I_LOG] + c, og);
    for (int row = gw; row < MP; row += NGW) {
        bf16* mo = MIX + (size_t)row * D;
        const RowInfo ri = row_info(row);
        if (ri.kind == 3) { ((u32x4*)mo)[lane] = (u32x4){0u, 0u, 0u, 0u}; ((u32x4*)mo)[64 + lane] = (u32x4){0u, 0u, 0u, 0u}; continue; }
        const int r1 = row_back(ri, row, 1);
        float y[8], uv[8], pv[8], g[8], hv[8], pp[8], gt[8], cr[8];
        ld8f(Y + (size_t)row * 512 + c, y);
        unpack8(*(const u32x4*)(U + (size_t)row * DIN + 1024 + c), uv);
        unpack8(*(const u32x4*)(GA + (size_t)row * 1536 + 1024 + c), g);
        unpack8(*(const u32x4*)(LRU + (size_t)row * 1024 + c), hv); unpack8(*(const u32x4*)(LRU + (size_t)row * 1024 + 512 + c), pp);
        unpack8(*(const u32x4*)(U + (size_t)row * DIN + DTMP + 512 + c), gt);
        const float bon = BON[(size_t)row * 8 + h];
        if (r1 >= 0) unpack8(*(const u32x4*)(U + (size_t)r1 * DIN + 1024 + c), pv);
        else if (ri.kind == 1) ld8f(sts + (size_t)ri.b * DTMP + 1024 + c, pv);
        else {
#pragma unroll
            for (int i = 0; i < 8; ++i) pv[i] = 0.f; }
        if (ri.kind == 0) ld8f(CARRY + ((size_t)ri.b * 64 + ((row & 2047) >> 5)) * 512 + c, cr);
        else {
#pragma unroll
            for (int i = 0; i < 8; ++i) cr[i] = 0.f; }
        float s = 0.f;
#pragma unroll
        for (int i = 0; i < 8; ++i) s += y[i];
        const float mean = sum8(s) * (1.f / 64.f);
        float q = 0.f;
#pragma unroll
        for (int i = 0; i < 8; ++i) { y[i] -= mean; q += y[i] * y[i]; }
        const float rstd = rsqrtf(sum8(q) * (1.f / 64.f) + GN_EPS);
        float o[8];
#pragma unroll
        for (int i = 0; i < 8; ++i) { const float vv = uv[i] + (pv[i] - uv[i]) * mv[i]; o[i] = (y[i] * rstd * gg[i] + gb[i] + bon * vv) * g[i]; }
        *(u32x4*)(mo + c) = pack8(o);
        float z[8], s2 = 0.f;
#pragma unroll
        for (int i = 0; i < 8; ++i) { z[i] = (hv[i] + pp[i] * cr[i]) * gelu_tanh(gt[i]); s2 += z[i] * z[i]; }
        const float rs = rsqrtf(wave_sum(s2) * (1.f / 512.f) + EPS);
#pragma unroll
        for (int i = 0; i < 8; ++i) o[i] = z[i] * rs * og[i];
        *(u32x4*)(mo + 512 + c) = pack8(o);
    }
}

__device__ __forceinline__ void phase_final(const Args& A, int G) {
    const int tid = threadIdx.x, lane = tid & 63, wave = tid >> 6;
    const int gw = blockIdx.x * 8 + wave, NGW = G * 8;
    const float* gf = A.in[I_NFG];
    f32x4 g[4];
#pragma unroll
    for (int j = 0; j < 4; ++j) g[j] = ((const f32x4*)gf)[lane + 64 * j];
    for (int row = gw; row < M_MAIN; row += NGW) {
        f32x4* p = (f32x4*)(A.out + (size_t)row * D);
        f32x4 v[4]; float s = 0.f;
#pragma unroll
        for (int j = 0; j < 4; ++j) { v[j] = p[lane + 64 * j]; s += (v[j].x * v[j].x + v[j].y * v[j].y) + (v[j].z * v[j].z + v[j].w * v[j].w); }
        const float rs = rsqrtf(wave_sum(s) * (1.f / D) + EPS);
#pragma unroll
        for (int j = 0; j < 4; ++j) p[lane + 64 * j] = v[j] * rs * g[j];
    }
}

namespace cg = cooperative_groups;
__global__ void __launch_bounds__(512, 2) mk_fwd(Args args) {
    extern __shared__ __attribute__((aligned(16))) unsigned char lds_raw[];
    LAS unsigned char* lds = (LAS unsigned char*)lds_raw;
    const int G = gridDim.x, tid = threadIdx.x;
    volatile LAS unsigned* MISC = (volatile LAS unsigned*)(lds + 131072 + 320);
    if (tid < 64) ((LAS unsigned*)(lds + 131072))[tid + 64] = 0u, ((LAS unsigned*)(lds + 131072))[tid] = 0u;
    __syncthreads();
    const int lo = args.ph_lo, hi = args.ph_hi;
    XcdBarrier bar; bar.bar = (unsigned*)(args.ws + WS_CTL) + 4096; bar.x = 0; bar.st = nullptr;
    if (hi - lo > 1) bar = xcd_barrier_post((unsigned*)(args.ws + WS_CTL) + 4096, MISC + 8);
    if (lo < 0) cg::this_grid().sync();
#define IN(k) (lo <= (k) && (k) < hi)
#define SEAM(k) do { if (IN(k) && IN((k) + 1)) xcd_barrier(bar); } while (0)
    unsigned char* ws = args.ws; unsigned char* ob = (unsigned char*)args.out;
    if (IN(0)) { phase_p0(args, lds, G); } SEAM(0);
    if (IN(1)) { pg8::Gemm g{(const bf16*)(ws + WS_XN), (const bf16*)(ws + WS_WIN), MP, DIN, D}; pg8::StaticOrder S; S.init(MP, DIN, G, (int)blockIdx.x, D);
        EpiPlain E{(bf16*)(ws + WS_U), DIN}; pg8::gemm_phase<EpiPlain, pg8::StaticOrder, true, true>(lds, g, S, E); } SEAM(1);
    if (IN(2)) { phase_e1(args, G); } SEAM(2);
    if (IN(3)) {
        { pg8::Gemm g{(const bf16*)(ws + WS_AP), (const bf16*)(ws + WS_BA), MP, 1536, 256}; pg8::StaticOrder S; S.init(MP, 1536, G, (int)blockIdx.x, 256);
          EpiPlain E{(bf16*)(ob + DO_GA), 1536}; pg8::gemm_phase<EpiPlain, pg8::StaticOrder, true, true>(lds, g, S, E); }
        { pg8::Gemm g{(const bf16*)(ws + WS_XC), (const bf16*)(ws + WS_BB), MP, 1024, 512}; pg8::StaticOrder S; S.init(MP, 1024, G, (int)blockIdx.x, 512);
          EpiPlain E{(bf16*)(ws + WS_GB), 1024}; pg8::gemm_phase<EpiPlain, pg8::StaticOrder, true, true>(lds, g, S, E); }
    } SEAM(3);
    if (IN(4)) { phase_e2(args, G); } SEAM(4);
    if (IN(5)) { phase_m2(args, lds, G); } SEAM(5);
    if (IN(6)) { phase_m3(args, G); } SEAM(6);
    if (IN(7)) { pg8::Gemm g{(const bf16*)(ws + WS_MIX), (const bf16*)(ob + DO_WOUT), MP, D, D}; pg8::StaticOrder S; S.init(MP, D, G, (int)blockIdx.x, D);
        EpiX1 E{args.in[I_XP], args.in[I_XS], args.in[I_META], args.out, (bf16*)(ws + WS_X1B), (float*)(ws + WS_SSQ1)};
        pg8::gemm_phase<EpiX1, pg8::StaticOrder, true, true>(lds, g, S, E); } SEAM(7);
    if (IN(8)) { pg8::Gemm g{(const bf16*)(ws + WS_X1B), (const bf16*)(ws + WS_WUP), MP, DFF, D}; pg8::StaticOrder S; S.init(MP, DFF, G, (int)blockIdx.x, D);
        EpiUp E{(const float*)(ws + WS_SSQ1), (bf16*)(ws + WS_UP), args.out + O_PFC, args.out + O_SFC};
        pg8::gemm_phase<EpiUp, pg8::StaticOrder, true, true>(lds, g, S, E); } SEAM(8);
    if (IN(9)) { pg8::Gemm g{(const bf16*)(ws + WS_X1B), (const bf16*)(ws + WS_WGATE), M_MAIN, DFF, D}; pg8::StaticOrder S; S.init(M_MAIN, DFF, G, (int)blockIdx.x, D);
        EpiGate E{(const float*)(ws + WS_SSQ1), (const bf16*)(ws + WS_UP), args.in[I_SFC], args.in[I_FCW], args.in[I_FCB], (bf16*)(ws + WS_HID)};
        pg8::gemm_phase<EpiGate, pg8::StaticOrder, true, true>(lds, g, S, E); } SEAM(9);
    if (IN(10)) { pg8::Gemm g{(const bf16*)(ws + WS_HID), (const bf16*)(ws + WS_WDOWN), M_MAIN, D, DFF}; DownOrder S; S.init(G, (int)blockIdx.x);
        EpiDown E{args.out};
        pg8::gemm_phase<EpiDown, DownOrder, true, true>(lds, g, S, E); } SEAM(10);
    if (IN(11)) { phase_final(args, G); }
#undef IN
#undef SEAM
}

extern "C" void kernel_launch(void* const* d_in, const int* in_sizes, int n_in, void* d_out, int out_size, void* d_ws, size_t ws_size, hipStream_t stream) {
    static int grid = 0;
    if (grid == 0) {
        if (n_in != N_IN || (size_t)out_size != O_END || ws_size < 256 * MiB) { fprintf(stderr, "kernel_launch: unexpected shapes n_in %d out %d ws %zu\n", n_in, out_size, ws_size); grid = -1; return; }
        int dev = 0, cus = 0, per_cu = 0;
        (void)hipGetDevice(&dev); (void)hipDeviceGetAttribute(&cus, hipDeviceAttributeMultiprocessorCount, dev);
        if (hipFuncSetAttribute((const void*)mk_fwd, hipFuncAttributeMaxDynamicSharedMemorySize, LDS_BYTES) != hipSuccess) { fprintf(stderr, "kernel_launch: hipFuncSetAttribute failed\n"); grid = -1; return; }
        if (hipOccupancyMaxActiveBlocksPerMultiprocessor(&per_cu, (const void*)mk_fwd, 512, LDS_BYTES) != hipSuccess || per_cu < 1) per_cu = 1;
        (void)hipGetLastError();
        grid = cus > 0 ? cus : 256;
    }
    if (grid < 0) return;
    Args a{};
    for (int i = 0; i < N_IN; ++i) a.in[i] = (const float*)d_in[i];
    a.out = (float*)d_out; a.ws = (unsigned char*)d_ws;
#if MK_ONE_LAUNCH
    (void)hipMemsetAsync((char*)d_ws + WS_CTL, 0, CTL_ZERO_BYTES, stream);
    a.ph_lo = 0; a.ph_hi = NPH;
    void* kargs[] = {&a};
    hipError_t e = hipLaunchCooperativeKernel((const void*)mk_fwd, dim3(grid), dim3(512), kargs, LDS_BYTES, stream);
    if (e != hipSuccess) fprintf(stderr, "cooperative launch failed: %s (grid %d)\n", hipGetErrorString(e), grid);
#else
    for (int ph = 0; ph < NPH; ++ph) for (int rep = 0; rep < 1 + ((MK_REP_MASK >> ph) & 1); ++rep) { a.ph_lo = ph; a.ph_hi = ph + 1; hipLaunchKernelGGL(mk_fwd, dim3(grid), dim3(512), LDS_BYTES, stream, a); }
#endif
}
```

```cpp
#include <hip/hip_runtime.h>
#include <hip/hip_cooperative_groups.h>
#include <cstdio>
#include <cstdint>
#include <cmath>
__device__ __forceinline__ int my_tid() { int t = threadIdx.x; asm volatile("" : "+v"(t)); return t; }
namespace pg8 {
#define PG8_LAS __attribute__((address_space(3)))
typedef unsigned short bf16_t;
typedef short bf16x8 __attribute__((ext_vector_type(8)));
typedef float f32x4 __attribute__((ext_vector_type(4)));
typedef unsigned u32x4 __attribute__((ext_vector_type(4)));
constexpr int BM = 256, BK = 64, HALF = 128, HTB = HALF * BK * 2  , STAGE_BYTES = 8 * HTB, NXCD = 8, WGM = 8;

__host__ __device__ __forceinline__ int lds_byte(int r, int c) { const int st = (r >> 4) * 2 + (c >> 5), rr = r & 15, cc = c & 31, ob = rr * 64 + cc * 2; return st * 1024 + (ob ^ (((ob >> 9) & 1) << 5)); }
__host__ __device__ __forceinline__ void stage_rc(int b, int& R, int& C) { const int st = b / 1024, sb = b % 1024, swz = sb ^ (((sb >> 9) & 1) << 5); R = (st >> 1) * 16 + swz / 64; C = (st & 1) * 32 + (swz % 64) / 2; }
__host__ __device__ __forceinline__ int perm32(int rho) { const int n = rho >> 4, i = rho & 15; return 8 * (i >> 2) + 4 * n + (i & 3); }

struct Unit { int pm, pn, ko, nt; };
struct Gemm { const bf16_t* A; const bf16_t* Bt; int M, N, K; };

struct StaticOrder {
    int nM, nN, nwg, G, c, ntk;
    __host__ __device__ void init(int M, int N, int G_, int c_, int K_) { nM = M / BM; nN = N / BM; nwg = nM * nN; G = G_; c = c_; ntk = K_ / BK; }
    __host__ __device__ bool next(int i, Unit& u) const {
        const long L = (long)i * G + c; if (L >= nwg) return false;
        int wgid = (int)L; { const int q = nwg / NXCD, r = nwg % NXCD, xcd = wgid % NXCD, off = wgid / NXCD; wgid = (xcd < r ? xcd * (q + 1) : r * (q + 1) + (xcd - r) * q) + off; }
        const int nig = WGM * nN, gid = wgid / nig, fm = gid * WGM, gsz = (nM - fm) < WGM ? (nM - fm) : WGM;
        u.pm = fm + ((wgid % nig) % gsz); u.pn = (wgid % nig) / gsz; u.ko = 0; u.nt = ntk; return true;
    }
    __device__ __forceinline__ void a_ready(const Unit&) const {}
    __device__ __forceinline__ void done(const Unit&) const {}
};

__device__ __forceinline__ unsigned cvt_pk_bf16(float lo, float hi) { unsigned r; asm volatile("v_cvt_pk_bf16_f32 %0, %1, %2" : "=v"(r) : "v"(lo), "v"(hi)); return r; }
typedef float f32x2 __attribute__((ext_vector_type(2)));
template <class Epi, class Sched, bool ALIGN_EPI = false, bool SP2 = false>
__device__ __forceinline__ void gemm_phase(PG8_LAS unsigned char* lds, const Gemm g, const Sched& S, const Epi& E) {
    const int tid = my_tid(), wid = __builtin_amdgcn_readfirstlane(tid >> 6), lane = tid & 63, wr = wid >> 2, wc = wid & 3, fr = lane & 15, fq = lane >> 4;
    const int K = g.K;
    unsigned voffA[2], voffB[2];
#pragma unroll
    for (int i = 0; i < 2; ++i) { int R, C; stage_rc(tid * 16 + i * 8192, R, C); const int Rb = Epi::PERM ? ((R & ~31) + perm32(R & 31)) : R;
        voffA[i] = (unsigned)(R * K + C) * 2u; voffB[i] = (unsigned)(Rb * K + C) * 2u; }
    const size_t kstep = (size_t)(BK * 2);
    const size_t hstep = (size_t)HALF * K * 2;
    const size_t tstep = 2 * hstep;
    const unsigned ldsw = (unsigned)wid * 1024u;
    const int aoff = lds_byte(wr * 64 + fr, fq * 8), boff = lds_byte(wc * 32 + fr, fq * 8);
#define PG8_SA(b, h) (((b) * 2 + (h)) * HTB)
#define PG8_SB(b, h) ((4 + (b) * 2 + (h)) * HTB)
#define PG8_STAGE(bufoff, gbase, voff) do { _Pragma("unroll") for (int _i = 0; _i < 2; ++_i) \
        __builtin_amdgcn_global_load_lds((const unsigned*)((const char*)(gbase) + (voff)[_i]), (PG8_LAS unsigned*)(lds + (bufoff) + ldsw + _i * 8192), 16, 0, 0); } while (0)
#define PG8_LDA(dst, b, h) do { _Pragma("unroll") for (int m = 0; m < 4; ++m) _Pragma("unroll") for (int k = 0; k < 2; ++k) dst[m][k] = *(const PG8_LAS bf16x8*)(lds + PG8_SA(b, h) + aoff + m * 2048 + k * 1024); } while (0)
#define PG8_LDB(dst, b, h) do { _Pragma("unroll") for (int n = 0; n < 2; ++n) _Pragma("unroll") for (int k = 0; k < 2; ++k) dst[n][k] = *(const PG8_LAS bf16x8*)(lds + PG8_SB(b, h) + boff + n * 2048 + k * 1024); } while (0)
#define PG8_MMA(ai, bj, At, Bt) do { __builtin_amdgcn_s_setprio(1); _Pragma("unroll") for (int m = 0; m < 4; ++m) _Pragma("unroll") for (int n = 0; n < 2; ++n) _Pragma("unroll") for (int k = 0; k < 2; ++k) \
        acc[ai][bj][m][n] = __builtin_amdgcn_mfma_f32_16x16x32_bf16(Bt[n][k], At[m][k], acc[ai][bj][m][n], 0, 0, 0); __builtin_amdgcn_s_setprio(0); } while (0)
#define PG8_WAIT_V(n) asm volatile("s_waitcnt vmcnt(" #n ")" ::: "memory")
#define PG8_WAIT_L(n) asm volatile("s_waitcnt lgkmcnt(" #n ")" ::: "memory")
#define PG8_BAR __builtin_amdgcn_s_barrier()
#define PG8_SCHED __builtin_amdgcn_sched_barrier(0)
    Unit cur, nxt; int ui = 0;
    if (!S.next(0, cur)) return;
    f32x4 acc[2][2][4][2];
#pragma unroll
    for (int a = 0; a < 2; ++a)
#pragma unroll
        for (int b = 0; b < 2; ++b)
#pragma unroll
            for (int m = 0; m < 4; ++m)
#pragma unroll
                for (int n = 0; n < 2; ++n) acc[a][b][m][n] = (f32x4){0.f, 0.f, 0.f, 0.f};
    bf16x8 At[4][2], B0[2][2], B1[2][2];
    const char* cA = (const char*)g.A + (size_t)cur.pm * tstep + (size_t)cur.ko * 2; const char* cB = (const char*)g.Bt + (size_t)cur.pn * tstep + (size_t)cur.ko * 2;
    S.a_ready(cur);
    if constexpr (SP2) {
        PG8_STAGE(PG8_SB(0, 0), cB, voffB); PG8_STAGE(PG8_SB(0, 1), cB + hstep, voffB); PG8_STAGE(PG8_SA(0, 0), cA, voffA); PG8_STAGE(PG8_SA(0, 1), cA + hstep, voffA);
        if (wr == 1) PG8_BAR;
        PG8_WAIT_V(2); PG8_BAR;
        PG8_STAGE(PG8_SB(1, 0), cB + kstep, voffB); PG8_STAGE(PG8_SA(1, 0), cA + kstep, voffA); PG8_STAGE(PG8_SB(1, 1), cB + hstep + kstep, voffB);
        PG8_WAIT_V(6); PG8_BAR;
    } else {
        PG8_STAGE(PG8_SB(0, 0), cB, voffB); PG8_STAGE(PG8_SA(0, 0), cA, voffA); PG8_STAGE(PG8_SB(0, 1), cB + hstep, voffB); PG8_STAGE(PG8_SA(0, 1), cA + hstep, voffA);
        if (wr == 1) PG8_BAR;
        PG8_WAIT_V(4); PG8_BAR;
        PG8_STAGE(PG8_SB(1, 0), cB + kstep, voffB); PG8_STAGE(PG8_SA(1, 0), cA + kstep, voffA); PG8_STAGE(PG8_SB(1, 1), cB + hstep + kstep, voffB);
        PG8_WAIT_V(6); PG8_BAR;
    }
    for (;;) {
        const bool has_next = S.next(ui + 1, nxt);
        const char* nA = has_next ? (const char*)g.A + (size_t)nxt.pm * tstep + (size_t)nxt.ko * 2 : cA; const char* nB = has_next ? (const char*)g.Bt + (size_t)nxt.pn * tstep + (size_t)nxt.ko * 2 : cB;
        const int nt = cur.nt;
        for (int t = 0; t < nt; t += 2) {
            const bool last = (t == nt - 2);
            const char* a1 = cA + (size_t)(t + 1) * kstep;
            const char* a2 = last ? nA : cA + (size_t)(t + 2) * kstep; const char* b2 = last ? nB : cB + (size_t)(t + 2) * kstep;
            const char* a3 = a2 + kstep; const char* b3 = b2 + kstep;
            if (last && has_next) S.a_ready(nxt);
            if constexpr (SP2) {
            PG8_LDB(B0, 0, 0); PG8_LDB(B1, 0, 1); PG8_SCHED; PG8_LDA(At, 0, 0); PG8_STAGE(PG8_SA(1, 1), a1 + hstep, voffA);
            PG8_WAIT_V(8); PG8_WAIT_L(0); PG8_BAR; PG8_MMA(0, 0, At, B0); PG8_MMA(0, 1, At, B1); PG8_BAR; PG8_SCHED;
            PG8_LDA(At, 0, 1); PG8_STAGE(PG8_SB(0, 0), b2, voffB); PG8_STAGE(PG8_SB(0, 1), b2 + hstep, voffB); PG8_STAGE(PG8_SA(0, 0), a2, voffA);
            PG8_WAIT_V(8); PG8_WAIT_L(0); PG8_BAR; PG8_MMA(1, 0, At, B0); PG8_MMA(1, 1, At, B1); PG8_BAR; PG8_SCHED;
            PG8_LDB(B0, 1, 0); PG8_LDB(B1, 1, 1); PG8_SCHED; PG8_LDA(At, 1, 0); PG8_STAGE(PG8_SA(0, 1), a2 + hstep, voffA);
            PG8_WAIT_V(8); PG8_WAIT_L(0); PG8_BAR; PG8_MMA(0, 0, At, B0); PG8_MMA(0, 1, At, B1); PG8_BAR; PG8_SCHED;
            PG8_LDA(At, 1, 1); PG8_STAGE(PG8_SB(1, 0), b3, voffB); PG8_STAGE(PG8_SB(1, 1), b3 + hstep, voffB); PG8_STAGE(PG8_SA(1, 0), a3, voffA);
            PG8_WAIT_V(8); PG8_WAIT_L(0); PG8_BAR; PG8_MMA(1, 0, At, B0); PG8_MMA(1, 1, At, B1); PG8_BAR; PG8_SCHED;
            } else {
            PG8_LDB(B0, 0, 0); PG8_SCHED; PG8_LDA(At, 0, 0); PG8_STAGE(PG8_SA(1, 1), a1 + hstep, voffA);
            PG8_WAIT_L(8); PG8_BAR; PG8_WAIT_L(0); PG8_MMA(0, 0, At, B0); PG8_BAR; PG8_SCHED;
            PG8_LDB(B1, 0, 1); PG8_STAGE(PG8_SB(0, 0), b2, voffB);
            PG8_BAR; PG8_WAIT_L(0); PG8_MMA(0, 1, At, B1); PG8_BAR;
            PG8_LDA(At, 0, 1); PG8_STAGE(PG8_SA(0, 0), a2, voffA);
            PG8_BAR; PG8_WAIT_L(0); PG8_MMA(1, 0, At, B0); PG8_BAR; PG8_SCHED;
            PG8_STAGE(PG8_SB(0, 1), b2 + hstep, voffB);
            PG8_WAIT_V(6); PG8_BAR; PG8_MMA(1, 1, At, B1); PG8_BAR;
            PG8_LDB(B0, 1, 0); PG8_SCHED; PG8_LDA(At, 1, 0); PG8_STAGE(PG8_SA(0, 1), a2 + hstep, voffA);
            PG8_WAIT_L(8); PG8_BAR; PG8_WAIT_L(0); PG8_MMA(0, 0, At, B0); PG8_BAR; PG8_SCHED;
            PG8_LDB(B1, 1, 1); PG8_STAGE(PG8_SB(1, 0), b3, voffB);
            PG8_BAR; PG8_WAIT_L(0); PG8_MMA(0, 1, At, B1); PG8_BAR;
            PG8_LDA(At, 1, 1); PG8_STAGE(PG8_SA(1, 0), a3, voffA);
            PG8_BAR; PG8_WAIT_L(0); PG8_MMA(1, 0, At, B0); PG8_BAR; PG8_SCHED;
            PG8_STAGE(PG8_SB(1, 1), b3 + hstep, voffB);
            PG8_WAIT_V(6); PG8_BAR; PG8_MMA(1, 1, At, B1); PG8_BAR;
            }
        }
        if constexpr (ALIGN_EPI) { if (wr == 0) PG8_BAR; }
        if constexpr (!Epi::AFTER_DRAIN) { E(acc, cur, wr, wc, fr, fq); S.done(cur); }
        if (!has_next) break;
#pragma unroll
        for (int a = 0; a < 2; ++a)
#pragma unroll
            for (int b = 0; b < 2; ++b)
#pragma unroll
                for (int m = 0; m < 4; ++m)
#pragma unroll
                    for (int n = 0; n < 2; ++n) acc[a][b][m][n] = (f32x4){0.f, 0.f, 0.f, 0.f};
        cur = nxt; cA = nA; cB = nB; ++ui;
        if constexpr (ALIGN_EPI) { if (wr == 1) PG8_BAR; }
    }
    PG8_WAIT_V(0);
    if constexpr (!ALIGN_EPI) { if (wr == 0) PG8_BAR; }
    PG8_BAR;
    if constexpr (Epi::AFTER_DRAIN) { E.fused(acc, cur, wr, wc, fr, fq, lds, wid, lane); S.done(cur); }
#undef PG8_SA
#undef PG8_SB
#undef PG8_STAGE
#undef PG8_LDA
#undef PG8_LDB
#undef PG8_MMA
#undef PG8_WAIT_V
#undef PG8_WAIT_L
#undef PG8_BAR
#undef PG8_SCHED
}
}

#ifndef MK_REP_MASK
#define MK_REP_MASK 0
#endif
#ifndef MK_ONE_LAUNCH
#define MK_ONE_LAUNCH 1
#endif
#define LAS __attribute__((address_space(3)))
typedef unsigned short bf16;
typedef float f32x4 __attribute__((ext_vector_type(4)));
typedef unsigned u32x4 __attribute__((ext_vector_type(4)));
typedef unsigned u32x2 __attribute__((ext_vector_type(2)));
constexpr int D = 1024, NB = 8, SEQ = 2048, NMETA = 16, TP = SEQ + NMETA, DB = 128, DS = 4;
constexpr int NH = 8, DTMP = 1792, DIN = 2816, DFF = 3072;
constexpr int R_SAMPLE = NB * SEQ, R_META = R_SAMPLE + DB * DS, R_END = R_META + NMETA, MP = 17152, M_MAIN = 16896;
constexpr float EPS = 1e-6f, GN_EPS = 64e-5f;
constexpr int NPH = 12;
constexpr int LDS_BYTES = 147456;
enum { I_XP = 0, I_XS, I_STS, I_SWKV, I_SLC, I_SLH, I_SFC, I_META, I_N1G, I_WIN, I_MU, I_W0, I_WUP, I_A0, I_AUP, I_GUP, I_KK, I_KA, I_RK,
       I_GNG, I_GNB, I_LCW, I_LCB, I_LWA, I_LBA, I_LWX, I_LBX, I_LAM, I_LOG, I_WOUT, I_N2G, I_FUP, I_FGATE, I_FCW, I_FCB, I_FDOWN, I_NFG, N_IN };
constexpr size_t O_YP = 0, O_YS = 16777216, O_PSHIFT = 17301504, O_PWKV = 17315840, O_PLC = 17577984, O_PLH = 17590272, O_PFC = 17594368,
                 O_SSHIFT = 17643520, O_SWKV = 17872896, O_SLC = 22067200, O_SLH = 22263808, O_SFC = 22329344, O_END = 23115776;
constexpr size_t MiB = 1u << 20;
constexpr size_t WS_CTL = 0, CTL_ZERO_BYTES = 65536;
constexpr size_t WS_SSQ1 = 1 * MiB, WS_SSQ2 = WS_SSQ1 + (size_t)MP * 16 * 4;
constexpr size_t WS_WUP = 4 * MiB, WS_WGATE = 10 * MiB, WS_WDOWN = 16 * MiB;
constexpr size_t WS_X1B = 22 * MiB, WS_UP = WS_X1B + (size_t)MP * D * 2, WS_HID = WS_UP + (size_t)MP * DFF * 2;
constexpr size_t WS_U = 22 * MiB;
constexpr size_t WS_XN = 115 * MiB, WS_WIN = WS_XN + (size_t)MP * D * 2;
constexpr size_t WS_AP = 190 * MiB, WS_XC = 199 * MiB, WS_BA = 216 * MiB, WS_BB = 217 * MiB, WS_GB = 220 * MiB;
constexpr size_t WS_REC = 115 * MiB, WS_LRU = 182 * MiB, WS_Y = 220 * MiB, WS_MIX = 115 * MiB;
static_assert(WS_SSQ2 + (size_t)MP * 16 * 4 <= WS_WUP, "ssq");
static_assert(WS_HID + (size_t)M_MAIN * DFF * 2 <= 256 * MiB, "hid");
static_assert(WS_U + (size_t)MP * DIN * 2 <= WS_XN, "u");
static_assert(WS_WIN + (size_t)DIN * D * 2 <= WS_LRU, "win");
static_assert(WS_AP + (size_t)MP * 256 * 2 <= WS_XC && WS_XC + (size_t)MP * 512 * 2 <= WS_BA, "ap/xc");
static_assert(WS_GB + (size_t)MP * 1024 * 2 <= 256 * MiB, "gb");
static_assert(WS_REC + (size_t)R_END * 4096 <= WS_LRU && WS_LRU + (size_t)R_END * 2048 <= WS_BA, "rec/lru");
static_assert(WS_Y + (size_t)R_END * 2048 <= 256 * MiB, "y");
constexpr size_t DO_GA = 0, DO_LTOT = (size_t)MP * 1536 * 2, DO_CARRY = DO_LTOT + 513 * 2 * 512 * 4, DO_BON = DO_CARRY + 8 * 64 * 512 * 4, DO_WOUT = O_SFC * 4;
static_assert(DO_BON + (size_t)R_END * 8 * 4 <= O_PSHIFT * 4, "d_out scratch");

struct Args { const float* in[N_IN]; float* out; unsigned char* ws; int ph_lo, ph_hi; };

__device__ __forceinline__ float bf2f(bf16 h) { return __uint_as_float(((unsigned)h) << 16); }
__device__ __forceinline__ unsigned f2bf(float f) { unsigned u = __float_as_uint(f); return (u + 0x7fffu + ((u >> 16) & 1u)) >> 16; }
typedef float f32x2_t __attribute__((ext_vector_type(2))); typedef __bf16 bf16x2_t __attribute__((ext_vector_type(2)));
__device__ __forceinline__ unsigned pk2(float lo, float hi) { const f32x2_t v = {lo, hi}; const bf16x2_t b = __builtin_convertvector(v, bf16x2_t); return __builtin_bit_cast(unsigned, b); }
__device__ __forceinline__ float lo16(unsigned w) { return __uint_as_float(w << 16); }
__device__ __forceinline__ float hi16(unsigned w) { return __uint_as_float(w & 0xffff0000u); }
__device__ __forceinline__ float sigm(float x) { return __builtin_amdgcn_rcpf(1.f + __builtin_amdgcn_exp2f(-1.4426950409f * x)); }
__device__ __forceinline__ float softplus_(float z) { return fmaxf(z, 0.f) + log1pf(__expf(-fabsf(z))); }
__device__ __forceinline__ float gelu_tanh(float x) { const float t = x * (-2.3022082f + -0.10294324f * (x * x)); return x * __builtin_amdgcn_rcpf(1.f + __builtin_amdgcn_exp2f(t)); }
__device__ __forceinline__ float tanh_(float x) { const float e = __builtin_amdgcn_exp2f(2.8853900818f * x); return 1.f - 2.f * __builtin_amdgcn_rcpf(e + 1.f); }
__device__ __forceinline__ float wave_sum(float v) {
#pragma unroll
    for (int o = 1; o < 64; o <<= 1) v += __shfl_xor(v, o);
    return v;
}
template <int CTRL> __device__ __forceinline__ float dpp_f(float x) { return __int_as_float(__builtin_amdgcn_update_dpp(0, __float_as_int(x), CTRL, 0xF, 0xF, true)); }
__device__ __forceinline__ float allsum16(float x) { x += dpp_f<0xB1>(x); x += dpp_f<0x4E>(x); x += dpp_f<0x141>(x); x += dpp_f<0x140>(x); return x; }

struct RowInfo { int kind, b, t; };
__device__ __forceinline__ RowInfo row_info(int row) {
    RowInfo r;
    if (row < R_SAMPLE) { r.kind = 0; r.b = row >> 11; r.t = (row & 2047) + NMETA; }
    else if (row < R_META) { r.kind = 1; r.b = (row - R_SAMPLE) >> 2; r.t = (row - R_SAMPLE) & 3; }
    else if (row < R_END) { r.kind = 2; r.b = 0; r.t = row - R_META; }
    else { r.kind = 3; r.b = 0; r.t = 0; }
    return r;
}
__device__ __forceinline__ int prompt_row(int b, int t) { return t < NMETA ? R_META + t : b * SEQ + t - NMETA; }
__device__ __forceinline__ int row_back(const RowInfo& ri, int row, int j) {
    const int tt = ri.t - j; if (tt < 0) return -1;
    if (ri.kind == 1) return row - j;
    return prompt_row(ri.b, tt);
}
__device__ __forceinline__ void unpack8(const u32x4 w, float (&f)[8]) {
    f[0] = lo16(w.x); f[1] = hi16(w.x); f[2] = lo16(w.y); f[3] = hi16(w.y); f[4] = lo16(w.z); f[5] = hi16(w.z); f[6] = lo16(w.w); f[7] = hi16(w.w);
}
__device__ __forceinline__ void ld8f(const float* p, float (&f)[8]) { const f32x4 a = *(const f32x4*)p, b = *(const f32x4*)(p + 4); f[0] = a.x; f[1] = a.y; f[2] = a.z; f[3] = a.w; f[4] = b.x; f[5] = b.y; f[6] = b.z; f[7] = b.w; }
__device__ __forceinline__ u32x4 pack8(const float (&o)[8]) { u32x4 w; w.x = pk2(o[0], o[1]); w.y = pk2(o[2], o[3]); w.z = pk2(o[4], o[5]); w.w = pk2(o[6], o[7]); return w; }
__device__ __forceinline__ float row_rs(const float* ssq, int row) {
    const f32x4* p = (const f32x4*)(ssq + (size_t)row * 16); const f32x4 a = p[0], b = p[1], c = p[2], d = p[3];
    const float s = ((a.x + a.y) + (a.z + a.w)) + ((b.x + b.y) + (b.z + b.w)) + ((c.x + c.y) + (c.z + c.w)) + ((d.x + d.y) + (d.z + d.w));
    return __builtin_amdgcn_rsqf(s * (1.f / 1024.f) + EPS);
}

#define EPI_ROW(ai, m) (u.pm * 256 + (ai) * 128 + wr * 64 + (m) * 16 + fr)
#define EPI_COL(bj) (u.pn * 256 + (bj) * 128 + wc * 32 + 8 * fq)
struct EpiX1 {
    static constexpr bool PERM = true, AFTER_DRAIN = false;
    const float* __restrict__ xp; const float* __restrict__ xs; const float* __restrict__ meta; float* __restrict__ x1; bf16* __restrict__ x1b; float* __restrict__ ssq;
    __device__ __forceinline__ void operator()(const f32x4 (&acc)[2][2][4][2], const pg8::Unit& u, int wr, int wc, int fr, int fq) const {
#pragma unroll
        for (int ai = 0; ai < 2; ++ai)
#pragma unroll
            for (int m = 0; m < 4; ++m) {
                const int row = EPI_ROW(ai, m);
                const float* res = row < R_SAMPLE ? xp + (size_t)row * D : row < R_META ? xs + (size_t)(row - R_SAMPLE) * D : row < R_END ? meta + (size_t)(row - R_META) * D : nullptr;
                float s = 0.f;
#pragma unroll
                for (int bj = 0; bj < 2; ++bj) {
                    const int col = EPI_COL(bj);
                    f32x4 v0 = acc[ai][bj][m][0], v1 = acc[ai][bj][m][1];
                    if (res) { v0 += *(const f32x4*)(res + col); v1 += *(const f32x4*)(res + col + 4); }
                    if (row < M_MAIN) { *(f32x4*)(x1 + (size_t)row * D + col) = v0; *(f32x4*)(x1 + (size_t)row * D + col + 4) = v1; }
                    u32x4 w; w.x = pk2(v0.x, v0.y); w.y = pk2(v0.z, v0.w); w.z = pk2(v1.x, v1.y); w.w = pk2(v1.z, v1.w);
                    *(u32x4*)(x1b + (size_t)row * D + col) = w;
                    s += (v0.x * v0.x + v0.y * v0.y) + (v0.z * v0.z + v0.w * v0.w) + (v1.x * v1.x + v1.y * v1.y) + (v1.z * v1.z + v1.w * v1.w);
                }
                s += __shfl_xor(s, 16); s += __shfl_xor(s, 32);
                if (fq == 0) ssq[(size_t)row * 16 + u.pn * 4 + wc] = s;
            }
    }
};
struct EpiUp {
    static constexpr bool PERM = true, AFTER_DRAIN = false;
    const float* __restrict__ ssq; bf16* __restrict__ up; float* __restrict__ pffn; float* __restrict__ sffn;
    __device__ __forceinline__ void operator()(const f32x4 (&acc)[2][2][4][2], const pg8::Unit& u, int wr, int wc, int fr, int fq) const {
#pragma unroll
        for (int ai = 0; ai < 2; ++ai)
#pragma unroll
            for (int m = 0; m < 4; ++m) {
                const int row = EPI_ROW(ai, m);
                const float rs = row_rs(ssq, row);
                const RowInfo ri = row_info(row);
                float* st = nullptr;
                if (ri.kind == 0 && ri.t >= TP - 2) st = pffn + ((size_t)ri.b * 2 + (ri.t - (TP - 2))) * DFF;
                else if (ri.kind == 1 && ri.t >= 2) st = sffn + ((size_t)ri.b * 2 + (ri.t - 2)) * DFF;
#pragma unroll
                for (int bj = 0; bj < 2; ++bj) {
                    const int col = EPI_COL(bj);
                    const f32x4 v0 = acc[ai][bj][m][0] * rs, v1 = acc[ai][bj][m][1] * rs;
                    u32x4 w; w.x = pk2(v0.x, v0.y); w.y = pk2(v0.z, v0.w); w.z = pk2(v1.x, v1.y); w.w = pk2(v1.z, v1.w);
                    *(u32x4*)(up + (size_t)row * DFF + col) = w;
                    if (st) { *(f32x4*)(st + col) = v0; *(f32x4*)(st + col + 4) = v1; }
                }
            }
    }
};
struct EpiGate {
    static constexpr bool PERM = true, AFTER_DRAIN = false;
    const float* ssq; const bf16* up; const float* stf; const float* cw; const float* cb; bf16* hid;
    __device__ __forceinline__ void operator()(const f32x4 (&acc)[2][2][4][2], const pg8::Unit& u, int wr, int wc, int fr, int fq) const {
#pragma unroll
        for (int ai = 0; ai < 2; ++ai)
#pragma unroll
            for (int m = 0; m < 4; ++m) {
                const int row = EPI_ROW(ai, m);
                const float rs = row_rs(ssq, row);
                const RowInfo ri = row_info(row);
                const int r1 = row_back(ri, row, 1), r2 = row_back(ri, row, 2);
#pragma unroll
                for (int bj = 0; bj < 2; ++bj) {
                    const int col = EPI_COL(bj);
                    float g[8], u0[8], p1[8], p2[8];
                    { const f32x4 v0 = acc[ai][bj][m][0] * rs, v1 = acc[ai][bj][m][1] * rs; g[0] = v0.x; g[1] = v0.y; g[2] = v0.z; g[3] = v0.w; g[4] = v1.x; g[5] = v1.y; g[6] = v1.z; g[7] = v1.w; }
                    unpack8(*(const u32x4*)(up + (size_t)row * DFF + col), u0);
                    if (r1 >= 0) unpack8(*(const u32x4*)(up + (size_t)r1 * DFF + col), p1);
                    else if (ri.kind == 1) { const float* s = stf + ((size_t)ri.b * 2 + (1 + ri.t)) * DFF + col; const f32x4 a = *(const f32x4*)s, b = *(const f32x4*)(s + 4);
                        p1[0] = a.x; p1[1] = a.y; p1[2] = a.z; p1[3] = a.w; p1[4] = b.x; p1[5] = b.y; p1[6] = b.z; p1[7] = b.w; }
                    else {
#pragma unroll
                        for (int i = 0; i < 8; ++i) p1[i] = 0.f; }
                    if (r2 >= 0) unpack8(*(const u32x4*)(up + (size_t)r2 * DFF + col), p2);
                    else if (ri.kind == 1) { const float* s = stf + ((size_t)ri.b * 2 + ri.t) * DFF + col; const f32x4 a = *(const f32x4*)s, b = *(const f32x4*)(s + 4);
                        p2[0] = a.x; p2[1] = a.y; p2[2] = a.z; p2[3] = a.w; p2[4] = b.x; p2[5] = b.y; p2[6] = b.z; p2[7] = b.w; }
                    else {
#pragma unroll
                        for (int i = 0; i < 8; ++i) p2[i] = 0.f; }
                    float o[8];
#pragma unroll
                    for (int h = 0; h < 2; ++h) {
                        const f32x4 w0 = *(const f32x4*)(cw + col + 4 * h), w1 = *(const f32x4*)(cw + DFF + col + 4 * h), w2 = *(const f32x4*)(cw + 2 * DFF + col + 4 * h), bb = *(const f32x4*)(cb + col + 4 * h);
#pragma unroll
                        for (int i = 0; i < 4; ++i) { const int e = 4 * h + i; const float c = bb[i] + w0[i] * p2[e] + w1[i] * p1[e] + w2[i] * u0[e]; o[e] = gelu_tanh(c) * g[e]; }
                    }
                    u32x4 w; w.x = pk2(o[0], o[1]); w.y = pk2(o[2], o[3]); w.z = pk2(o[4], o[5]); w.w = pk2(o[6], o[7]);
                    *(u32x4*)(hid + (size_t)row * DFF + col) = w;
                }
            }
    }
};
struct EpiDown {
    static constexpr bool PERM = true, AFTER_DRAIN = false;
    float* x;
    __device__ __forceinline__ void operator()(const f32x4 (&acc)[2][2][4][2], const pg8::Unit& u, int wr, int wc, int fr, int fq) const {
        const bool part = u.nt != DFF / 64;
#pragma unroll
        for (int ai = 0; ai < 2; ++ai)
#pragma unroll
            for (int m = 0; m < 4; ++m) {
                const int row = EPI_ROW(ai, m);
#pragma unroll
                for (int bj = 0; bj < 2; ++bj) {
                    const int col = EPI_COL(bj);
                    float* p = x + (size_t)row * D + col;
                    if (part) {
#pragma unroll
                        for (int i = 0; i < 4; ++i) { unsafeAtomicAdd(p + i, acc[ai][bj][m][0][i]); unsafeAtomicAdd(p + 4 + i, acc[ai][bj][m][1][i]); }
                    } else {
                        const f32x4 v0 = acc[ai][bj][m][0] + *(const f32x4*)p, v1 = acc[ai][bj][m][1] + *(const f32x4*)(p + 4);
                        *(f32x4*)p = v0; *(f32x4*)(p + 4) = v1;
                    }
                }
            }
    }
};
struct DownOrder {
    pg8::StaticOrder base; int G, c;
    __device__ void init(int G_, int c_) { base.init(R_SAMPLE, D, G_, c_, DFF); G = G_; c = c_; }
    __device__ bool next(int i, pg8::Unit& u) const {
        const int nb = (256 - c + G - 1) / G;
        if (i < nb) return base.next(i, u);
        const int j = (i - nb) * G + c; if (j >= 48) return false;
        u.pm = 64 + j / 24; u.pn = (j / 6) % 4; u.ko = (j % 6) * 512; u.nt = 8; return true;
    }
    __device__ __forceinline__ void a_ready(const pg8::Unit&) const {}
    __device__ __forceinline__ void done(const pg8::Unit&) const {}
};
struct EpiPlain {
    static constexpr bool PERM = true, AFTER_DRAIN = false;
    bf16* O; int ldc;
    __device__ __forceinline__ void operator()(const f32x4 (&acc)[2][2][4][2], const pg8::Unit& u, int wr, int wc, int fr, int fq) const {
#pragma unroll
        for (int ai = 0; ai < 2; ++ai)
#pragma unroll
            for (int m = 0; m < 4; ++m) {
                const int row = EPI_ROW(ai, m);
#pragma unroll
                for (int bj = 0; bj < 2; ++bj) {
                    const int col = EPI_COL(bj);
                    const f32x4 v0 = acc[ai][bj][m][0], v1 = acc[ai][bj][m][1];
                    u32x4 w; w.x = pk2(v0.x, v0.y); w.y = pk2(v0.z, v0.w); w.z = pk2(v1.x, v1.y); w.w = pk2(v1.z, v1.w);
                    *(u32x4*)(O + (size_t)row * ldc + col) = w;
                }
            }
    }
};

#define XB_TMO      128
#define XB_XCNT(j)  (256  + 64 * (j))
#define XB_XSUB(j)  (1280 + 64 * (j))
#define XB_XGEN(j)  (2304 + 64 * (j))
#define XB_TOP      3328
#define XB_TOPGEN   3392
#define XCD_BAR_WORDS 3456
#define XB_SPIN_CAP (1u << 22)
__device__ __forceinline__ unsigned xb_ld(unsigned* p)              { return __hip_atomic_load(p, __ATOMIC_RELAXED, __HIP_MEMORY_SCOPE_AGENT); }
__device__ __forceinline__ unsigned xb_add(unsigned* p, unsigned v) { return __hip_atomic_fetch_add(p, v, __ATOMIC_RELAXED, __HIP_MEMORY_SCOPE_AGENT); }
__device__ __forceinline__ unsigned xb_xcc_id() { return (unsigned)__builtin_amdgcn_s_getreg((3 << 11) | 20) & 0xFu; }
#define XB_SPIN(cond, bar) do { unsigned _sp = 0; while (cond) { __builtin_amdgcn_s_sleep(1); \
    if ((++_sp & 255u) == 0u) { if (xb_ld(&(bar)[XB_TMO])) break; if (_sp > XB_SPIN_CAP) { atomicAdd(&(bar)[XB_TMO], 1u); break; } } } } while (0)
struct XcdBarrier { unsigned* bar; unsigned x; volatile LAS unsigned* st; };
__device__ __forceinline__ XcdBarrier xcd_barrier_post(unsigned* bar, volatile LAS unsigned* st) {
    XcdBarrier b; b.bar = bar; b.x = xb_xcc_id(); b.st = st;
    if (threadIdx.x == 0) (void)xb_add(&bar[XB_XCNT(b.x)], 1u);
    return b;
}
__device__ __forceinline__ void xcd_barrier_complete(unsigned* bar, unsigned x, unsigned& nloc, unsigned& nx) {
    const unsigned G = gridDim.x * gridDim.y * gridDim.z;
    unsigned sum, cnt, mine, sp = 0u;
    for (;;) {
        sum = 0u; cnt = 0u; mine = 0u;
#pragma unroll
        for (unsigned j = 0; j < 16; ++j) { const unsigned c = xb_ld(&bar[XB_XCNT(j)]); sum += c; cnt += (c > 0u) ? 1u : 0u; mine = (j == x) ? c : mine; }
        if (sum == G) break;
        __builtin_amdgcn_s_sleep(1);
        if ((++sp & 255u) == 0u) { if (xb_ld(&bar[XB_TMO])) break; if (sp > XB_SPIN_CAP) { atomicAdd(&bar[XB_TMO], 1u); break; } }
    }
    nloc = mine > 0u ? mine : 1u; nx = cnt > 0u ? cnt : 1u;
}
__device__ __forceinline__ void xcd_barrier(const XcdBarrier& b) {
    asm volatile("s_waitcnt vmcnt(0)" ::: "memory");
    __syncthreads();
    if (threadIdx.x == 0) {
        unsigned* bar = b.bar;
        __builtin_amdgcn_s_waitcnt(0);
        unsigned nloc = b.st[0], nx = b.st[1];
        if (nloc == 0u) { xcd_barrier_complete(bar, b.x, nloc, nx); b.st[0] = nloc; b.st[1] = nx; }
        const unsigned old = xb_add(&bar[XB_XSUB(b.x)], 1u);
        const unsigned gen = old / nloc;
        if (old + 1u == (gen + 1u) * nloc) {
            __builtin_amdgcn_fence(__ATOMIC_RELEASE, "agent");
            asm volatile("s_waitcnt vmcnt(0)" ::: "memory");
            const unsigned og = xb_add(&bar[XB_TOP], 1u);
            const unsigned tg = og / nx;
            if (og + 1u == (tg + 1u) * nx) xb_add(&bar[XB_TOPGEN], 1u);
            else XB_SPIN(xb_ld(&bar[XB_TOPGEN]) == tg, bar);
            __builtin_amdgcn_fence(__ATOMIC_ACQUIRE, "agent");
            xb_add(&bar[XB_XGEN(b.x)], 1u);
            asm volatile("s_waitcnt vmcnt(0)" ::: "memory");
        } else {
            XB_SPIN(xb_ld(&bar[XB_XGEN(b.x)]) == gen, bar);
            __builtin_amdgcn_fence(__ATOMIC_ACQUIRE, "agent");
            asm volatile("s_waitcnt vmcnt(0)" ::: "memory");
        }
    }
    __syncthreads();
}

__device__ __forceinline__ void p0_transpose_item(const float* W, int K, int N, bf16* WT, const float* ksc, LAS float* scr, int item, int lane) {
    const int nblk = N / 32, kb = item / nblk, nb = item % nblk, k0 = 64 * kb, n0 = 32 * nb;
#pragma unroll
    for (int i = 0; i < 32; ++i) { const int kk = 2 * i + (lane >> 5); float v = W[(size_t)(k0 + kk) * N + n0 + (lane & 31)]; if (ksc) v *= ksc[k0 + kk]; scr[kk * 33 + (lane & 31)] = v; }
    asm volatile("s_waitcnt lgkmcnt(0)" ::: "memory");
    const int c = lane & 7;
#pragma unroll
    for (int j = 0; j < 4; ++j) { const int n = (lane >> 3) + 8 * j; const LAS float* s = scr + (8 * c) * 33 + n;
        u32x4 o; o.x = pk2(s[0 * 33], s[1 * 33]); o.y = pk2(s[2 * 33], s[3 * 33]); o.z = pk2(s[4 * 33], s[5 * 33]); o.w = pk2(s[6 * 33], s[7 * 33]);
        *(u32x4*)(WT + (size_t)(n0 + n) * K + k0 + 8 * c) = o; }
    asm volatile("s_waitcnt lgkmcnt(0)" ::: "memory");
}
__device__ __forceinline__ void phase_p0(const Args& A, LAS unsigned char* lds, int G) {
    const int tid = my_tid(), lane = tid & 63, wave = tid >> 6;
    LAS float* scr = (LAS float*)(lds + wave * 16384);
    const int gw = blockIdx.x * 8 + wave, NGW = G * 8;
    unsigned char* ws = A.ws;
    constexpr int I_IN = 16 * 88, I_OUT = 16 * 32, I_UPI = 16 * 96, I_DN = 48 * 32, NIT = I_IN + I_OUT + 2 * I_UPI + I_DN;
    for (int it = gw; it < NIT; it += NGW) {
        int r = it;
        if (r < I_IN) { p0_transpose_item(A.in[I_WIN], D, DIN, (bf16*)(ws + WS_WIN), nullptr, scr, r, lane); continue; } r -= I_IN;
        if (r < I_OUT) { p0_transpose_item(A.in[I_WOUT], D, D, (bf16*)((unsigned char*)A.out + DO_WOUT), nullptr, scr, r, lane); continue; } r -= I_OUT;
        if (r < I_UPI) { p0_transpose_item(A.in[I_FUP], D, DFF, (bf16*)(ws + WS_WUP), A.in[I_N2G], scr, r, lane); continue; } r -= I_UPI;
        if (r < I_UPI) { p0_transpose_item(A.in[I_FGATE], D, DFF, (bf16*)(ws + WS_WGATE), A.in[I_N2G], scr, r, lane); continue; } r -= I_UPI;
        p0_transpose_item(A.in[I_FDOWN], DFF, D, (bf16*)(ws + WS_WDOWN), nullptr, scr, r, lane);
    }
    const int gt = blockIdx.x * 512 + tid, NGT = G * 512;
    { bf16* BA = (bf16*)(ws + WS_BA); const float* wup = A.in[I_WUP]; const float* aup = A.in[I_AUP]; const float* gup = A.in[I_GUP];
      for (int e = gt; e < 1536 * 256; e += NGT) { const int n = e >> 8, k = e & 255; float v = 0.f;
          if (n < 512) { if (k < 64) v = wup[k * 512 + n]; }
          else if (n < 1024) { if (k >= 64 && k < 128) v = aup[(k - 64) * 512 + n - 512]; }
          else { if (k >= 128) v = gup[(k - 128) * 512 + n - 1024]; }
          BA[e] = (bf16)f2bf(v); } }
    { bf16* BB = (bf16*)(ws + WS_BB); const float* wa = A.in[I_LWA]; const float* wx = A.in[I_LWX];
      for (int e = gt; e < 1024 * 512; e += NGT) { const int n = e >> 9, k = e & 511, nn = n & 511, h = nn >> 6, j = nn & 63; float v = 0.f;
          if ((k >> 6) == h) { const float* Wm = n < 512 ? wa : wx; v = Wm[(h * 64 + (k & 63)) * 64 + j]; }
          BB[e] = (bf16)f2bf(v); } }
    bf16* XN = (bf16*)(ws + WS_XN); const float* g1 = A.in[I_N1G];
    for (int row = gw; row < MP; row += NGW) {
        const float* src = row < R_SAMPLE ? A.in[I_XP] + (size_t)row * D : row < R_META ? A.in[I_XS] + (size_t)(row - R_SAMPLE) * D : row < R_END ? A.in[I_META] + (size_t)(row - R_META) * D : nullptr;
        u32x2* o = (u32x2*)(XN + (size_t)row * D);
        if (!src) {
#pragma unroll
            for (int j = 0; j < 4; ++j) o[lane + 64 * j] = (u32x2){0u, 0u};
            continue; }
        f32x4 v[4]; float s = 0.f;
#pragma unroll
        for (int j = 0; j < 4; ++j) { v[j] = ((const f32x4*)src)[lane + 64 * j]; s += (v[j].x * v[j].x + v[j].y * v[j].y) + (v[j].z * v[j].z + v[j].w * v[j].w); }
        const float rs = __builtin_amdgcn_rsqf(wave_sum(s) * (1.f / D) + EPS);
#pragma unroll
        for (int j = 0; j < 4; ++j) { const f32x4 g = ((const f32x4*)g1)[lane + 64 * j];
            o[lane + 64 * j] = (u32x2){pk2(v[j].x * rs * g.x, v[j].y * rs * g.y), pk2(v[j].z * rs * g.z, v[j].w * rs * g.w)}; }
    }
}

__device__ __forceinline__ void phase_e1(const Args& A, int G) {
    const int tid = my_tid(), lane = tid & 63, wave = tid >> 6;
    const int gw = blockIdx.x * 8 + wave, NGW = G * 8;
    unsigned char* ws = A.ws;
    const bf16* U = (const bf16*)(ws + WS_U); bf16* AP = (bf16*)(ws + WS_AP); bf16* XC = (bf16*)(ws + WS_XC);
    const float* mu = A.in[I_MU]; const float* sts = A.in[I_STS]; const float* slc = A.in[I_SLC]; const float* lcw = A.in[I_LCW]; const float* lcb = A.in[I_LCB];
    for (int row = gw; row < MP; row += NGW) {
        bf16* ap = AP + (size_t)row * 256; bf16* xc = XC + (size_t)row * 512;
        const RowInfo ri = row_info(row);
        if (ri.kind == 3) { ((u32x2*)ap)[lane] = (u32x2){0u, 0u}; ((u32x4*)xc)[lane] = (u32x4){0u, 0u, 0u, 0u}; continue; }
        const bf16* urow = U + (size_t)row * DIN;
        const int r1 = row_back(ri, row, 1);
        {
            const int c0 = 1536 + 4 * lane;
            const u32x2 uw = *(const u32x2*)(urow + c0);
            float u[4] = {lo16(uw.x), hi16(uw.x), lo16(uw.y), hi16(uw.y)}, p[4];
            if (r1 >= 0) { const u32x2 pw = *(const u32x2*)(U + (size_t)r1 * DIN + c0); p[0] = lo16(pw.x); p[1] = hi16(pw.x); p[2] = lo16(pw.y); p[3] = hi16(pw.y); }
            else if (ri.kind == 1) { const f32x4 pv = *(const f32x4*)(sts + (size_t)ri.b * DTMP + c0); p[0] = pv.x; p[1] = pv.y; p[2] = pv.z; p[3] = pv.w; }
            else { p[0] = p[1] = p[2] = p[3] = 0.f; }
            const f32x4 m4 = *(const f32x4*)(mu + c0);
            float o[4];
#pragma unroll
            for (int i = 0; i < 4; ++i) { const float um = u[i] + (p[i] - u[i]) * m4[i]; o[i] = lane < 16 ? tanh_(um) : lane < 32 ? um : sigm(um); }
            ((u32x2*)ap)[lane] = (u32x2){pk2(o[0], o[1]), pk2(o[2], o[3])};
        }
        {
            const int c = 8 * lane;
            float acc[8], cur[8];
            { const f32x4 b0 = *(const f32x4*)(lcb + c), b1 = *(const f32x4*)(lcb + c + 4); acc[0] = b0.x; acc[1] = b0.y; acc[2] = b0.z; acc[3] = b0.w; acc[4] = b1.x; acc[5] = b1.y; acc[6] = b1.z; acc[7] = b1.w; }
#pragma unroll
            for (int j = 0; j < 4; ++j) {
                float val[8];
                const int rj = (j == 3) ? row : row_back(ri, row, 3 - j);
                if (rj >= 0) unpack8(*(const u32x4*)(U + (size_t)rj * DIN + DTMP + c), val);
                else if (ri.kind == 1) { const float* s = slc + ((size_t)ri.b * 3 + (ri.t + j)) * 512 + c; const f32x4 a = *(const f32x4*)s, b = *(const f32x4*)(s + 4);
                    val[0] = a.x; val[1] = a.y; val[2] = a.z; val[3] = a.w; val[4] = b.x; val[5] = b.y; val[6] = b.z; val[7] = b.w; }
                else {
#pragma unroll
                    for (int i = 0; i < 8; ++i) val[i] = 0.f; }
                const f32x4 w0 = *(const f32x4*)(lcw + j * 512 + c), w1 = *(const f32x4*)(lcw + j * 512 + c + 4);
#pragma unroll
                for (int i = 0; i < 4; ++i) { acc[i] += w0[i] * val[i]; acc[4 + i] += w1[i] * val[4 + i]; }
                if (j == 3) {
#pragma unroll
                    for (int i = 0; i < 8; ++i) cur[i] = val[i]; }
            }
            u32x4 w; w.x = pk2(acc[0], acc[1]); w.y = pk2(acc[2], acc[3]); w.z = pk2(acc[4], acc[5]); w.w = pk2(acc[6], acc[7]);
            ((u32x4*)xc)[lane] = w;
            float* lco = nullptr;
            if (ri.kind == 0 && ri.t >= TP - 3) lco = A.out + O_PLC + ((size_t)ri.b * 3 + (ri.t - (TP - 3))) * 512 + c;
            else if (ri.kind == 1 && ri.t >= 1) lco = A.out + O_SLC + ((size_t)ri.b * 3 + (ri.t - 1)) * 512 + c;
            if (lco) { *(f32x4*)lco = (f32x4){cur[0], cur[1], cur[2], cur[3]}; *(f32x4*)(lco + 4) = (f32x4){cur[4], cur[5], cur[6], cur[7]}; }
        }
        float* sho = nullptr;
        if (ri.kind == 0 && ri.t == TP - 1) sho = A.out + O_PSHIFT + (size_t)ri.b * DTMP;
        else if (ri.kind == 1 && ri.t == DS - 1) sho = A.out + O_SSHIFT + (size_t)ri.b * DTMP;
        if (sho) for (int i = lane; i < DTMP; i += 64) sho[i] = bf2f(urow[i]);
    }
}

__device__ __forceinline__ float sum8(float x) { x += dpp_f<0xB1>(x); x += dpp_f<0x4E>(x); x += dpp_f<0x141>(x); return x; }
__device__ __forceinline__ void phase_e2(const Args& A, int G) {
    const int tid = my_tid(), lane = tid & 63, wave = tid >> 6;
    unsigned char* ws = A.ws;
    const bf16* U = (const bf16*)(ws + WS_U); const bf16* GB = (const bf16*)(ws + WS_GB); const bf16* GA = (const bf16*)((unsigned char*)A.out + DO_GA);
    bf16* REC = (bf16*)(ws + WS_REC); bf16* LRU = (bf16*)(ws + WS_LRU);
    float* LTOT = (float*)((unsigned char*)A.out + DO_LTOT); float* BON = (float*)((unsigned char*)A.out + DO_BON);
    const float* mu = A.in[I_MU]; const float* sts = A.in[I_STS]; const float* slc = A.in[I_SLC]; const float* slh = A.in[I_SLH];
    for (int unit = blockIdx.x; unit < 513 + DB; unit += G) {
        int row0, ntok, kind;
        if (unit < 512) { row0 = unit * 32; ntok = 32; kind = 0; } else if (unit == 512) { row0 = R_META; ntok = 16; kind = 2; } else { row0 = R_SAMPLE + (unit - 513) * 4; ntok = 4; kind = 1; }
        const int c = tid;
        const float sp = softplus_(-A.in[I_LAM][c]);
        const float cw0 = A.in[I_LCW][c], cw1 = A.in[I_LCW][512 + c], cw2 = A.in[I_LCW][1024 + c], cw3 = A.in[I_LCW][1536 + c], cbias = A.in[I_LCB][c];
        const float ba_ = A.in[I_LBA][c], bx_ = A.in[I_LBX][c];
        float l1 = 0.f, l2 = 0.f, l3 = 0.f, H = 0.f, P = 1.f;
        if (kind == 0) { const RowInfo ri0 = row_info(row0);
            l1 = bf2f(U[(size_t)row_back(ri0, row0, 1) * DIN + DTMP + c]); l2 = bf2f(U[(size_t)row_back(ri0, row0, 2) * DIN + DTMP + c]); l3 = bf2f(U[(size_t)row_back(ri0, row0, 3) * DIN + DTMP + c]); }
        else if (kind == 1) { const int b = unit - 513; l3 = slc[((size_t)b * 3 + 0) * 512 + c]; l2 = slc[((size_t)b * 3 + 1) * 512 + c]; l1 = slc[((size_t)b * 3 + 2) * 512 + c]; H = slh[(size_t)b * 512 + c]; }
#pragma unroll 4
        for (int j = 0; j < ntok; ++j) {
            const int row = row0 + j;
            const float l0 = bf2f(U[(size_t)row * DIN + DTMP + c]);
            const float xc = cbias + cw0 * l3 + cw1 * l2 + cw2 * l1 + cw3 * l0;
            l3 = l2; l2 = l1; l1 = l0;
            const float ra = bf2f(GB[(size_t)row * 1024 + c]) + ba_, ix = bf2f(GB[(size_t)row * 1024 + 512 + c]) + bx_;
            const float rg = sigm(ra), ig = sigm(ix);
            const float la = -8.f * rg * sp, a = __builtin_amdgcn_exp2f(1.4426950409f * la);
            float mult = __builtin_amdgcn_sqrtf(fmaxf(1.f - __builtin_amdgcn_exp2f(2.8853900818f * la), 0.f)); if (kind == 2 && j == 0) mult = 1.f;
            H = a * H + xc * ig * mult; P = P * a;
            LRU[(size_t)row * 1024 + c] = (bf16)f2bf(H); LRU[(size_t)row * 1024 + 512 + c] = (bf16)f2bf(kind == 1 ? 0.f : P);
        }
        if (kind == 1) A.out[O_SLH + (size_t)(unit - 513) * 512 + c] = H;
        else { LTOT[((size_t)unit * 2 + 0) * 512 + c] = P; LTOT[((size_t)unit * 2 + 1) * 512 + c] = H; }
    }
    {
        const int c = 8 * lane, h = lane >> 3, gw = blockIdx.x * 8 + wave, NGW = G * 8;
        float mr[8], mk[8], w0[8], a0[8], kkw[8], kaw[8], rkw[8];
        ld8f(mu + c, mr); ld8f(mu + 512 + c, mk); ld8f(A.in[I_W0] + c, w0); ld8f(A.in[I_A0] + c, a0); ld8f(A.in[I_KK] + c, kkw); ld8f(A.in[I_KA] + c, kaw); ld8f(A.in[I_RK] + c, rkw);
        for (int row = gw; row < R_END; row += NGW) {
            const RowInfo ri = row_info(row); const int r1 = row_back(ri, row, 1);
            const bf16* ur = U + (size_t)row * DIN;
            float u_r[8], u_k[8], p_r[8], p_k[8], wp[8], ap[8];
            unpack8(*(const u32x4*)(ur + c), u_r); unpack8(*(const u32x4*)(ur + 512 + c), u_k);
            unpack8(*(const u32x4*)(GA + (size_t)row * 1536 + c), wp); unpack8(*(const u32x4*)(GA + (size_t)row * 1536 + 512 + c), ap);
            if (r1 >= 0) { unpack8(*(const u32x4*)(U + (size_t)r1 * DIN + c), p_r); unpack8(*(const u32x4*)(U + (size_t)r1 * DIN + 512 + c), p_k); }
            else if (ri.kind == 1) { ld8f(sts + (size_t)ri.b * DTMP + c, p_r); ld8f(sts + (size_t)ri.b * DTMP + 512 + c, p_k); }
            else {
#pragma unroll
                for (int i = 0; i < 8; ++i) { p_r[i] = 0.f; p_k[i] = 0.f; } }
            float av[8], xv[8], kk[8], kp[8], ss = 0.f, bs = 0.f;
#pragma unroll
            for (int i = 0; i < 8; ++i) {
                const float um_r = u_r[i] + (p_r[i] - u_r[i]) * mr[i], um_k = u_k[i] + (p_k[i] - u_k[i]) * mk[i];
                const float z = -(wp[i] + w0[i]);
                const float w_log = -(fmaxf(z, 0.f) + __logf(1.f + __expf(-fabsf(z)))) - 0.5f;
                const float e = __builtin_amdgcn_exp2f(1.4426950409f * w_log); xv[i] = 1.f - __builtin_amdgcn_exp2f(-1.4426950409f * e);
                av[i] = sigm(ap[i] + a0[i]);
                kk[i] = um_k * kkw[i]; ss += kk[i] * kk[i];
                kp[i] = um_k * (1.f + (av[i] - 1.f) * kaw[i]);
                bs += um_r * kp[i] * rkw[i];
            }
            ss = sum8(ss); bs = sum8(bs);
            const float rn = __builtin_amdgcn_rsqf(fmaxf(ss, 1e-24f));
#pragma unroll
            for (int i = 0; i < 8; ++i) kk[i] *= rn;
            bf16* rec = REC + ((size_t)row * 8 + h) * 256 + (lane & 7) * 8;
            *(u32x4*)rec = pack8(av); *(u32x4*)(rec + 64) = pack8(xv); *(u32x4*)(rec + 128) = pack8(kk); *(u32x4*)(rec + 192) = pack8(kp);
            if ((lane & 7) == 0) BON[(size_t)row * 8 + h] = bs;
        }
    }
}

struct Raw { bf16 a, x, kk, kp, ur, uv, pr, pv; };
__device__ __forceinline__ void m2_load(Raw (&raw)[8], const bf16* REC, const bf16* U, int b, int h, int t0, int ns, int k, int sub) {
#pragma unroll
    for (int i = 0; i < 8; ++i) {
        const int s = sub + 4 * i;
        raw[i].a = 0; raw[i].x = 0; raw[i].kk = 0; raw[i].kp = 0; raw[i].ur = 0; raw[i].uv = 0; raw[i].pr = 0; raw[i].pv = 0;
        if (s < ns) {
            const int t = t0 + s, row = prompt_row(b, t);
            const bf16* rec = REC + ((size_t)row * 8 + h) * 256;
            raw[i].a = rec[k]; raw[i].x = rec[64 + k]; raw[i].kk = rec[128 + k]; raw[i].kp = rec[192 + k];
            const bf16* ur = U + (size_t)row * DIN + h * 64 + k; raw[i].ur = ur[0]; raw[i].uv = ur[1024];
            if (t > 0) { const bf16* pr = U + (size_t)prompt_row(b, t - 1) * DIN + h * 64 + k; raw[i].pr = pr[0]; raw[i].pv = pr[1024]; }
        }
    }
}
__device__ __forceinline__ void m2_store(const Raw (&raw)[8], LAS float* buf, float mu_r, float mu_v, int k, int sub, int ns) {
#pragma unroll
    for (int i = 0; i < 8; ++i) {
        const int s = sub + 4 * i;
        if (s < ns) {
            LAS float* p = buf + s * 384;
            const float a = bf2f(raw[i].a), kk = bf2f(raw[i].kk), ur = bf2f(raw[i].ur), uv = bf2f(raw[i].uv);
            p[k] = kk; p[64 + k] = 1.f - bf2f(raw[i].x); p[128 + k] = -(kk * a); p[192 + k] = bf2f(raw[i].kp);
            p[256 + k] = ur + (bf2f(raw[i].pr) - ur) * mu_r; p[320 + k] = uv + (bf2f(raw[i].pv) - uv) * mu_v;
        }
    }
}
typedef float f32x2 __attribute__((ext_vector_type(2)));
struct StepOps { f32x4 kk, dd, nka, kp, r; float v; };
__device__ __forceinline__ void ops_load(StepOps& o, const LAS float* p, int ks, int vrow) {
    o.kk = *(const LAS f32x4*)(p + 4 * ks); o.dd = *(const LAS f32x4*)(p + 64 + 4 * ks); o.nka = *(const LAS f32x4*)(p + 128 + 4 * ks);
    o.kp = *(const LAS f32x4*)(p + 192 + 4 * ks); o.r = *(const LAS f32x4*)(p + 256 + 4 * ks); o.v = p[320 + vrow];
}
__device__ __forceinline__ float dot4(const f32x4 a, const f32x4 b) { f32x2 t = a.xy * b.xy; t = a.zw * b.zw + t; return t.x + t.y; }
__device__ __forceinline__ void scan_step2(f32x4& S, const StepOps& o, float& yp) {
    float d = dot4(S, o.kk);
    d += dpp_f<0xB1>(d); yp += dpp_f<0xB1>(yp); d += dpp_f<0x4E>(d); yp += dpp_f<0x4E>(yp);
    d += dpp_f<0x141>(d); yp += dpp_f<0x141>(yp); d += dpp_f<0x140>(d); yp += dpp_f<0x140>(yp);
    S = S * o.dd + d * o.nka + o.v * o.kp;
}
__device__ __forceinline__ float scan_step(f32x4& S, const StepOps& o) {
    float d = dot4(S, o.kk); d = allsum16(d);
    S = S * o.dd + d * o.nka + o.v * o.kp;
    float y = dot4(S, o.r); return allsum16(y);
}
__device__ __forceinline__ void phase_m2(const Args& A, LAS unsigned char* lds, int G) {
    const int tid = my_tid(), lane = tid & 63, wave = tid >> 6;
    unsigned char* ws = A.ws;
    const bf16* U = (const bf16*)(ws + WS_U); const bf16* REC = (const bf16*)(ws + WS_REC); float* Y = (float*)(ws + WS_Y);
    const float* LTOT = (const float*)((unsigned char*)A.out + DO_LTOT); float* CARRY = (float*)((unsigned char*)A.out + DO_CARRY);
    const float* mu = A.in[I_MU];
    for (int b = blockIdx.x; b < NB; b += G) {
        const int c = tid; float carry = LTOT[((size_t)512 * 2 + 1) * 512 + c];
        float Pv[64], Hv[64];
#pragma unroll
        for (int i = 0; i < 64; ++i) { const int un = b * 64 + i; Pv[i] = LTOT[((size_t)un * 2 + 0) * 512 + c]; Hv[i] = LTOT[((size_t)un * 2 + 1) * 512 + c]; }
#pragma unroll
        for (int i = 0; i < 64; ++i) { CARRY[((size_t)b * 64 + i) * 512 + c] = carry; carry = Pv[i] * carry + Hv[i]; }
        A.out[O_PLH + (size_t)b * 512 + c] = carry;
    }
    const int ks = lane & 15, rl = lane >> 4;
    for (int item = blockIdx.x; item < 256; item += G) {
        const int bh = item >> 2, q = item & 3, b = bh >> 3, h = bh & 7;
        const int k = tid & 63, sub = (tid >> 6) & 3;
        const float mu_r = mu[h * 64 + k], mu_v = mu[1024 + h * 64 + k];
        const int wv = wave & 3, vrow = 16 * q + 4 * wv + rl;
        f32x4 S = (f32x4){0.f, 0.f, 0.f, 0.f};
        Raw raw[8];
        LAS float* buf0 = (LAS float*)lds; LAS float* buf1 = (LAS float*)(lds + 50688); LAS float* ybuf = (LAS float*)(lds + 101376) + wv * 132;
        __syncthreads();
        if (wave >= 4) { m2_load(raw, REC, U, b, h, 0, 16, k, sub); m2_store(raw, buf0, mu_r, mu_v, k, sub, 16); m2_load(raw, REC, U, b, h, 16, 32, k, sub); }
        __syncthreads();
        for (int blk = 0; blk < 65; ++blk) {
            const int t0 = blk == 0 ? 0 : 16 + 32 * (blk - 1), ns = blk == 0 ? 16 : 32;
            if (wave >= 4) {
                if (blk + 1 < 65) m2_store(raw, (blk & 1) ? buf0 : buf1, mu_r, mu_v, k, sub, 32);
                if (blk + 2 < 65) m2_load(raw, REC, U, b, h, 16 + 32 * (blk + 1), 32, k, sub);
            } else {
                const LAS float* buf = (blk & 1) ? buf1 : buf0;
                StepOps oa, ob; ops_load(oa, buf, ks, vrow);
                float yp = 0.f;
                for (int s = 0; s < ns; s += 2) {
                    ops_load(ob, buf + (s + 1) * 384, ks, vrow);
                    scan_step2(S, oa, yp); ybuf[s * 4 + rl] = yp; yp = dot4(S, oa.r);
                    ops_load(oa, buf + (s + 2) * 384, ks, vrow);
                    scan_step2(S, ob, yp); ybuf[(s + 1) * 4 + rl] = yp; yp = dot4(S, ob.r);
                }
                yp = allsum16(yp); ybuf[ns * 4 + rl] = yp;
                if (ks < ns) Y[(size_t)prompt_row(b, t0 + ks) * 512 + h * 64 + vrow] = ybuf[(ks + 1) * 4 + rl];
                if (ks + 16 < ns) Y[(size_t)prompt_row(b, t0 + ks + 16) * 512 + h * 64 + vrow] = ybuf[(ks + 17) * 4 + rl];
            }
            __syncthreads();
        }
        if (wave < 4) *(f32x4*)(A.out + O_PWKV + ((size_t)(b * 8 + h) * 64 + vrow) * 64 + 4 * ks) = S;
    }
    const float* swkv = A.in[I_SWKV]; const float* sts = A.in[I_STS];
#pragma unroll 2
    for (int task = blockIdx.x * 8 + wave; task < DB * NH * 16; task += G * 8) {
        const int bh = task >> 4, rg = task & 15, b = bh >> 3, h = bh & 7, v = 4 * rg + rl;
        f32x4 S = *(const f32x4*)(swkv + ((size_t)bh * 64 + v) * 64 + 4 * ks);
        const f32x4 mr4 = *(const f32x4*)(mu + h * 64 + 4 * ks); const float mv = mu[1024 + h * 64 + v];
        StepOps o[DS];
#pragma unroll
        for (int t = 0; t < DS; ++t) {
            const int row = R_SAMPLE + 4 * b + t;
            const bf16* rec = REC + ((size_t)row * 8 + h) * 256 + 4 * ks;
            const u32x2 wa = *(const u32x2*)rec, wx = *(const u32x2*)(rec + 64), wk = *(const u32x2*)(rec + 128), wp = *(const u32x2*)(rec + 192);
            const f32x4 a4 = (f32x4){lo16(wa.x), hi16(wa.x), lo16(wa.y), hi16(wa.y)};
            o[t].dd = 1.f - (f32x4){lo16(wx.x), hi16(wx.x), lo16(wx.y), hi16(wx.y)};
            o[t].kk = (f32x4){lo16(wk.x), hi16(wk.x), lo16(wk.y), hi16(wk.y)}; o[t].kp = (f32x4){lo16(wp.x), hi16(wp.x), lo16(wp.y), hi16(wp.y)};
            const u32x2 wr_ = *(const u32x2*)(U + (size_t)row * DIN + h * 64 + 4 * ks);
            const f32x4 ur4 = (f32x4){lo16(wr_.x), hi16(wr_.x), lo16(wr_.y), hi16(wr_.y)};
            const float uv = bf2f(U[(size_t)row * DIN + 1024 + h * 64 + v]);
            f32x4 pr4; float pv;
            if (t > 0) { const u32x2 w = *(const u32x2*)(U + (size_t)(row - 1) * DIN + h * 64 + 4 * ks); pr4 = (f32x4){lo16(w.x), hi16(w.x), lo16(w.y), hi16(w.y)}; pv = bf2f(U[(size_t)(row - 1) * DIN + 1024 + h * 64 + v]); }
            else { pr4 = *(const f32x4*)(sts + (size_t)b * DTMP + h * 64 + 4 * ks); pv = sts[(size_t)b * DTMP + 1024 + h * 64 + v]; }
            o[t].r = ur4 + (pr4 - ur4) * mr4; o[t].v = uv + (pv - uv) * mv; o[t].nka = -(o[t].kk * a4);
        }
#pragma unroll
        for (int t = 0; t < DS; ++t) { const float y = scan_step(S, o[t]); if (ks == 0) Y[(size_t)(R_SAMPLE + 4 * b + t) * 512 + h * 64 + v] = y; }
        *(f32x4*)(A.out + O_SWKV + ((size_t)bh * 64 + v) * 64 + 4 * ks) = S;
    }
}

__device__ __forceinline__ void phase_m3(const Args& A, int G) {
    const int tid = my_tid(), lane = tid & 63, wave = tid >> 6;
    const int gw = blockIdx.x * 8 + wave, NGW = G * 8;
    unsigned char* ws = A.ws;
    const bf16* U = (const bf16*)(ws + WS_U); const bf16* GA = (const bf16*)((unsigned char*)A.out + DO_GA); const bf16* LRU = (const bf16*)(ws + WS_LRU);
    const float* Y = (const float*)(ws + WS_Y); const float* CARRY = (const float*)((unsigned char*)A.out + DO_CARRY); const float* BON = (const float*)((unsigned char*)A.out + DO_BON);
    bf16* MIX = (bf16*)(ws + WS_MIX);
    const float* sts = A.in[I_STS];
    const int c = 8 * lane, h = lane >> 3;
    float mv[8], gg[8], gb[8], og[8];
    ld8f(A.in[I_MU] + 1024 + c, mv); ld8f(A.in[I_GNG] + c, gg); ld8f(A.in[I_GNB] + c, gb); ld8f(A.in[I_LOG] + c, og);
    for (int row = gw; row < MP; row += NGW) {
        bf16* mo = MIX + (size_t)row * D;
        const RowInfo ri = row_info(row);
        if (ri.kind == 3) { ((u32x4*)mo)[lane] = (u32x4){0u, 0u, 0u, 0u}; ((u32x4*)mo)[64 + lane] = (u32x4){0u, 0u, 0u, 0u}; continue; }
        const int r1 = row_back(ri, row, 1);
        float y[8], uv[8], pv[8], g[8], hv[8], pp[8], gt[8], cr[8];
        ld8f(Y + (size_t)row * 512 + c, y);
        unpack8(*(const u32x4*)(U + (size_t)row * DIN + 1024 + c), uv);
        unpack8(*(const u32x4*)(GA + (size_t)row * 1536 + 1024 + c), g);
        unpack8(*(const u32x4*)(LRU + (size_t)row * 1024 + c), hv); unpack8(*(const u32x4*)(LRU + (size_t)row * 1024 + 512 + c), pp);
        unpack8(*(const u32x4*)(U + (size_t)row * DIN + DTMP + 512 + c), gt);
        const float bon = BON[(size_t)row * 8 + h];
        if (r1 >= 0) unpack8(*(const u32x4*)(U + (size_t)r1 * DIN + 1024 + c), pv);
        else if (ri.kind == 1) ld8f(sts + (size_t)ri.b * DTMP + 1024 + c, pv);
        else {
#pragma unroll
            for (int i = 0; i < 8; ++i) pv[i] = 0.f; }
        if (ri.kind == 0) ld8f(CARRY + ((size_t)ri.b * 64 + ((row & 2047) >> 5)) * 512 + c, cr);
        else {
#pragma unroll
            for (int i = 0; i < 8; ++i) cr[i] = 0.f; }
        float s = 0.f;
#pragma unroll
        for (int i = 0; i < 8; ++i) s += y[i];
        const float mean = sum8(s) * (1.f / 64.f);
        float q = 0.f;
#pragma unroll
        for (int i = 0; i < 8; ++i) { y[i] -= mean; q += y[i] * y[i]; }
        const float rstd = __builtin_amdgcn_rsqf(sum8(q) * (1.f / 64.f) + GN_EPS);
        float o[8];
#pragma unroll
        for (int i = 0; i < 8; ++i) { const float vv = uv[i] + (pv[i] - uv[i]) * mv[i]; o[i] = (y[i] * rstd * gg[i] + gb[i] + bon * vv) * g[i]; }
        *(u32x4*)(mo + c) = pack8(o);
        float z[8], s2 = 0.f;
#pragma unroll
        for (int i = 0; i < 8; ++i) { z[i] = (hv[i] + pp[i] * cr[i]) * gelu_tanh(gt[i]); s2 += z[i] * z[i]; }
        const float rs = __builtin_amdgcn_rsqf(wave_sum(s2) * (1.f / 512.f) + EPS);
#pragma unroll
        for (int i = 0; i < 8; ++i) o[i] = z[i] * rs * og[i];
        *(u32x4*)(mo + 512 + c) = pack8(o);
    }
}

__device__ __forceinline__ void phase_final(const Args& A, int G) {
    const int tid = my_tid(), lane = tid & 63, wave = tid >> 6;
    const int gw = blockIdx.x * 8 + wave, NGW = G * 8;
    const float* gf = A.in[I_NFG];
    f32x4 g[4];
#pragma unroll
    for (int j = 0; j < 4; ++j) g[j] = ((const f32x4*)gf)[lane + 64 * j];
    for (int row = gw; row < M_MAIN; row += NGW) {
        f32x4* p = (f32x4*)(A.out + (size_t)row * D);
        f32x4 v[4]; float s = 0.f;
#pragma unroll
        for (int j = 0; j < 4; ++j) { v[j] = p[lane + 64 * j]; s += (v[j].x * v[j].x + v[j].y * v[j].y) + (v[j].z * v[j].z + v[j].w * v[j].w); }
        const float rs = __builtin_amdgcn_rsqf(wave_sum(s) * (1.f / D) + EPS);
#pragma unroll
        for (int j = 0; j < 4; ++j) p[lane + 64 * j] = v[j] * rs * g[j];
    }
}

namespace cg = cooperative_groups;
__global__ void __launch_bounds__(512, 2) mk_fwd(Args args) {
    extern __shared__ __attribute__((aligned(16))) unsigned char lds_raw[];
    LAS unsigned char* lds = (LAS unsigned char*)lds_raw;
    const int G = gridDim.x, tid = threadIdx.x;
    volatile LAS unsigned* MISC = (volatile LAS unsigned*)(lds + 131072 + 320);
    if (tid < 64) ((LAS unsigned*)(lds + 131072))[tid + 64] = 0u, ((LAS unsigned*)(lds + 131072))[tid] = 0u;
    __syncthreads();
    const int lo = args.ph_lo, hi = args.ph_hi;
    XcdBarrier bar; bar.bar = (unsigned*)(args.ws + WS_CTL) + 4096; bar.x = 0; bar.st = nullptr;
    if (hi - lo > 1) bar = xcd_barrier_post((unsigned*)(args.ws + WS_CTL) + 4096, MISC + 8);
    if (lo < 0) cg::this_grid().sync();
#define IN(k) (lo <= (k) && (k) < hi)
#define SEAM(k) do { if (IN(k) && IN((k) + 1)) xcd_barrier(bar); } while (0)
    unsigned char* ws = args.ws; unsigned char* ob = (unsigned char*)args.out;
    if (IN(0)) { phase_p0(args, lds, G); } SEAM(0);
    if (IN(1)) { pg8::Gemm g{(const bf16*)(ws + WS_XN), (const bf16*)(ws + WS_WIN), MP, DIN, D}; pg8::StaticOrder S; S.init(MP, DIN, G, (int)blockIdx.x, D);
        EpiPlain E{(bf16*)(ws + WS_U), DIN}; pg8::gemm_phase<EpiPlain, pg8::StaticOrder, true, true>(lds, g, S, E); } SEAM(1);
    if (IN(2)) { phase_e1(args, G); } SEAM(2);
    if (IN(3)) {
        { pg8::Gemm g{(const bf16*)(ws + WS_AP), (const bf16*)(ws + WS_BA), MP, 1536, 256}; pg8::StaticOrder S; S.init(MP, 1536, G, (int)blockIdx.x, 256);
          EpiPlain E{(bf16*)(ob + DO_GA), 1536}; pg8::gemm_phase<EpiPlain, pg8::StaticOrder, true, true>(lds, g, S, E); }
        { pg8::Gemm g{(const bf16*)(ws + WS_XC), (const bf16*)(ws + WS_BB), MP, 1024, 512}; pg8::StaticOrder S; S.init(MP, 1024, G, (int)blockIdx.x, 512);
          EpiPlain E{(bf16*)(ws + WS_GB), 1024}; pg8::gemm_phase<EpiPlain, pg8::StaticOrder, true, true>(lds, g, S, E); }
    } SEAM(3);
    if (IN(4)) { phase_e2(args, G); } SEAM(4);
    if (IN(5)) { phase_m2(args, lds, G); } SEAM(5);
    if (IN(6)) { phase_m3(args, G); } SEAM(6);
    if (IN(7)) { pg8::Gemm g{(const bf16*)(ws + WS_MIX), (const bf16*)(ob + DO_WOUT), MP, D, D}; pg8::StaticOrder S; S.init(MP, D, G, (int)blockIdx.x, D);
        EpiX1 E{args.in[I_XP], args.in[I_XS], args.in[I_META], args.out, (bf16*)(ws + WS_X1B), (float*)(ws + WS_SSQ1)};
        pg8::gemm_phase<EpiX1, pg8::StaticOrder, true, true>(lds, g, S, E); } SEAM(7);
    if (IN(8)) { pg8::Gemm g{(const bf16*)(ws + WS_X1B), (const bf16*)(ws + WS_WUP), MP, DFF, D}; pg8::StaticOrder S; S.init(MP, DFF, G, (int)blockIdx.x, D);
        EpiUp E{(const float*)(ws + WS_SSQ1), (bf16*)(ws + WS_UP), args.out + O_PFC, args.out + O_SFC};
        pg8::gemm_phase<EpiUp, pg8::StaticOrder, true, true>(lds, g, S, E); } SEAM(8);
    if (IN(9)) { pg8::Gemm g{(const bf16*)(ws + WS_X1B), (const bf16*)(ws + WS_WGATE), M_MAIN, DFF, D}; pg8::StaticOrder S; S.init(M_MAIN, DFF, G, (int)blockIdx.x, D);
        EpiGate E{(const float*)(ws + WS_SSQ1), (const bf16*)(ws + WS_UP), args.in[I_SFC], args.in[I_FCW], args.in[I_FCB], (bf16*)(ws + WS_HID)};
        pg8::gemm_phase<EpiGate, pg8::StaticOrder, true, true>(lds, g, S, E); } SEAM(9);
    if (IN(10)) { pg8::Gemm g{(const bf16*)(ws + WS_HID), (const bf16*)(ws + WS_WDOWN), M_MAIN, D, DFF}; DownOrder S; S.init(G, (int)blockIdx.x);
        EpiDown E{args.out};
        pg8::gemm_phase<EpiDown, DownOrder, true, true>(lds, g, S, E); } SEAM(10);
    if (IN(11)) { phase_final(args, G); }
#undef IN
#undef SEAM
}

extern "C" void kernel_launch(void* const* d_in, const int* in_sizes, int n_in, void* d_out, int out_size, void* d_ws, size_t ws_size, hipStream_t stream) {
    static int grid = 0;
    if (grid == 0) {
        if (n_in != N_IN || (size_t)out_size != O_END || ws_size < 256 * MiB) { fprintf(stderr, "kernel_launch: unexpected shapes n_in %d out %d ws %zu\n", n_in, out_size, ws_size); grid = -1; return; }
        int dev = 0, cus = 0, per_cu = 0;
        (void)hipGetDevice(&dev); (void)hipDeviceGetAttribute(&cus, hipDeviceAttributeMultiprocessorCount, dev);
        if (hipFuncSetAttribute((const void*)mk_fwd, hipFuncAttributeMaxDynamicSharedMemorySize, LDS_BYTES) != hipSuccess) { fprintf(stderr, "kernel_launch: hipFuncSetAttribute failed\n"); grid = -1; return; }
        if (hipOccupancyMaxActiveBlocksPerMultiprocessor(&per_cu, (const void*)mk_fwd, 512, LDS_BYTES) != hipSuccess || per_cu < 1) per_cu = 1;
        (void)hipGetLastError();
        grid = cus > 0 ? cus : 256;
    }
    if (grid < 0) return;
    Args a{};
    for (int i = 0; i < N_IN; ++i) a.in[i] = (const float*)d_in[i];
    a.out = (float*)d_out; a.ws = (unsigned char*)d_ws;
#if MK_ONE_LAUNCH
    (void)hipMemsetAsync((char*)d_ws + WS_CTL, 0, CTL_ZERO_BYTES, stream);
    a.ph_lo = 0; a.ph_hi = NPH;
    void* kargs[] = {&a};
    hipError_t e = hipLaunchCooperativeKernel((const void*)mk_fwd, dim3(grid), dim3(512), kargs, LDS_BYTES, stream);
    if (e != hipSuccess) fprintf(stderr, "cooperative launch failed: %s (grid %d)\n", hipGetErrorString(e), grid);
#else
    for (int ph = 0; ph < NPH; ++ph) for (int rep = 0; rep < 1 + ((MK_REP_MASK >> ph) & 1); ++rep) { a.ph_lo = ph; a.ph_hi = ph + 1; hipLaunchKernelGGL(mk_fwd, dim3(grid), dim3(512), LDS_BYTES, stream, a); }
#endif
}
```

```cpp
#include <hip/hip_runtime.h>
#include <hip/hip_cooperative_groups.h>
#include <cstdio>
#include <cstdint>
#include <cmath>
__device__ __forceinline__ int my_tid() { int t = threadIdx.x; asm volatile("" : "+v"(t)); return t; }
namespace pg8 {
#define PG8_LAS __attribute__((address_space(3)))
typedef unsigned short bf16_t;
typedef short bf16x8 __attribute__((ext_vector_type(8)));
typedef float f32x4 __attribute__((ext_vector_type(4)));
typedef unsigned u32x4 __attribute__((ext_vector_type(4)));
constexpr int BM = 256, BK = 64, HALF = 128, HTB = HALF * BK * 2  , STAGE_BYTES = 8 * HTB, NXCD = 8, WGM = 8;

__host__ __device__ __forceinline__ int lds_byte(int r, int c) { const int st = (r >> 4) * 2 + (c >> 5), rr = r & 15, cc = c & 31, ob = rr * 64 + cc * 2; return st * 1024 + (ob ^ (((ob >> 9) & 1) << 5)); }
__host__ __device__ __forceinline__ void stage_rc(int b, int& R, int& C) { const int st = b / 1024, sb = b % 1024, swz = sb ^ (((sb >> 9) & 1) << 5); R = (st >> 1) * 16 + swz / 64; C = (st & 1) * 32 + (swz % 64) / 2; }
__host__ __device__ __forceinline__ int perm32(int rho) { const int n = rho >> 4, i = rho & 15; return 8 * (i >> 2) + 4 * n + (i & 3); }

struct Unit { int pm, pn, ko, nt; };
struct Gemm { const bf16_t* A; const bf16_t* Bt; int M, N, K; };

struct StaticOrder {
    int nM, nN, nwg, G, c, ntk;
    __host__ __device__ void init(int M, int N, int G_, int c_, int K_) { nM = M / BM; nN = N / BM; nwg = nM * nN; G = G_; c = c_; ntk = K_ / BK; }
    __host__ __device__ bool next(int i, Unit& u) const {
        const long L = (long)i * G + c; if (L >= nwg) return false;
        int wgid = (int)L; { const int q = nwg / NXCD, r = nwg % NXCD, xcd = wgid % NXCD, off = wgid / NXCD; wgid = (xcd < r ? xcd * (q + 1) : r * (q + 1) + (xcd - r) * q) + off; }
        const int nig = WGM * nN, gid = wgid / nig, fm = gid * WGM, gsz = (nM - fm) < WGM ? (nM - fm) : WGM;
        u.pm = fm + ((wgid % nig) % gsz); u.pn = (wgid % nig) / gsz; u.ko = 0; u.nt = ntk; return true;
    }
    __device__ __forceinline__ void a_ready(const Unit&) const {}
    __device__ __forceinline__ void done(const Unit&) const {}
};

__device__ __forceinline__ unsigned cvt_pk_bf16(float lo, float hi) { unsigned r; asm volatile("v_cvt_pk_bf16_f32 %0, %1, %2" : "=v"(r) : "v"(lo), "v"(hi)); return r; }
typedef float f32x2 __attribute__((ext_vector_type(2)));
template <class Epi, class Sched, bool ALIGN_EPI = false, bool SP2 = false>
__device__ __forceinline__ void gemm_phase(PG8_LAS unsigned char* lds, const Gemm g, const Sched& S, const Epi& E) {
    const int tid = my_tid(), wid = __builtin_amdgcn_readfirstlane(tid >> 6), lane = tid & 63, wr = wid >> 2, wc = wid & 3, fr = lane & 15, fq = lane >> 4;
    const int K = g.K;
    unsigned voffA[2], voffB[2];
#pragma unroll
    for (int i = 0; i < 2; ++i) { int R, C; stage_rc(tid * 16 + i * 8192, R, C); const int Rb = Epi::PERM ? ((R & ~31) + perm32(R & 31)) : R;
        voffA[i] = (unsigned)(R * K + C) * 2u; voffB[i] = (unsigned)(Rb * K + C) * 2u; }
    const size_t kstep = (size_t)(BK * 2);
    const size_t hstep = (size_t)HALF * K * 2;
    const size_t tstep = 2 * hstep;
    const unsigned ldsw = (unsigned)wid * 1024u;
    const int aoff = lds_byte(wr * 64 + fr, fq * 8), boff = lds_byte(wc * 32 + fr, fq * 8);
#define PG8_SA(b, h) (((b) * 2 + (h)) * HTB)
#define PG8_SB(b, h) ((4 + (b) * 2 + (h)) * HTB)
#define PG8_STAGE(bufoff, gbase, voff) do { _Pragma("unroll") for (int _i = 0; _i < 2; ++_i) \
        __builtin_amdgcn_global_load_lds((const unsigned*)((const char*)(gbase) + (voff)[_i]), (PG8_LAS unsigned*)(lds + (bufoff) + ldsw + _i * 8192), 16, 0, 0); } while (0)
#define PG8_LDA(dst, b, h) do { _Pragma("unroll") for (int m = 0; m < 4; ++m) _Pragma("unroll") for (int k = 0; k < 2; ++k) dst[m][k] = *(const PG8_LAS bf16x8*)(lds + PG8_SA(b, h) + aoff + m * 2048 + k * 1024); } while (0)
#define PG8_LDB(dst, b, h) do { _Pragma("unroll") for (int n = 0; n < 2; ++n) _Pragma("unroll") for (int k = 0; k < 2; ++k) dst[n][k] = *(const PG8_LAS bf16x8*)(lds + PG8_SB(b, h) + boff + n * 2048 + k * 1024); } while (0)
#define PG8_MMA(ai, bj, At, Bt) do { __builtin_amdgcn_s_setprio(1); _Pragma("unroll") for (int m = 0; m < 4; ++m) _Pragma("unroll") for (int n = 0; n < 2; ++n) _Pragma("unroll") for (int k = 0; k < 2; ++k) \
        acc[ai][bj][m][n] = __builtin_amdgcn_mfma_f32_16x16x32_bf16(Bt[n][k], At[m][k], acc[ai][bj][m][n], 0, 0, 0); __builtin_amdgcn_s_setprio(0); } while (0)
#define PG8_WAIT_V(n) asm volatile("s_waitcnt vmcnt(" #n ")" ::: "memory")
#define PG8_WAIT_L(n) asm volatile("s_waitcnt lgkmcnt(" #n ")" ::: "memory")
#define PG8_BAR __builtin_amdgcn_s_barrier()
#define PG8_SCHED __builtin_amdgcn_sched_barrier(0)
    Unit cur, nxt; int ui = 0;
    if (!S.next(0, cur)) return;
    f32x4 acc[2][2][4][2];
#pragma unroll
    for (int a = 0; a < 2; ++a)
#pragma unroll
        for (int b = 0; b < 2; ++b)
#pragma unroll
            for (int m = 0; m < 4; ++m)
#pragma unroll
                for (int n = 0; n < 2; ++n) acc[a][b][m][n] = (f32x4){0.f, 0.f, 0.f, 0.f};
    bf16x8 At[4][2], B0[2][2], B1[2][2];
    const char* cA = (const char*)g.A + (size_t)cur.pm * tstep + (size_t)cur.ko * 2; const char* cB = (const char*)g.Bt + (size_t)cur.pn * tstep + (size_t)cur.ko * 2;
    S.a_ready(cur);
    if constexpr (SP2) {
        PG8_STAGE(PG8_SB(0, 0), cB, voffB); PG8_STAGE(PG8_SB(0, 1), cB + hstep, voffB); PG8_STAGE(PG8_SA(0, 0), cA, voffA); PG8_STAGE(PG8_SA(0, 1), cA + hstep, voffA);
        if (wr == 1) PG8_BAR;
        PG8_WAIT_V(2); PG8_BAR;
        PG8_STAGE(PG8_SB(1, 0), cB + kstep, voffB); PG8_STAGE(PG8_SA(1, 0), cA + kstep, voffA); PG8_STAGE(PG8_SB(1, 1), cB + hstep + kstep, voffB);
        PG8_WAIT_V(6); PG8_BAR;
    } else {
        PG8_STAGE(PG8_SB(0, 0), cB, voffB); PG8_STAGE(PG8_SA(0, 0), cA, voffA); PG8_STAGE(PG8_SB(0, 1), cB + hstep, voffB); PG8_STAGE(PG8_SA(0, 1), cA + hstep, voffA);
        if (wr == 1) PG8_BAR;
        PG8_WAIT_V(4); PG8_BAR;
        PG8_STAGE(PG8_SB(1, 0), cB + kstep, voffB); PG8_STAGE(PG8_SA(1, 0), cA + kstep, voffA); PG8_STAGE(PG8_SB(1, 1), cB + hstep + kstep, voffB);
        PG8_WAIT_V(6); PG8_BAR;
    }
    for (;;) {
        const bool has_next = S.next(ui + 1, nxt);
        const char* nA = has_next ? (const char*)g.A + (size_t)nxt.pm * tstep + (size_t)nxt.ko * 2 : cA; const char* nB = has_next ? (const char*)g.Bt + (size_t)nxt.pn * tstep + (size_t)nxt.ko * 2 : cB;
        const int nt = cur.nt;
        for (int t = 0; t < nt; t += 2) {
            const bool last = (t == nt - 2);
            const char* a1 = cA + (size_t)(t + 1) * kstep;
            const char* a2 = last ? nA : cA + (size_t)(t + 2) * kstep; const char* b2 = last ? nB : cB + (size_t)(t + 2) * kstep;
            const char* a3 = a2 + kstep; const char* b3 = b2 + kstep;
            if (last && has_next) S.a_ready(nxt);
            if constexpr (SP2) {
            PG8_LDB(B0, 0, 0); PG8_LDB(B1, 0, 1); PG8_SCHED; PG8_LDA(At, 0, 0); PG8_STAGE(PG8_SA(1, 1), a1 + hstep, voffA);
            PG8_WAIT_V(8); PG8_WAIT_L(0); PG8_BAR; PG8_MMA(0, 0, At, B0); PG8_MMA(0, 1, At, B1); PG8_BAR; PG8_SCHED;
            PG8_LDA(At, 0, 1); PG8_STAGE(PG8_SB(0, 0), b2, voffB); PG8_STAGE(PG8_SB(0, 1), b2 + hstep, voffB); PG8_STAGE(PG8_SA(0, 0), a2, voffA);
            PG8_WAIT_V(8); PG8_WAIT_L(0); PG8_BAR; PG8_MMA(1, 0, At, B0); PG8_MMA(1, 1, At, B1); PG8_BAR; PG8_SCHED;
            PG8_LDB(B0, 1, 0); PG8_LDB(B1, 1, 1); PG8_SCHED; PG8_LDA(At, 1, 0); PG8_STAGE(PG8_SA(0, 1), a2 + hstep, voffA);
            PG8_WAIT_V(8); PG8_WAIT_L(0); PG8_BAR; PG8_MMA(0, 0, At, B0); PG8_MMA(0, 1, At, B1); PG8_BAR; PG8_SCHED;
            PG8_LDA(At, 1, 1); PG8_STAGE(PG8_SB(1, 0), b3, voffB); PG8_STAGE(PG8_SB(1, 1), b3 + hstep, voffB); PG8_STAGE(PG8_SA(1, 0), a3, voffA);
            PG8_WAIT_V(8); PG8_WAIT_L(0); PG8_BAR; PG8_MMA(1, 0, At, B0); PG8_MMA(1, 1, At, B1); PG8_BAR; PG8_SCHED;
            } else {
            PG8_LDB(B0, 0, 0); PG8_SCHED; PG8_LDA(At, 0, 0); PG8_STAGE(PG8_SA(1, 1), a1 + hstep, voffA);
            PG8_WAIT_L(8); PG8_BAR; PG8_WAIT_L(0); PG8_MMA(0, 0, At, B0); PG8_BAR; PG8_SCHED;
            PG8_LDB(B1, 0, 1); PG8_STAGE(PG8_SB(0, 0), b2, voffB);
            PG8_BAR; PG8_WAIT_L(0); PG8_MMA(0, 1, At, B1); PG8_BAR;
            PG8_LDA(At, 0, 1); PG8_STAGE(PG8_SA(0, 0), a2, voffA);
            PG8_BAR; PG8_WAIT_L(0); PG8_MMA(1, 0, At, B0); PG8_BAR; PG8_SCHED;
            PG8_STAGE(PG8_SB(0, 1), b2 + hstep, voffB);
            PG8_WAIT_V(6); PG8_BAR; PG8_MMA(1, 1, At, B1); PG8_BAR;
            PG8_LDB(B0, 1, 0); PG8_SCHED; PG8_LDA(At, 1, 0); PG8_STAGE(PG8_SA(0, 1), a2 + hstep, voffA);
            PG8_WAIT_L(8); PG8_BAR; PG8_WAIT_L(0); PG8_MMA(0, 0, At, B0); PG8_BAR; PG8_SCHED;
            PG8_LDB(B1, 1, 1); PG8_STAGE(PG8_SB(1, 0), b3, voffB);
            PG8_BAR; PG8_WAIT_L(0); PG8_MMA(0, 1, At, B1); PG8_BAR;
            PG8_LDA(At, 1, 1); PG8_STAGE(PG8_SA(1, 0), a3, voffA);
            PG8_BAR; PG8_WAIT_L(0); PG8_MMA(1, 0, At, B0); PG8_BAR; PG8_SCHED;
            PG8_STAGE(PG8_SB(1, 1), b3 + hstep, voffB);
            PG8_WAIT_V(6); PG8_BAR; PG8_MMA(1, 1, At, B1); PG8_BAR;
            }
        }
        if constexpr (ALIGN_EPI) { if (wr == 0) PG8_BAR; }
        if constexpr (!Epi::AFTER_DRAIN) { E(acc, cur, wr, wc, fr, fq); S.done(cur); }
        if (!has_next) break;
#pragma unroll
        for (int a = 0; a < 2; ++a)
#pragma unroll
            for (int b = 0; b < 2; ++b)
#pragma unroll
                for (int m = 0; m < 4; ++m)
#pragma unroll
                    for (int n = 0; n < 2; ++n) acc[a][b][m][n] = (f32x4){0.f, 0.f, 0.f, 0.f};
        cur = nxt; cA = nA; cB = nB; ++ui;
        if constexpr (ALIGN_EPI) { if (wr == 1) PG8_BAR; }
    }
    PG8_WAIT_V(0);
    if constexpr (!ALIGN_EPI) { if (wr == 0) PG8_BAR; }
    PG8_BAR;
    if constexpr (Epi::AFTER_DRAIN) { E.fused(acc, cur, wr, wc, fr, fq, lds, wid, lane); S.done(cur); }
#undef PG8_SA
#undef PG8_SB
#undef PG8_STAGE
#undef PG8_LDA
#undef PG8_LDB
#undef PG8_MMA
#undef PG8_WAIT_V
#undef PG8_WAIT_L
#undef PG8_BAR
#undef PG8_SCHED
}
}

#ifndef MK_REP_MASK
#define MK_REP_MASK 0
#endif
#ifndef MK_ONE_LAUNCH
#define MK_ONE_LAUNCH 1
#endif
#define LAS __attribute__((address_space(3)))
typedef unsigned short bf16;
typedef float f32x4 __attribute__((ext_vector_type(4)));
typedef unsigned u32x4 __attribute__((ext_vector_type(4)));
typedef unsigned u32x2 __attribute__((ext_vector_type(2)));
constexpr int D = 1024, NB = 8, SEQ = 2048, NMETA = 16, TP = SEQ + NMETA, DB = 128, DS = 4;
constexpr int NH = 8, DTMP = 1792, DIN = 2816, DFF = 3072;
constexpr int R_SAMPLE = NB * SEQ, R_META = R_SAMPLE + DB * DS, R_END = R_META + NMETA, MP = 17152, M_MAIN = 16896;
constexpr float EPS = 1e-6f, GN_EPS = 64e-5f;
constexpr int NPH = 12;
constexpr int LDS_BYTES = 147456;
enum { I_XP = 0, I_XS, I_STS, I_SWKV, I_SLC, I_SLH, I_SFC, I_META, I_N1G, I_WIN, I_MU, I_W0, I_WUP, I_A0, I_AUP, I_GUP, I_KK, I_KA, I_RK,
       I_GNG, I_GNB, I_LCW, I_LCB, I_LWA, I_LBA, I_LWX, I_LBX, I_LAM, I_LOG, I_WOUT, I_N2G, I_FUP, I_FGATE, I_FCW, I_FCB, I_FDOWN, I_NFG, N_IN };
constexpr size_t O_YP = 0, O_YS = 16777216, O_PSHIFT = 17301504, O_PWKV = 17315840, O_PLC = 17577984, O_PLH = 17590272, O_PFC = 17594368,
                 O_SSHIFT = 17643520, O_SWKV = 17872896, O_SLC = 22067200, O_SLH = 22263808, O_SFC = 22329344, O_END = 23115776;
constexpr size_t MiB = 1u << 20;
constexpr size_t WS_CTL = 0, CTL_ZERO_BYTES = 65536;
constexpr size_t WS_SSQ1 = 1 * MiB, WS_SSQ2 = WS_SSQ1 + (size_t)MP * 16 * 4;
constexpr size_t WS_WUP = 4 * MiB, WS_WGATE = 10 * MiB, WS_WDOWN = 16 * MiB;
constexpr size_t WS_X1B = 22 * MiB, WS_UP = WS_X1B + (size_t)MP * D * 2, WS_HID = WS_UP + (size_t)MP * DFF * 2;
constexpr size_t WS_U = 22 * MiB;
constexpr size_t WS_XN = 115 * MiB, WS_WIN = WS_XN + (size_t)MP * D * 2;
constexpr size_t WS_AP = 190 * MiB, WS_XC = 199 * MiB, WS_BA = 216 * MiB, WS_BB = 217 * MiB, WS_GB = 220 * MiB;
constexpr size_t WS_REC = 115 * MiB, WS_LRU = 182 * MiB, WS_Y = 220 * MiB, WS_MIX = 115 * MiB;
static_assert(WS_SSQ2 + (size_t)MP * 16 * 4 <= WS_WUP, "ssq");
static_assert(WS_HID + (size_t)M_MAIN * DFF * 2 <= 256 * MiB, "hid");
static_assert(WS_U + (size_t)MP * DIN * 2 <= WS_XN, "u");
static_assert(WS_WIN + (size_t)DIN * D * 2 <= WS_LRU, "win");
static_assert(WS_AP + (size_t)MP * 256 * 2 <= WS_XC && WS_XC + (size_t)MP * 512 * 2 <= WS_BA, "ap/xc");
static_assert(WS_GB + (size_t)MP * 1024 * 2 <= 256 * MiB, "gb");
static_assert(WS_REC + (size_t)R_END * 4096 <= WS_LRU && WS_LRU + (size_t)R_END * 2048 <= WS_BA, "rec/lru");
static_assert(WS_Y + (size_t)R_END * 2048 <= 256 * MiB, "y");
constexpr size_t DO_GA = 0, DO_LTOT = (size_t)MP * 1536 * 2, DO_CARRY = DO_LTOT + 513 * 2 * 512 * 4, DO_BON = DO_CARRY + 8 * 64 * 512 * 4, DO_WOUT = O_SFC * 4;
static_assert(DO_BON + (size_t)R_END * 8 * 4 <= O_PSHIFT * 4, "d_out scratch");

struct Args { const float* in[N_IN]; float* out; unsigned char* ws; int ph_lo, ph_hi; };

__device__ __forceinline__ float bf2f(bf16 h) { return __uint_as_float(((unsigned)h) << 16); }
__device__ __forceinline__ unsigned f2bf(float f) { unsigned u = __float_as_uint(f); return (u + 0x7fffu + ((u >> 16) & 1u)) >> 16; }
typedef float f32x2_t __attribute__((ext_vector_type(2))); typedef __bf16 bf16x2_t __attribute__((ext_vector_type(2)));
__device__ __forceinline__ unsigned pk2(float lo, float hi) { const f32x2_t v = {lo, hi}; const bf16x2_t b = __builtin_convertvector(v, bf16x2_t); return __builtin_bit_cast(unsigned, b); }
__device__ __forceinline__ float lo16(unsigned w) { return __uint_as_float(w << 16); }
__device__ __forceinline__ float hi16(unsigned w) { return __uint_as_float(w & 0xffff0000u); }
__device__ __forceinline__ float sigm(float x) { return __builtin_amdgcn_rcpf(1.f + __builtin_amdgcn_exp2f(-1.4426950409f * x)); }
__device__ __forceinline__ float softplus_(float z) { return fmaxf(z, 0.f) + log1pf(__expf(-fabsf(z))); }
__device__ __forceinline__ float gelu_tanh(float x) { const float t = x * (-2.3022082f + -0.10294324f * (x * x)); return x * __builtin_amdgcn_rcpf(1.f + __builtin_amdgcn_exp2f(t)); }
__device__ __forceinline__ float tanh_(float x) { const float e = __builtin_amdgcn_exp2f(2.8853900818f * x); return 1.f - 2.f * __builtin_amdgcn_rcpf(e + 1.f); }
__device__ __forceinline__ float wave_sum(float v) {
#pragma unroll
    for (int o = 1; o < 64; o <<= 1) v += __shfl_xor(v, o);
    return v;
}
template <int CTRL> __device__ __forceinline__ float dpp_f(float x) { return __int_as_float(__builtin_amdgcn_update_dpp(0, __float_as_int(x), CTRL, 0xF, 0xF, true)); }
__device__ __forceinline__ float allsum16(float x) { x += dpp_f<0xB1>(x); x += dpp_f<0x4E>(x); x += dpp_f<0x141>(x); x += dpp_f<0x140>(x); return x; }

struct RowInfo { int kind, b, t; };
__device__ __forceinline__ RowInfo row_info(int row) {
    RowInfo r;
    if (row < R_SAMPLE) { r.kind = 0; r.b = row >> 11; r.t = (row & 2047) + NMETA; }
    else if (row < R_META) { r.kind = 1; r.b = (row - R_SAMPLE) >> 2; r.t = (row - R_SAMPLE) & 3; }
    else if (row < R_END) { r.kind = 2; r.b = 0; r.t = row - R_META; }
    else { r.kind = 3; r.b = 0; r.t = 0; }
    return r;
}
__device__ __forceinline__ int prompt_row(int b, int t) { return t < NMETA ? R_META + t : b * SEQ + t - NMETA; }
__device__ __forceinline__ int row_back(const RowInfo& ri, int row, int j) {
    const int tt = ri.t - j; if (tt < 0) return -1;
    if (ri.kind == 1) return row - j;
    return prompt_row(ri.b, tt);
}
__device__ __forceinline__ void unpack8(const u32x4 w, float (&f)[8]) {
    f[0] = lo16(w.x); f[1] = hi16(w.x); f[2] = lo16(w.y); f[3] = hi16(w.y); f[4] = lo16(w.z); f[5] = hi16(w.z); f[6] = lo16(w.w); f[7] = hi16(w.w);
}
__device__ __forceinline__ void ld8f(const float* p, float (&f)[8]) { const f32x4 a = *(const f32x4*)p, b = *(const f32x4*)(p + 4); f[0] = a.x; f[1] = a.y; f[2] = a.z; f[3] = a.w; f[4] = b.x; f[5] = b.y; f[6] = b.z; f[7] = b.w; }
__device__ __forceinline__ u32x4 pack8(const float (&o)[8]) { u32x4 w; w.x = pk2(o[0], o[1]); w.y = pk2(o[2], o[3]); w.z = pk2(o[4], o[5]); w.w = pk2(o[6], o[7]); return w; }
__device__ __forceinline__ float row_rs(const float* ssq, int row) {
    const f32x4* p = (const f32x4*)(ssq + (size_t)row * 16); const f32x4 a = p[0], b = p[1], c = p[2], d = p[3];
    const float s = ((a.x + a.y) + (a.z + a.w)) + ((b.x + b.y) + (b.z + b.w)) + ((c.x + c.y) + (c.z + c.w)) + ((d.x + d.y) + (d.z + d.w));
    return __builtin_amdgcn_rsqf(s * (1.f / 1024.f) + EPS);
}

#define EPI_ROW(ai, m) (u.pm * 256 + (ai) * 128 + wr * 64 + (m) * 16 + fr)
#define EPI_COL(bj) (u.pn * 256 + (bj) * 128 + wc * 32 + 8 * fq)
struct EpiX1 {
    static constexpr bool PERM = true, AFTER_DRAIN = false;
    const float* __restrict__ xp; const float* __restrict__ xs; const float* __restrict__ meta; float* __restrict__ x1; bf16* __restrict__ x1b; float* __restrict__ ssq;
    __device__ __forceinline__ void operator()(const f32x4 (&acc)[2][2][4][2], const pg8::Unit& u, int wr, int wc, int fr, int fq) const {
#pragma unroll
        for (int ai = 0; ai < 2; ++ai)
#pragma unroll
            for (int m = 0; m < 4; ++m) {
                const int row = EPI_ROW(ai, m);
                const float* res = row < R_SAMPLE ? xp + (size_t)row * D : row < R_META ? xs + (size_t)(row - R_SAMPLE) * D : row < R_END ? meta + (size_t)(row - R_META) * D : nullptr;
                float s = 0.f;
#pragma unroll
                for (int bj = 0; bj < 2; ++bj) {
                    const int col = EPI_COL(bj);
                    f32x4 v0 = acc[ai][bj][m][0], v1 = acc[ai][bj][m][1];
                    if (res) { v0 += *(const f32x4*)(res + col); v1 += *(const f32x4*)(res + col + 4); }
                    if (row >= R_SAMPLE && row < M_MAIN) { *(f32x4*)(x1 + (size_t)row * D + col) = v0; *(f32x4*)(x1 + (size_t)row * D + col + 4) = v1; }
                    u32x4 w; w.x = pk2(v0.x, v0.y); w.y = pk2(v0.z, v0.w); w.z = pk2(v1.x, v1.y); w.w = pk2(v1.z, v1.w);
                    *(u32x4*)(x1b + (size_t)row * D + col) = w;
                    s += (v0.x * v0.x + v0.y * v0.y) + (v0.z * v0.z + v0.w * v0.w) + (v1.x * v1.x + v1.y * v1.y) + (v1.z * v1.z + v1.w * v1.w);
                }
                s += __shfl_xor(s, 16); s += __shfl_xor(s, 32);
                if (fq == 0) ssq[(size_t)row * 16 + u.pn * 4 + wc] = s;
            }
    }
};
struct EpiUp {
    static constexpr bool PERM = true, AFTER_DRAIN = false;
    const float* __restrict__ ssq; bf16* __restrict__ up; float* __restrict__ pffn; float* __restrict__ sffn;
    __device__ __forceinline__ void operator()(const f32x4 (&acc)[2][2][4][2], const pg8::Unit& u, int wr, int wc, int fr, int fq) const {
#pragma unroll
        for (int ai = 0; ai < 2; ++ai)
#pragma unroll
            for (int m = 0; m < 4; ++m) {
                const int row = EPI_ROW(ai, m);
                const float rs = row_rs(ssq, row);
                const RowInfo ri = row_info(row);
                float* st = nullptr;
                if (ri.kind == 0 && ri.t >= TP - 2) st = pffn + ((size_t)ri.b * 2 + (ri.t - (TP - 2))) * DFF;
                else if (ri.kind == 1 && ri.t >= 2) st = sffn + ((size_t)ri.b * 2 + (ri.t - 2)) * DFF;
#pragma unroll
                for (int bj = 0; bj < 2; ++bj) {
                    const int col = EPI_COL(bj);
                    const f32x4 v0 = acc[ai][bj][m][0] * rs, v1 = acc[ai][bj][m][1] * rs;
                    u32x4 w; w.x = pk2(v0.x, v0.y); w.y = pk2(v0.z, v0.w); w.z = pk2(v1.x, v1.y); w.w = pk2(v1.z, v1.w);
                    *(u32x4*)(up + (size_t)row * DFF + col) = w;
                    if (st) { *(f32x4*)(st + col) = v0; *(f32x4*)(st + col + 4) = v1; }
                }
            }
    }
};
struct EpiGate {
    static constexpr bool PERM = true, AFTER_DRAIN = false;
    const float* ssq; const bf16* up; const float* stf; const float* cw; const float* cb; bf16* hid;
    __device__ __forceinline__ void operator()(const f32x4 (&acc)[2][2][4][2], const pg8::Unit& u, int wr, int wc, int fr, int fq) const {
#pragma unroll
        for (int ai = 0; ai < 2; ++ai)
#pragma unroll
            for (int m = 0; m < 4; ++m) {
                const int row = EPI_ROW(ai, m);
                const float rs = row_rs(ssq, row);
                const RowInfo ri = row_info(row);
                const int r1 = row_back(ri, row, 1), r2 = row_back(ri, row, 2);
#pragma unroll
                for (int bj = 0; bj < 2; ++bj) {
                    const int col = EPI_COL(bj);
                    float g[8], u0[8], p1[8], p2[8];
                    { const f32x4 v0 = acc[ai][bj][m][0] * rs, v1 = acc[ai][bj][m][1] * rs; g[0] = v0.x; g[1] = v0.y; g[2] = v0.z; g[3] = v0.w; g[4] = v1.x; g[5] = v1.y; g[6] = v1.z; g[7] = v1.w; }
                    unpack8(*(const u32x4*)(up + (size_t)row * DFF + col), u0);
                    if (r1 >= 0) unpack8(*(const u32x4*)(up + (size_t)r1 * DFF + col), p1);
                    else if (ri.kind == 1) { const float* s = stf + ((size_t)ri.b * 2 + (1 + ri.t)) * DFF + col; const f32x4 a = *(const f32x4*)s, b = *(const f32x4*)(s + 4);
                        p1[0] = a.x; p1[1] = a.y; p1[2] = a.z; p1[3] = a.w; p1[4] = b.x; p1[5] = b.y; p1[6] = b.z; p1[7] = b.w; }
                    else {
#pragma unroll
                        for (int i = 0; i < 8; ++i) p1[i] = 0.f; }
                    if (r2 >= 0) unpack8(*(const u32x4*)(up + (size_t)r2 * DFF + col), p2);
                    else if (ri.kind == 1) { const float* s = stf + ((size_t)ri.b * 2 + ri.t) * DFF + col; const f32x4 a = *(const f32x4*)s, b = *(const f32x4*)(s + 4);
                        p2[0] = a.x; p2[1] = a.y; p2[2] = a.z; p2[3] = a.w; p2[4] = b.x; p2[5] = b.y; p2[6] = b.z; p2[7] = b.w; }
                    else {
#pragma unroll
                        for (int i = 0; i < 8; ++i) p2[i] = 0.f; }
                    float o[8];
#pragma unroll
                    for (int h = 0; h < 2; ++h) {
                        const f32x4 w0 = *(const f32x4*)(cw + col + 4 * h), w1 = *(const f32x4*)(cw + DFF + col + 4 * h), w2 = *(const f32x4*)(cw + 2 * DFF + col + 4 * h), bb = *(const f32x4*)(cb + col + 4 * h);
#pragma unroll
                        for (int i = 0; i < 4; ++i) { const int e = 4 * h + i; const float c = bb[i] + w0[i] * p2[e] + w1[i] * p1[e] + w2[i] * u0[e]; o[e] = gelu_tanh(c) * g[e]; }
                    }
                    u32x4 w; w.x = pk2(o[0], o[1]); w.y = pk2(o[2], o[3]); w.z = pk2(o[4], o[5]); w.w = pk2(o[6], o[7]);
                    *(u32x4*)(hid + (size_t)row * DFF + col) = w;
                }
            }
    }
};
struct EpiDown {
    static constexpr bool PERM = true, AFTER_DRAIN = false;
    float* __restrict__ x; const bf16* __restrict__ x1b;
    __device__ __forceinline__ void operator()(const f32x4 (&acc)[2][2][4][2], const pg8::Unit& u, int wr, int wc, int fr, int fq) const {
        const bool part = u.nt != DFF / 64;
#pragma unroll
        for (int ai = 0; ai < 2; ++ai)
#pragma unroll
            for (int m = 0; m < 4; ++m) {
                const int row = EPI_ROW(ai, m);
#pragma unroll
                for (int bj = 0; bj < 2; ++bj) {
                    const int col = EPI_COL(bj);
                    float* p = x + (size_t)row * D + col;
                    if (part) {
#pragma unroll
                        for (int i = 0; i < 4; ++i) { unsafeAtomicAdd(p + i, acc[ai][bj][m][0][i]); unsafeAtomicAdd(p + 4 + i, acc[ai][bj][m][1][i]); }
                    } else {
                        float r8[8]; unpack8(*(const u32x4*)(x1b + (size_t)row * D + col), r8);
                        const f32x4 v0 = acc[ai][bj][m][0] + (f32x4){r8[0], r8[1], r8[2], r8[3]}, v1 = acc[ai][bj][m][1] + (f32x4){r8[4], r8[5], r8[6], r8[7]};
                        *(f32x4*)p = v0; *(f32x4*)(p + 4) = v1;
                    }
                }
            }
    }
};
struct DownOrder {
    pg8::StaticOrder base; int G, c;
    __device__ void init(int G_, int c_) { base.init(R_SAMPLE, D, G_, c_, DFF); G = G_; c = c_; }
    __device__ bool next(int i, pg8::Unit& u) const {
        const int nb = (256 - c + G - 1) / G;
        if (i < nb) return base.next(i, u);
        const int j = (i - nb) * G + c; if (j >= 48) return false;
        u.pm = 64 + j / 24; u.pn = (j / 6) % 4; u.ko = (j % 6) * 512; u.nt = 8; return true;
    }
    __device__ __forceinline__ void a_ready(const pg8::Unit&) const {}
    __device__ __forceinline__ void done(const pg8::Unit&) const {}
};
struct EpiPlain {
    static constexpr bool PERM = true, AFTER_DRAIN = false;
    bf16* O; int ldc;
    __device__ __forceinline__ void operator()(const f32x4 (&acc)[2][2][4][2], const pg8::Unit& u, int wr, int wc, int fr, int fq) const {
#pragma unroll
        for (int ai = 0; ai < 2; ++ai)
#pragma unroll
            for (int m = 0; m < 4; ++m) {
                const int row = EPI_ROW(ai, m);
#pragma unroll
                for (int bj = 0; bj < 2; ++bj) {
                    const int col = EPI_COL(bj);
                    const f32x4 v0 = acc[ai][bj][m][0], v1 = acc[ai][bj][m][1];
                    u32x4 w; w.x = pk2(v0.x, v0.y); w.y = pk2(v0.z, v0.w); w.z = pk2(v1.x, v1.y); w.w = pk2(v1.z, v1.w);
                    *(u32x4*)(O + (size_t)row * ldc + col) = w;
                }
            }
    }
};

#define XB_TMO      128
#define XB_XCNT(j)  (256  + 64 * (j))
#define XB_XSUB(j)  (1280 + 64 * (j))
#define XB_XGEN(j)  (2304 + 64 * (j))
#define XB_TOP      3328
#define XB_TOPGEN   3392
#define XCD_BAR_WORDS 3456
#define XB_SPIN_CAP (1u << 22)
__device__ __forceinline__ unsigned xb_ld(unsigned* p)              { return __hip_atomic_load(p, __ATOMIC_RELAXED, __HIP_MEMORY_SCOPE_AGENT); }
__device__ __forceinline__ unsigned xb_add(unsigned* p, unsigned v) { return __hip_atomic_fetch_add(p, v, __ATOMIC_RELAXED, __HIP_MEMORY_SCOPE_AGENT); }
__device__ __forceinline__ unsigned xb_xcc_id() { return (unsigned)__builtin_amdgcn_s_getreg((3 << 11) | 20) & 0xFu; }
#define XB_SPIN(cond, bar) do { unsigned _sp = 0; while (cond) { __builtin_amdgcn_s_sleep(1); \
    if ((++_sp & 255u) == 0u) { if (xb_ld(&(bar)[XB_TMO])) break; if (_sp > XB_SPIN_CAP) { atomicAdd(&(bar)[XB_TMO], 1u); break; } } } } while (0)
struct XcdBarrier { unsigned* bar; unsigned x; volatile LAS unsigned* st; };
__device__ __forceinline__ XcdBarrier xcd_barrier_post(unsigned* bar, volatile LAS unsigned* st) {
    XcdBarrier b; b.bar = bar; b.x = xb_xcc_id(); b.st = st;
    if (threadIdx.x == 0) (void)xb_add(&bar[XB_XCNT(b.x)], 1u);
    return b;
}
__device__ __forceinline__ void xcd_barrier_complete(unsigned* bar, unsigned x, unsigned& nloc, unsigned& nx) {
    const unsigned G = gridDim.x * gridDim.y * gridDim.z;
    unsigned sum, cnt, mine, sp = 0u;
    for (;;) {
        sum = 0u; cnt = 0u; mine = 0u;
#pragma unroll
        for (unsigned j = 0; j < 16; ++j) { const unsigned c = xb_ld(&bar[XB_XCNT(j)]); sum += c; cnt += (c > 0u) ? 1u : 0u; mine = (j == x) ? c : mine; }
        if (sum == G) break;
        __builtin_amdgcn_s_sleep(1);
        if ((++sp & 255u) == 0u) { if (xb_ld(&bar[XB_TMO])) break; if (sp > XB_SPIN_CAP) { atomicAdd(&bar[XB_TMO], 1u); break; } }
    }
    nloc = mine > 0u ? mine : 1u; nx = cnt > 0u ? cnt : 1u;
}
__device__ __forceinline__ void xcd_barrier(const XcdBarrier& b) {
    asm volatile("s_waitcnt vmcnt(0)" ::: "memory");
    __syncthreads();
    if (threadIdx.x == 0) {
        unsigned* bar = b.bar;
        __builtin_amdgcn_s_waitcnt(0);
        unsigned nloc = b.st[0], nx = b.st[1];
        if (nloc == 0u) { xcd_barrier_complete(bar, b.x, nloc, nx); b.st[0] = nloc; b.st[1] = nx; }
        const unsigned old = xb_add(&bar[XB_XSUB(b.x)], 1u);
        const unsigned gen = old / nloc;
        if (old + 1u == (gen + 1u) * nloc) {
            __builtin_amdgcn_fence(__ATOMIC_RELEASE, "agent");
            asm volatile("s_waitcnt vmcnt(0)" ::: "memory");
            const unsigned og = xb_add(&bar[XB_TOP], 1u);
            const unsigned tg = og / nx;
            if (og + 1u == (tg + 1u) * nx) xb_add(&bar[XB_TOPGEN], 1u);
            else XB_SPIN(xb_ld(&bar[XB_TOPGEN]) == tg, bar);
            __builtin_amdgcn_fence(__ATOMIC_ACQUIRE, "agent");
            xb_add(&bar[XB_XGEN(b.x)], 1u);
            asm volatile("s_waitcnt vmcnt(0)" ::: "memory");
        } else {
            XB_SPIN(xb_ld(&bar[XB_XGEN(b.x)]) == gen, bar);
            __builtin_amdgcn_fence(__ATOMIC_ACQUIRE, "agent");
            asm volatile("s_waitcnt vmcnt(0)" ::: "memory");
        }
    }
    __syncthreads();
}

__device__ __forceinline__ void p0_transpose_item(const float* W, int K, int N, bf16* WT, const float* ksc, LAS float* scr, int item, int lane) {
    const int nblk = N / 32, kb = item / nblk, nb = item % nblk, k0 = 64 * kb, n0 = 32 * nb;
#pragma unroll
    for (int i = 0; i < 32; ++i) { const int kk = 2 * i + (lane >> 5); float v = W[(size_t)(k0 + kk) * N + n0 + (lane & 31)]; if (ksc) v *= ksc[k0 + kk]; scr[kk * 33 + (lane & 31)] = v; }
    asm volatile("s_waitcnt lgkmcnt(0)" ::: "memory");
    const int c = lane & 7;
#pragma unroll
    for (int j = 0; j < 4; ++j) { const int n = (lane >> 3) + 8 * j; const LAS float* s = scr + (8 * c) * 33 + n;
        u32x4 o; o.x = pk2(s[0 * 33], s[1 * 33]); o.y = pk2(s[2 * 33], s[3 * 33]); o.z = pk2(s[4 * 33], s[5 * 33]); o.w = pk2(s[6 * 33], s[7 * 33]);
        *(u32x4*)(WT + (size_t)(n0 + n) * K + k0 + 8 * c) = o; }
    asm volatile("s_waitcnt lgkmcnt(0)" ::: "memory");
}
__device__ __forceinline__ void phase_p0(const Args& A, LAS unsigned char* lds, int G) {
    const int tid = my_tid(), lane = tid & 63, wave = tid >> 6;
    LAS float* scr = (LAS float*)(lds + wave * 16384);
    const int gw = blockIdx.x * 8 + wave, NGW = G * 8;
    unsigned char* ws = A.ws;
    constexpr int I_IN = 16 * 88, I_OUT = 16 * 32, I_UPI = 16 * 96, I_DN = 48 * 32, NIT = I_IN + I_OUT + 2 * I_UPI + I_DN;
    for (int it = gw; it < NIT; it += NGW) {
        int r = it;
        if (r < I_IN) { p0_transpose_item(A.in[I_WIN], D, DIN, (bf16*)(ws + WS_WIN), nullptr, scr, r, lane); continue; } r -= I_IN;
        if (r < I_OUT) { p0_transpose_item(A.in[I_WOUT], D, D, (bf16*)((unsigned char*)A.out + DO_WOUT), nullptr, scr, r, lane); continue; } r -= I_OUT;
        if (r < I_UPI) { p0_transpose_item(A.in[I_FUP], D, DFF, (bf16*)(ws + WS_WUP), A.in[I_N2G], scr, r, lane); continue; } r -= I_UPI;
        if (r < I_UPI) { p0_transpose_item(A.in[I_FGATE], D, DFF, (bf16*)(ws + WS_WGATE), A.in[I_N2G], scr, r, lane); continue; } r -= I_UPI;
        p0_transpose_item(A.in[I_FDOWN], DFF, D, (bf16*)(ws + WS_WDOWN), nullptr, scr, r, lane);
    }
    const int gt = blockIdx.x * 512 + tid, NGT = G * 512;
    { bf16* BA = (bf16*)(ws + WS_BA); const float* wup = A.in[I_WUP]; const float* aup = A.in[I_AUP]; const float* gup = A.in[I_GUP];
      for (int e = gt; e < 1536 * 256; e += NGT) { const int n = e >> 8, k = e & 255; float v = 0.f;
          if (n < 512) { if (k < 64) v = wup[k * 512 + n]; }
          else if (n < 1024) { if (k >= 64 && k < 128) v = aup[(k - 64) * 512 + n - 512]; }
          else { if (k >= 128) v = gup[(k - 128) * 512 + n - 1024]; }
          BA[e] = (bf16)f2bf(v); } }
    { bf16* BB = (bf16*)(ws + WS_BB); const float* wa = A.in[I_LWA]; const float* wx = A.in[I_LWX];
      for (int e = gt; e < 1024 * 512; e += NGT) { const int n = e >> 9, k = e & 511, nn = n & 511, h = nn >> 6, j = nn & 63; float v = 0.f;
          if ((k >> 6) == h) { const float* Wm = n < 512 ? wa : wx; v = Wm[(h * 64 + (k & 63)) * 64 + j]; }
          BB[e] = (bf16)f2bf(v); } }
    bf16* XN = (bf16*)(ws + WS_XN); const float* g1 = A.in[I_N1G];
    f32x4 gv[4];
#pragma unroll
    for (int j = 0; j < 4; ++j) gv[j] = ((const f32x4*)g1)[lane + 64 * j];
#pragma unroll 2
    for (int row = gw; row < MP; row += NGW) {
        const float* src = row < R_SAMPLE ? A.in[I_XP] + (size_t)row * D : row < R_META ? A.in[I_XS] + (size_t)(row - R_SAMPLE) * D : row < R_END ? A.in[I_META] + (size_t)(row - R_META) * D : nullptr;
        u32x2* o = (u32x2*)(XN + (size_t)row * D);
        if (!src) {
#pragma unroll
            for (int j = 0; j < 4; ++j) o[lane + 64 * j] = (u32x2){0u, 0u};
            continue; }
        f32x4 v[4]; float s = 0.f;
#pragma unroll
        for (int j = 0; j < 4; ++j) { v[j] = ((const f32x4*)src)[lane + 64 * j]; s += (v[j].x * v[j].x + v[j].y * v[j].y) + (v[j].z * v[j].z + v[j].w * v[j].w); }
        const float rs = __builtin_amdgcn_rsqf(wave_sum(s) * (1.f / D) + EPS);
#pragma unroll
        for (int j = 0; j < 4; ++j) { const f32x4 g = gv[j];
            o[lane + 64 * j] = (u32x2){pk2(v[j].x * rs * g.x, v[j].y * rs * g.y), pk2(v[j].z * rs * g.z, v[j].w * rs * g.w)}; }
    }
}

__device__ __forceinline__ void phase_e1(const Args& A, int G) {
    const int tid = my_tid(), lane = tid & 63, wave = tid >> 6;
    const int gw = blockIdx.x * 8 + wave, NGW = G * 8;
    unsigned char* ws = A.ws;
    const bf16* __restrict__ U = (const bf16*)(ws + WS_U); bf16* __restrict__ AP = (bf16*)(ws + WS_AP); bf16* __restrict__ XC = (bf16*)(ws + WS_XC);
    const float* mu = A.in[I_MU]; const float* sts = A.in[I_STS]; const float* slc = A.in[I_SLC]; const float* lcw = A.in[I_LCW]; const float* lcb = A.in[I_LCB];
#pragma unroll 2
    for (int row = gw; row < MP; row += NGW) {
        bf16* ap = AP + (size_t)row * 256; bf16* xc = XC + (size_t)row * 512;
        const RowInfo ri = row_info(row);
        if (ri.kind == 3) { ((u32x2*)ap)[lane] = (u32x2){0u, 0u}; ((u32x4*)xc)[lane] = (u32x4){0u, 0u, 0u, 0u}; continue; }
        const bf16* urow = U + (size_t)row * DIN;
        const int r1 = row_back(ri, row, 1);
        {
            const int c0 = 1536 + 4 * lane;
            const u32x2 uw = *(const u32x2*)(urow + c0);
            float u[4] = {lo16(uw.x), hi16(uw.x), lo16(uw.y), hi16(uw.y)}, p[4];
            if (r1 >= 0) { const u32x2 pw = *(const u32x2*)(U + (size_t)r1 * DIN + c0); p[0] = lo16(pw.x); p[1] = hi16(pw.x); p[2] = lo16(pw.y); p[3] = hi16(pw.y); }
            else if (ri.kind == 1) { const f32x4 pv = *(const f32x4*)(sts + (size_t)ri.b * DTMP + c0); p[0] = pv.x; p[1] = pv.y; p[2] = pv.z; p[3] = pv.w; }
            else { p[0] = p[1] = p[2] = p[3] = 0.f; }
            const f32x4 m4 = *(const f32x4*)(mu + c0);
            float o[4];
#pragma unroll
            for (int i = 0; i < 4; ++i) { const float um = u[i] + (p[i] - u[i]) * m4[i]; o[i] = lane < 16 ? tanh_(um) : lane < 32 ? um : sigm(um); }
            ((u32x2*)ap)[lane] = (u32x2){pk2(o[0], o[1]), pk2(o[2], o[3])};
        }
        {
            const int c = 8 * lane;
            float acc[8], cur[8];
            { const f32x4 b0 = *(const f32x4*)(lcb + c), b1 = *(const f32x4*)(lcb + c + 4); acc[0] = b0.x; acc[1] = b0.y; acc[2] = b0.z; acc[3] = b0.w; acc[4] = b1.x; acc[5] = b1.y; acc[6] = b1.z; acc[7] = b1.w; }
#pragma unroll
            for (int j = 0; j < 4; ++j) {
                float val[8];
                const int rj = (j == 3) ? row : row_back(ri, row, 3 - j);
                if (rj >= 0) unpack8(*(const u32x4*)(U + (size_t)rj * DIN + DTMP + c), val);
                else if (ri.kind == 1) { const float* s = slc + ((size_t)ri.b * 3 + (ri.t + j)) * 512 + c; const f32x4 a = *(const f32x4*)s, b = *(const f32x4*)(s + 4);
                    val[0] = a.x; val[1] = a.y; val[2] = a.z; val[3] = a.w; val[4] = b.x; val[5] = b.y; val[6] = b.z; val[7] = b.w; }
                else {
#pragma unroll
                    for (int i = 0; i < 8; ++i) val[i] = 0.f; }
                const f32x4 w0 = *(const f32x4*)(lcw + j * 512 + c), w1 = *(const f32x4*)(lcw + j * 512 + c + 4);
#pragma unroll
                for (int i = 0; i < 4; ++i) { acc[i] += w0[i] * val[i]; acc[4 + i] += w1[i] * val[4 + i]; }
                if (j == 3) {
#pragma unroll
                    for (int i = 0; i < 8; ++i) cur[i] = val[i]; }
            }
            u32x4 w; w.x = pk2(acc[0], acc[1]); w.y = pk2(acc[2], acc[3]); w.z = pk2(acc[4], acc[5]); w.w = pk2(acc[6], acc[7]);
            ((u32x4*)xc)[lane] = w;
            float* lco = nullptr;
            if (ri.kind == 0 && ri.t >= TP - 3) lco = A.out + O_PLC + ((size_t)ri.b * 3 + (ri.t - (TP - 3))) * 512 + c;
            else if (ri.kind == 1 && ri.t >= 1) lco = A.out + O_SLC + ((size_t)ri.b * 3 + (ri.t - 1)) * 512 + c;
            if (lco) { *(f32x4*)lco = (f32x4){cur[0], cur[1], cur[2], cur[3]}; *(f32x4*)(lco + 4) = (f32x4){cur[4], cur[5], cur[6], cur[7]}; }
        }
        float* sho = nullptr;
        if (ri.kind == 0 && ri.t == TP - 1) sho = A.out + O_PSHIFT + (size_t)ri.b * DTMP;
        else if (ri.kind == 1 && ri.t == DS - 1) sho = A.out + O_SSHIFT + (size_t)ri.b * DTMP;
        if (sho) for (int i = lane; i < DTMP; i += 64) sho[i] = bf2f(urow[i]);
    }
}

__device__ __forceinline__ float sum8(float x) { x += dpp_f<0xB1>(x); x += dpp_f<0x4E>(x); x += dpp_f<0x141>(x); return x; }
__device__ __forceinline__ void phase_e2(const Args& A, int G) {
    const int tid = my_tid(), lane = tid & 63, wave = tid >> 6;
    unsigned char* ws = A.ws;
    const bf16* __restrict__ U = (const bf16*)(ws + WS_U); const bf16* __restrict__ GB = (const bf16*)(ws + WS_GB); const bf16* __restrict__ GA = (const bf16*)((unsigned char*)A.out + DO_GA);
    bf16* __restrict__ REC = (bf16*)(ws + WS_REC); bf16* __restrict__ LRU = (bf16*)(ws + WS_LRU);
    float* __restrict__ LTOT = (float*)((unsigned char*)A.out + DO_LTOT); float* __restrict__ BON = (float*)((unsigned char*)A.out + DO_BON);
    const float* mu = A.in[I_MU]; const float* sts = A.in[I_STS]; const float* slc = A.in[I_SLC]; const float* slh = A.in[I_SLH];
    for (int unit = blockIdx.x; unit < 513 + DB; unit += G) {
        int row0, ntok, kind;
        if (unit < 512) { row0 = unit * 32; ntok = 32; kind = 0; } else if (unit == 512) { row0 = R_META; ntok = 16; kind = 2; } else { row0 = R_SAMPLE + (unit - 513) * 4; ntok = 4; kind = 1; }
        const int c = tid;
        const float sp = softplus_(-A.in[I_LAM][c]);
        const float cw0 = A.in[I_LCW][c], cw1 = A.in[I_LCW][512 + c], cw2 = A.in[I_LCW][1024 + c], cw3 = A.in[I_LCW][1536 + c], cbias = A.in[I_LCB][c];
        const float ba_ = A.in[I_LBA][c], bx_ = A.in[I_LBX][c];
        float l1 = 0.f, l2 = 0.f, l3 = 0.f, H = 0.f, P = 1.f;
        if (kind == 0) { const RowInfo ri0 = row_info(row0);
            l1 = bf2f(U[(size_t)row_back(ri0, row0, 1) * DIN + DTMP + c]); l2 = bf2f(U[(size_t)row_back(ri0, row0, 2) * DIN + DTMP + c]); l3 = bf2f(U[(size_t)row_back(ri0, row0, 3) * DIN + DTMP + c]); }
        else if (kind == 1) { const int b = unit - 513; l3 = slc[((size_t)b * 3 + 0) * 512 + c]; l2 = slc[((size_t)b * 3 + 1) * 512 + c]; l1 = slc[((size_t)b * 3 + 2) * 512 + c]; H = slh[(size_t)b * 512 + c]; }
#pragma unroll 4
        for (int j = 0; j < ntok; ++j) {
            const int row = row0 + j;
            const float l0 = bf2f(U[(size_t)row * DIN + DTMP + c]);
            const float xc = cbias + cw0 * l3 + cw1 * l2 + cw2 * l1 + cw3 * l0;
            l3 = l2; l2 = l1; l1 = l0;
            const float ra = bf2f(GB[(size_t)row * 1024 + c]) + ba_, ix = bf2f(GB[(size_t)row * 1024 + 512 + c]) + bx_;
            const float rg = sigm(ra), ig = sigm(ix);
            const float la = -8.f * rg * sp, a = __builtin_amdgcn_exp2f(1.4426950409f * la);
            float mult = __builtin_amdgcn_sqrtf(fmaxf(1.f - __builtin_amdgcn_exp2f(2.8853900818f * la), 0.f)); if (kind == 2 && j == 0) mult = 1.f;
            H = a * H + xc * ig * mult; P = P * a;
            LRU[(size_t)row * 1024 + c] = (bf16)f2bf(H); LRU[(size_t)row * 1024 + 512 + c] = (bf16)f2bf(kind == 1 ? 0.f : P);
        }
        if (kind == 1) A.out[O_SLH + (size_t)(unit - 513) * 512 + c] = H;
        else { LTOT[((size_t)unit * 2 + 0) * 512 + c] = P; LTOT[((size_t)unit * 2 + 1) * 512 + c] = H; }
    }
    {
        const int c = 8 * lane, h = lane >> 3, gw = blockIdx.x * 8 + wave, NGW = G * 8;
        float mr[8], mk[8], w0[8], a0[8], kkw[8], kaw[8], rkw[8];
        ld8f(mu + c, mr); ld8f(mu + 512 + c, mk); ld8f(A.in[I_W0] + c, w0); ld8f(A.in[I_A0] + c, a0); ld8f(A.in[I_KK] + c, kkw); ld8f(A.in[I_KA] + c, kaw); ld8f(A.in[I_RK] + c, rkw);
#pragma unroll 2
        for (int row = gw; row < R_END; row += NGW) {
            const RowInfo ri = row_info(row); const int r1 = row_back(ri, row, 1);
            const bf16* ur = U + (size_t)row * DIN;
            float u_r[8], u_k[8], p_r[8], p_k[8], wp[8], ap[8];
            unpack8(*(const u32x4*)(ur + c), u_r); unpack8(*(const u32x4*)(ur + 512 + c), u_k);
            unpack8(*(const u32x4*)(GA + (size_t)row * 1536 + c), wp); unpack8(*(const u32x4*)(GA + (size_t)row * 1536 + 512 + c), ap);
            if (r1 >= 0) { unpack8(*(const u32x4*)(U + (size_t)r1 * DIN + c), p_r); unpack8(*(const u32x4*)(U + (size_t)r1 * DIN + 512 + c), p_k); }
            else if (ri.kind == 1) { ld8f(sts + (size_t)ri.b * DTMP + c, p_r); ld8f(sts + (size_t)ri.b * DTMP + 512 + c, p_k); }
            else {
#pragma unroll
                for (int i = 0; i < 8; ++i) { p_r[i] = 0.f; p_k[i] = 0.f; } }
            float av[8], xv[8], kk[8], kp[8], ss = 0.f, bs = 0.f;
#pragma unroll
            for (int i = 0; i < 8; ++i) {
                const float um_r = u_r[i] + (p_r[i] - u_r[i]) * mr[i], um_k = u_k[i] + (p_k[i] - u_k[i]) * mk[i];
                const float z = -(wp[i] + w0[i]);
                const float w_log = -(fmaxf(z, 0.f) + __logf(1.f + __expf(-fabsf(z)))) - 0.5f;
                const float e = __builtin_amdgcn_exp2f(1.4426950409f * w_log); xv[i] = 1.f - __builtin_amdgcn_exp2f(-1.4426950409f * e);
                av[i] = sigm(ap[i] + a0[i]);
                kk[i] = um_k * kkw[i]; ss += kk[i] * kk[i];
                kp[i] = um_k * (1.f + (av[i] - 1.f) * kaw[i]);
                bs += um_r * kp[i] * rkw[i];
            }
            ss = sum8(ss); bs = sum8(bs);
            const float rn = __builtin_amdgcn_rsqf(fmaxf(ss, 1e-24f));
#pragma unroll
            for (int i = 0; i < 8; ++i) kk[i] *= rn;
            bf16* rec = REC + ((size_t)row * 8 + h) * 256 + (lane & 7) * 8;
            *(u32x4*)rec = pack8(av); *(u32x4*)(rec + 64) = pack8(xv); *(u32x4*)(rec + 128) = pack8(kk); *(u32x4*)(rec + 192) = pack8(kp);
            if ((lane & 7) == 0) BON[(size_t)row * 8 + h] = bs;
        }
    }
}

struct Raw { bf16 a, x, kk, kp, ur, uv, pr, pv; };
__device__ __forceinline__ void m2_load(Raw (&raw)[8], const bf16* REC, const bf16* U, int b, int h, int t0, int ns, int k, int sub) {
#pragma unroll
    for (int i = 0; i < 8; ++i) {
        const int s = sub + 4 * i;
        raw[i].a = 0; raw[i].x = 0; raw[i].kk = 0; raw[i].kp = 0; raw[i].ur = 0; raw[i].uv = 0; raw[i].pr = 0; raw[i].pv = 0;
        if (s < ns) {
            const int t = t0 + s, row = prompt_row(b, t);
            const bf16* rec = REC + ((size_t)row * 8 + h) * 256;
            raw[i].a = rec[k]; raw[i].x = rec[64 + k]; raw[i].kk = rec[128 + k]; raw[i].kp = rec[192 + k];
            const bf16* ur = U + (size_t)row * DIN + h * 64 + k; raw[i].ur = ur[0]; raw[i].uv = ur[1024];
            if (t > 0) { const bf16* pr = U + (size_t)prompt_row(b, t - 1) * DIN + h * 64 + k; raw[i].pr = pr[0]; raw[i].pv = pr[1024]; }
        }
    }
}
__device__ __forceinline__ void m2_store(const Raw (&raw)[8], LAS float* buf, float mu_r, float mu_v, int k, int sub, int ns) {
#pragma unroll
    for (int i = 0; i < 8; ++i) {
        const int s = sub + 4 * i;
        if (s < ns) {
            LAS float* p = buf + s * 384;
            const float a = bf2f(raw[i].a), kk = bf2f(raw[i].kk), ur = bf2f(raw[i].ur), uv = bf2f(raw[i].uv);
            p[k] = kk; p[64 + k] = 1.f - bf2f(raw[i].x); p[128 + k] = -(kk * a); p[192 + k] = bf2f(raw[i].kp);
            p[256 + k] = ur + (bf2f(raw[i].pr) - ur) * mu_r; p[320 + k] = uv + (bf2f(raw[i].pv) - uv) * mu_v;
        }
    }
}
typedef float f32x2 __attribute__((ext_vector_type(2)));
struct StepOps { f32x4 kk, dd, nka, kp, r; float v; };
__device__ __forceinline__ void ops_load(StepOps& o, const LAS float* p, int ks, int vrow) {
    o.kk = *(const LAS f32x4*)(p + 4 * ks); o.dd = *(const LAS f32x4*)(p + 64 + 4 * ks); o.nka = *(const LAS f32x4*)(p + 128 + 4 * ks);
    o.kp = *(const LAS f32x4*)(p + 192 + 4 * ks); o.r = *(const LAS f32x4*)(p + 256 + 4 * ks); o.v = p[320 + vrow];
}
__device__ __forceinline__ float dot4(const f32x4 a, const f32x4 b) { f32x2 t = a.xy * b.xy; t = a.zw * b.zw + t; return t.x + t.y; }
__device__ __forceinline__ void scan_step2(f32x4& S, const StepOps& o, float& yp) {
    float d = dot4(S, o.kk);
    d += dpp_f<0xB1>(d); yp += dpp_f<0xB1>(yp); d += dpp_f<0x4E>(d); yp += dpp_f<0x4E>(yp);
    d += dpp_f<0x141>(d); yp += dpp_f<0x141>(yp); d += dpp_f<0x140>(d); yp += dpp_f<0x140>(yp);
    S = S * o.dd + d * o.nka + o.v * o.kp;
}
__device__ __forceinline__ float scan_step(f32x4& S, const StepOps& o) {
    float d = dot4(S, o.kk); d = allsum16(d);
    S = S * o.dd + d * o.nka + o.v * o.kp;
    float y = dot4(S, o.r); return allsum16(y);
}
__device__ __forceinline__ void phase_m2(const Args& A, LAS unsigned char* lds, int G) {
    const int tid = my_tid(), lane = tid & 63, wave = tid >> 6;
    unsigned char* ws = A.ws;
    const bf16* U = (const bf16*)(ws + WS_U); const bf16* REC = (const bf16*)(ws + WS_REC); float* Y = (float*)(ws + WS_Y);
    const float* LTOT = (const float*)((unsigned char*)A.out + DO_LTOT); float* CARRY = (float*)((unsigned char*)A.out + DO_CARRY);
    const float* mu = A.in[I_MU];
    for (int b = blockIdx.x; b < NB; b += G) {
        const int c = tid; float carry = LTOT[((size_t)512 * 2 + 1) * 512 + c];
        float Pv[64], Hv[64];
#pragma unroll
        for (int i = 0; i < 64; ++i) { const int un = b * 64 + i; Pv[i] = LTOT[((size_t)un * 2 + 0) * 512 + c]; Hv[i] = LTOT[((size_t)un * 2 + 1) * 512 + c]; }
#pragma unroll
        for (int i = 0; i < 64; ++i) { CARRY[((size_t)b * 64 + i) * 512 + c] = carry; carry = Pv[i] * carry + Hv[i]; }
        A.out[O_PLH + (size_t)b * 512 + c] = carry;
    }
    const int ks = lane & 15, rl = lane >> 4;
    for (int item = blockIdx.x; item < 256; item += G) {
        const int bh = item >> 2, q = item & 3, b = bh >> 3, h = bh & 7;
        const int k = tid & 63, sub = (tid >> 6) & 3;
        const float mu_r = mu[h * 64 + k], mu_v = mu[1024 + h * 64 + k];
        const int wv = wave & 3, vrow = 16 * q + 4 * wv + rl;
        f32x4 S = (f32x4){0.f, 0.f, 0.f, 0.f};
        Raw raw[8];
        LAS float* buf0 = (LAS float*)lds; LAS float* buf1 = (LAS float*)(lds + 50688); LAS float* ybuf = (LAS float*)(lds + 101376) + wv * 132;
        __syncthreads();
        if (wave >= 4) { m2_load(raw, REC, U, b, h, 0, 16, k, sub); m2_store(raw, buf0, mu_r, mu_v, k, sub, 16); m2_load(raw, REC, U, b, h, 16, 32, k, sub); }
        __syncthreads();
        for (int blk = 0; blk < 65; ++blk) {
            const int t0 = blk == 0 ? 0 : 16 + 32 * (blk - 1), ns = blk == 0 ? 16 : 32;
            if (wave >= 4) {
                if (blk + 1 < 65) m2_store(raw, (blk & 1) ? buf0 : buf1, mu_r, mu_v, k, sub, 32);
                if (blk + 2 < 65) m2_load(raw, REC, U, b, h, 16 + 32 * (blk + 1), 32, k, sub);
            } else {
                const LAS float* buf = (blk & 1) ? buf1 : buf0;
                StepOps oa, ob; ops_load(oa, buf, ks, vrow);
                float yp = 0.f;
                for (int s = 0; s < ns; s += 2) {
                    ops_load(ob, buf + (s + 1) * 384, ks, vrow);
                    scan_step2(S, oa, yp); ybuf[s * 4 + rl] = yp; yp = dot4(S, oa.r);
                    ops_load(oa, buf + (s + 2) * 384, ks, vrow);
                    scan_step2(S, ob, yp); ybuf[(s + 1) * 4 + rl] = yp; yp = dot4(S, ob.r);
                }
                yp = allsum16(yp); ybuf[ns * 4 + rl] = yp;
                if (ks < ns) Y[(size_t)prompt_row(b, t0 + ks) * 512 + h * 64 + vrow] = ybuf[(ks + 1) * 4 + rl];
                if (ks + 16 < ns) Y[(size_t)prompt_row(b, t0 + ks + 16) * 512 + h * 64 + vrow] = ybuf[(ks + 17) * 4 + rl];
            }
            __syncthreads();
        }
        if (wave < 4) *(f32x4*)(A.out + O_PWKV + ((size_t)(b * 8 + h) * 64 + vrow) * 64 + 4 * ks) = S;
    }
    const float* swkv = A.in[I_SWKV]; const float* sts = A.in[I_STS];
#pragma unroll 2
    for (int task = blockIdx.x * 8 + wave; task < DB * NH * 16; task += G * 8) {
        const int bh = task >> 4, rg = task & 15, b = bh >> 3, h = bh & 7, v = 4 * rg + rl;
        f32x4 S = *(const f32x4*)(swkv + ((size_t)bh * 64 + v) * 64 + 4 * ks);
        const f32x4 mr4 = *(const f32x4*)(mu + h * 64 + 4 * ks); const float mv = mu[1024 + h * 64 + v];
        StepOps o[DS];
#pragma unroll
        for (int t = 0; t < DS; ++t) {
            const int row = R_SAMPLE + 4 * b + t;
            const bf16* rec = REC + ((size_t)row * 8 + h) * 256 + 4 * ks;
            const u32x2 wa = *(const u32x2*)rec, wx = *(const u32x2*)(rec + 64), wk = *(const u32x2*)(rec + 128), wp = *(const u32x2*)(rec + 192);
            const f32x4 a4 = (f32x4){lo16(wa.x), hi16(wa.x), lo16(wa.y), hi16(wa.y)};
            o[t].dd = 1.f - (f32x4){lo16(wx.x), hi16(wx.x), lo16(wx.y), hi16(wx.y)};
            o[t].kk = (f32x4){lo16(wk.x), hi16(wk.x), lo16(wk.y), hi16(wk.y)}; o[t].kp = (f32x4){lo16(wp.x), hi16(wp.x), lo16(wp.y), hi16(wp.y)};
            const u32x2 wr_ = *(const u32x2*)(U + (size_t)row * DIN + h * 64 + 4 * ks);
            const f32x4 ur4 = (f32x4){lo16(wr_.x), hi16(wr_.x), lo16(wr_.y), hi16(wr_.y)};
            const float uv = bf2f(U[(size_t)row * DIN + 1024 + h * 64 + v]);
            f32x4 pr4; float pv;
            if (t > 0) { const u32x2 w = *(const u32x2*)(U + (size_t)(row - 1) * DIN + h * 64 + 4 * ks); pr4 = (f32x4){lo16(w.x), hi16(w.x), lo16(w.y), hi16(w.y)}; pv = bf2f(U[(size_t)(row - 1) * DIN + 1024 + h * 64 + v]); }
            else { pr4 = *(const f32x4*)(sts + (size_t)b * DTMP + h * 64 + 4 * ks); pv = sts[(size_t)b * DTMP + 1024 + h * 64 + v]; }
            o[t].r = ur4 + (pr4 - ur4) * mr4; o[t].v = uv + (pv - uv) * mv; o[t].nka = -(o[t].kk * a4);
        }
#pragma unroll
        for (int t = 0; t < DS; ++t) { const float y = scan_step(S, o[t]); if (ks == 0) Y[(size_t)(R_SAMPLE + 4 * b + t) * 512 + h * 64 + v] = y; }
        *(f32x4*)(A.out + O_SWKV + ((size_t)bh * 64 + v) * 64 + 4 * ks) = S;
    }
}

__device__ __forceinline__ void phase_m3(const Args& A, int G) {
    const int tid = my_tid(), lane = tid & 63, wave = tid >> 6;
    const int gw = blockIdx.x * 8 + wave, NGW = G * 8;
    unsigned char* ws = A.ws;
    const bf16* __restrict__ U = (const bf16*)(ws + WS_U); const bf16* __restrict__ GA = (const bf16*)((unsigned char*)A.out + DO_GA); const bf16* __restrict__ LRU = (const bf16*)(ws + WS_LRU);
    const float* __restrict__ Y = (const float*)(ws + WS_Y); const float* __restrict__ CARRY = (const float*)((unsigned char*)A.out + DO_CARRY); const float* __restrict__ BON = (const float*)((unsigned char*)A.out + DO_BON);
    bf16* __restrict__ MIX = (bf16*)(ws + WS_MIX);
    const float* sts = A.in[I_STS];
    const int c = 8 * lane, h = lane >> 3;
    float mv[8], gg[8], gb[8], og[8];
    ld8f(A.in[I_MU] + 1024 + c, mv); ld8f(A.in[I_GNG] + c, gg); ld8f(A.in[I_GNB] + c, gb); ld8f(A.in[I_LOG] + c, og);
#pragma unroll 2
    for (int row = gw; row < MP; row += NGW) {
        bf16* mo = MIX + (size_t)row * D;
        const RowInfo ri = row_info(row);
        if (ri.kind == 3) { ((u32x4*)mo)[lane] = (u32x4){0u, 0u, 0u, 0u}; ((u32x4*)mo)[64 + lane] = (u32x4){0u, 0u, 0u, 0u}; continue; }
        const int r1 = row_back(ri, row, 1);
        float y[8], uv[8], pv[8], g[8], hv[8], pp[8], gt[8], cr[8];
        ld8f(Y + (size_t)row * 512 + c, y);
        unpack8(*(const u32x4*)(U + (size_t)row * DIN + 1024 + c), uv);
        unpack8(*(const u32x4*)(GA + (size_t)row * 1536 + 1024 + c), g);
        unpack8(*(const u32x4*)(LRU + (size_t)row * 1024 + c), hv); unpack8(*(const u32x4*)(LRU + (size_t)row * 1024 + 512 + c), pp);
        unpack8(*(const u32x4*)(U + (size_t)row * DIN + DTMP + 512 + c), gt);
        const float bon = BON[(size_t)row * 8 + h];
        if (r1 >= 0) unpack8(*(const u32x4*)(U + (size_t)r1 * DIN + 1024 + c), pv);
        else if (ri.kind == 1) ld8f(sts + (size_t)ri.b * DTMP + 1024 + c, pv);
        else {
#pragma unroll
            for (int i = 0; i < 8; ++i) pv[i] = 0.f; }
        if (ri.kind == 0) ld8f(CARRY + ((size_t)ri.b * 64 + ((row & 2047) >> 5)) * 512 + c, cr);
        else {
#pragma unroll
            for (int i = 0; i < 8; ++i) cr[i] = 0.f; }
        float s = 0.f;
#pragma unroll
        for (int i = 0; i < 8; ++i) s += y[i];
        const float mean = sum8(s) * (1.f / 64.f);
        float q = 0.f;
#pragma unroll
        for (int i = 0; i < 8; ++i) { y[i] -= mean; q += y[i] * y[i]; }
        const float rstd = __builtin_amdgcn_rsqf(sum8(q) * (1.f / 64.f) + GN_EPS);
        float o[8];
#pragma unroll
        for (int i = 0; i < 8; ++i) { const float vv = uv[i] + (pv[i] - uv[i]) * mv[i]; o[i] = (y[i] * rstd * gg[i] + gb[i] + bon * vv) * g[i]; }
        *(u32x4*)(mo + c) = pack8(o);
        float z[8], s2 = 0.f;
#pragma unroll
        for (int i = 0; i < 8; ++i) { z[i] = (hv[i] + pp[i] * cr[i]) * gelu_tanh(gt[i]); s2 += z[i] * z[i]; }
        const float rs = __builtin_amdgcn_rsqf(wave_sum(s2) * (1.f / 512.f) + EPS);
#pragma unroll
        for (int i = 0; i < 8; ++i) o[i] = z[i] * rs * og[i];
        *(u32x4*)(mo + 512 + c) = pack8(o);
    }
}

__device__ __forceinline__ void phase_final(const Args& A, int G) {
    const int tid = my_tid(), lane = tid & 63, wave = tid >> 6;
    const int gw = blockIdx.x * 8 + wave, NGW = G * 8;
    const float* gf = A.in[I_NFG];
    f32x4 g[4];
#pragma unroll
    for (int j = 0; j < 4; ++j) g[j] = ((const f32x4*)gf)[lane + 64 * j];
    for (int row = gw; row < M_MAIN; row += NGW) {
        f32x4* p = (f32x4*)(A.out + (size_t)row * D);
        f32x4 v[4]; float s = 0.f;
#pragma unroll
        for (int j = 0; j < 4; ++j) { v[j] = p[lane + 64 * j]; s += (v[j].x * v[j].x + v[j].y * v[j].y) + (v[j].z * v[j].z + v[j].w * v[j].w); }
        const float rs = __builtin_amdgcn_rsqf(wave_sum(s) * (1.f / D) + EPS);
#pragma unroll
        for (int j = 0; j < 4; ++j) p[lane + 64 * j] = v[j] * rs * g[j];
    }
}

namespace cg = cooperative_groups;
__global__ void __launch_bounds__(512, 2) mk_fwd(Args args) {
    extern __shared__ __attribute__((aligned(16))) unsigned char lds_raw[];
    LAS unsigned char* lds = (LAS unsigned char*)lds_raw;
    const int G = gridDim.x, tid = threadIdx.x;
    volatile LAS unsigned* MISC = (volatile LAS unsigned*)(lds + 131072 + 320);
    if (tid < 64) ((LAS unsigned*)(lds + 131072))[tid + 64] = 0u, ((LAS unsigned*)(lds + 131072))[tid] = 0u;
    __syncthreads();
    const int lo = args.ph_lo, hi = args.ph_hi;
    XcdBarrier bar; bar.bar = (unsigned*)(args.ws + WS_CTL) + 4096; bar.x = 0; bar.st = nullptr;
    if (hi - lo > 1) bar = xcd_barrier_post((unsigned*)(args.ws + WS_CTL) + 4096, MISC + 8);
    if (lo < 0) cg::this_grid().sync();
#define IN(k) (lo <= (k) && (k) < hi)
#define SEAM(k) do { if (IN(k) && IN((k) + 1)) xcd_barrier(bar); } while (0)
    unsigned char* ws = args.ws; unsigned char* ob = (unsigned char*)args.out;
    if (IN(0)) { phase_p0(args, lds, G); } SEAM(0);
    if (IN(1)) { pg8::Gemm g{(const bf16*)(ws + WS_XN), (const bf16*)(ws + WS_WIN), MP, DIN, D}; pg8::StaticOrder S; S.init(MP, DIN, G, (int)blockIdx.x, D);
        EpiPlain E{(bf16*)(ws + WS_U), DIN}; pg8::gemm_phase<EpiPlain, pg8::StaticOrder, true, true>(lds, g, S, E); } SEAM(1);
    if (IN(2)) { phase_e1(args, G); } SEAM(2);
    if (IN(3)) {
        { pg8::Gemm g{(const bf16*)(ws + WS_AP), (const bf16*)(ws + WS_BA), MP, 1536, 256}; pg8::StaticOrder S; S.init(MP, 1536, G, (int)blockIdx.x, 256);
          EpiPlain E{(bf16*)(ob + DO_GA), 1536}; pg8::gemm_phase<EpiPlain, pg8::StaticOrder, true, true>(lds, g, S, E); }
        { pg8::Gemm g{(const bf16*)(ws + WS_XC), (const bf16*)(ws + WS_BB), MP, 1024, 512}; pg8::StaticOrder S; S.init(MP, 1024, G, (int)blockIdx.x, 512);
          EpiPlain E{(bf16*)(ws + WS_GB), 1024}; pg8::gemm_phase<EpiPlain, pg8::StaticOrder, true, true>(lds, g, S, E); }
    } SEAM(3);
    if (IN(4)) { phase_e2(args, G); } SEAM(4);
    if (IN(5)) { phase_m2(args, lds, G); } SEAM(5);
    if (IN(6)) { phase_m3(args, G); } SEAM(6);
    if (IN(7)) { pg8::Gemm g{(const bf16*)(ws + WS_MIX), (const bf16*)(ob + DO_WOUT), MP, D, D}; pg8::StaticOrder S; S.init(MP, D, G, (int)blockIdx.x, D);
        EpiX1 E{args.in[I_XP], args.in[I_XS], args.in[I_META], args.out, (bf16*)(ws + WS_X1B), (float*)(ws + WS_SSQ1)};
        pg8::gemm_phase<EpiX1, pg8::StaticOrder, true, true>(lds, g, S, E); } SEAM(7);
    if (IN(8)) { pg8::Gemm g{(const bf16*)(ws + WS_X1B), (const bf16*)(ws + WS_WUP), MP, DFF, D}; pg8::StaticOrder S; S.init(MP, DFF, G, (int)blockIdx.x, D);
        EpiUp E{(const float*)(ws + WS_SSQ1), (bf16*)(ws + WS_UP), args.out + O_PFC, args.out + O_SFC};
        pg8::gemm_phase<EpiUp, pg8::StaticOrder, true, true>(lds, g, S, E); } SEAM(8);
    if (IN(9)) { pg8::Gemm g{(const bf16*)(ws + WS_X1B), (const bf16*)(ws + WS_WGATE), M_MAIN, DFF, D}; pg8::StaticOrder S; S.init(M_MAIN, DFF, G, (int)blockIdx.x, D);
        EpiGate E{(const float*)(ws + WS_SSQ1), (const bf16*)(ws + WS_UP), args.in[I_SFC], args.in[I_FCW], args.in[I_FCB], (bf16*)(ws + WS_HID)};
        pg8::gemm_phase<EpiGate, pg8::StaticOrder, true, true>(lds, g, S, E); } SEAM(9);
    if (IN(10)) { pg8::Gemm g{(const bf16*)(ws + WS_HID), (const bf16*)(ws + WS_WDOWN), M_MAIN, D, DFF}; DownOrder S; S.init(G, (int)blockIdx.x);
        EpiDown E{args.out, (const bf16*)(ws + WS_X1B)};
        pg8::gemm_phase<EpiDown, DownOrder, true, true>(lds, g, S, E); } SEAM(10);
    if (IN(11)) { phase_final(args, G); }
#undef IN
#undef SEAM
}

extern "C" void kernel_launch(void* const* d_in, const int* in_sizes, int n_in, void* d_out, int out_size, void* d_ws, size_t ws_size, hipStream_t stream) {
    static int grid = 0;
    if (grid == 0) {
        if (n_in != N_IN || (size_t)out_size != O_END || ws_size < 256 * MiB) { fprintf(stderr, "kernel_launch: unexpected shapes n_in %d out %d ws %zu\n", n_in, out_size, ws_size); grid = -1; return; }
        int dev = 0, cus = 0, per_cu = 0;
        (void)hipGetDevice(&dev); (void)hipDeviceGetAttribute(&cus, hipDeviceAttributeMultiprocessorCount, dev);
        if (hipFuncSetAttribute((const void*)mk_fwd, hipFuncAttributeMaxDynamicSharedMemorySize, LDS_BYTES) != hipSuccess) { fprintf(stderr, "kernel_launch: hipFuncSetAttribute failed\n"); grid = -1; return; }
        if (hipOccupancyMaxActiveBlocksPerMultiprocessor(&per_cu, (const void*)mk_fwd, 512, LDS_BYTES) != hipSuccess || per_cu < 1) per_cu = 1;
        (void)hipGetLastError();
        grid = cus > 0 ? cus : 256;
    }
    if (grid < 0) return;
    Args a{};
    for (int i = 0; i < N_IN; ++i) a.in[i] = (const float*)d_in[i];
    a.out = (float*)d_out; a.ws = (unsigned char*)d_ws;
#if MK_ONE_LAUNCH
    (void)hipMemsetAsync((char*)d_ws + WS_CTL, 0, CTL_ZERO_BYTES, stream);
    a.ph_lo = 0; a.ph_hi = NPH;
    void* kargs[] = {&a};
    hipError_t e = hipLaunchCooperativeKernel((const void*)mk_fwd, dim3(grid), dim3(512), kargs, LDS_BYTES, stream);
    if (e != hipSuccess) fprintf(stderr, "cooperative launch failed: %s (grid %d)\n", hipGetErrorString(e), grid);
#else
    for (int ph = 0; ph < NPH; ++ph) for (int rep = 0; rep < 1 + ((MK_REP_MASK >> ph) & 1); ++rep) { a.ph_lo = ph; a.ph_hi = ph + 1; hipLaunchKernelGGL(mk_fwd, dim3(grid), dim3(512), LDS_BYTES, stream, a); }
#endif
}
```

```cpp
#include <hip/hip_runtime.h>
#include <hip/hip_cooperative_groups.h>
#include <cstdio>
#include <cstdint>
#include <cmath>
__device__ __forceinline__ int my_tid() { int t = threadIdx.x; asm volatile("" : "+v"(t)); return t; }
namespace pg8 {
#define PG8_LAS __attribute__((address_space(3)))
typedef unsigned short bf16_t;
typedef short bf16x8 __attribute__((ext_vector_type(8)));
typedef float f32x4 __attribute__((ext_vector_type(4)));
typedef unsigned u32x4 __attribute__((ext_vector_type(4)));
constexpr int BM = 256, BK = 64, HALF = 128, HTB = HALF * BK * 2  , STAGE_BYTES = 8 * HTB, NXCD = 8, WGM = 8;

__host__ __device__ __forceinline__ int lds_byte(int r, int c) { const int st = (r >> 4) * 2 + (c >> 5), rr = r & 15, cc = c & 31, ob = rr * 64 + cc * 2; return st * 1024 + (ob ^ (((ob >> 9) & 1) << 5)); }
__host__ __device__ __forceinline__ void stage_rc(int b, int& R, int& C) { const int st = b / 1024, sb = b % 1024, swz = sb ^ (((sb >> 9) & 1) << 5); R = (st >> 1) * 16 + swz / 64; C = (st & 1) * 32 + (swz % 64) / 2; }
__host__ __device__ __forceinline__ int perm32(int rho) { const int n = rho >> 4, i = rho & 15; return 8 * (i >> 2) + 4 * n + (i & 3); }

struct Unit { int pm, pn, ko, nt; };
struct Gemm { const bf16_t* A; const bf16_t* Bt; int M, N, K; };

struct StaticOrder {
    int nM, nN, nwg, G, c, ntk;
    __host__ __device__ void init(int M, int N, int G_, int c_, int K_) { nM = M / BM; nN = N / BM; nwg = nM * nN; G = G_; c = c_; ntk = K_ / BK; }
    __host__ __device__ bool next(int i, Unit& u) const {
        const long L = (long)i * G + c; if (L >= nwg) return false;
        int wgid = (int)L; { const int q = nwg / NXCD, r = nwg % NXCD, xcd = wgid % NXCD, off = wgid / NXCD; wgid = (xcd < r ? xcd * (q + 1) : r * (q + 1) + (xcd - r) * q) + off; }
        const int nig = WGM * nN, gid = wgid / nig, fm = gid * WGM, gsz = (nM - fm) < WGM ? (nM - fm) : WGM;
        u.pm = fm + ((wgid % nig) % gsz); u.pn = (wgid % nig) / gsz; u.ko = 0; u.nt = ntk; return true;
    }
    __device__ __forceinline__ void a_ready(const Unit&) const {}
    __device__ __forceinline__ void done(const Unit&) const {}
};

__device__ __forceinline__ unsigned cvt_pk_bf16(float lo, float hi) { unsigned r; asm volatile("v_cvt_pk_bf16_f32 %0, %1, %2" : "=v"(r) : "v"(lo), "v"(hi)); return r; }
typedef float f32x2 __attribute__((ext_vector_type(2)));
template <class Epi, class Sched, bool ALIGN_EPI = false, bool SP2 = false>
__device__ __forceinline__ void gemm_phase(PG8_LAS unsigned char* lds, const Gemm g, const Sched& S, const Epi& E) {
    const int tid = my_tid(), wid = __builtin_amdgcn_readfirstlane(tid >> 6), lane = tid & 63, wr = wid >> 2, wc = wid & 3, fr = lane & 15, fq = lane >> 4;
    const int K = g.K;
    unsigned voffA[2], voffB[2];
#pragma unroll
    for (int i = 0; i < 2; ++i) { int R, C; stage_rc(tid * 16 + i * 8192, R, C); const int Rb = Epi::PERM ? ((R & ~31) + perm32(R & 31)) : R;
        voffA[i] = (unsigned)(R * K + C) * 2u; voffB[i] = (unsigned)(Rb * K + C) * 2u; }
    const size_t kstep = (size_t)(BK * 2);
    const size_t hstep = (size_t)HALF * K * 2;
    const size_t tstep = 2 * hstep;
    const unsigned ldsw = (unsigned)wid * 1024u;
    const int aoff = lds_byte(wr * 64 + fr, fq * 8), boff = lds_byte(wc * 32 + fr, fq * 8);
#define PG8_SA(b, h) (((b) * 2 + (h)) * HTB)
#define PG8_SB(b, h) ((4 + (b) * 2 + (h)) * HTB)
#define PG8_STAGE(bufoff, gbase, voff) do { _Pragma("unroll") for (int _i = 0; _i < 2; ++_i) \
        __builtin_amdgcn_global_load_lds((const unsigned*)((const char*)(gbase) + (voff)[_i]), (PG8_LAS unsigned*)(lds + (bufoff) + ldsw + _i * 8192), 16, 0, 0); } while (0)
#define PG8_LDA(dst, b, h) do { _Pragma("unroll") for (int m = 0; m < 4; ++m) _Pragma("unroll") for (int k = 0; k < 2; ++k) dst[m][k] = *(const PG8_LAS bf16x8*)(lds + PG8_SA(b, h) + aoff + m * 2048 + k * 1024); } while (0)
#define PG8_LDB(dst, b, h) do { _Pragma("unroll") for (int n = 0; n < 2; ++n) _Pragma("unroll") for (int k = 0; k < 2; ++k) dst[n][k] = *(const PG8_LAS bf16x8*)(lds + PG8_SB(b, h) + boff + n * 2048 + k * 1024); } while (0)
#define PG8_MMA(ai, bj, At, Bt) do { __builtin_amdgcn_s_setprio(1); _Pragma("unroll") for (int m = 0; m < 4; ++m) _Pragma("unroll") for (int n = 0; n < 2; ++n) _Pragma("unroll") for (int k = 0; k < 2; ++k) \
        acc[ai][bj][m][n] = __builtin_amdgcn_mfma_f32_16x16x32_bf16(Bt[n][k], At[m][k], acc[ai][bj][m][n], 0, 0, 0); __builtin_amdgcn_s_setprio(0); } while (0)
#define PG8_WAIT_V(n) asm volatile("s_waitcnt vmcnt(" #n ")" ::: "memory")
#define PG8_WAIT_L(n) asm volatile("s_waitcnt lgkmcnt(" #n ")" ::: "memory")
#define PG8_BAR __builtin_amdgcn_s_barrier()
#define PG8_SCHED __builtin_amdgcn_sched_barrier(0)
    Unit cur, nxt; int ui = 0;
    if (!S.next(0, cur)) return;
    f32x4 acc[2][2][4][2];
#pragma unroll
    for (int a = 0; a < 2; ++a)
#pragma unroll
        for (int b = 0; b < 2; ++b)
#pragma unroll
            for (int m = 0; m < 4; ++m)
#pragma unroll
                for (int n = 0; n < 2; ++n) acc[a][b][m][n] = (f32x4){0.f, 0.f, 0.f, 0.f};
    bf16x8 At[4][2], B0[2][2], B1[2][2];
    const char* cA = (const char*)g.A + (size_t)cur.pm * tstep + (size_t)cur.ko * 2; const char* cB = (const char*)g.Bt + (size_t)cur.pn * tstep + (size_t)cur.ko * 2;
    S.a_ready(cur);
    if constexpr (SP2) {
        PG8_STAGE(PG8_SB(0, 0), cB, voffB); PG8_STAGE(PG8_SB(0, 1), cB + hstep, voffB); PG8_STAGE(PG8_SA(0, 0), cA, voffA); PG8_STAGE(PG8_SA(0, 1), cA + hstep, voffA);
        if (wr == 1) PG8_BAR;
        PG8_WAIT_V(2); PG8_BAR;
        PG8_STAGE(PG8_SB(1, 0), cB + kstep, voffB); PG8_STAGE(PG8_SA(1, 0), cA + kstep, voffA); PG8_STAGE(PG8_SB(1, 1), cB + hstep + kstep, voffB);
        PG8_WAIT_V(6); PG8_BAR;
    } else {
        PG8_STAGE(PG8_SB(0, 0), cB, voffB); PG8_STAGE(PG8_SA(0, 0), cA, voffA); PG8_STAGE(PG8_SB(0, 1), cB + hstep, voffB); PG8_STAGE(PG8_SA(0, 1), cA + hstep, voffA);
        if (wr == 1) PG8_BAR;
        PG8_WAIT_V(4); PG8_BAR;
        PG8_STAGE(PG8_SB(1, 0), cB + kstep, voffB); PG8_STAGE(PG8_SA(1, 0), cA + kstep, voffA); PG8_STAGE(PG8_SB(1, 1), cB + hstep + kstep, voffB);
        PG8_WAIT_V(6); PG8_BAR;
    }
    for (;;) {
        const bool has_next = S.next(ui + 1, nxt);
        const char* nA = has_next ? (const char*)g.A + (size_t)nxt.pm * tstep + (size_t)nxt.ko * 2 : cA; const char* nB = has_next ? (const char*)g.Bt + (size_t)nxt.pn * tstep + (size_t)nxt.ko * 2 : cB;
        const int nt = cur.nt;
        for (int t = 0; t < nt; t += 2) {
            const bool last = (t == nt - 2);
            const char* a1 = cA + (size_t)(t + 1) * kstep;
            const char* a2 = last ? nA : cA + (size_t)(t + 2) * kstep; const char* b2 = last ? nB : cB + (size_t)(t + 2) * kstep;
            const char* a3 = a2 + kstep; const char* b3 = b2 + kstep;
            if (last && has_next) S.a_ready(nxt);
            if constexpr (SP2) {
            PG8_LDB(B0, 0, 0); PG8_LDB(B1, 0, 1); PG8_SCHED; PG8_LDA(At, 0, 0); PG8_STAGE(PG8_SA(1, 1), a1 + hstep, voffA);
            PG8_WAIT_V(8); PG8_WAIT_L(0); PG8_BAR; PG8_MMA(0, 0, At, B0); PG8_MMA(0, 1, At, B1); PG8_BAR; PG8_SCHED;
            PG8_LDA(At, 0, 1); PG8_STAGE(PG8_SB(0, 0), b2, voffB); PG8_STAGE(PG8_SB(0, 1), b2 + hstep, voffB); PG8_STAGE(PG8_SA(0, 0), a2, voffA);
            PG8_WAIT_V(8); PG8_WAIT_L(0); PG8_BAR; PG8_MMA(1, 0, At, B0); PG8_MMA(1, 1, At, B1); PG8_BAR; PG8_SCHED;
            PG8_LDB(B0, 1, 0); PG8_LDB(B1, 1, 1); PG8_SCHED; PG8_LDA(At, 1, 0); PG8_STAGE(PG8_SA(0, 1), a2 + hstep, voffA);
            PG8_WAIT_V(8); PG8_WAIT_L(0); PG8_BAR; PG8_MMA(0, 0, At, B0); PG8_MMA(0, 1, At, B1); PG8_BAR; PG8_SCHED;
            PG8_LDA(At, 1, 1); PG8_STAGE(PG8_SB(1, 0), b3, voffB); PG8_STAGE(PG8_SB(1, 1), b3 + hstep, voffB); PG8_STAGE(PG8_SA(1, 0), a3, voffA);
            PG8_WAIT_V(8); PG8_WAIT_L(0); PG8_BAR; PG8_MMA(1, 0, At, B0); PG8_MMA(1, 1, At, B1); PG8_BAR; PG8_SCHED;
            } else {
            PG8_LDB(B0, 0, 0); PG8_SCHED; PG8_LDA(At, 0, 0); PG8_STAGE(PG8_SA(1, 1), a1 + hstep, voffA);
            PG8_WAIT_L(8); PG8_BAR; PG8_WAIT_L(0); PG8_MMA(0, 0, At, B0); PG8_BAR; PG8_SCHED;
            PG8_LDB(B1, 0, 1); PG8_STAGE(PG8_SB(0, 0), b2, voffB);
            PG8_BAR; PG8_WAIT_L(0); PG8_MMA(0, 1, At, B1); PG8_BAR;
            PG8_LDA(At, 0, 1); PG8_STAGE(PG8_SA(0, 0), a2, voffA);
            PG8_BAR; PG8_WAIT_L(0); PG8_MMA(1, 0, At, B0); PG8_BAR; PG8_SCHED;
            PG8_STAGE(PG8_SB(0, 1), b2 + hstep, voffB);
            PG8_WAIT_V(6); PG8_BAR; PG8_MMA(1, 1, At, B1); PG8_BAR;
            PG8_LDB(B0, 1, 0); PG8_SCHED; PG8_LDA(At, 1, 0); PG8_STAGE(PG8_SA(0, 1), a2 + hstep, voffA);
            PG8_WAIT_L(8); PG8_BAR; PG8_WAIT_L(0); PG8_MMA(0, 0, At, B0); PG8_BAR; PG8_SCHED;
            PG8_LDB(B1, 1, 1); PG8_STAGE(PG8_SB(1, 0), b3, voffB);
            PG8_BAR; PG8_WAIT_L(0); PG8_MMA(0, 1, At, B1); PG8_BAR;
            PG8_LDA(At, 1, 1); PG8_STAGE(PG8_SA(1, 0), a3, voffA);
            PG8_BAR; PG8_WAIT_L(0); PG8_MMA(1, 0, At, B0); PG8_BAR; PG8_SCHED;
            PG8_STAGE(PG8_SB(1, 1), b3 + hstep, voffB);
            PG8_WAIT_V(6); PG8_BAR; PG8_MMA(1, 1, At, B1); PG8_BAR;
            }
        }
        if constexpr (ALIGN_EPI) { if (wr == 0) PG8_BAR; }
        if constexpr (!Epi::AFTER_DRAIN) { E(acc, cur, wr, wc, fr, fq); S.done(cur); }
        if (!has_next) break;
#pragma unroll
        for (int a = 0; a < 2; ++a)
#pragma unroll
            for (int b = 0; b < 2; ++b)
#pragma unroll
                for (int m = 0; m < 4; ++m)
#pragma unroll
                    for (int n = 0; n < 2; ++n) acc[a][b][m][n] = (f32x4){0.f, 0.f, 0.f, 0.f};
        cur = nxt; cA = nA; cB = nB; ++ui;
        if constexpr (ALIGN_EPI) { if (wr == 1) PG8_BAR; }
    }
    PG8_WAIT_V(0);
    if constexpr (!ALIGN_EPI) { if (wr == 0) PG8_BAR; }
    PG8_BAR;
    if constexpr (Epi::AFTER_DRAIN) { E.fused(acc, cur, wr, wc, fr, fq, lds, wid, lane); S.done(cur); }
#undef PG8_SA
#undef PG8_SB
#undef PG8_STAGE
#undef PG8_LDA
#undef PG8_LDB
#undef PG8_MMA
#undef PG8_WAIT_V
#undef PG8_WAIT_L
#undef PG8_BAR
#undef PG8_SCHED
}
}

#ifndef MK_REP_MASK
#define MK_REP_MASK 0
#endif
#ifndef MK_ONE_LAUNCH
#define MK_ONE_LAUNCH 1
#endif
#define LAS __attribute__((address_space(3)))
typedef unsigned short bf16;
typedef float f32x4 __attribute__((ext_vector_type(4)));
typedef unsigned u32x4 __attribute__((ext_vector_type(4)));
typedef unsigned u32x2 __attribute__((ext_vector_type(2)));
constexpr int D = 1024, NB = 8, SEQ = 2048, NMETA = 16, TP = SEQ + NMETA, DB = 128, DS = 4;
constexpr int NH = 8, DTMP = 1792, DIN = 2816, DFF = 3072;
constexpr int R_SAMPLE = NB * SEQ, R_META = R_SAMPLE + DB * DS, R_END = R_META + NMETA, MP = 17152, M_MAIN = 16896;
constexpr float EPS = 1e-6f, GN_EPS = 64e-5f;
constexpr int NPH = 12;
constexpr int LDS_BYTES = 147456;
enum { I_XP = 0, I_XS, I_STS, I_SWKV, I_SLC, I_SLH, I_SFC, I_META, I_N1G, I_WIN, I_MU, I_W0, I_WUP, I_A0, I_AUP, I_GUP, I_KK, I_KA, I_RK,
       I_GNG, I_GNB, I_LCW, I_LCB, I_LWA, I_LBA, I_LWX, I_LBX, I_LAM, I_LOG, I_WOUT, I_N2G, I_FUP, I_FGATE, I_FCW, I_FCB, I_FDOWN, I_NFG, N_IN };
constexpr size_t O_YP = 0, O_YS = 16777216, O_PSHIFT = 17301504, O_PWKV = 17315840, O_PLC = 17577984, O_PLH = 17590272, O_PFC = 17594368,
                 O_SSHIFT = 17643520, O_SWKV = 17872896, O_SLC = 22067200, O_SLH = 22263808, O_SFC = 22329344, O_END = 23115776;
constexpr size_t MiB = 1u << 20;
constexpr size_t WS_CTL = 0, CTL_ZERO_BYTES = 65536;
constexpr size_t WS_SSQ1 = 1 * MiB, WS_SSQ2 = WS_SSQ1 + (size_t)MP * 16 * 4;
constexpr size_t WS_WUP = 4 * MiB, WS_WGATE = 10 * MiB, WS_WDOWN = 16 * MiB;
constexpr size_t WS_X1B = 22 * MiB, WS_UP = WS_X1B + (size_t)MP * D * 2, WS_HID = WS_UP + (size_t)MP * DFF * 2;
constexpr size_t WS_U = 22 * MiB;
constexpr size_t WS_XN = 115 * MiB, WS_WIN = WS_XN + (size_t)MP * D * 2;
constexpr size_t WS_AP = 190 * MiB, WS_XC = 199 * MiB, WS_BA = 216 * MiB, WS_BB = 217 * MiB, WS_GB = 220 * MiB;
constexpr size_t WS_REC = 115 * MiB, WS_LRU = 182 * MiB, WS_Y = 220 * MiB, WS_MIX = 115 * MiB;
static_assert(WS_SSQ2 + (size_t)MP * 16 * 4 <= WS_WUP, "ssq");
static_assert(WS_HID + (size_t)M_MAIN * DFF * 2 <= 256 * MiB, "hid");
static_assert(WS_U + (size_t)MP * DIN * 2 <= WS_XN, "u");
static_assert(WS_WIN + (size_t)DIN * D * 2 <= WS_LRU, "win");
static_assert(WS_AP + (size_t)MP * 256 * 2 <= WS_XC && WS_XC + (size_t)MP * 512 * 2 <= WS_BA, "ap/xc");
static_assert(WS_GB + (size_t)MP * 1024 * 2 <= 256 * MiB, "gb");
static_assert(WS_REC + (size_t)R_END * 4096 <= WS_LRU && WS_LRU + (size_t)R_END * 2048 <= WS_BA, "rec/lru");
static_assert(WS_Y + (size_t)R_END * 2048 <= 256 * MiB, "y");
constexpr size_t DO_GA = 0, DO_LTOT = (size_t)MP * 1536 * 2, DO_CARRY = DO_LTOT + 513 * 2 * 512 * 4, DO_BON = DO_CARRY + 8 * 64 * 512 * 4, DO_WOUT = O_SFC * 4;
static_assert(DO_BON + (size_t)R_END * 8 * 4 <= O_PSHIFT * 4, "d_out scratch");

struct Args { const float* in[N_IN]; float* out; unsigned char* ws; int ph_lo, ph_hi; };

__device__ __forceinline__ float bf2f(bf16 h) { return __uint_as_float(((unsigned)h) << 16); }
__device__ __forceinline__ unsigned f2bf(float f) { unsigned u = __float_as_uint(f); return (u + 0x7fffu + ((u >> 16) & 1u)) >> 16; }
typedef float f32x2_t __attribute__((ext_vector_type(2))); typedef __bf16 bf16x2_t __attribute__((ext_vector_type(2)));
__device__ __forceinline__ unsigned pk2(float lo, float hi) { const f32x2_t v = {lo, hi}; const bf16x2_t b = __builtin_convertvector(v, bf16x2_t); return __builtin_bit_cast(unsigned, b); }
__device__ __forceinline__ float lo16(unsigned w) { return __uint_as_float(w << 16); }
__device__ __forceinline__ float hi16(unsigned w) { return __uint_as_float(w & 0xffff0000u); }
__device__ __forceinline__ float sigm(float x) { return __builtin_amdgcn_rcpf(1.f + __builtin_amdgcn_exp2f(-1.4426950409f * x)); }
__device__ __forceinline__ float softplus_(float z) { return fmaxf(z, 0.f) + log1pf(__expf(-fabsf(z))); }
__device__ __forceinline__ float gelu_tanh(float x) { const float t = x * (-2.3022082f + -0.10294324f * (x * x)); return x * __builtin_amdgcn_rcpf(1.f + __builtin_amdgcn_exp2f(t)); }
__device__ __forceinline__ float tanh_(float x) { const float e = __builtin_amdgcn_exp2f(2.8853900818f * x); return 1.f - 2.f * __builtin_amdgcn_rcpf(e + 1.f); }
__device__ __forceinline__ float wave_sum(float v) {
#pragma unroll
    for (int o = 1; o < 64; o <<= 1) v += __shfl_xor(v, o);
    return v;
}
template <int CTRL> __device__ __forceinline__ float dpp_f(float x) { return __int_as_float(__builtin_amdgcn_update_dpp(0, __float_as_int(x), CTRL, 0xF, 0xF, true)); }
__device__ __forceinline__ float allsum16(float x) { x += dpp_f<0xB1>(x); x += dpp_f<0x4E>(x); x += dpp_f<0x141>(x); x += dpp_f<0x140>(x); return x; }

struct RowInfo { int kind, b, t; };
__device__ __forceinline__ RowInfo row_info(int row) {
    RowInfo r;
    if (row < R_SAMPLE) { r.kind = 0; r.b = row >> 11; r.t = (row & 2047) + NMETA; }
    else if (row < R_META) { r.kind = 1; r.b = (row - R_SAMPLE) >> 2; r.t = (row - R_SAMPLE) & 3; }
    else if (row < R_END) { r.kind = 2; r.b = 0; r.t = row - R_META; }
    else { r.kind = 3; r.b = 0; r.t = 0; }
    return r;
}
__device__ __forceinline__ int prompt_row(int b, int t) { return t < NMETA ? R_META + t : b * SEQ + t - NMETA; }
__device__ __forceinline__ int row_back(const RowInfo& ri, int row, int j) {
    const int tt = ri.t - j; if (tt < 0) return -1;
    if (ri.kind == 1) return row - j;
    return prompt_row(ri.b, tt);
}
__device__ __forceinline__ void unpack8(const u32x4 w, float (&f)[8]) {
    f[0] = lo16(w.x); f[1] = hi16(w.x); f[2] = lo16(w.y); f[3] = hi16(w.y); f[4] = lo16(w.z); f[5] = hi16(w.z); f[6] = lo16(w.w); f[7] = hi16(w.w);
}
__device__ __forceinline__ void ld8f(const float* p, float (&f)[8]) { const f32x4 a = *(const f32x4*)p, b = *(const f32x4*)(p + 4); f[0] = a.x; f[1] = a.y; f[2] = a.z; f[3] = a.w; f[4] = b.x; f[5] = b.y; f[6] = b.z; f[7] = b.w; }
__device__ __forceinline__ u32x4 pack8(const float (&o)[8]) { u32x4 w; w.x = pk2(o[0], o[1]); w.y = pk2(o[2], o[3]); w.z = pk2(o[4], o[5]); w.w = pk2(o[6], o[7]); return w; }
__device__ __forceinline__ float row_rs(const float* ssq, int row) {
    const f32x4* p = (const f32x4*)(ssq + (size_t)row * 16); const f32x4 a = p[0], b = p[1], c = p[2], d = p[3];
    const float s = ((a.x + a.y) + (a.z + a.w)) + ((b.x + b.y) + (b.z + b.w)) + ((c.x + c.y) + (c.z + c.w)) + ((d.x + d.y) + (d.z + d.w));
    return __builtin_amdgcn_rsqf(s * (1.f / 1024.f) + EPS);
}

#define EPI_ROW(ai, m) (u.pm * 256 + (ai) * 128 + wr * 64 + (m) * 16 + fr)
#define EPI_COL(bj) (u.pn * 256 + (bj) * 128 + wc * 32 + 8 * fq)
struct EpiX1 {
    static constexpr bool PERM = true, AFTER_DRAIN = false;
    const float* __restrict__ xp; const float* __restrict__ xs; const float* __restrict__ meta; float* __restrict__ x1; bf16* __restrict__ x1b; float* __restrict__ ssq;
    __device__ __forceinline__ void operator()(const f32x4 (&acc)[2][2][4][2], const pg8::Unit& u, int wr, int wc, int fr, int fq) const {
#pragma unroll
        for (int ai = 0; ai < 2; ++ai)
#pragma unroll
            for (int m = 0; m < 4; ++m) {
                const int row = EPI_ROW(ai, m);
                const float* res = row < R_SAMPLE ? xp + (size_t)row * D : row < R_META ? xs + (size_t)(row - R_SAMPLE) * D : row < R_END ? meta + (size_t)(row - R_META) * D : nullptr;
                float s = 0.f;
#pragma unroll
                for (int bj = 0; bj < 2; ++bj) {
                    const int col = EPI_COL(bj);
                    f32x4 v0 = acc[ai][bj][m][0], v1 = acc[ai][bj][m][1];
                    if (res) { v0 += *(const f32x4*)(res + col); v1 += *(const f32x4*)(res + col + 4); }
                    if (row >= R_SAMPLE && row < M_MAIN) { *(f32x4*)(x1 + (size_t)row * D + col) = v0; *(f32x4*)(x1 + (size_t)row * D + col + 4) = v1; }
                    u32x4 w; w.x = pk2(v0.x, v0.y); w.y = pk2(v0.z, v0.w); w.z = pk2(v1.x, v1.y); w.w = pk2(v1.z, v1.w);
                    *(u32x4*)(x1b + (size_t)row * D + col) = w;
                    s += (v0.x * v0.x + v0.y * v0.y) + (v0.z * v0.z + v0.w * v0.w) + (v1.x * v1.x + v1.y * v1.y) + (v1.z * v1.z + v1.w * v1.w);
                }
                s += __shfl_xor(s, 16); s += __shfl_xor(s, 32);
                if (fq == 0) ssq[(size_t)row * 16 + u.pn * 4 + wc] = s;
            }
    }
};
struct EpiUp {
    static constexpr bool PERM = true, AFTER_DRAIN = false;
    const float* __restrict__ ssq; bf16* __restrict__ up; float* __restrict__ pffn; float* __restrict__ sffn;
    __device__ __forceinline__ void operator()(const f32x4 (&acc)[2][2][4][2], const pg8::Unit& u, int wr, int wc, int fr, int fq) const {
#pragma unroll
        for (int ai = 0; ai < 2; ++ai)
#pragma unroll
            for (int m = 0; m < 4; ++m) {
                const int row = EPI_ROW(ai, m);
                const float rs = row_rs(ssq, row);
                const RowInfo ri = row_info(row);
                float* st = nullptr;
                if (ri.kind == 0 && ri.t >= TP - 2) st = pffn + ((size_t)ri.b * 2 + (ri.t - (TP - 2))) * DFF;
                else if (ri.kind == 1 && ri.t >= 2) st = sffn + ((size_t)ri.b * 2 + (ri.t - 2)) * DFF;
#pragma unroll
                for (int bj = 0; bj < 2; ++bj) {
                    const int col = EPI_COL(bj);
                    const f32x4 v0 = acc[ai][bj][m][0] * rs, v1 = acc[ai][bj][m][1] * rs;
                    u32x4 w; w.x = pk2(v0.x, v0.y); w.y = pk2(v0.z, v0.w); w.z = pk2(v1.x, v1.y); w.w = pk2(v1.z, v1.w);
                    *(u32x4*)(up + (size_t)row * DFF + col) = w;
                    if (st) { *(f32x4*)(st + col) = v0; *(f32x4*)(st + col + 4) = v1; }
                }
            }
    }
};
struct EpiGate {
    static constexpr bool PERM = true, AFTER_DRAIN = false;
    const float* ssq; const bf16* up; const float* stf; const float* cw; const float* cb; bf16* hid;
    __device__ __forceinline__ void operator()(const f32x4 (&acc)[2][2][4][2], const pg8::Unit& u, int wr, int wc, int fr, int fq) const {
#pragma unroll
        for (int ai = 0; ai < 2; ++ai)
#pragma unroll
            for (int m = 0; m < 4; ++m) {
                const int row = EPI_ROW(ai, m);
                const float rs = row_rs(ssq, row);
                const RowInfo ri = row_info(row);
                const int r1 = row_back(ri, row, 1), r2 = row_back(ri, row, 2);
#pragma unroll
                for (int bj = 0; bj < 2; ++bj) {
                    const int col = EPI_COL(bj);
                    float g[8], u0[8], p1[8], p2[8];
                    { const f32x4 v0 = acc[ai][bj][m][0] * rs, v1 = acc[ai][bj][m][1] * rs; g[0] = v0.x; g[1] = v0.y; g[2] = v0.z; g[3] = v0.w; g[4] = v1.x; g[5] = v1.y; g[6] = v1.z; g[7] = v1.w; }
                    unpack8(*(const u32x4*)(up + (size_t)row * DFF + col), u0);
                    if (r1 >= 0) unpack8(*(const u32x4*)(up + (size_t)r1 * DFF + col), p1);
                    else if (ri.kind == 1) { const float* s = stf + ((size_t)ri.b * 2 + (1 + ri.t)) * DFF + col; const f32x4 a = *(const f32x4*)s, b = *(const f32x4*)(s + 4);
                        p1[0] = a.x; p1[1] = a.y; p1[2] = a.z; p1[3] = a.w; p1[4] = b.x; p1[5] = b.y; p1[6] = b.z; p1[7] = b.w; }
                    else {
#pragma unroll
                        for (int i = 0; i < 8; ++i) p1[i] = 0.f; }
                    if (r2 >= 0) unpack8(*(const u32x4*)(up + (size_t)r2 * DFF + col), p2);
                    else if (ri.kind == 1) { const float* s = stf + ((size_t)ri.b * 2 + ri.t) * DFF + col; const f32x4 a = *(const f32x4*)s, b = *(const f32x4*)(s + 4);
                        p2[0] = a.x; p2[1] = a.y; p2[2] = a.z; p2[3] = a.w; p2[4] = b.x; p2[5] = b.y; p2[6] = b.z; p2[7] = b.w; }
                    else {
#pragma unroll
                        for (int i = 0; i < 8; ++i) p2[i] = 0.f; }
                    float o[8];
#pragma unroll
                    for (int h = 0; h < 2; ++h) {
                        const f32x4 w0 = *(const f32x4*)(cw + col + 4 * h), w1 = *(const f32x4*)(cw + DFF + col + 4 * h), w2 = *(const f32x4*)(cw + 2 * DFF + col + 4 * h), bb = *(const f32x4*)(cb + col + 4 * h);
#pragma unroll
                        for (int i = 0; i < 4; ++i) { const int e = 4 * h + i; const float c = bb[i] + w0[i] * p2[e] + w1[i] * p1[e] + w2[i] * u0[e]; o[e] = gelu_tanh(c) * g[e]; }
                    }
                    u32x4 w; w.x = pk2(o[0], o[1]); w.y = pk2(o[2], o[3]); w.z = pk2(o[4], o[5]); w.w = pk2(o[6], o[7]);
                    *(u32x4*)(hid + (size_t)row * DFF + col) = w;
                }
            }
    }
};
struct EpiDown {
    static constexpr bool PERM = true, AFTER_DRAIN = false;
    float* __restrict__ x; const bf16* __restrict__ x1b;
    __device__ __forceinline__ void operator()(const f32x4 (&acc)[2][2][4][2], const pg8::Unit& u, int wr, int wc, int fr, int fq) const {
        const bool part = u.nt != DFF / 64;
#pragma unroll
        for (int ai = 0; ai < 2; ++ai)
#pragma unroll
            for (int m = 0; m < 4; ++m) {
                const int row = EPI_ROW(ai, m);
#pragma unroll
                for (int bj = 0; bj < 2; ++bj) {
                    const int col = EPI_COL(bj);
                    float* p = x + (size_t)row * D + col;
                    if (part) {
#pragma unroll
                        for (int i = 0; i < 4; ++i) { unsafeAtomicAdd(p + i, acc[ai][bj][m][0][i]); unsafeAtomicAdd(p + 4 + i, acc[ai][bj][m][1][i]); }
                    } else {
                        float r8[8]; unpack8(*(const u32x4*)(x1b + (size_t)row * D + col), r8);
                        const f32x4 v0 = acc[ai][bj][m][0] + (f32x4){r8[0], r8[1], r8[2], r8[3]}, v1 = acc[ai][bj][m][1] + (f32x4){r8[4], r8[5], r8[6], r8[7]};
                        *(f32x4*)p = v0; *(f32x4*)(p + 4) = v1;
                    }
                }
            }
    }
};
struct DownOrder {
    pg8::StaticOrder base; int G, c;
    __device__ void init(int G_, int c_) { base.init(R_SAMPLE, D, G_, c_, DFF); G = G_; c = c_; }
    __device__ bool next(int i, pg8::Unit& u) const {
        const int nb = (256 - c + G - 1) / G;
        if (i < nb) return base.next(i, u);
        const int j = (i - nb) * G + c; if (j >= 48) return false;
        u.pm = 64 + j / 24; u.pn = (j / 6) % 4; u.ko = (j % 6) * 512; u.nt = 8; return true;
    }
    __device__ __forceinline__ void a_ready(const pg8::Unit&) const {}
    __device__ __forceinline__ void done(const pg8::Unit&) const {}
};
struct EpiPlain {
    static constexpr bool PERM = true, AFTER_DRAIN = false;
    bf16* O; int ldc;
    __device__ __forceinline__ void operator()(const f32x4 (&acc)[2][2][4][2], const pg8::Unit& u, int wr, int wc, int fr, int fq) const {
#pragma unroll
        for (int ai = 0; ai < 2; ++ai)
#pragma unroll
            for (int m = 0; m < 4; ++m) {
                const int row = EPI_ROW(ai, m);
#pragma unroll
                for (int bj = 0; bj < 2; ++bj) {
                    const int col = EPI_COL(bj);
                    const f32x4 v0 = acc[ai][bj][m][0], v1 = acc[ai][bj][m][1];
                    u32x4 w; w.x = pk2(v0.x, v0.y); w.y = pk2(v0.z, v0.w); w.z = pk2(v1.x, v1.y); w.w = pk2(v1.z, v1.w);
                    *(u32x4*)(O + (size_t)row * ldc + col) = w;
                }
            }
    }
};

#define XB_TMO      128
#define XB_XCNT(j)  (256  + 64 * (j))
#define XB_XSUB(j)  (1280 + 64 * (j))
#define XB_XGEN(j)  (2304 + 64 * (j))
#define XB_TOP      3328
#define XB_TOPGEN   3392
#define XCD_BAR_WORDS 3456
#define XB_SPIN_CAP (1u << 22)
__device__ __forceinline__ unsigned xb_ld(unsigned* p)              { return __hip_atomic_load(p, __ATOMIC_RELAXED, __HIP_MEMORY_SCOPE_AGENT); }
__device__ __forceinline__ unsigned xb_add(unsigned* p, unsigned v) { return __hip_atomic_fetch_add(p, v, __ATOMIC_RELAXED, __HIP_MEMORY_SCOPE_AGENT); }
__device__ __forceinline__ unsigned xb_xcc_id() { return (unsigned)__builtin_amdgcn_s_getreg((3 << 11) | 20) & 0xFu; }
#define XB_SPIN(cond, bar) do { unsigned _sp = 0; while (cond) { __builtin_amdgcn_s_sleep(1); \
    if ((++_sp & 255u) == 0u) { if (xb_ld(&(bar)[XB_TMO])) break; if (_sp > XB_SPIN_CAP) { atomicAdd(&(bar)[XB_TMO], 1u); break; } } } } while (0)
struct XcdBarrier { unsigned* bar; unsigned x; volatile LAS unsigned* st; };
__device__ __forceinline__ XcdBarrier xcd_barrier_post(unsigned* bar, volatile LAS unsigned* st) {
    XcdBarrier b; b.bar = bar; b.x = xb_xcc_id(); b.st = st;
    if (threadIdx.x == 0) (void)xb_add(&bar[XB_XCNT(b.x)], 1u);
    return b;
}
__device__ __forceinline__ void xcd_barrier_complete(unsigned* bar, unsigned x, unsigned& nloc, unsigned& nx) {
    const unsigned G = gridDim.x * gridDim.y * gridDim.z;
    unsigned sum, cnt, mine, sp = 0u;
    for (;;) {
        sum = 0u; cnt = 0u; mine = 0u;
#pragma unroll
        for (unsigned j = 0; j < 16; ++j) { const unsigned c = xb_ld(&bar[XB_XCNT(j)]); sum += c; cnt += (c > 0u) ? 1u : 0u; mine = (j == x) ? c : mine; }
        if (sum == G) break;
        __builtin_amdgcn_s_sleep(1);
        if ((++sp & 255u) == 0u) { if (xb_ld(&bar[XB_TMO])) break; if (sp > XB_SPIN_CAP) { atomicAdd(&bar[XB_TMO], 1u); break; } }
    }
    nloc = mine > 0u ? mine : 1u; nx = cnt > 0u ? cnt : 1u;
}
__device__ __forceinline__ void xcd_barrier(const XcdBarrier& b) {
    asm volatile("s_waitcnt vmcnt(0)" ::: "memory");
    __syncthreads();
    if (threadIdx.x == 0) {
        unsigned* bar = b.bar;
        __builtin_amdgcn_s_waitcnt(0);
        unsigned nloc = b.st[0], nx = b.st[1];
        if (nloc == 0u) { xcd_barrier_complete(bar, b.x, nloc, nx); b.st[0] = nloc; b.st[1] = nx; }
        const unsigned old = xb_add(&bar[XB_XSUB(b.x)], 1u);
        const unsigned gen = old / nloc;
        if (old + 1u == (gen + 1u) * nloc) {
            __builtin_amdgcn_fence(__ATOMIC_RELEASE, "agent");
            asm volatile("s_waitcnt vmcnt(0)" ::: "memory");
            const unsigned og = xb_add(&bar[XB_TOP], 1u);
            const unsigned tg = og / nx;
            if (og + 1u == (tg + 1u) * nx) xb_add(&bar[XB_TOPGEN], 1u);
            else XB_SPIN(xb_ld(&bar[XB_TOPGEN]) == tg, bar);
            __builtin_amdgcn_fence(__ATOMIC_ACQUIRE, "agent");
            xb_add(&bar[XB_XGEN(b.x)], 1u);
            asm volatile("s_waitcnt vmcnt(0)" ::: "memory");
        } else {
            XB_SPIN(xb_ld(&bar[XB_XGEN(b.x)]) == gen, bar);
            __builtin_amdgcn_fence(__ATOMIC_ACQUIRE, "agent");
            asm volatile("s_waitcnt vmcnt(0)" ::: "memory");
        }
    }
    __syncthreads();
}

__device__ __forceinline__ void p0_transpose_item(const float* W, int K, int N, bf16* WT, const float* ksc, LAS float* scr, int item, int lane) {
    const int nblk = N / 32, kb = item / nblk, nb = item % nblk, k0 = 64 * kb, n0 = 32 * nb;
#pragma unroll
    for (int i = 0; i < 32; ++i) { const int kk = 2 * i + (lane >> 5); float v = W[(size_t)(k0 + kk) * N + n0 + (lane & 31)]; if (ksc) v *= ksc[k0 + kk]; scr[kk * 33 + (lane & 31)] = v; }
    asm volatile("s_waitcnt lgkmcnt(0)" ::: "memory");
    const int c = lane & 7;
#pragma unroll
    for (int j = 0; j < 4; ++j) { const int n = (lane >> 3) + 8 * j; const LAS float* s = scr + (8 * c) * 33 + n;
        u32x4 o; o.x = pk2(s[0 * 33], s[1 * 33]); o.y = pk2(s[2 * 33], s[3 * 33]); o.z = pk2(s[4 * 33], s[5 * 33]); o.w = pk2(s[6 * 33], s[7 * 33]);
        *(u32x4*)(WT + (size_t)(n0 + n) * K + k0 + 8 * c) = o; }
    asm volatile("s_waitcnt lgkmcnt(0)" ::: "memory");
}
__device__ __forceinline__ void phase_p0(const Args& A, LAS unsigned char* lds, int G) {
    const int tid = my_tid(), lane = tid & 63, wave = tid >> 6;
    LAS float* scr = (LAS float*)(lds + wave * 16384);
    const int gw = blockIdx.x * 8 + wave, NGW = G * 8;
    unsigned char* ws = A.ws;
    constexpr int I_IN = 16 * 88, I_OUT = 16 * 32, I_UPI = 16 * 96, I_DN = 48 * 32, NIT = I_IN + I_OUT + 2 * I_UPI + I_DN;
    for (int it = gw; it < NIT; it += NGW) {
        int r = it;
        if (r < I_IN) { p0_transpose_item(A.in[I_WIN], D, DIN, (bf16*)(ws + WS_WIN), nullptr, scr, r, lane); continue; } r -= I_IN;
        if (r < I_OUT) { p0_transpose_item(A.in[I_WOUT], D, D, (bf16*)((unsigned char*)A.out + DO_WOUT), nullptr, scr, r, lane); continue; } r -= I_OUT;
        if (r < I_UPI) { p0_transpose_item(A.in[I_FUP], D, DFF, (bf16*)(ws + WS_WUP), A.in[I_N2G], scr, r, lane); continue; } r -= I_UPI;
        if (r < I_UPI) { p0_transpose_item(A.in[I_FGATE], D, DFF, (bf16*)(ws + WS_WGATE), A.in[I_N2G], scr, r, lane); continue; } r -= I_UPI;
        p0_transpose_item(A.in[I_FDOWN], DFF, D, (bf16*)(ws + WS_WDOWN), nullptr, scr, r, lane);
    }
    const int gt = blockIdx.x * 512 + tid, NGT = G * 512;
    { bf16* BA = (bf16*)(ws + WS_BA); const float* wup = A.in[I_WUP]; const float* aup = A.in[I_AUP]; const float* gup = A.in[I_GUP];
      for (int e = gt; e < 1536 * 256; e += NGT) { const int n = e >> 8, k = e & 255; float v = 0.f;
          if (n < 512) { if (k < 64) v = wup[k * 512 + n]; }
          else if (n < 1024) { if (k >= 64 && k < 128) v = aup[(k - 64) * 512 + n - 512]; }
          else { if (k >= 128) v = gup[(k - 128) * 512 + n - 1024]; }
          BA[e] = (bf16)f2bf(v); } }
    { bf16* BB = (bf16*)(ws + WS_BB); const float* wa = A.in[I_LWA]; const float* wx = A.in[I_LWX];
      for (int e = gt; e < 1024 * 512; e += NGT) { const int n = e >> 9, k = e & 511, nn = n & 511, h = nn >> 6, j = nn & 63; float v = 0.f;
          if ((k >> 6) == h) { const float* Wm = n < 512 ? wa : wx; v = Wm[(h * 64 + (k & 63)) * 64 + j]; }
          BB[e] = (bf16)f2bf(v); } }
    bf16* XN = (bf16*)(ws + WS_XN); const float* g1 = A.in[I_N1G];
    f32x4 gv[4];
#pragma unroll
    for (int j = 0; j < 4; ++j) gv[j] = ((const f32x4*)g1)[lane + 64 * j];
#pragma unroll 2
    for (int row = gw; row < MP; row += NGW) {
        const float* src = row < R_SAMPLE ? A.in[I_XP] + (size_t)row * D : row < R_META ? A.in[I_XS] + (size_t)(row - R_SAMPLE) * D : row < R_END ? A.in[I_META] + (size_t)(row - R_META) * D : nullptr;
        u32x2* o = (u32x2*)(XN + (size_t)row * D);
        if (!src) {
#pragma unroll
            for (int j = 0; j < 4; ++j) o[lane + 64 * j] = (u32x2){0u, 0u};
            continue; }
        f32x4 v[4]; float s = 0.f;
#pragma unroll
        for (int j = 0; j < 4; ++j) { v[j] = ((const f32x4*)src)[lane + 64 * j]; s += (v[j].x * v[j].x + v[j].y * v[j].y) + (v[j].z * v[j].z + v[j].w * v[j].w); }
        const float rs = __builtin_amdgcn_rsqf(wave_sum(s) * (1.f / D) + EPS);
#pragma unroll
        for (int j = 0; j < 4; ++j) { const f32x4 g = gv[j];
            o[lane + 64 * j] = (u32x2){pk2(v[j].x * rs * g.x, v[j].y * rs * g.y), pk2(v[j].z * rs * g.z, v[j].w * rs * g.w)}; }
    }
}

__device__ __forceinline__ void phase_e1(const Args& A, int G) {
    const int tid = my_tid(), lane = tid & 63, wave = tid >> 6;
    const int gw = blockIdx.x * 8 + wave, NGW = G * 8;
    unsigned char* ws = A.ws;
    const bf16* __restrict__ U = (const bf16*)(ws + WS_U); bf16* __restrict__ AP = (bf16*)(ws + WS_AP); bf16* __restrict__ XC = (bf16*)(ws + WS_XC);
    const float* mu = A.in[I_MU]; const float* sts = A.in[I_STS]; const float* slc = A.in[I_SLC]; const float* lcw = A.in[I_LCW]; const float* lcb = A.in[I_LCB];
#pragma unroll 2
    for (int row = gw; row < MP; row += NGW) {
        bf16* ap = AP + (size_t)row * 256; bf16* xc = XC + (size_t)row * 512;
        const RowInfo ri = row_info(row);
        if (ri.kind == 3) { ((u32x2*)ap)[lane] = (u32x2){0u, 0u}; ((u32x4*)xc)[lane] = (u32x4){0u, 0u, 0u, 0u}; continue; }
        const bf16* urow = U + (size_t)row * DIN;
        const int r1 = row_back(ri, row, 1);
        {
            const int c0 = 1536 + 4 * lane;
            const u32x2 uw = *(const u32x2*)(urow + c0);
            float u[4] = {lo16(uw.x), hi16(uw.x), lo16(uw.y), hi16(uw.y)}, p[4];
            if (r1 >= 0) { const u32x2 pw = *(const u32x2*)(U + (size_t)r1 * DIN + c0); p[0] = lo16(pw.x); p[1] = hi16(pw.x); p[2] = lo16(pw.y); p[3] = hi16(pw.y); }
            else if (ri.kind == 1) { const f32x4 pv = *(const f32x4*)(sts + (size_t)ri.b * DTMP + c0); p[0] = pv.x; p[1] = pv.y; p[2] = pv.z; p[3] = pv.w; }
            else { p[0] = p[1] = p[2] = p[3] = 0.f; }
            const f32x4 m4 = *(const f32x4*)(mu + c0);
            float o[4];
#pragma unroll
            for (int i = 0; i < 4; ++i) { const float um = u[i] + (p[i] - u[i]) * m4[i]; o[i] = lane < 16 ? tanh_(um) : lane < 32 ? um : sigm(um); }
            ((u32x2*)ap)[lane] = (u32x2){pk2(o[0], o[1]), pk2(o[2], o[3])};
        }
        {
            const int c = 8 * lane;
            float acc[8], cur[8];
            { const f32x4 b0 = *(const f32x4*)(lcb + c), b1 = *(const f32x4*)(lcb + c + 4); acc[0] = b0.x; acc[1] = b0.y; acc[2] = b0.z; acc[3] = b0.w; acc[4] = b1.x; acc[5] = b1.y; acc[6] = b1.z; acc[7] = b1.w; }
#pragma unroll
            for (int j = 0; j < 4; ++j) {
                float val[8];
                const int rj = (j == 3) ? row : row_back(ri, row, 3 - j);
                if (rj >= 0) unpack8(*(const u32x4*)(U + (size_t)rj * DIN + DTMP + c), val);
                else if (ri.kind == 1) { const float* s = slc + ((size_t)ri.b * 3 + (ri.t + j)) * 512 + c; const f32x4 a = *(const f32x4*)s, b = *(const f32x4*)(s + 4);
                    val[0] = a.x; val[1] = a.y; val[2] = a.z; val[3] = a.w; val[4] = b.x; val[5] = b.y; val[6] = b.z; val[7] = b.w; }
                else {
#pragma unroll
                    for (int i = 0; i < 8; ++i) val[i] = 0.f; }
                const f32x4 w0 = *(const f32x4*)(lcw + j * 512 + c), w1 = *(const f32x4*)(lcw + j * 512 + c + 4);
#pragma unroll
                for (int i = 0; i < 4; ++i) { acc[i] += w0[i] * val[i]; acc[4 + i] += w1[i] * val[4 + i]; }
                if (j == 3) {
#pragma unroll
                    for (int i = 0; i < 8; ++i) cur[i] = val[i]; }
            }
            u32x4 w; w.x = pk2(acc[0], acc[1]); w.y = pk2(acc[2], acc[3]); w.z = pk2(acc[4], acc[5]); w.w = pk2(acc[6], acc[7]);
            ((u32x4*)xc)[lane] = w;
            float* lco = nullptr;
            if (ri.kind == 0 && ri.t >= TP - 3) lco = A.out + O_PLC + ((size_t)ri.b * 3 + (ri.t - (TP - 3))) * 512 + c;
            else if (ri.kind == 1 && ri.t >= 1) lco = A.out + O_SLC + ((size_t)ri.b * 3 + (ri.t - 1)) * 512 + c;
            if (lco) { *(f32x4*)lco = (f32x4){cur[0], cur[1], cur[2], cur[3]}; *(f32x4*)(lco + 4) = (f32x4){cur[4], cur[5], cur[6], cur[7]}; }
        }
        float* sho = nullptr;
        if (ri.kind == 0 && ri.t == TP - 1) sho = A.out + O_PSHIFT + (size_t)ri.b * DTMP;
        else if (ri.kind == 1 && ri.t == DS - 1) sho = A.out + O_SSHIFT + (size_t)ri.b * DTMP;
        if (sho) for (int i = lane; i < DTMP; i += 64) sho[i] = bf2f(urow[i]);
    }
}

__device__ __forceinline__ float sum8(float x) { x += dpp_f<0xB1>(x); x += dpp_f<0x4E>(x); x += dpp_f<0x141>(x); return x; }
__device__ __forceinline__ void phase_e2(const Args& A, int G) {
    const int tid = my_tid(), lane = tid & 63, wave = tid >> 6;
    unsigned char* ws = A.ws;
    const bf16* __restrict__ U = (const bf16*)(ws + WS_U); const bf16* __restrict__ GB = (const bf16*)(ws + WS_GB); const bf16* __restrict__ GA = (const bf16*)((unsigned char*)A.out + DO_GA);
    bf16* __restrict__ REC = (bf16*)(ws + WS_REC); bf16* __restrict__ LRU = (bf16*)(ws + WS_LRU);
    float* __restrict__ LTOT = (float*)((unsigned char*)A.out + DO_LTOT); float* __restrict__ BON = (float*)((unsigned char*)A.out + DO_BON);
    const float* mu = A.in[I_MU]; const float* sts = A.in[I_STS]; const float* slc = A.in[I_SLC]; const float* slh = A.in[I_SLH];
    for (int unit = blockIdx.x; unit < 513 + DB; unit += G) {
        int row0, ntok, kind;
        if (unit < 512) { row0 = unit * 32; ntok = 32; kind = 0; } else if (unit == 512) { row0 = R_META; ntok = 16; kind = 2; } else { row0 = R_SAMPLE + (unit - 513) * 4; ntok = 4; kind = 1; }
        const int c = tid;
        const float sp = softplus_(-A.in[I_LAM][c]);
        const float cw0 = A.in[I_LCW][c], cw1 = A.in[I_LCW][512 + c], cw2 = A.in[I_LCW][1024 + c], cw3 = A.in[I_LCW][1536 + c], cbias = A.in[I_LCB][c];
        const float ba_ = A.in[I_LBA][c], bx_ = A.in[I_LBX][c];
        float l1 = 0.f, l2 = 0.f, l3 = 0.f, H = 0.f, P = 1.f;
        if (kind == 0) { const RowInfo ri0 = row_info(row0);
            l1 = bf2f(U[(size_t)row_back(ri0, row0, 1) * DIN + DTMP + c]); l2 = bf2f(U[(size_t)row_back(ri0, row0, 2) * DIN + DTMP + c]); l3 = bf2f(U[(size_t)row_back(ri0, row0, 3) * DIN + DTMP + c]); }
        else if (kind == 1) { const int b = unit - 513; l3 = slc[((size_t)b * 3 + 0) * 512 + c]; l2 = slc[((size_t)b * 3 + 1) * 512 + c]; l1 = slc[((size_t)b * 3 + 2) * 512 + c]; H = slh[(size_t)b * 512 + c]; }
#pragma unroll 4
        for (int j = 0; j < ntok; ++j) {
            const int row = row0 + j;
            const float l0 = bf2f(U[(size_t)row * DIN + DTMP + c]);
            const float xc = cbias + cw0 * l3 + cw1 * l2 + cw2 * l1 + cw3 * l0;
            l3 = l2; l2 = l1; l1 = l0;
            const float ra = bf2f(GB[(size_t)row * 1024 + c]) + ba_, ix = bf2f(GB[(size_t)row * 1024 + 512 + c]) + bx_;
            const float rg = sigm(ra), ig = sigm(ix);
            const float la = -8.f * rg * sp, a = __builtin_amdgcn_exp2f(1.4426950409f * la);
            float mult = __builtin_amdgcn_sqrtf(fmaxf(1.f - __builtin_amdgcn_exp2f(2.8853900818f * la), 0.f)); if (kind == 2 && j == 0) mult = 1.f;
            H = a * H + xc * ig * mult; P = P * a;
            LRU[(size_t)row * 1024 + c] = (bf16)f2bf(H); LRU[(size_t)row * 1024 + 512 + c] = (bf16)f2bf(kind == 1 ? 0.f : P);
        }
        if (kind == 1) A.out[O_SLH + (size_t)(unit - 513) * 512 + c] = H;
        else { LTOT[((size_t)unit * 2 + 0) * 512 + c] = P; LTOT[((size_t)unit * 2 + 1) * 512 + c] = H; }
    }
    {
        const int c = 8 * lane, h = lane >> 3, gw = blockIdx.x * 8 + wave, NGW = G * 8;
        float mr[8], mk[8], w0[8], a0[8], kkw[8], kaw[8], rkw[8];
        ld8f(mu + c, mr); ld8f(mu + 512 + c, mk); ld8f(A.in[I_W0] + c, w0); ld8f(A.in[I_A0] + c, a0); ld8f(A.in[I_KK] + c, kkw); ld8f(A.in[I_KA] + c, kaw); ld8f(A.in[I_RK] + c, rkw);
#pragma unroll 2
        for (int row = gw; row < R_END; row += NGW) {
            const RowInfo ri = row_info(row); const int r1 = row_back(ri, row, 1);
            const bf16* ur = U + (size_t)row * DIN;
            float u_r[8], u_k[8], p_r[8], p_k[8], wp[8], ap[8];
            unpack8(*(const u32x4*)(ur + c), u_r); unpack8(*(const u32x4*)(ur + 512 + c), u_k);
            unpack8(*(const u32x4*)(GA + (size_t)row * 1536 + c), wp); unpack8(*(const u32x4*)(GA + (size_t)row * 1536 + 512 + c), ap);
            if (r1 >= 0) { unpack8(*(const u32x4*)(U + (size_t)r1 * DIN + c), p_r); unpack8(*(const u32x4*)(U + (size_t)r1 * DIN + 512 + c), p_k); }
            else if (ri.kind == 1) { ld8f(sts + (size_t)ri.b * DTMP + c, p_r); ld8f(sts + (size_t)ri.b * DTMP + 512 + c, p_k); }
            else {
#pragma unroll
                for (int i = 0; i < 8; ++i) { p_r[i] = 0.f; p_k[i] = 0.f; } }
            float av[8], xv[8], kk[8], kp[8], ss = 0.f, bs = 0.f;
#pragma unroll
            for (int i = 0; i < 8; ++i) {
                const float um_r = u_r[i] + (p_r[i] - u_r[i]) * mr[i], um_k = u_k[i] + (p_k[i] - u_k[i]) * mk[i];
                const float z = -(wp[i] + w0[i]);
                const float w_log = -(fmaxf(z, 0.f) + __logf(1.f + __expf(-fabsf(z)))) - 0.5f;
                const float e = __builtin_amdgcn_exp2f(1.4426950409f * w_log); xv[i] = 1.f - __builtin_amdgcn_exp2f(-1.4426950409f * e);
                av[i] = sigm(ap[i] + a0[i]);
                kk[i] = um_k * kkw[i]; ss += kk[i] * kk[i];
                kp[i] = um_k * (1.f + (av[i] - 1.f) * kaw[i]);
                bs += um_r * kp[i] * rkw[i];
            }
            ss = sum8(ss); bs = sum8(bs);
            const float rn = __builtin_amdgcn_rsqf(fmaxf(ss, 1e-24f));
#pragma unroll
            for (int i = 0; i < 8; ++i) kk[i] *= rn;
            bf16* rec = REC + ((size_t)row * 8 + h) * 256 + (lane & 7) * 8;
            *(u32x4*)rec = pack8(av); *(u32x4*)(rec + 64) = pack8(xv); *(u32x4*)(rec + 128) = pack8(kk); *(u32x4*)(rec + 192) = pack8(kp);
            if ((lane & 7) == 0) BON[(size_t)row * 8 + h] = bs;
        }
    }
}

struct Raw { bf16 a, x, kk, kp, ur, uv, pr, pv; };
__device__ __forceinline__ void m2_load(Raw (&raw)[8], const bf16* REC, const bf16* U, int b, int h, int t0, int ns, int k, int sub) {
#pragma unroll
    for (int i = 0; i < 8; ++i) {
        const int s = sub + 4 * i;
        raw[i].a = 0; raw[i].x = 0; raw[i].kk = 0; raw[i].kp = 0; raw[i].ur = 0; raw[i].uv = 0; raw[i].pr = 0; raw[i].pv = 0;
        if (s < ns) {
            const int t = t0 + s, row = prompt_row(b, t);
            const bf16* rec = REC + ((size_t)row * 8 + h) * 256;
            raw[i].a = rec[k]; raw[i].x = rec[64 + k]; raw[i].kk = rec[128 + k]; raw[i].kp = rec[192 + k];
            const bf16* ur = U + (size_t)row * DIN + h * 64 + k; raw[i].ur = ur[0]; raw[i].uv = ur[1024];
            if (t > 0) { const bf16* pr = U + (size_t)prompt_row(b, t - 1) * DIN + h * 64 + k; raw[i].pr = pr[0]; raw[i].pv = pr[1024]; }
        }
    }
}
__device__ __forceinline__ void m2_store(const Raw (&raw)[8], LAS float* buf, float mu_r, float mu_v, int k, int sub, int ns) {
#pragma unroll
    for (int i = 0; i < 8; ++i) {
        const int s = sub + 4 * i;
        if (s < ns) {
            LAS float* p = buf + s * 384;
            const float a = bf2f(raw[i].a), kk = bf2f(raw[i].kk), ur = bf2f(raw[i].ur), uv = bf2f(raw[i].uv);
            p[k] = kk; p[64 + k] = 1.f - bf2f(raw[i].x); p[128 + k] = -(kk * a); p[192 + k] = bf2f(raw[i].kp);
            p[256 + k] = ur + (bf2f(raw[i].pr) - ur) * mu_r; p[320 + k] = uv + (bf2f(raw[i].pv) - uv) * mu_v;
        }
    }
}
typedef float f32x2 __attribute__((ext_vector_type(2)));
struct StepOps { f32x4 kk, dd, nka, kp, r; float v; };
__device__ __forceinline__ void ops_load(StepOps& o, const LAS float* p, int ks, int vrow) {
    o.kk = *(const LAS f32x4*)(p + 4 * ks); o.dd = *(const LAS f32x4*)(p + 64 + 4 * ks); o.nka = *(const LAS f32x4*)(p + 128 + 4 * ks);
    o.kp = *(const LAS f32x4*)(p + 192 + 4 * ks); o.r = *(const LAS f32x4*)(p + 256 + 4 * ks); o.v = p[320 + vrow];
}
__device__ __forceinline__ float dot4(const f32x4 a, const f32x4 b) { f32x2 t = a.xy * b.xy; t = a.zw * b.zw + t; return t.x + t.y; }
__device__ __forceinline__ void scan_step2(f32x4& S, const StepOps& o, float& yp) {
    float d = dot4(S, o.kk);
    d += dpp_f<0xB1>(d); yp += dpp_f<0xB1>(yp); d += dpp_f<0x4E>(d); yp += dpp_f<0x4E>(yp);
    d += dpp_f<0x141>(d); yp += dpp_f<0x141>(yp); d += dpp_f<0x140>(d); yp += dpp_f<0x140>(yp);
    S = S * o.dd + d * o.nka + o.v * o.kp;
}
__device__ __forceinline__ float scan_step(f32x4& S, const StepOps& o) {
    float d = dot4(S, o.kk); d = allsum16(d);
    S = S * o.dd + d * o.nka + o.v * o.kp;
    float y = dot4(S, o.r); return allsum16(y);
}
__device__ __forceinline__ void sample_load(int task, int rl, int ks, f32x4& S, StepOps (&o)[DS], const bf16* __restrict__ REC, const bf16* __restrict__ U, const float* __restrict__ swkv, const float* __restrict__ sts, const float* __restrict__ mu) {
    const int bh = task >> 4, rg = task & 15, b = bh >> 3, h = bh & 7, v = 4 * rg + rl;
    S = *(const f32x4*)(swkv + ((size_t)bh * 64 + v) * 64 + 4 * ks);
    const f32x4 mr4 = *(const f32x4*)(mu + h * 64 + 4 * ks); const float mv = mu[1024 + h * 64 + v];
#pragma unroll
    for (int t = 0; t < DS; ++t) {
        const int row = R_SAMPLE + 4 * b + t;
        const bf16* rec = REC + ((size_t)row * 8 + h) * 256 + 4 * ks;
        const u32x2 wa = *(const u32x2*)rec, wx = *(const u32x2*)(rec + 64), wk = *(const u32x2*)(rec + 128), wp = *(const u32x2*)(rec + 192);
        const f32x4 a4 = (f32x4){lo16(wa.x), hi16(wa.x), lo16(wa.y), hi16(wa.y)};
        o[t].dd = 1.f - (f32x4){lo16(wx.x), hi16(wx.x), lo16(wx.y), hi16(wx.y)};
        o[t].kk = (f32x4){lo16(wk.x), hi16(wk.x), lo16(wk.y), hi16(wk.y)}; o[t].kp = (f32x4){lo16(wp.x), hi16(wp.x), lo16(wp.y), hi16(wp.y)};
        const u32x2 wr_ = *(const u32x2*)(U + (size_t)row * DIN + h * 64 + 4 * ks);
        const f32x4 ur4 = (f32x4){lo16(wr_.x), hi16(wr_.x), lo16(wr_.y), hi16(wr_.y)};
        const float uv = bf2f(U[(size_t)row * DIN + 1024 + h * 64 + v]);
        f32x4 pr4; float pv;
        if (t > 0) { const u32x2 w = *(const u32x2*)(U + (size_t)(row - 1) * DIN + h * 64 + 4 * ks); pr4 = (f32x4){lo16(w.x), hi16(w.x), lo16(w.y), hi16(w.y)}; pv = bf2f(U[(size_t)(row - 1) * DIN + 1024 + h * 64 + v]); }
        else { pr4 = *(const f32x4*)(sts + (size_t)b * DTMP + h * 64 + 4 * ks); pv = sts[(size_t)b * DTMP + 1024 + h * 64 + v]; }
        o[t].r = ur4 + (pr4 - ur4) * mr4; o[t].v = uv + (pv - uv) * mv; o[t].nka = -(o[t].kk * a4);
    }
}
__device__ __forceinline__ void sample_finish(int task, int rl, int ks, f32x4 S, const StepOps (&o)[DS], float* __restrict__ Y, float* __restrict__ out) {
    const int bh = task >> 4, rg = task & 15, b = bh >> 3, h = bh & 7, v = 4 * rg + rl;
#pragma unroll
    for (int t = 0; t < DS; ++t) { const float y = scan_step(S, o[t]); if (ks == 0) Y[(size_t)(R_SAMPLE + 4 * b + t) * 512 + h * 64 + v] = y; }
    *(f32x4*)(out + O_SWKV + ((size_t)bh * 64 + v) * 64 + 4 * ks) = S;
}
__device__ __forceinline__ void phase_m2(const Args& A, LAS unsigned char* lds, int G) {
    const int tid = my_tid(), lane = tid & 63, wave = tid >> 6;
    unsigned char* ws = A.ws;
    const bf16* __restrict__ U = (const bf16*)(ws + WS_U); const bf16* __restrict__ REC = (const bf16*)(ws + WS_REC); float* __restrict__ Y = (float*)(ws + WS_Y);
    const float* LTOT = (const float*)((unsigned char*)A.out + DO_LTOT); float* CARRY = (float*)((unsigned char*)A.out + DO_CARRY);
    const float* mu = A.in[I_MU];
    for (int b = blockIdx.x; b < NB; b += G) {
        const int c = tid; float carry = LTOT[((size_t)512 * 2 + 1) * 512 + c];
        float Pv[64], Hv[64];
#pragma unroll
        for (int i = 0; i < 64; ++i) { const int un = b * 64 + i; Pv[i] = LTOT[((size_t)un * 2 + 0) * 512 + c]; Hv[i] = LTOT[((size_t)un * 2 + 1) * 512 + c]; }
#pragma unroll
        for (int i = 0; i < 64; ++i) { CARRY[((size_t)b * 64 + i) * 512 + c] = carry; carry = Pv[i] * carry + Hv[i]; }
        A.out[O_PLH + (size_t)b * 512 + c] = carry;
    }
    const int ks = lane & 15, rl = lane >> 4;
    for (int item = blockIdx.x; item < 256; item += G) {
        const int bh = item >> 2, q = item & 3, b = bh >> 3, h = bh & 7;
        int k = tid & 63, sub = (tid >> 6) & 3;
        asm volatile("" : "+v"(k), "+v"(sub));
        const float mu_r = mu[h * 64 + k], mu_v = mu[1024 + h * 64 + k];
        const int wv = wave & 3, vrow = 16 * q + 4 * wv + rl;
        f32x4 S = (f32x4){0.f, 0.f, 0.f, 0.f};
        const bool first_item = item == (int)blockIdx.x;
        Raw raw[8];
        LAS float* buf0 = (LAS float*)lds; LAS float* buf1 = (LAS float*)(lds + 50688); LAS float* ybuf = (LAS float*)(lds + 101376) + wv * 132;
        __syncthreads();
        if (wave >= 4) { m2_load(raw, REC, U, b, h, 0, 16, k, sub); m2_store(raw, buf0, mu_r, mu_v, k, sub, 16); m2_load(raw, REC, U, b, h, 16, 32, k, sub); }
        __syncthreads();
        for (int blk = 0; blk < 65; ++blk) {
            const int t0 = blk == 0 ? 0 : 16 + 32 * (blk - 1), ns = blk == 0 ? 16 : 32;
            if (wave >= 4) {
                const int jt = blk >> 2; int task = (int)blockIdx.x * 4 + (wave - 4) + G * 4 * jt;
                asm volatile("" : "+v"(task));
                const bool do_task = first_item && (blk & 3) == 0 && jt < 16 && task < DB * NH * 16;
                f32x4 Sc; StepOps oc[DS];
                if (do_task) sample_load(task, rl, ks, Sc, oc, REC, U, A.in[I_SWKV], A.in[I_STS], mu);
                if (blk + 1 < 65) m2_store(raw, (blk & 1) ? buf0 : buf1, mu_r, mu_v, k, sub, 32);
                if (blk + 2 < 65) m2_load(raw, REC, U, b, h, 16 + 32 * (blk + 1), 32, k, sub);
                if (do_task) sample_finish(task, rl, ks, Sc, oc, Y, A.out);
            } else {
                const LAS float* buf = (blk & 1) ? buf1 : buf0;
                StepOps oa, ob; ops_load(oa, buf, ks, vrow);
                float yp = 0.f;
                for (int s = 0; s < ns; s += 2) {
                    ops_load(ob, buf + (s + 1) * 384, ks, vrow);
                    scan_step2(S, oa, yp); ybuf[s * 4 + rl] = yp; yp = dot4(S, oa.r);
                    ops_load(oa, buf + (s + 2) * 384, ks, vrow);
                    scan_step2(S, ob, yp); ybuf[(s + 1) * 4 + rl] = yp; yp = dot4(S, ob.r);
                }
                yp = allsum16(yp); ybuf[ns * 4 + rl] = yp;
                if (ks < ns) Y[(size_t)prompt_row(b, t0 + ks) * 512 + h * 64 + vrow] = ybuf[(ks + 1) * 4 + rl];
                if (ks + 16 < ns) Y[(size_t)prompt_row(b, t0 + ks + 16) * 512 + h * 64 + vrow] = ybuf[(ks + 17) * 4 + rl];
            }
            __syncthreads();
        }
        if (wave < 4) *(f32x4*)(A.out + O_PWKV + ((size_t)(b * 8 + h) * 64 + vrow) * 64 + 4 * ks) = S;
    }
    for (int task = G * 4 * 16 + blockIdx.x * 8 + wave; task < DB * NH * 16; task += G * 8) {
        f32x4 Sc; StepOps oc[DS];
        sample_load(task, rl, ks, Sc, oc, REC, U, A.in[I_SWKV], A.in[I_STS], mu);
        sample_finish(task, rl, ks, Sc, oc, Y, A.out);
    }
}

__device__ __forceinline__ void phase_m3(const Args& A, int G) {
    const int tid = my_tid(), lane = tid & 63, wave = tid >> 6;
    const int gw = blockIdx.x * 8 + wave, NGW = G * 8;
    unsigned char* ws = A.ws;
    const bf16* __restrict__ U = (const bf16*)(ws + WS_U); const bf16* __restrict__ GA = (const bf16*)((unsigned char*)A.out + DO_GA); const bf16* __restrict__ LRU = (const bf16*)(ws + WS_LRU);
    const float* __restrict__ Y = (const float*)(ws + WS_Y); const float* __restrict__ CARRY = (const float*)((unsigned char*)A.out + DO_CARRY); const float* __restrict__ BON = (const float*)((unsigned char*)A.out + DO_BON);
    bf16* __restrict__ MIX = (bf16*)(ws + WS_MIX);
    const float* sts = A.in[I_STS];
    const int c = 8 * lane, h = lane >> 3;
    float mv[8], gg[8], gb[8], og[8];
    ld8f(A.in[I_MU] + 1024 + c, mv); ld8f(A.in[I_GNG] + c, gg); ld8f(A.in[I_GNB] + c, gb); ld8f(A.in[I_LOG] + c, og);
#pragma unroll 2
    for (int row = gw; row < MP; row += NGW) {
        bf16* mo = MIX + (size_t)row * D;
        const RowInfo ri = row_info(row);
        if (ri.kind == 3) { ((u32x4*)mo)[lane] = (u32x4){0u, 0u, 0u, 0u}; ((u32x4*)mo)[64 + lane] = (u32x4){0u, 0u, 0u, 0u}; continue; }
        const int r1 = row_back(ri, row, 1);
        float y[8], uv[8], pv[8], g[8], hv[8], pp[8], gt[8], cr[8];
        ld8f(Y + (size_t)row * 512 + c, y);
        unpack8(*(const u32x4*)(U + (size_t)row * DIN + 1024 + c), uv);
        unpack8(*(const u32x4*)(GA + (size_t)row * 1536 + 1024 + c), g);
        unpack8(*(const u32x4*)(LRU + (size_t)row * 1024 + c), hv); unpack8(*(const u32x4*)(LRU + (size_t)row * 1024 + 512 + c), pp);
        unpack8(*(const u32x4*)(U + (size_t)row * DIN + DTMP + 512 + c), gt);
        const float bon = BON[(size_t)row * 8 + h];
        if (r1 >= 0) unpack8(*(const u32x4*)(U + (size_t)r1 * DIN + 1024 + c), pv);
        else if (ri.kind == 1) ld8f(sts + (size_t)ri.b * DTMP + 1024 + c, pv);
        else {
#pragma unroll
            for (int i = 0; i < 8; ++i) pv[i] = 0.f; }
        if (ri.kind == 0) ld8f(CARRY + ((size_t)ri.b * 64 + ((row & 2047) >> 5)) * 512 + c, cr);
        else {
#pragma unroll
            for (int i = 0; i < 8; ++i) cr[i] = 0.f; }
        float s = 0.f;
#pragma unroll
        for (int i = 0; i < 8; ++i) s += y[i];
        const float mean = sum8(s) * (1.f / 64.f);
        float q = 0.f;
#pragma unroll
        for (int i = 0; i < 8; ++i) { y[i] -= mean; q += y[i] * y[i]; }
        const float rstd = __builtin_amdgcn_rsqf(sum8(q) * (1.f / 64.f) + GN_EPS);
        float o[8];
#pragma unroll
        for (int i = 0; i < 8; ++i) { const float vv = uv[i] + (pv[i] - uv[i]) * mv[i]; o[i] = (y[i] * rstd * gg[i] + gb[i] + bon * vv) * g[i]; }
        *(u32x4*)(mo + c) = pack8(o);
        float z[8], s2 = 0.f;
#pragma unroll
        for (int i = 0; i < 8; ++i) { z[i] = (hv[i] + pp[i] * cr[i]) * gelu_tanh(gt[i]); s2 += z[i] * z[i]; }
        const float rs = __builtin_amdgcn_rsqf(wave_sum(s2) * (1.f / 512.f) + EPS);
#pragma unroll
        for (int i = 0; i < 8; ++i) o[i] = z[i] * rs * og[i];
        *(u32x4*)(mo + 512 + c) = pack8(o);
    }
}

__device__ __forceinline__ void phase_final(const Args& A, int G) {
    const int tid = my_tid(), lane = tid & 63, wave = tid >> 6;
    const int gw = blockIdx.x * 8 + wave, NGW = G * 8;
    const float* gf = A.in[I_NFG];
    f32x4 g[4];
#pragma unroll
    for (int j = 0; j < 4; ++j) g[j] = ((const f32x4*)gf)[lane + 64 * j];
    for (int row = gw; row < M_MAIN; row += NGW) {
        f32x4* p = (f32x4*)(A.out + (size_t)row * D);
        f32x4 v[4]; float s = 0.f;
#pragma unroll
        for (int j = 0; j < 4; ++j) { v[j] = p[lane + 64 * j]; s += (v[j].x * v[j].x + v[j].y * v[j].y) + (v[j].z * v[j].z + v[j].w * v[j].w); }
        const float rs = __builtin_amdgcn_rsqf(wave_sum(s) * (1.f / D) + EPS);
#pragma unroll
        for (int j = 0; j < 4; ++j) p[lane + 64 * j] = v[j] * rs * g[j];
    }
}

namespace cg = cooperative_groups;
__global__ void __launch_bounds__(512, 2) mk_fwd(Args args) {
    extern __shared__ __attribute__((aligned(16))) unsigned char lds_raw[];
    LAS unsigned char* lds = (LAS unsigned char*)lds_raw;
    const int G = gridDim.x, tid = threadIdx.x;
    volatile LAS unsigned* MISC = (volatile LAS unsigned*)(lds + 131072 + 320);
    if (tid < 64) ((LAS unsigned*)(lds + 131072))[tid + 64] = 0u, ((LAS unsigned*)(lds + 131072))[tid] = 0u;
    __syncthreads();
    const int lo = args.ph_lo, hi = args.ph_hi;
    XcdBarrier bar; bar.bar = (unsigned*)(args.ws + WS_CTL) + 4096; bar.x = 0; bar.st = nullptr;
    if (hi - lo > 1) bar = xcd_barrier_post((unsigned*)(args.ws + WS_CTL) + 4096, MISC + 8);
    if (lo < 0) cg::this_grid().sync();
#define IN(k) (lo <= (k) && (k) < hi)
#define SEAM(k) do { if (IN(k) && IN((k) + 1)) xcd_barrier(bar); } while (0)
    unsigned char* ws = args.ws; unsigned char* ob = (unsigned char*)args.out;
    if (IN(0)) { phase_p0(args, lds, G); } SEAM(0);
    if (IN(1)) { pg8::Gemm g{(const bf16*)(ws + WS_XN), (const bf16*)(ws + WS_WIN), MP, DIN, D}; pg8::StaticOrder S; S.init(MP, DIN, G, (int)blockIdx.x, D);
        EpiPlain E{(bf16*)(ws + WS_U), DIN}; pg8::gemm_phase<EpiPlain, pg8::StaticOrder, true, true>(lds, g, S, E); } SEAM(1);
    if (IN(2)) { phase_e1(args, G); } SEAM(2);
    if (IN(3)) {
        { pg8::Gemm g{(const bf16*)(ws + WS_AP), (const bf16*)(ws + WS_BA), MP, 1536, 256}; pg8::StaticOrder S; S.init(MP, 1536, G, (int)blockIdx.x, 256);
          EpiPlain E{(bf16*)(ob + DO_GA), 1536}; pg8::gemm_phase<EpiPlain, pg8::StaticOrder, true, true>(lds, g, S, E); }
        { pg8::Gemm g{(const bf16*)(ws + WS_XC), (const bf16*)(ws + WS_BB), MP, 1024, 512}; pg8::StaticOrder S; S.init(MP, 1024, G, (int)blockIdx.x, 512);
          EpiPlain E{(bf16*)(ws + WS_GB), 1024}; pg8::gemm_phase<EpiPlain, pg8::StaticOrder, true, true>(lds, g, S, E); }
    } SEAM(3);
    if (IN(4)) { phase_e2(args, G); } SEAM(4);
    if (IN(5)) { phase_m2(args, lds, G); } SEAM(5);
    if (IN(6)) { phase_m3(args, G); } SEAM(6);
    if (IN(7)) { pg8::Gemm g{(const bf16*)(ws + WS_MIX), (const bf16*)(ob + DO_WOUT), MP, D, D}; pg8::StaticOrder S; S.init(MP, D, G, (int)blockIdx.x, D);
        EpiX1 E{args.in[I_XP], args.in[I_XS], args.in[I_META], args.out, (bf16*)(ws + WS_X1B), (float*)(ws + WS_SSQ1)};
        pg8::gemm_phase<EpiX1, pg8::StaticOrder, true, true>(lds, g, S, E); } SEAM(7);
    if (IN(8)) { pg8::Gemm g{(const bf16*)(ws + WS_X1B), (const bf16*)(ws + WS_WUP), MP, DFF, D}; pg8::StaticOrder S; S.init(MP, DFF, G, (int)blockIdx.x, D);
        EpiUp E{(const float*)(ws + WS_SSQ1), (bf16*)(ws + WS_UP), args.out + O_PFC, args.out + O_SFC};
        pg8::gemm_phase<EpiUp, pg8::StaticOrder, true, true>(lds, g, S, E); } SEAM(8);
    if (IN(9)) { pg8::Gemm g{(const bf16*)(ws + WS_X1B), (const bf16*)(ws + WS_WGATE), M_MAIN, DFF, D}; pg8::StaticOrder S; S.init(M_MAIN, DFF, G, (int)blockIdx.x, D);
        EpiGate E{(const float*)(ws + WS_SSQ1), (const bf16*)(ws + WS_UP), args.in[I_SFC], args.in[I_FCW], args.in[I_FCB], (bf16*)(ws + WS_HID)};
        pg8::gemm_phase<EpiGate, pg8::StaticOrder, true, true>(lds, g, S, E); } SEAM(9);
    if (IN(10)) { pg8::Gemm g{(const bf16*)(ws + WS_HID), (const bf16*)(ws + WS_WDOWN), M_MAIN, D, DFF}; DownOrder S; S.init(G, (int)blockIdx.x);
        EpiDown E{args.out, (const bf16*)(ws + WS_X1B)};
        pg8::gemm_phase<EpiDown, DownOrder, true, true>(lds, g, S, E); } SEAM(10);
    if (IN(11)) { phase_final(args, G); }
#undef IN
#undef SEAM
}

extern "C" void kernel_launch(void* const* d_in, const int* in_sizes, int n_in, void* d_out, int out_size, void* d_ws, size_t ws_size, hipStream_t stream) {
    static int grid = 0;
    if (grid == 0) {
        if (n_in != N_IN || (size_t)out_size != O_END || ws_size < 256 * MiB) { fprintf(stderr, "kernel_launch: unexpected shapes n_in %d out %d ws %zu\n", n_in, out_size, ws_size); grid = -1; return; }
        int dev = 0, cus = 0, per_cu = 0;
        (void)hipGetDevice(&dev); (void)hipDeviceGetAttribute(&cus, hipDeviceAttributeMultiprocessorCount, dev);
        if (hipFuncSetAttribute((const void*)mk_fwd, hipFuncAttributeMaxDynamicSharedMemorySize, LDS_BYTES) != hipSuccess) { fprintf(stderr, "kernel_launch: hipFuncSetAttribute failed\n"); grid = -1; return; }
        if (hipOccupancyMaxActiveBlocksPerMultiprocessor(&per_cu, (const void*)mk_fwd, 512, LDS_BYTES) != hipSuccess || per_cu < 1) per_cu = 1;
        (void)hipGetLastError();
        grid = cus > 0 ? cus : 256;
    }
    if (grid < 0) return;
    Args a{};
    for (int i = 0; i < N_IN; ++i) a.in[i] = (const float*)d_in[i];
    a.out = (float*)d_out; a.ws = (unsigned char*)d_ws;
#if MK_ONE_LAUNCH
    (void)hipMemsetAsync((char*)d_ws + WS_CTL, 0, CTL_ZERO_BYTES, stream);
    a.ph_lo = 0; a.ph_hi = NPH;
    void* kargs[] = {&a};
    hipError_t e = hipLaunchCooperativeKernel((const void*)mk_fwd, dim3(grid), dim3(512), kargs, LDS_BYTES, stream);
    if (e != hipSuccess) fprintf(stderr, "cooperative launch failed: %s (grid %d)\n", hipGetErrorString(e), grid);
#else
    for (int ph = 0; ph < NPH; ++ph) for (int rep = 0; rep < 1 + ((MK_REP_MASK >> ph) & 1); ++rep) { a.ph_lo = ph; a.ph_hi = ph + 1; hipLaunchKernelGGL(mk_fwd, dim3(grid), dim3(512), LDS_BYTES, stream, a); }
#endif
}
```

```cpp
#include <hip/hip_runtime.h>
#include <hip/hip_cooperative_groups.h>
#include <cstdio>
#include <cstdint>
#include <cmath>
__device__ __forceinline__ int my_tid() { int t = threadIdx.x; asm volatile("" : "+v"(t)); return t; }
namespace pg8 {
#define PG8_LAS __attribute__((address_space(3)))
typedef unsigned short bf16_t;
typedef short bf16x8 __attribute__((ext_vector_type(8)));
typedef float f32x4 __attribute__((ext_vector_type(4)));
typedef unsigned u32x4 __attribute__((ext_vector_type(4)));
constexpr int BM = 256, BK = 64, HALF = 128, HTB = HALF * BK * 2  , STAGE_BYTES = 8 * HTB, NXCD = 8, WGM = 8;

__host__ __device__ __forceinline__ int lds_byte(int r, int c) { const int st = (r >> 4) * 2 + (c >> 5), rr = r & 15, cc = c & 31, ob = rr * 64 + cc * 2; return st * 1024 + (ob ^ (((ob >> 9) & 1) << 5)); }
__host__ __device__ __forceinline__ void stage_rc(int b, int& R, int& C) { const int st = b / 1024, sb = b % 1024, swz = sb ^ (((sb >> 9) & 1) << 5); R = (st >> 1) * 16 + swz / 64; C = (st & 1) * 32 + (swz % 64) / 2; }
__host__ __device__ __forceinline__ int perm32(int rho) { const int n = rho >> 4, i = rho & 15; return 8 * (i >> 2) + 4 * n + (i & 3); }

struct Unit { int pm, pn, ko, nt; };
struct Gemm { const bf16_t* A; const bf16_t* Bt; int M, N, K; };

struct StaticOrder {
    int nM, nN, nwg, G, c, ntk;
    __host__ __device__ void init(int M, int N, int G_, int c_, int K_) { nM = M / BM; nN = N / BM; nwg = nM * nN; G = G_; c = c_; ntk = K_ / BK; }
    __host__ __device__ bool next(int i, Unit& u) const {
        const long L = (long)i * G + c; if (L >= nwg) return false;
        int wgid = (int)L; { const int q = nwg / NXCD, r = nwg % NXCD, xcd = wgid % NXCD, off = wgid / NXCD; wgid = (xcd < r ? xcd * (q + 1) : r * (q + 1) + (xcd - r) * q) + off; }
        const int nig = WGM * nN, gid = wgid / nig, fm = gid * WGM, gsz = (nM - fm) < WGM ? (nM - fm) : WGM;
        u.pm = fm + ((wgid % nig) % gsz); u.pn = (wgid % nig) / gsz; u.ko = 0; u.nt = ntk; return true;
    }
    __device__ __forceinline__ void a_ready(const Unit&) const {}
    __device__ __forceinline__ void done(const Unit&) const {}
};

__device__ __forceinline__ unsigned cvt_pk_bf16(float lo, float hi) { unsigned r; asm volatile("v_cvt_pk_bf16_f32 %0, %1, %2" : "=v"(r) : "v"(lo), "v"(hi)); return r; }
typedef float f32x2 __attribute__((ext_vector_type(2)));
template <class Epi, class Sched, bool ALIGN_EPI = false, bool SP2 = false>
__device__ __forceinline__ void gemm_phase(PG8_LAS unsigned char* lds, const Gemm g, const Sched& S, const Epi& E) {
    const int tid = my_tid(), wid = __builtin_amdgcn_readfirstlane(tid >> 6), lane = tid & 63, wr = wid >> 2, wc = wid & 3, fr = lane & 15, fq = lane >> 4;
    const int K = g.K;
    unsigned voffA[2], voffB[2];
#pragma unroll
    for (int i = 0; i < 2; ++i) { int R, C; stage_rc(tid * 16 + i * 8192, R, C); const int Rb = Epi::PERM ? ((R & ~31) + perm32(R & 31)) : R;
        voffA[i] = (unsigned)(R * K + C) * 2u; voffB[i] = (unsigned)(Rb * K + C) * 2u; }
    const size_t kstep = (size_t)(BK * 2);
    const size_t hstep = (size_t)HALF * K * 2;
    const size_t tstep = 2 * hstep;
    const unsigned ldsw = (unsigned)wid * 1024u;
    const int aoff = lds_byte(wr * 64 + fr, fq * 8), boff = lds_byte(wc * 32 + fr, fq * 8);
#define PG8_SA(b, h) (((b) * 2 + (h)) * HTB)
#define PG8_SB(b, h) ((4 + (b) * 2 + (h)) * HTB)
#define PG8_STAGE(bufoff, gbase, voff) do { _Pragma("unroll") for (int _i = 0; _i < 2; ++_i) \
        __builtin_amdgcn_global_load_lds((const unsigned*)((const char*)(gbase) + (voff)[_i]), (PG8_LAS unsigned*)(lds + (bufoff) + ldsw + _i * 8192), 16, 0, 0); } while (0)
#define PG8_LDA(dst, b, h) do { _Pragma("unroll") for (int m = 0; m < 4; ++m) _Pragma("unroll") for (int k = 0; k < 2; ++k) dst[m][k] = *(const PG8_LAS bf16x8*)(lds + PG8_SA(b, h) + aoff + m * 2048 + k * 1024); } while (0)
#define PG8_LDB(dst, b, h) do { _Pragma("unroll") for (int n = 0; n < 2; ++n) _Pragma("unroll") for (int k = 0; k < 2; ++k) dst[n][k] = *(const PG8_LAS bf16x8*)(lds + PG8_SB(b, h) + boff + n * 2048 + k * 1024); } while (0)
#define PG8_MMA(ai, bj, At, Bt) do { __builtin_amdgcn_s_setprio(1); _Pragma("unroll") for (int m = 0; m < 4; ++m) _Pragma("unroll") for (int n = 0; n < 2; ++n) _Pragma("unroll") for (int k = 0; k < 2; ++k) \
        acc[ai][bj][m][n] = __builtin_amdgcn_mfma_f32_16x16x32_bf16(Bt[n][k], At[m][k], acc[ai][bj][m][n], 0, 0, 0); __builtin_amdgcn_s_setprio(0); } while (0)
#define PG8_WAIT_V(n) asm volatile("s_waitcnt vmcnt(" #n ")" ::: "memory")
#define PG8_WAIT_L(n) asm volatile("s_waitcnt lgkmcnt(" #n ")" ::: "memory")
#define PG8_BAR __builtin_amdgcn_s_barrier()
#define PG8_SCHED __builtin_amdgcn_sched_barrier(0)
    Unit cur, nxt; int ui = 0;
    if (!S.next(0, cur)) return;
    f32x4 acc[2][2][4][2];
#pragma unroll
    for (int a = 0; a < 2; ++a)
#pragma unroll
        for (int b = 0; b < 2; ++b)
#pragma unroll
            for (int m = 0; m < 4; ++m)
#pragma unroll
                for (int n = 0; n < 2; ++n) acc[a][b][m][n] = (f32x4){0.f, 0.f, 0.f, 0.f};
    bf16x8 At[4][2], B0[2][2], B1[2][2];
    const char* cA = (const char*)g.A + (size_t)cur.pm * tstep + (size_t)cur.ko * 2; const char* cB = (const char*)g.Bt + (size_t)cur.pn * tstep + (size_t)cur.ko * 2;
    S.a_ready(cur);
    if constexpr (SP2) {
        PG8_STAGE(PG8_SB(0, 0), cB, voffB); PG8_STAGE(PG8_SB(0, 1), cB + hstep, voffB); PG8_STAGE(PG8_SA(0, 0), cA, voffA); PG8_STAGE(PG8_SA(0, 1), cA + hstep, voffA);
        if (wr == 1) PG8_BAR;
        PG8_WAIT_V(2); PG8_BAR;
        PG8_STAGE(PG8_SB(1, 0), cB + kstep, voffB); PG8_STAGE(PG8_SA(1, 0), cA + kstep, voffA); PG8_STAGE(PG8_SB(1, 1), cB + hstep + kstep, voffB);
        PG8_WAIT_V(6); PG8_BAR;
    } else {
        PG8_STAGE(PG8_SB(0, 0), cB, voffB); PG8_STAGE(PG8_SA(0, 0), cA, voffA); PG8_STAGE(PG8_SB(0, 1), cB + hstep, voffB); PG8_STAGE(PG8_SA(0, 1), cA + hstep, voffA);
        if (wr == 1) PG8_BAR;
        PG8_WAIT_V(4); PG8_BAR;
        PG8_STAGE(PG8_SB(1, 0), cB + kstep, voffB); PG8_STAGE(PG8_SA(1, 0), cA + kstep, voffA); PG8_STAGE(PG8_SB(1, 1), cB + hstep + kstep, voffB);
        PG8_WAIT_V(6); PG8_BAR;
    }
    for (;;) {
        const bool has_next = S.next(ui + 1, nxt);
        const char* nA = has_next ? (const char*)g.A + (size_t)nxt.pm * tstep + (size_t)nxt.ko * 2 : cA; const char* nB = has_next ? (const char*)g.Bt + (size_t)nxt.pn * tstep + (size_t)nxt.ko * 2 : cB;
        const int nt = cur.nt;
        for (int t = 0; t < nt; t += 2) {
            const bool last = (t == nt - 2);
            const char* a1 = cA + (size_t)(t + 1) * kstep;
            const char* a2 = last ? nA : cA + (size_t)(t + 2) * kstep; const char* b2 = last ? nB : cB + (size_t)(t + 2) * kstep;
            const char* a3 = a2 + kstep; const char* b3 = b2 + kstep;
            if (last && has_next) S.a_ready(nxt);
            if constexpr (SP2) {
            PG8_LDB(B0, 0, 0); PG8_LDB(B1, 0, 1); PG8_SCHED; PG8_LDA(At, 0, 0); PG8_STAGE(PG8_SA(1, 1), a1 + hstep, voffA);
            PG8_WAIT_V(8); PG8_WAIT_L(0); PG8_BAR; PG8_MMA(0, 0, At, B0); PG8_MMA(0, 1, At, B1); PG8_BAR; PG8_SCHED;
            PG8_LDA(At, 0, 1); PG8_STAGE(PG8_SB(0, 0), b2, voffB); PG8_STAGE(PG8_SB(0, 1), b2 + hstep, voffB); PG8_STAGE(PG8_SA(0, 0), a2, voffA);
            PG8_WAIT_V(8); PG8_WAIT_L(0); PG8_BAR; PG8_MMA(1, 0, At, B0); PG8_MMA(1, 1, At, B1); PG8_BAR; PG8_SCHED;
            PG8_LDB(B0, 1, 0); PG8_LDB(B1, 1, 1); PG8_SCHED; PG8_LDA(At, 1, 0); PG8_STAGE(PG8_SA(0, 1), a2 + hstep, voffA);
            PG8_WAIT_V(8); PG8_WAIT_L(0); PG8_BAR; PG8_MMA(0, 0, At, B0); PG8_MMA(0, 1, At, B1); PG8_BAR; PG8_SCHED;
            PG8_LDA(At, 1, 1); PG8_STAGE(PG8_SB(1, 0), b3, voffB); PG8_STAGE(PG8_SB(1, 1), b3 + hstep, voffB); PG8_STAGE(PG8_SA(1, 0), a3, voffA);
            PG8_WAIT_V(8); PG8_WAIT_L(0); PG8_BAR; PG8_MMA(1, 0, At, B0); PG8_MMA(1, 1, At, B1); PG8_BAR; PG8_SCHED;
            } else {
            PG8_LDB(B0, 0, 0); PG8_SCHED; PG8_LDA(At, 0, 0); PG8_STAGE(PG8_SA(1, 1), a1 + hstep, voffA);
            PG8_WAIT_L(8); PG8_BAR; PG8_WAIT_L(0); PG8_MMA(0, 0, At, B0); PG8_BAR; PG8_SCHED;
            PG8_LDB(B1, 0, 1); PG8_STAGE(PG8_SB(0, 0), b2, voffB);
            PG8_BAR; PG8_WAIT_L(0); PG8_MMA(0, 1, At, B1); PG8_BAR;
            PG8_LDA(At, 0, 1); PG8_STAGE(PG8_SA(0, 0), a2, voffA);
            PG8_BAR; PG8_WAIT_L(0); PG8_MMA(1, 0, At, B0); PG8_BAR; PG8_SCHED;
            PG8_STAGE(PG8_SB(0, 1), b2 + hstep, voffB);
            PG8_WAIT_V(6); PG8_BAR; PG8_MMA(1, 1, At, B1); PG8_BAR;
            PG8_LDB(B0, 1, 0); PG8_SCHED; PG8_LDA(At, 1, 0); PG8_STAGE(PG8_SA(0, 1), a2 + hstep, voffA);
            PG8_WAIT_L(8); PG8_BAR; PG8_WAIT_L(0); PG8_MMA(0, 0, At, B0); PG8_BAR; PG8_SCHED;
            PG8_LDB(B1, 1, 1); PG8_STAGE(PG8_SB(1, 0), b3, voffB);
            PG8_BAR; PG8_WAIT_L(0); PG8_MMA(0, 1, At, B1); PG8_BAR;
            PG8_LDA(At, 1, 1); PG8_STAGE(PG8_SA(1, 0), a3, voffA);
            PG8_BAR; PG8_WAIT_L(0); PG8_MMA(1, 0, At, B0); PG8_BAR; PG8_SCHED;
            PG8_STAGE(PG8_SB(1, 1), b3 + hstep, voffB);
            PG8_WAIT_V(6); PG8_BAR; PG8_MMA(1, 1, At, B1); PG8_BAR;
            }
        }
        if constexpr (ALIGN_EPI) { if (wr == 0) PG8_BAR; }
        if constexpr (!Epi::AFTER_DRAIN) { E(acc, cur, wr, wc, fr, fq); S.done(cur); }
        if (!has_next) break;
#pragma unroll
        for (int a = 0; a < 2; ++a)
#pragma unroll
            for (int b = 0; b < 2; ++b)
#pragma unroll
                for (int m = 0; m < 4; ++m)
#pragma unroll
                    for (int n = 0; n < 2; ++n) acc[a][b][m][n] = (f32x4){0.f, 0.f, 0.f, 0.f};
        cur = nxt; cA = nA; cB = nB; ++ui;
        if constexpr (ALIGN_EPI) { if (wr == 1) PG8_BAR; }
    }
    PG8_WAIT_V(0);
    if constexpr (!ALIGN_EPI) { if (wr == 0) PG8_BAR; }
    PG8_BAR;
    if constexpr (Epi::AFTER_DRAIN) { E.fused(acc, cur, wr, wc, fr, fq, lds, wid, lane); S.done(cur); }
#undef PG8_SA
#undef PG8_SB
#undef PG8_STAGE
#undef PG8_LDA
#undef PG8_LDB
#undef PG8_MMA
#undef PG8_WAIT_V
#undef PG8_WAIT_L
#undef PG8_BAR
#undef PG8_SCHED
}
}

#ifndef MK_REP_MASK
#define MK_REP_MASK 0
#endif
#ifndef MK_ONE_LAUNCH
#define MK_ONE_LAUNCH 1
#endif
#define LAS __attribute__((address_space(3)))
typedef unsigned short bf16;
typedef float f32x4 __attribute__((ext_vector_type(4)));
typedef unsigned u32x4 __attribute__((ext_vector_type(4)));
typedef unsigned u32x2 __attribute__((ext_vector_type(2)));
constexpr int D = 1024, NB = 8, SEQ = 2048, NMETA = 16, TP = SEQ + NMETA, DB = 128, DS = 4;
constexpr int NH = 8, DTMP = 1792, DIN = 2816, DFF = 3072;
constexpr int R_SAMPLE = NB * SEQ, R_META = R_SAMPLE + DB * DS, R_END = R_META + NMETA, MP = 17152, M_MAIN = 16896;
constexpr float EPS = 1e-6f, GN_EPS = 64e-5f;
constexpr int NPH = 12;
constexpr int LDS_BYTES = 147456;
enum { I_XP = 0, I_XS, I_STS, I_SWKV, I_SLC, I_SLH, I_SFC, I_META, I_N1G, I_WIN, I_MU, I_W0, I_WUP, I_A0, I_AUP, I_GUP, I_KK, I_KA, I_RK,
       I_GNG, I_GNB, I_LCW, I_LCB, I_LWA, I_LBA, I_LWX, I_LBX, I_LAM, I_LOG, I_WOUT, I_N2G, I_FUP, I_FGATE, I_FCW, I_FCB, I_FDOWN, I_NFG, N_IN };
constexpr size_t O_YP = 0, O_YS = 16777216, O_PSHIFT = 17301504, O_PWKV = 17315840, O_PLC = 17577984, O_PLH = 17590272, O_PFC = 17594368,
                 O_SSHIFT = 17643520, O_SWKV = 17872896, O_SLC = 22067200, O_SLH = 22263808, O_SFC = 22329344, O_END = 23115776;
constexpr size_t MiB = 1u << 20;
constexpr size_t WS_CTL = 0, CTL_ZERO_BYTES = 65536;
constexpr size_t WS_SSQ1 = 1 * MiB, WS_SSQ2 = WS_SSQ1 + (size_t)MP * 16 * 4;
constexpr size_t WS_WUP = 4 * MiB, WS_WGATE = 10 * MiB, WS_WDOWN = 16 * MiB;
constexpr size_t WS_X1B = 22 * MiB, WS_UP = WS_X1B + (size_t)MP * D * 2, WS_HID = WS_UP + (size_t)MP * DFF * 2;
constexpr size_t WS_U = 22 * MiB;
constexpr size_t WS_XN = 115 * MiB, WS_WIN = WS_XN + (size_t)MP * D * 2;
constexpr size_t WS_AP = 190 * MiB, WS_XC = 199 * MiB, WS_BA = 216 * MiB, WS_BB = 217 * MiB, WS_GB = 220 * MiB;
constexpr size_t WS_REC = 115 * MiB, WS_LRU = 182 * MiB, WS_Y = 220 * MiB, WS_MIX = 115 * MiB;
static_assert(WS_SSQ2 + (size_t)MP * 16 * 4 <= WS_WUP, "ssq");
static_assert(WS_HID + (size_t)M_MAIN * DFF * 2 <= 256 * MiB, "hid");
static_assert(WS_U + (size_t)MP * DIN * 2 <= WS_XN, "u");
static_assert(WS_WIN + (size_t)DIN * D * 2 <= WS_LRU, "win");
static_assert(WS_AP + (size_t)MP * 256 * 2 <= WS_XC && WS_XC + (size_t)MP * 512 * 2 <= WS_BA, "ap/xc");
static_assert(WS_GB + (size_t)MP * 1024 * 2 <= 256 * MiB, "gb");
static_assert(WS_REC + (size_t)R_END * 4096 <= WS_LRU && WS_LRU + (size_t)R_END * 2048 <= WS_BA, "rec/lru");
static_assert(WS_Y + (size_t)R_END * 2048 <= 256 * MiB, "y");
constexpr size_t DO_GA = 0, DO_LTOT = (size_t)MP * 1536 * 2, DO_CARRY = DO_LTOT + 513 * 2 * 512 * 4, DO_BON = DO_CARRY + 8 * 64 * 512 * 4, DO_WOUT = O_SFC * 4;
static_assert(DO_BON + (size_t)R_END * 8 * 4 <= O_PSHIFT * 4, "d_out scratch");

struct Args { const float* in[N_IN]; float* out; unsigned char* ws; int ph_lo, ph_hi; };

__device__ __forceinline__ float bf2f(bf16 h) { return __uint_as_float(((unsigned)h) << 16); }
__device__ __forceinline__ unsigned f2bf(float f) { unsigned u = __float_as_uint(f); return (u + 0x7fffu + ((u >> 16) & 1u)) >> 16; }
typedef float f32x2_t __attribute__((ext_vector_type(2))); typedef __bf16 bf16x2_t __attribute__((ext_vector_type(2)));
__device__ __forceinline__ unsigned pk2(float lo, float hi) { const f32x2_t v = {lo, hi}; const bf16x2_t b = __builtin_convertvector(v, bf16x2_t); return __builtin_bit_cast(unsigned, b); }
__device__ __forceinline__ float lo16(unsigned w) { return __uint_as_float(w << 16); }
__device__ __forceinline__ float hi16(unsigned w) { return __uint_as_float(w & 0xffff0000u); }
__device__ __forceinline__ float sigm(float x) { return __builtin_amdgcn_rcpf(1.f + __builtin_amdgcn_exp2f(-1.4426950409f * x)); }
__device__ __forceinline__ float softplus_(float z) { return fmaxf(z, 0.f) + log1pf(__expf(-fabsf(z))); }
__device__ __forceinline__ float gelu_tanh(float x) { const float t = x * (-2.3022082f + -0.10294324f * (x * x)); return x * __builtin_amdgcn_rcpf(1.f + __builtin_amdgcn_exp2f(t)); }
__device__ __forceinline__ float tanh_(float x) { const float e = __builtin_amdgcn_exp2f(2.8853900818f * x); return 1.f - 2.f * __builtin_amdgcn_rcpf(e + 1.f); }
__device__ __forceinline__ float wave_sum(float v) {
#pragma unroll
    for (int o = 1; o < 64; o <<= 1) v += __shfl_xor(v, o);
    return v;
}
template <int CTRL> __device__ __forceinline__ float dpp_f(float x) { return __int_as_float(__builtin_amdgcn_update_dpp(0, __float_as_int(x), CTRL, 0xF, 0xF, true)); }
__device__ __forceinline__ float allsum16(float x) { x += dpp_f<0xB1>(x); x += dpp_f<0x4E>(x); x += dpp_f<0x141>(x); x += dpp_f<0x140>(x); return x; }

struct RowInfo { int kind, b, t; };
__device__ __forceinline__ RowInfo row_info(int row) {
    RowInfo r;
    if (row < R_SAMPLE) { r.kind = 0; r.b = row >> 11; r.t = (row & 2047) + NMETA; }
    else if (row < R_META) { r.kind = 1; r.b = (row - R_SAMPLE) >> 2; r.t = (row - R_SAMPLE) & 3; }
    else if (row < R_END) { r.kind = 2; r.b = 0; r.t = row - R_META; }
    else { r.kind = 3; r.b = 0; r.t = 0; }
    return r;
}
__device__ __forceinline__ int prompt_row(int b, int t) { return t < NMETA ? R_META + t : b * SEQ + t - NMETA; }
__device__ __forceinline__ int row_back(const RowInfo& ri, int row, int j) {
    const int tt = ri.t - j; if (tt < 0) return -1;
    if (ri.kind == 1) return row - j;
    return prompt_row(ri.b, tt);
}
__device__ __forceinline__ void unpack8(const u32x4 w, float (&f)[8]) {
    f[0] = lo16(w.x); f[1] = hi16(w.x); f[2] = lo16(w.y); f[3] = hi16(w.y); f[4] = lo16(w.z); f[5] = hi16(w.z); f[6] = lo16(w.w); f[7] = hi16(w.w);
}
__device__ __forceinline__ void ld8f(const float* p, float (&f)[8]) { const f32x4 a = *(const f32x4*)p, b = *(const f32x4*)(p + 4); f[0] = a.x; f[1] = a.y; f[2] = a.z; f[3] = a.w; f[4] = b.x; f[5] = b.y; f[6] = b.z; f[7] = b.w; }
__device__ __forceinline__ u32x4 pack8(const float (&o)[8]) { u32x4 w; w.x = pk2(o[0], o[1]); w.y = pk2(o[2], o[3]); w.z = pk2(o[4], o[5]); w.w = pk2(o[6], o[7]); return w; }
__device__ __forceinline__ float row_rs(const float* ssq, int row) {
    const f32x4* p = (const f32x4*)(ssq + (size_t)row * 16); const f32x4 a = p[0], b = p[1], c = p[2], d = p[3];
    const float s = ((a.x + a.y) + (a.z + a.w)) + ((b.x + b.y) + (b.z + b.w)) + ((c.x + c.y) + (c.z + c.w)) + ((d.x + d.y) + (d.z + d.w));
    return __builtin_amdgcn_rsqf(s * (1.f / 1024.f) + EPS);
}

#define EPI_ROW(ai, m) (u.pm * 256 + (ai) * 128 + wr * 64 + (m) * 16 + fr)
#define EPI_COL(bj) (u.pn * 256 + (bj) * 128 + wc * 32 + 8 * fq)
struct EpiX1 {
    static constexpr bool PERM = true, AFTER_DRAIN = false;
    const float* __restrict__ xp; const float* __restrict__ xs; const float* __restrict__ meta; float* __restrict__ x1; bf16* __restrict__ x1b; float* __restrict__ ssq;
    __device__ __forceinline__ void operator()(const f32x4 (&acc)[2][2][4][2], const pg8::Unit& u, int wr, int wc, int fr, int fq) const {
#pragma unroll
        for (int ai = 0; ai < 2; ++ai)
#pragma unroll
            for (int m = 0; m < 4; ++m) {
                const int row = EPI_ROW(ai, m);
                const float* res = row < R_SAMPLE ? xp + (size_t)row * D : row < R_META ? xs + (size_t)(row - R_SAMPLE) * D : row < R_END ? meta + (size_t)(row - R_META) * D : nullptr;
                float s = 0.f;
#pragma unroll
                for (int bj = 0; bj < 2; ++bj) {
                    const int col = EPI_COL(bj);
                    f32x4 v0 = acc[ai][bj][m][0], v1 = acc[ai][bj][m][1];
                    if (res) { v0 += *(const f32x4*)(res + col); v1 += *(const f32x4*)(res + col + 4); }
                    if (row >= R_SAMPLE && row < M_MAIN) { *(f32x4*)(x1 + (size_t)row * D + col) = v0; *(f32x4*)(x1 + (size_t)row * D + col + 4) = v1; }
                    u32x4 w; w.x = pk2(v0.x, v0.y); w.y = pk2(v0.z, v0.w); w.z = pk2(v1.x, v1.y); w.w = pk2(v1.z, v1.w);
                    *(u32x4*)(x1b + (size_t)row * D + col) = w;
                    s += (v0.x * v0.x + v0.y * v0.y) + (v0.z * v0.z + v0.w * v0.w) + (v1.x * v1.x + v1.y * v1.y) + (v1.z * v1.z + v1.w * v1.w);
                }
                s += __shfl_xor(s, 16); s += __shfl_xor(s, 32);
                if (fq == 0) ssq[(size_t)row * 16 + u.pn * 4 + wc] = s;
            }
    }
};
struct EpiUp {
    static constexpr bool PERM = true, AFTER_DRAIN = false;
    const float* __restrict__ ssq; bf16* __restrict__ up; float* __restrict__ pffn; float* __restrict__ sffn;
    __device__ __forceinline__ void operator()(const f32x4 (&acc)[2][2][4][2], const pg8::Unit& u, int wr, int wc, int fr, int fq) const {
#pragma unroll
        for (int ai = 0; ai < 2; ++ai)
#pragma unroll
            for (int m = 0; m < 4; ++m) {
                const int row = EPI_ROW(ai, m);
                const float rs = row_rs(ssq, row);
                const RowInfo ri = row_info(row);
                float* st = nullptr;
                if (ri.kind == 0 && ri.t >= TP - 2) st = pffn + ((size_t)ri.b * 2 + (ri.t - (TP - 2))) * DFF;
                else if (ri.kind == 1 && ri.t >= 2) st = sffn + ((size_t)ri.b * 2 + (ri.t - 2)) * DFF;
#pragma unroll
                for (int bj = 0; bj < 2; ++bj) {
                    const int col = EPI_COL(bj);
                    const f32x4 v0 = acc[ai][bj][m][0] * rs, v1 = acc[ai][bj][m][1] * rs;
                    u32x4 w; w.x = pk2(v0.x, v0.y); w.y = pk2(v0.z, v0.w); w.z = pk2(v1.x, v1.y); w.w = pk2(v1.z, v1.w);
                    *(u32x4*)(up + (size_t)row * DFF + col) = w;
                    if (st) { *(f32x4*)(st + col) = v0; *(f32x4*)(st + col + 4) = v1; }
                }
            }
    }
};
struct EpiGate {
    static constexpr bool PERM = true, AFTER_DRAIN = false;
    const float* ssq; const bf16* up; const float* stf; const float* cw; const float* cb; bf16* hid;
    __device__ __forceinline__ void operator()(const f32x4 (&acc)[2][2][4][2], const pg8::Unit& u, int wr, int wc, int fr, int fq) const {
#pragma unroll
        for (int ai = 0; ai < 2; ++ai)
#pragma unroll
            for (int m = 0; m < 4; ++m) {
                const int row = EPI_ROW(ai, m);
                const float rs = row_rs(ssq, row);
                const RowInfo ri = row_info(row);
                const int r1 = row_back(ri, row, 1), r2 = row_back(ri, row, 2);
#pragma unroll
                for (int bj = 0; bj < 2; ++bj) {
                    const int col = EPI_COL(bj);
                    float g[8], u0[8], p1[8], p2[8];
                    { const f32x4 v0 = acc[ai][bj][m][0] * rs, v1 = acc[ai][bj][m][1] * rs; g[0] = v0.x; g[1] = v0.y; g[2] = v0.z; g[3] = v0.w; g[4] = v1.x; g[5] = v1.y; g[6] = v1.z; g[7] = v1.w; }
                    unpack8(*(const u32x4*)(up + (size_t)row * DFF + col), u0);
                    if (r1 >= 0) unpack8(*(const u32x4*)(up + (size_t)r1 * DFF + col), p1);
                    else if (ri.kind == 1) { const float* s = stf + ((size_t)ri.b * 2 + (1 + ri.t)) * DFF + col; const f32x4 a = *(const f32x4*)s, b = *(const f32x4*)(s + 4);
                        p1[0] = a.x; p1[1] = a.y; p1[2] = a.z; p1[3] = a.w; p1[4] = b.x; p1[5] = b.y; p1[6] = b.z; p1[7] = b.w; }
                    else {
#pragma unroll
                        for (int i = 0; i < 8; ++i) p1[i] = 0.f; }
                    if (r2 >= 0) unpack8(*(const u32x4*)(up + (size_t)r2 * DFF + col), p2);
                    else if (ri.kind == 1) { const float* s = stf + ((size_t)ri.b * 2 + ri.t) * DFF + col; const f32x4 a = *(const f32x4*)s, b = *(const f32x4*)(s + 4);
                        p2[0] = a.x; p2[1] = a.y; p2[2] = a.z; p2[3] = a.w; p2[4] = b.x; p2[5] = b.y; p2[6] = b.z; p2[7] = b.w; }
                    else {
#pragma unroll
                        for (int i = 0; i < 8; ++i) p2[i] = 0.f; }
                    float o[8];
#pragma unroll
                    for (int h = 0; h < 2; ++h) {
                        const f32x4 w0 = *(const f32x4*)(cw + col + 4 * h), w1 = *(const f32x4*)(cw + DFF + col + 4 * h), w2 = *(const f32x4*)(cw + 2 * DFF + col + 4 * h), bb = *(const f32x4*)(cb + col + 4 * h);
#pragma unroll
                        for (int i = 0; i < 4; ++i) { const int e = 4 * h + i; const float c = bb[i] + w0[i] * p2[e] + w1[i] * p1[e] + w2[i] * u0[e]; o[e] = gelu_tanh(c) * g[e]; }
                    }
                    u32x4 w; w.x = pk2(o[0], o[1]); w.y = pk2(o[2], o[3]); w.z = pk2(o[4], o[5]); w.w = pk2(o[6], o[7]);
                    *(u32x4*)(hid + (size_t)row * DFF + col) = w;
                }
            }
    }
};
struct EpiDown {
    static constexpr bool PERM = true, AFTER_DRAIN = false;
    float* __restrict__ x; const bf16* __restrict__ x1b;
    __device__ __forceinline__ void operator()(const f32x4 (&acc)[2][2][4][2], const pg8::Unit& u, int wr, int wc, int fr, int fq) const {
        const bool part = u.nt != DFF / 64;
#pragma unroll
        for (int ai = 0; ai < 2; ++ai)
#pragma unroll
            for (int m = 0; m < 4; ++m) {
                const int row = EPI_ROW(ai, m);
#pragma unroll
                for (int bj = 0; bj < 2; ++bj) {
                    const int col = EPI_COL(bj);
                    float* p = x + (size_t)row * D + col;
                    if (part) {
#pragma unroll
                        for (int i = 0; i < 4; ++i) { unsafeAtomicAdd(p + i, acc[ai][bj][m][0][i]); unsafeAtomicAdd(p + 4 + i, acc[ai][bj][m][1][i]); }
                    } else {
                        float r8[8]; unpack8(*(const u32x4*)(x1b + (size_t)row * D + col), r8);
                        const f32x4 v0 = acc[ai][bj][m][0] + (f32x4){r8[0], r8[1], r8[2], r8[3]}, v1 = acc[ai][bj][m][1] + (f32x4){r8[4], r8[5], r8[6], r8[7]};
                        *(f32x4*)p = v0; *(f32x4*)(p + 4) = v1;
                    }
                }
            }
    }
};
struct DownOrder {
    pg8::StaticOrder base; int G, c;
    __device__ void init(int G_, int c_) { base.init(R_SAMPLE, D, G_, c_, DFF); G = G_; c = c_; }
    __device__ bool next(int i, pg8::Unit& u) const {
        const int nb = (256 - c + G - 1) / G;
        if (i < nb) return base.next(i, u);
        const int j = (i - nb) * G + c; if (j >= 48) return false;
        u.pm = 64 + j / 24; u.pn = (j / 6) % 4; u.ko = (j % 6) * 512; u.nt = 8; return true;
    }
    __device__ __forceinline__ void a_ready(const pg8::Unit&) const {}
    __device__ __forceinline__ void done(const pg8::Unit&) const {}
};
struct EpiPlain {
    static constexpr bool PERM = true, AFTER_DRAIN = false;
    bf16* O; int ldc;
    __device__ __forceinline__ void operator()(const f32x4 (&acc)[2][2][4][2], const pg8::Unit& u, int wr, int wc, int fr, int fq) const {
#pragma unroll
        for (int ai = 0; ai < 2; ++ai)
#pragma unroll
            for (int m = 0; m < 4; ++m) {
                const int row = EPI_ROW(ai, m);
#pragma unroll
                for (int bj = 0; bj < 2; ++bj) {
                    const int col = EPI_COL(bj);
                    const f32x4 v0 = acc[ai][bj][m][0], v1 = acc[ai][bj][m][1];
                    u32x4 w; w.x = pk2(v0.x, v0.y); w.y = pk2(v0.z, v0.w); w.z = pk2(v1.x, v1.y); w.w = pk2(v1.z, v1.w);
                    *(u32x4*)(O + (size_t)row * ldc + col) = w;
                }
            }
    }
};

#define XB_TMO      128
#define XB_XCNT(j)  (256  + 64 * (j))
#define XB_XSUB(j)  (1280 + 64 * (j))
#define XB_XGEN(j)  (2304 + 64 * (j))
#define XB_TOP      3328
#define XB_TOPGEN   3392
#define XCD_BAR_WORDS 3456
#define XB_SPIN_CAP (1u << 22)
__device__ __forceinline__ unsigned xb_ld(unsigned* p)              { return __hip_atomic_load(p, __ATOMIC_RELAXED, __HIP_MEMORY_SCOPE_AGENT); }
__device__ __forceinline__ unsigned xb_add(unsigned* p, unsigned v) { return __hip_atomic_fetch_add(p, v, __ATOMIC_RELAXED, __HIP_MEMORY_SCOPE_AGENT); }
__device__ __forceinline__ unsigned xb_xcc_id() { return (unsigned)__builtin_amdgcn_s_getreg((3 << 11) | 20) & 0xFu; }
#define XB_SPIN(cond, bar) do { unsigned _sp = 0; while (cond) { __builtin_amdgcn_s_sleep(1); \
    if ((++_sp & 255u) == 0u) { if (xb_ld(&(bar)[XB_TMO])) break; if (_sp > XB_SPIN_CAP) { atomicAdd(&(bar)[XB_TMO], 1u); break; } } } } while (0)
struct XcdBarrier { unsigned* bar; unsigned x; volatile LAS unsigned* st; };
__device__ __forceinline__ XcdBarrier xcd_barrier_post(unsigned* bar, volatile LAS unsigned* st) {
    XcdBarrier b; b.bar = bar; b.x = xb_xcc_id(); b.st = st;
    if (threadIdx.x == 0) (void)xb_add(&bar[XB_XCNT(b.x)], 1u);
    return b;
}
__device__ __forceinline__ void xcd_barrier_complete(unsigned* bar, unsigned x, unsigned& nloc, unsigned& nx) {
    const unsigned G = gridDim.x * gridDim.y * gridDim.z;
    unsigned sum, cnt, mine, sp = 0u;
    for (;;) {
        sum = 0u; cnt = 0u; mine = 0u;
#pragma unroll
        for (unsigned j = 0; j < 16; ++j) { const unsigned c = xb_ld(&bar[XB_XCNT(j)]); sum += c; cnt += (c > 0u) ? 1u : 0u; mine = (j == x) ? c : mine; }
        if (sum == G) break;
        __builtin_amdgcn_s_sleep(1);
        if ((++sp & 255u) == 0u) { if (xb_ld(&bar[XB_TMO])) break; if (sp > XB_SPIN_CAP) { atomicAdd(&bar[XB_TMO], 1u); break; } }
    }
    nloc = mine > 0u ? mine : 1u; nx = cnt > 0u ? cnt : 1u;
}
__device__ __forceinline__ void xcd_barrier(const XcdBarrier& b) {
    asm volatile("s_waitcnt vmcnt(0)" ::: "memory");
    __syncthreads();
    if (threadIdx.x == 0) {
        unsigned* bar = b.bar;
        __builtin_amdgcn_s_waitcnt(0);
        unsigned nloc = b.st[0], nx = b.st[1];
        if (nloc == 0u) { xcd_barrier_complete(bar, b.x, nloc, nx); b.st[0] = nloc; b.st[1] = nx; }
        const unsigned old = xb_add(&bar[XB_XSUB(b.x)], 1u);
        const unsigned gen = old / nloc;
        if (old + 1u == (gen + 1u) * nloc) {
            __builtin_amdgcn_fence(__ATOMIC_RELEASE, "agent");
            asm volatile("s_waitcnt vmcnt(0)" ::: "memory");
            const unsigned og = xb_add(&bar[XB_TOP], 1u);
            const unsigned tg = og / nx;
            if (og + 1u == (tg + 1u) * nx) xb_add(&bar[XB_TOPGEN], 1u);
            else XB_SPIN(xb_ld(&bar[XB_TOPGEN]) == tg, bar);
            __builtin_amdgcn_fence(__ATOMIC_ACQUIRE, "agent");
            xb_add(&bar[XB_XGEN(b.x)], 1u);
            asm volatile("s_waitcnt vmcnt(0)" ::: "memory");
        } else {
            XB_SPIN(xb_ld(&bar[XB_XGEN(b.x)]) == gen, bar);
            __builtin_amdgcn_fence(__ATOMIC_ACQUIRE, "agent");
            asm volatile("s_waitcnt vmcnt(0)" ::: "memory");
        }
    }
    __syncthreads();
}

__device__ __forceinline__ void p0_transpose_item(const float* W, int K, int N, bf16* WT, const float* ksc, LAS float* scr, int item, int lane) {
    const int nblk = N / 32, kb = item / nblk, nb = item % nblk, k0 = 64 * kb, n0 = 32 * nb;
#pragma unroll
    for (int i = 0; i < 32; ++i) { const int kk = 2 * i + (lane >> 5); float v = W[(size_t)(k0 + kk) * N + n0 + (lane & 31)]; if (ksc) v *= ksc[k0 + kk]; scr[kk * 33 + (lane & 31)] = v; }
    asm volatile("s_waitcnt lgkmcnt(0)" ::: "memory");
    const int c = lane & 7;
#pragma unroll
    for (int j = 0; j < 4; ++j) { const int n = (lane >> 3) + 8 * j; const LAS float* s = scr + (8 * c) * 33 + n;
        u32x4 o; o.x = pk2(s[0 * 33], s[1 * 33]); o.y = pk2(s[2 * 33], s[3 * 33]); o.z = pk2(s[4 * 33], s[5 * 33]); o.w = pk2(s[6 * 33], s[7 * 33]);
        *(u32x4*)(WT + (size_t)(n0 + n) * K + k0 + 8 * c) = o; }
    asm volatile("s_waitcnt lgkmcnt(0)" ::: "memory");
}
__device__ __forceinline__ void phase_p0(const Args& A, LAS unsigned char* lds, int G) {
    const int tid = my_tid(), lane = tid & 63, wave = tid >> 6;
    LAS float* scr = (LAS float*)(lds + wave * 16384);
    const int gw = blockIdx.x * 8 + wave, NGW = G * 8;
    unsigned char* ws = A.ws;
    constexpr int I_IN = 16 * 88, I_OUT = 16 * 32, I_UPI = 16 * 96, I_DN = 48 * 32, NIT = I_IN + I_OUT + 2 * I_UPI + I_DN;
    for (int it = gw; it < NIT; it += NGW) {
        int r = it;
        if (r < I_IN) { p0_transpose_item(A.in[I_WIN], D, DIN, (bf16*)(ws + WS_WIN), nullptr, scr, r, lane); continue; } r -= I_IN;
        if (r < I_OUT) { p0_transpose_item(A.in[I_WOUT], D, D, (bf16*)((unsigned char*)A.out + DO_WOUT), nullptr, scr, r, lane); continue; } r -= I_OUT;
        if (r < I_UPI) { p0_transpose_item(A.in[I_FUP], D, DFF, (bf16*)(ws + WS_WUP), A.in[I_N2G], scr, r, lane); continue; } r -= I_UPI;
        if (r < I_UPI) { p0_transpose_item(A.in[I_FGATE], D, DFF, (bf16*)(ws + WS_WGATE), A.in[I_N2G], scr, r, lane); continue; } r -= I_UPI;
        p0_transpose_item(A.in[I_FDOWN], DFF, D, (bf16*)(ws + WS_WDOWN), nullptr, scr, r, lane);
    }
    const int gt = blockIdx.x * 512 + tid, NGT = G * 512;
    { bf16* BA = (bf16*)(ws + WS_BA); const float* wup = A.in[I_WUP]; const float* aup = A.in[I_AUP]; const float* gup = A.in[I_GUP];
      for (int e = gt; e < 1536 * 256; e += NGT) { const int n = e >> 8, k = e & 255; float v = 0.f;
          if (n < 512) { if (k < 64) v = wup[k * 512 + n]; }
          else if (n < 1024) { if (k >= 64 && k < 128) v = aup[(k - 64) * 512 + n - 512]; }
          else { if (k >= 128) v = gup[(k - 128) * 512 + n - 1024]; }
          BA[e] = (bf16)f2bf(v); } }
    { bf16* BB = (bf16*)(ws + WS_BB); const float* wa = A.in[I_LWA]; const float* wx = A.in[I_LWX];
      for (int e = gt; e < 1024 * 512; e += NGT) { const int n = e >> 9, k = e & 511, nn = n & 511, h = nn >> 6, j = nn & 63; float v = 0.f;
          if ((k >> 6) == h) { const float* Wm = n < 512 ? wa : wx; v = Wm[(h * 64 + (k & 63)) * 64 + j]; }
          BB[e] = (bf16)f2bf(v); } }
    bf16* XN = (bf16*)(ws + WS_XN); const float* g1 = A.in[I_N1G];
    f32x4 gv[4];
#pragma unroll
    for (int j = 0; j < 4; ++j) gv[j] = ((const f32x4*)g1)[lane + 64 * j];
#pragma unroll 2
    for (int row = gw; row < MP; row += NGW) {
        const float* src = row < R_SAMPLE ? A.in[I_XP] + (size_t)row * D : row < R_META ? A.in[I_XS] + (size_t)(row - R_SAMPLE) * D : row < R_END ? A.in[I_META] + (size_t)(row - R_META) * D : nullptr;
        u32x2* o = (u32x2*)(XN + (size_t)row * D);
        if (!src) {
#pragma unroll
            for (int j = 0; j < 4; ++j) o[lane + 64 * j] = (u32x2){0u, 0u};
            continue; }
        f32x4 v[4]; float s = 0.f;
#pragma unroll
        for (int j = 0; j < 4; ++j) { v[j] = ((const f32x4*)src)[lane + 64 * j]; s += (v[j].x * v[j].x + v[j].y * v[j].y) + (v[j].z * v[j].z + v[j].w * v[j].w); }
        const float rs = __builtin_amdgcn_rsqf(wave_sum(s) * (1.f / D) + EPS);
#pragma unroll
        for (int j = 0; j < 4; ++j) { const f32x4 g = gv[j];
            o[lane + 64 * j] = (u32x2){pk2(v[j].x * rs * g.x, v[j].y * rs * g.y), pk2(v[j].z * rs * g.z, v[j].w * rs * g.w)}; }
    }
}

__device__ __forceinline__ void phase_e1(const Args& A, int G) {
    const int tid = my_tid(), lane = tid & 63, wave = tid >> 6;
    const int gw = blockIdx.x * 8 + wave, NGW = G * 8;
    unsigned char* ws = A.ws;
    const bf16* __restrict__ U = (const bf16*)(ws + WS_U); bf16* __restrict__ AP = (bf16*)(ws + WS_AP); bf16* __restrict__ XC = (bf16*)(ws + WS_XC);
    const float* mu = A.in[I_MU]; const float* sts = A.in[I_STS]; const float* slc = A.in[I_SLC]; const float* lcw = A.in[I_LCW]; const float* lcb = A.in[I_LCB];
#pragma unroll 4
    for (int row = gw; row < MP; row += NGW) {
        bf16* ap = AP + (size_t)row * 256; bf16* xc = XC + (size_t)row * 512;
        const RowInfo ri = row_info(row);
        if (ri.kind == 3) { ((u32x2*)ap)[lane] = (u32x2){0u, 0u}; ((u32x4*)xc)[lane] = (u32x4){0u, 0u, 0u, 0u}; continue; }
        const bf16* urow = U + (size_t)row * DIN;
        const int r1 = row_back(ri, row, 1);
        {
            const int c0 = 1536 + 4 * lane;
            const u32x2 uw = *(const u32x2*)(urow + c0);
            float u[4] = {lo16(uw.x), hi16(uw.x), lo16(uw.y), hi16(uw.y)}, p[4];
            if (r1 >= 0) { const u32x2 pw = *(const u32x2*)(U + (size_t)r1 * DIN + c0); p[0] = lo16(pw.x); p[1] = hi16(pw.x); p[2] = lo16(pw.y); p[3] = hi16(pw.y); }
            else if (ri.kind == 1) { const f32x4 pv = *(const f32x4*)(sts + (size_t)ri.b * DTMP + c0); p[0] = pv.x; p[1] = pv.y; p[2] = pv.z; p[3] = pv.w; }
            else { p[0] = p[1] = p[2] = p[3] = 0.f; }
            const f32x4 m4 = *(const f32x4*)(mu + c0);
            float o[4];
#pragma unroll
            for (int i = 0; i < 4; ++i) { const float um = u[i] + (p[i] - u[i]) * m4[i]; o[i] = lane < 16 ? tanh_(um) : lane < 32 ? um : sigm(um); }
            ((u32x2*)ap)[lane] = (u32x2){pk2(o[0], o[1]), pk2(o[2], o[3])};
        }
        {
            const int c = 8 * lane;
            float acc[8], cur[8];
            { const f32x4 b0 = *(const f32x4*)(lcb + c), b1 = *(const f32x4*)(lcb + c + 4); acc[0] = b0.x; acc[1] = b0.y; acc[2] = b0.z; acc[3] = b0.w; acc[4] = b1.x; acc[5] = b1.y; acc[6] = b1.z; acc[7] = b1.w; }
#pragma unroll
            for (int j = 0; j < 4; ++j) {
                float val[8];
                const int rj = (j == 3) ? row : row_back(ri, row, 3 - j);
                if (rj >= 0) unpack8(*(const u32x4*)(U + (size_t)rj * DIN + DTMP + c), val);
                else if (ri.kind == 1) { const float* s = slc + ((size_t)ri.b * 3 + (ri.t + j)) * 512 + c; const f32x4 a = *(const f32x4*)s, b = *(const f32x4*)(s + 4);
                    val[0] = a.x; val[1] = a.y; val[2] = a.z; val[3] = a.w; val[4] = b.x; val[5] = b.y; val[6] = b.z; val[7] = b.w; }
                else {
#pragma unroll
                    for (int i = 0; i < 8; ++i) val[i] = 0.f; }
                const f32x4 w0 = *(const f32x4*)(lcw + j * 512 + c), w1 = *(const f32x4*)(lcw + j * 512 + c + 4);
#pragma unroll
                for (int i = 0; i < 4; ++i) { acc[i] += w0[i] * val[i]; acc[4 + i] += w1[i] * val[4 + i]; }
                if (j == 3) {
#pragma unroll
                    for (int i = 0; i < 8; ++i) cur[i] = val[i]; }
            }
            u32x4 w; w.x = pk2(acc[0], acc[1]); w.y = pk2(acc[2], acc[3]); w.z = pk2(acc[4], acc[5]); w.w = pk2(acc[6], acc[7]);
            ((u32x4*)xc)[lane] = w;
            float* lco = nullptr;
            if (ri.kind == 0 && ri.t >= TP - 3) lco = A.out + O_PLC + ((size_t)ri.b * 3 + (ri.t - (TP - 3))) * 512 + c;
            else if (ri.kind == 1 && ri.t >= 1) lco = A.out + O_SLC + ((size_t)ri.b * 3 + (ri.t - 1)) * 512 + c;
            if (lco) { *(f32x4*)lco = (f32x4){cur[0], cur[1], cur[2], cur[3]}; *(f32x4*)(lco + 4) = (f32x4){cur[4], cur[5], cur[6], cur[7]}; }
        }
        float* sho = nullptr;
        if (ri.kind == 0 && ri.t == TP - 1) sho = A.out + O_PSHIFT + (size_t)ri.b * DTMP;
        else if (ri.kind == 1 && ri.t == DS - 1) sho = A.out + O_SSHIFT + (size_t)ri.b * DTMP;
        if (sho) for (int i = lane; i < DTMP; i += 64) sho[i] = bf2f(urow[i]);
    }
}

__device__ __forceinline__ float sum8(float x) { x += dpp_f<0xB1>(x); x += dpp_f<0x4E>(x); x += dpp_f<0x141>(x); return x; }
__device__ __forceinline__ void phase_e2(const Args& A, int G) {
    const int tid = my_tid(), lane = tid & 63, wave = tid >> 6;
    unsigned char* ws = A.ws;
    const bf16* __restrict__ U = (const bf16*)(ws + WS_U); const bf16* __restrict__ GB = (const bf16*)(ws + WS_GB); const bf16* __restrict__ GA = (const bf16*)((unsigned char*)A.out + DO_GA);
    bf16* __restrict__ REC = (bf16*)(ws + WS_REC); bf16* __restrict__ LRU = (bf16*)(ws + WS_LRU);
    float* __restrict__ LTOT = (float*)((unsigned char*)A.out + DO_LTOT); float* __restrict__ BON = (float*)((unsigned char*)A.out + DO_BON);
    const float* mu = A.in[I_MU]; const float* sts = A.in[I_STS]; const float* slc = A.in[I_SLC]; const float* slh = A.in[I_SLH];
    for (int unit = blockIdx.x; unit < 513 + DB; unit += G) {
        int row0, ntok, kind;
        if (unit < 512) { row0 = unit * 32; ntok = 32; kind = 0; } else if (unit == 512) { row0 = R_META; ntok = 16; kind = 2; } else { row0 = R_SAMPLE + (unit - 513) * 4; ntok = 4; kind = 1; }
        const int c = tid;
        const float sp = softplus_(-A.in[I_LAM][c]);
        const float cw0 = A.in[I_LCW][c], cw1 = A.in[I_LCW][512 + c], cw2 = A.in[I_LCW][1024 + c], cw3 = A.in[I_LCW][1536 + c], cbias = A.in[I_LCB][c];
        const float ba_ = A.in[I_LBA][c], bx_ = A.in[I_LBX][c];
        float l1 = 0.f, l2 = 0.f, l3 = 0.f, H = 0.f, P = 1.f;
        if (kind == 0) { const RowInfo ri0 = row_info(row0);
            l1 = bf2f(U[(size_t)row_back(ri0, row0, 1) * DIN + DTMP + c]); l2 = bf2f(U[(size_t)row_back(ri0, row0, 2) * DIN + DTMP + c]); l3 = bf2f(U[(size_t)row_back(ri0, row0, 3) * DIN + DTMP + c]); }
        else if (kind == 1) { const int b = unit - 513; l3 = slc[((size_t)b * 3 + 0) * 512 + c]; l2 = slc[((size_t)b * 3 + 1) * 512 + c]; l1 = slc[((size_t)b * 3 + 2) * 512 + c]; H = slh[(size_t)b * 512 + c]; }
#pragma unroll 4
        for (int j = 0; j < ntok; ++j) {
            const int row = row0 + j;
            const float l0 = bf2f(U[(size_t)row * DIN + DTMP + c]);
            const float xc = cbias + cw0 * l3 + cw1 * l2 + cw2 * l1 + cw3 * l0;
            l3 = l2; l2 = l1; l1 = l0;
            const float ra = bf2f(GB[(size_t)row * 1024 + c]) + ba_, ix = bf2f(GB[(size_t)row * 1024 + 512 + c]) + bx_;
            const float rg = sigm(ra), ig = sigm(ix);
            const float la = -8.f * rg * sp, a = __builtin_amdgcn_exp2f(1.4426950409f * la);
            float mult = __builtin_amdgcn_sqrtf(fmaxf(1.f - __builtin_amdgcn_exp2f(2.8853900818f * la), 0.f)); if (kind == 2 && j == 0) mult = 1.f;
            H = a * H + xc * ig * mult; P = P * a;
            LRU[(size_t)row * 1024 + c] = (bf16)f2bf(H); LRU[(size_t)row * 1024 + 512 + c] = (bf16)f2bf(kind == 1 ? 0.f : P);
        }
        if (kind == 1) A.out[O_SLH + (size_t)(unit - 513) * 512 + c] = H;
        else { LTOT[((size_t)unit * 2 + 0) * 512 + c] = P; LTOT[((size_t)unit * 2 + 1) * 512 + c] = H; }
    }
    {
        const int c = 8 * lane, h = lane >> 3, gw = blockIdx.x * 8 + wave, NGW = G * 8;
        float mr[8], mk[8], w0[8], a0[8], kkw[8], kaw[8], rkw[8];
        ld8f(mu + c, mr); ld8f(mu + 512 + c, mk); ld8f(A.in[I_W0] + c, w0); ld8f(A.in[I_A0] + c, a0); ld8f(A.in[I_KK] + c, kkw); ld8f(A.in[I_KA] + c, kaw); ld8f(A.in[I_RK] + c, rkw);
#pragma unroll 2
        for (int row = gw; row < R_END; row += NGW) {
            const RowInfo ri = row_info(row); const int r1 = row_back(ri, row, 1);
            const bf16* ur = U + (size_t)row * DIN;
            float u_r[8], u_k[8], p_r[8], p_k[8], wp[8], ap[8];
            unpack8(*(const u32x4*)(ur + c), u_r); unpack8(*(const u32x4*)(ur + 512 + c), u_k);
            unpack8(*(const u32x4*)(GA + (size_t)row * 1536 + c), wp); unpack8(*(const u32x4*)(GA + (size_t)row * 1536 + 512 + c), ap);
            if (r1 >= 0) { unpack8(*(const u32x4*)(U + (size_t)r1 * DIN + c), p_r); unpack8(*(const u32x4*)(U + (size_t)r1 * DIN + 512 + c), p_k); }
            else if (ri.kind == 1) { ld8f(sts + (size_t)ri.b * DTMP + c, p_r); ld8f(sts + (size_t)ri.b * DTMP + 512 + c, p_k); }
            else {
#pragma unroll
                for (int i = 0; i < 8; ++i) { p_r[i] = 0.f; p_k[i] = 0.f; } }
            float av[8], xv[8], kk[8], kp[8], ss = 0.f, bs = 0.f;
#pragma unroll
            for (int i = 0; i < 8; ++i) {
                const float um_r = u_r[i] + (p_r[i] - u_r[i]) * mr[i], um_k = u_k[i] + (p_k[i] - u_k[i]) * mk[i];
                const float z = -(wp[i] + w0[i]);
                const float w_log = -(fmaxf(z, 0.f) + __logf(1.f + __expf(-fabsf(z)))) - 0.5f;
                const float e = __builtin_amdgcn_exp2f(1.4426950409f * w_log); xv[i] = 1.f - __builtin_amdgcn_exp2f(-1.4426950409f * e);
                av[i] = sigm(ap[i] + a0[i]);
                kk[i] = um_k * kkw[i]; ss += kk[i] * kk[i];
                kp[i] = um_k * (1.f + (av[i] - 1.f) * kaw[i]);
                bs += um_r * kp[i] * rkw[i];
            }
            ss = sum8(ss); bs = sum8(bs);
            const float rn = __builtin_amdgcn_rsqf(fmaxf(ss, 1e-24f));
#pragma unroll
            for (int i = 0; i < 8; ++i) kk[i] *= rn;
            bf16* rec = REC + ((size_t)row * 8 + h) * 256 + (lane & 7) * 8;
            *(u32x4*)rec = pack8(av); *(u32x4*)(rec + 64) = pack8(xv); *(u32x4*)(rec + 128) = pack8(kk); *(u32x4*)(rec + 192) = pack8(kp);
            if ((lane & 7) == 0) BON[(size_t)row * 8 + h] = bs;
        }
    }
}

struct Raw { bf16 a, x, kk, kp, ur, uv, pr, pv; };
__device__ __forceinline__ void m2_load(Raw (&raw)[8], const bf16* REC, const bf16* U, int b, int h, int t0, int ns, int k, int sub) {
#pragma unroll
    for (int i = 0; i < 8; ++i) {
        const int s = sub + 4 * i;
        raw[i].a = 0; raw[i].x = 0; raw[i].kk = 0; raw[i].kp = 0; raw[i].ur = 0; raw[i].uv = 0; raw[i].pr = 0; raw[i].pv = 0;
        if (s < ns) {
            const int t = t0 + s, row = prompt_row(b, t);
            const bf16* rec = REC + ((size_t)row * 8 + h) * 256;
            raw[i].a = rec[k]; raw[i].x = rec[64 + k]; raw[i].kk = rec[128 + k]; raw[i].kp = rec[192 + k];
            const bf16* ur = U + (size_t)row * DIN + h * 64 + k; raw[i].ur = ur[0]; raw[i].uv = ur[1024];
            if (t > 0) { const bf16* pr = U + (size_t)prompt_row(b, t - 1) * DIN + h * 64 + k; raw[i].pr = pr[0]; raw[i].pv = pr[1024]; }
        }
    }
}
__device__ __forceinline__ void m2_store(const Raw (&raw)[8], LAS float* buf, float mu_r, float mu_v, int k, int sub, int ns) {
#pragma unroll
    for (int i = 0; i < 8; ++i) {
        const int s = sub + 4 * i;
        if (s < ns) {
            LAS float* p = buf + s * 384;
            const float a = bf2f(raw[i].a), kk = bf2f(raw[i].kk), ur = bf2f(raw[i].ur), uv = bf2f(raw[i].uv);
            p[k] = kk; p[64 + k] = 1.f - bf2f(raw[i].x); p[128 + k] = -(kk * a); p[192 + k] = bf2f(raw[i].kp);
            p[256 + k] = ur + (bf2f(raw[i].pr) - ur) * mu_r; p[320 + k] = uv + (bf2f(raw[i].pv) - uv) * mu_v;
        }
    }
}
typedef float f32x2 __attribute__((ext_vector_type(2)));
struct StepOps { f32x4 kk, dd, nka, kp, r; float v; };
__device__ __forceinline__ void ops_load(StepOps& o, const LAS float* p, int ks, int vrow) {
    o.kk = *(const LAS f32x4*)(p + 4 * ks); o.dd = *(const LAS f32x4*)(p + 64 + 4 * ks); o.nka = *(const LAS f32x4*)(p + 128 + 4 * ks);
    o.kp = *(const LAS f32x4*)(p + 192 + 4 * ks); o.r = *(const LAS f32x4*)(p + 256 + 4 * ks); o.v = p[320 + vrow];
}
__device__ __forceinline__ float dot4(const f32x4 a, const f32x4 b) { f32x2 t = a.xy * b.xy; t = a.zw * b.zw + t; return t.x + t.y; }
__device__ __forceinline__ void scan_step2(f32x4& S, const StepOps& o, float& yp) {
    float d = dot4(S, o.kk);
    d += dpp_f<0xB1>(d); yp += dpp_f<0xB1>(yp); d += dpp_f<0x4E>(d); yp += dpp_f<0x4E>(yp);
    d += dpp_f<0x141>(d); yp += dpp_f<0x141>(yp); d += dpp_f<0x140>(d); yp += dpp_f<0x140>(yp);
    S = S * o.dd + d * o.nka + o.v * o.kp;
}
__device__ __forceinline__ float scan_step(f32x4& S, const StepOps& o) {
    float d = dot4(S, o.kk); d = allsum16(d);
    S = S * o.dd + d * o.nka + o.v * o.kp;
    float y = dot4(S, o.r); return allsum16(y);
}
__device__ __forceinline__ void sample_load(int task, int rl, int ks, f32x4& S, StepOps (&o)[DS], const bf16* __restrict__ REC, const bf16* __restrict__ U, const float* __restrict__ swkv, const float* __restrict__ sts, const float* __restrict__ mu) {
    const int bh = task >> 4, rg = task & 15, b = bh >> 3, h = bh & 7, v = 4 * rg + rl;
    S = *(const f32x4*)(swkv + ((size_t)bh * 64 + v) * 64 + 4 * ks);
    const f32x4 mr4 = *(const f32x4*)(mu + h * 64 + 4 * ks); const float mv = mu[1024 + h * 64 + v];
#pragma unroll
    for (int t = 0; t < DS; ++t) {
        const int row = R_SAMPLE + 4 * b + t;
        const bf16* rec = REC + ((size_t)row * 8 + h) * 256 + 4 * ks;
        const u32x2 wa = *(const u32x2*)rec, wx = *(const u32x2*)(rec + 64), wk = *(const u32x2*)(rec + 128), wp = *(const u32x2*)(rec + 192);
        const f32x4 a4 = (f32x4){lo16(wa.x), hi16(wa.x), lo16(wa.y), hi16(wa.y)};
        o[t].dd = 1.f - (f32x4){lo16(wx.x), hi16(wx.x), lo16(wx.y), hi16(wx.y)};
        o[t].kk = (f32x4){lo16(wk.x), hi16(wk.x), lo16(wk.y), hi16(wk.y)}; o[t].kp = (f32x4){lo16(wp.x), hi16(wp.x), lo16(wp.y), hi16(wp.y)};
        const u32x2 wr_ = *(const u32x2*)(U + (size_t)row * DIN + h * 64 + 4 * ks);
        const f32x4 ur4 = (f32x4){lo16(wr_.x), hi16(wr_.x), lo16(wr_.y), hi16(wr_.y)};
        const float uv = bf2f(U[(size_t)row * DIN + 1024 + h * 64 + v]);
        f32x4 pr4; float pv;
        if (t > 0) { const u32x2 w = *(const u32x2*)(U + (size_t)(row - 1) * DIN + h * 64 + 4 * ks); pr4 = (f32x4){lo16(w.x), hi16(w.x), lo16(w.y), hi16(w.y)}; pv = bf2f(U[(size_t)(row - 1) * DIN + 1024 + h * 64 + v]); }
        else { pr4 = *(const f32x4*)(sts + (size_t)b * DTMP + h * 64 + 4 * ks); pv = sts[(size_t)b * DTMP + 1024 + h * 64 + v]; }
        o[t].r = ur4 + (pr4 - ur4) * mr4; o[t].v = uv + (pv - uv) * mv; o[t].nka = -(o[t].kk * a4);
    }
}
__device__ __forceinline__ void sample_finish(int task, int rl, int ks, f32x4 S, const StepOps (&o)[DS], float* __restrict__ Y, float* __restrict__ out) {
    const int bh = task >> 4, rg = task & 15, b = bh >> 3, h = bh & 7, v = 4 * rg + rl;
#pragma unroll
    for (int t = 0; t < DS; ++t) { const float y = scan_step(S, o[t]); if (ks == 0) Y[(size_t)(R_SAMPLE + 4 * b + t) * 512 + h * 64 + v] = y; }
    *(f32x4*)(out + O_SWKV + ((size_t)bh * 64 + v) * 64 + 4 * ks) = S;
}
__device__ __forceinline__ void phase_m2(const Args& A, LAS unsigned char* lds, int G) {
    const int tid = my_tid(), lane = tid & 63, wave = tid >> 6;
    unsigned char* ws = A.ws;
    const bf16* __restrict__ U = (const bf16*)(ws + WS_U); const bf16* __restrict__ REC = (const bf16*)(ws + WS_REC); float* __restrict__ Y = (float*)(ws + WS_Y);
    const float* LTOT = (const float*)((unsigned char*)A.out + DO_LTOT); float* CARRY = (float*)((unsigned char*)A.out + DO_CARRY);
    const float* mu = A.in[I_MU];
    for (int b = blockIdx.x; b < NB; b += G) {
        const int c = tid; float carry = LTOT[((size_t)512 * 2 + 1) * 512 + c];
        float Pv[64], Hv[64];
#pragma unroll
        for (int i = 0; i < 64; ++i) { const int un = b * 64 + i; Pv[i] = LTOT[((size_t)un * 2 + 0) * 512 + c]; Hv[i] = LTOT[((size_t)un * 2 + 1) * 512 + c]; }
#pragma unroll
        for (int i = 0; i < 64; ++i) { CARRY[((size_t)b * 64 + i) * 512 + c] = carry; carry = Pv[i] * carry + Hv[i]; }
        A.out[O_PLH + (size_t)b * 512 + c] = carry;
    }
    const int ks = lane & 15, rl = lane >> 4;
    for (int item = blockIdx.x; item < 256; item += G) {
        const int bh = item >> 2, q = item & 3, b = bh >> 3, h = bh & 7;
        int k = tid & 63, sub = (tid >> 6) & 3;
        asm volatile("" : "+v"(k), "+v"(sub));
        const float mu_r = mu[h * 64 + k], mu_v = mu[1024 + h * 64 + k];
        const int wv = wave & 3, vrow = 16 * q + 4 * wv + rl;
        f32x4 S = (f32x4){0.f, 0.f, 0.f, 0.f};
        const bool first_item = item == (int)blockIdx.x;
        Raw raw[8];
        LAS float* buf0 = (LAS float*)lds; LAS float* buf1 = (LAS float*)(lds + 50688); LAS float* ybuf = (LAS float*)(lds + 101376) + wv * 132;
        __syncthreads();
        if (wave >= 4) { m2_load(raw, REC, U, b, h, 0, 16, k, sub); m2_store(raw, buf0, mu_r, mu_v, k, sub, 16); m2_load(raw, REC, U, b, h, 16, 32, k, sub); }
        __syncthreads();
        for (int blk = 0; blk < 65; ++blk) {
            const int t0 = blk == 0 ? 0 : 16 + 32 * (blk - 1), ns = blk == 0 ? 16 : 32;
            if (wave >= 4) {
                const int jt = blk >> 2; int task = (int)blockIdx.x * 4 + (wave - 4) + G * 4 * jt;
                asm volatile("" : "+v"(task));
                const bool do_task = first_item && (blk & 3) == 0 && jt < 16 && task < DB * NH * 16;
                f32x4 Sc; StepOps oc[DS];
                if (do_task) sample_load(task, rl, ks, Sc, oc, REC, U, A.in[I_SWKV], A.in[I_STS], mu);
                if (blk + 1 < 65) m2_store(raw, (blk & 1) ? buf0 : buf1, mu_r, mu_v, k, sub, 32);
                if (blk + 2 < 65) m2_load(raw, REC, U, b, h, 16 + 32 * (blk + 1), 32, k, sub);
                if (do_task) sample_finish(task, rl, ks, Sc, oc, Y, A.out);
            } else {
                const LAS float* buf = (blk & 1) ? buf1 : buf0;
                StepOps oa, ob; ops_load(oa, buf, ks, vrow);
                float yp = 0.f;
                for (int s = 0; s < ns; s += 2) {
                    ops_load(ob, buf + (s + 1) * 384, ks, vrow);
                    scan_step2(S, oa, yp); ybuf[s * 4 + rl] = yp; yp = dot4(S, oa.r);
                    ops_load(oa, buf + (s + 2) * 384, ks, vrow);
                    scan_step2(S, ob, yp); ybuf[(s + 1) * 4 + rl] = yp; yp = dot4(S, ob.r);
                }
                yp = allsum16(yp); ybuf[ns * 4 + rl] = yp;
                if (ks < ns) Y[(size_t)prompt_row(b, t0 + ks) * 512 + h * 64 + vrow] = ybuf[(ks + 1) * 4 + rl];
                if (ks + 16 < ns) Y[(size_t)prompt_row(b, t0 + ks + 16) * 512 + h * 64 + vrow] = ybuf[(ks + 17) * 4 + rl];
            }
            __syncthreads();
        }
        if (wave < 4) *(f32x4*)(A.out + O_PWKV + ((size_t)(b * 8 + h) * 64 + vrow) * 64 + 4 * ks) = S;
    }
    for (int task = G * 4 * 16 + blockIdx.x * 8 + wave; task < DB * NH * 16; task += G * 8) {
        f32x4 Sc; StepOps oc[DS];
        sample_load(task, rl, ks, Sc, oc, REC, U, A.in[I_SWKV], A.in[I_STS], mu);
        sample_finish(task, rl, ks, Sc, oc, Y, A.out);
    }
}

__device__ __forceinline__ void phase_m3(const Args& A, int G) {
    const int tid = my_tid(), lane = tid & 63, wave = tid >> 6;
    const int gw = blockIdx.x * 8 + wave, NGW = G * 8;
    unsigned char* ws = A.ws;
    const bf16* __restrict__ U = (const bf16*)(ws + WS_U); const bf16* __restrict__ GA = (const bf16*)((unsigned char*)A.out + DO_GA); const bf16* __restrict__ LRU = (const bf16*)(ws + WS_LRU);
    const float* __restrict__ Y = (const float*)(ws + WS_Y); const float* __restrict__ CARRY = (const float*)((unsigned char*)A.out + DO_CARRY); const float* __restrict__ BON = (const float*)((unsigned char*)A.out + DO_BON);
    bf16* __restrict__ MIX = (bf16*)(ws + WS_MIX);
    const float* sts = A.in[I_STS];
    const int c = 8 * lane, h = lane >> 3;
    float mv[8], gg[8], gb[8], og[8];
    ld8f(A.in[I_MU] + 1024 + c, mv); ld8f(A.in[I_GNG] + c, gg); ld8f(A.in[I_GNB] + c, gb); ld8f(A.in[I_LOG] + c, og);
#pragma unroll 3
    for (int row = gw; row < MP; row += NGW) {
        bf16* mo = MIX + (size_t)row * D;
        const RowInfo ri = row_info(row);
        if (ri.kind == 3) { ((u32x4*)mo)[lane] = (u32x4){0u, 0u, 0u, 0u}; ((u32x4*)mo)[64 + lane] = (u32x4){0u, 0u, 0u, 0u}; continue; }
        const int r1 = row_back(ri, row, 1);
        float y[8], uv[8], pv[8], g[8], hv[8], pp[8], gt[8], cr[8];
        ld8f(Y + (size_t)row * 512 + c, y);
        unpack8(*(const u32x4*)(U + (size_t)row * DIN + 1024 + c), uv);
        unpack8(*(const u32x4*)(GA + (size_t)row * 1536 + 1024 + c), g);
        unpack8(*(const u32x4*)(LRU + (size_t)row * 1024 + c), hv); unpack8(*(const u32x4*)(LRU + (size_t)row * 1024 + 512 + c), pp);
        unpack8(*(const u32x4*)(U + (size_t)row * DIN + DTMP + 512 + c), gt);
        const float bon = BON[(size_t)row * 8 + h];
        if (r1 >= 0) unpack8(*(const u32x4*)(U + (size_t)r1 * DIN + 1024 + c), pv);
        else if (ri.kind == 1) ld8f(sts + (size_t)ri.b * DTMP + 1024 + c, pv);
        else {
#pragma unroll
            for (int i = 0; i < 8; ++i) pv[i] = 0.f; }
        if (ri.kind == 0) ld8f(CARRY + ((size_t)ri.b * 64 + ((row & 2047) >> 5)) * 512 + c, cr);
        else {
#pragma unroll
            for (int i = 0; i < 8; ++i) cr[i] = 0.f; }
        float s = 0.f;
#pragma unroll
        for (int i = 0; i < 8; ++i) s += y[i];
        const float mean = sum8(s) * (1.f / 64.f);
        float q = 0.f;
#pragma unroll
        for (int i = 0; i < 8; ++i) { y[i] -= mean; q += y[i] * y[i]; }
        const float rstd = __builtin_amdgcn_rsqf(sum8(q) * (1.f / 64.f) + GN_EPS);
        float o[8];
#pragma unroll
        for (int i = 0; i < 8; ++i) { const float vv = uv[i] + (pv[i] - uv[i]) * mv[i]; o[i] = (y[i] * rstd * gg[i] + gb[i] + bon * vv) * g[i]; }
        *(u32x4*)(mo + c) = pack8(o);
        float z[8], s2 = 0.f;
#pragma unroll
        for (int i = 0; i < 8; ++i) { z[i] = (hv[i] + pp[i] * cr[i]) * gelu_tanh(gt[i]); s2 += z[i] * z[i]; }
        const float rs = __builtin_amdgcn_rsqf(wave_sum(s2) * (1.f / 512.f) + EPS);
#pragma unroll
        for (int i = 0; i < 8; ++i) o[i] = z[i] * rs * og[i];
        *(u32x4*)(mo + 512 + c) = pack8(o);
    }
}

__device__ __forceinline__ void phase_final(const Args& A, int G) {
    const int tid = my_tid(), lane = tid & 63, wave = tid >> 6;
    const int gw = blockIdx.x * 8 + wave, NGW = G * 8;
    const float* gf = A.in[I_NFG];
    f32x4 g[4];
#pragma unroll
    for (int j = 0; j < 4; ++j) g[j] = ((const f32x4*)gf)[lane + 64 * j];
    for (int row = gw; row < M_MAIN; row += NGW) {
        f32x4* p = (f32x4*)(A.out + (size_t)row * D);
        f32x4 v[4]; float s = 0.f;
#pragma unroll
        for (int j = 0; j < 4; ++j) { v[j] = p[lane + 64 * j]; s += (v[j].x * v[j].x + v[j].y * v[j].y) + (v[j].z * v[j].z + v[j].w * v[j].w); }
        const float rs = __builtin_amdgcn_rsqf(wave_sum(s) * (1.f / D) + EPS);
#pragma unroll
        for (int j = 0; j < 4; ++j) p[lane + 64 * j] = v[j] * rs * g[j];
    }
}

namespace cg = cooperative_groups;
__global__ void __launch_bounds__(512, 2) mk_fwd(Args args) {
    extern __shared__ __attribute__((aligned(16))) unsigned char lds_raw[];
    LAS unsigned char* lds = (LAS unsigned char*)lds_raw;
    const int G = gridDim.x, tid = threadIdx.x;
    volatile LAS unsigned* MISC = (volatile LAS unsigned*)(lds + 131072 + 320);
    if (tid < 64) ((LAS unsigned*)(lds + 131072))[tid + 64] = 0u, ((LAS unsigned*)(lds + 131072))[tid] = 0u;
    __syncthreads();
    const int lo = args.ph_lo, hi = args.ph_hi;
    XcdBarrier bar; bar.bar = (unsigned*)(args.ws + WS_CTL) + 4096; bar.x = 0; bar.st = nullptr;
    if (hi - lo > 1) bar = xcd_barrier_post((unsigned*)(args.ws + WS_CTL) + 4096, MISC + 8);
    if (lo < 0) cg::this_grid().sync();
#define IN(k) (lo <= (k) && (k) < hi)
#define SEAM(k) do { if (IN(k) && IN((k) + 1)) xcd_barrier(bar); } while (0)
    unsigned char* ws = args.ws; unsigned char* ob = (unsigned char*)args.out;
    if (IN(0)) { phase_p0(args, lds, G); } SEAM(0);
    if (IN(1)) { pg8::Gemm g{(const bf16*)(ws + WS_XN), (const bf16*)(ws + WS_WIN), MP, DIN, D}; pg8::StaticOrder S; S.init(MP, DIN, G, (int)blockIdx.x, D);
        EpiPlain E{(bf16*)(ws + WS_U), DIN}; pg8::gemm_phase<EpiPlain, pg8::StaticOrder, true, true>(lds, g, S, E); } SEAM(1);
    if (IN(2)) { phase_e1(args, G); } SEAM(2);
    if (IN(3)) {
        { pg8::Gemm g{(const bf16*)(ws + WS_AP), (const bf16*)(ws + WS_BA), MP, 1536, 256}; pg8::StaticOrder S; S.init(MP, 1536, G, (int)blockIdx.x, 256);
          EpiPlain E{(bf16*)(ob + DO_GA), 1536}; pg8::gemm_phase<EpiPlain, pg8::StaticOrder, true, true>(lds, g, S, E); }
        { pg8::Gemm g{(const bf16*)(ws + WS_XC), (const bf16*)(ws + WS_BB), MP, 1024, 512}; pg8::StaticOrder S; S.init(MP, 1024, G, (int)((blockIdx.x + 96u) % (unsigned)G), 512);
          EpiPlain E{(bf16*)(ws + WS_GB), 1024}; pg8::gemm_phase<EpiPlain, pg8::StaticOrder, true, true>(lds, g, S, E); }
    } SEAM(3);
    if (IN(4)) { phase_e2(args, G); } SEAM(4);
    if (IN(5)) { phase_m2(args, lds, G); } SEAM(5);
    if (IN(6)) { phase_m3(args, G); } SEAM(6);
    if (IN(7)) { pg8::Gemm g{(const bf16*)(ws + WS_MIX), (const bf16*)(ob + DO_WOUT), MP, D, D}; pg8::StaticOrder S; S.init(MP, D, G, (int)blockIdx.x, D);
        EpiX1 E{args.in[I_XP], args.in[I_XS], args.in[I_META], args.out, (bf16*)(ws + WS_X1B), (float*)(ws + WS_SSQ1)};
        pg8::gemm_phase<EpiX1, pg8::StaticOrder, true, true>(lds, g, S, E); } SEAM(7);
    if (IN(8)) { pg8::Gemm g{(const bf16*)(ws + WS_X1B), (const bf16*)(ws + WS_WUP), MP, DFF, D}; pg8::StaticOrder S; S.init(MP, DFF, G, (int)blockIdx.x, D);
        EpiUp E{(const float*)(ws + WS_SSQ1), (bf16*)(ws + WS_UP), args.out + O_PFC, args.out + O_SFC};
        pg8::gemm_phase<EpiUp, pg8::StaticOrder, true, true>(lds, g, S, E); } SEAM(8);
    if (IN(9)) { pg8::Gemm g{(const bf16*)(ws + WS_X1B), (const bf16*)(ws + WS_WGATE), M_MAIN, DFF, D}; pg8::StaticOrder S; S.init(M_MAIN, DFF, G, (int)blockIdx.x, D);
        EpiGate E{(const float*)(ws + WS_SSQ1), (const bf16*)(ws + WS_UP), args.in[I_SFC], args.in[I_FCW], args.in[I_FCB], (bf16*)(ws + WS_HID)};
        pg8::gemm_phase<EpiGate, pg8::StaticOrder, true, true>(lds, g, S, E); } SEAM(9);
    if (IN(10)) { pg8::Gemm g{(const bf16*)(ws + WS_HID), (const bf16*)(ws + WS_WDOWN), M_MAIN, D, DFF}; DownOrder S; S.init(G, (int)blockIdx.x);
        EpiDown E{args.out, (const bf16*)(ws + WS_X1B)};
        pg8::gemm_phase<EpiDown, DownOrder, true, true>(lds, g, S, E); } SEAM(10);
    if (IN(11)) { phase_final(args, G); }
#undef IN
#undef SEAM
}

extern "C" void kernel_launch(void* const* d_in, const int* in_sizes, int n_in, void* d_out, int out_size, void* d_ws, size_t ws_size, hipStream_t stream) {
    static int grid = 0;
    if (grid == 0) {
        if (n_in != N_IN || (size_t)out_size != O_END || ws_size < 256 * MiB) { fprintf(stderr, "kernel_launch: unexpected shapes n_in %d out %d ws %zu\n", n_in, out_size, ws_size); grid = -1; return; }
        int dev = 0, cus = 0, per_cu = 0;
        (void)hipGetDevice(&dev); (void)hipDeviceGetAttribute(&cus, hipDeviceAttributeMultiprocessorCount, dev);
        if (hipFuncSetAttribute((const void*)mk_fwd, hipFuncAttributeMaxDynamicSharedMemorySize, LDS_BYTES) != hipSuccess) { fprintf(stderr, "kernel_launch: hipFuncSetAttribute failed\n"); grid = -1; return; }
        if (hipOccupancyMaxActiveBlocksPerMultiprocessor(&per_cu, (const void*)mk_fwd, 512, LDS_BYTES) != hipSuccess || per_cu < 1) per_cu = 1;
        (void)hipGetLastError();
        grid = cus > 0 ? cus : 256;
    }
    if (grid < 0) return;
    Args a{};
    for (int i = 0; i < N_IN; ++i) a.in[i] = (const float*)d_in[i];
    a.out = (float*)d_out; a.ws = (unsigned char*)d_ws;
#if MK_ONE_LAUNCH
    (void)hipMemsetAsync((char*)d_ws + WS_CTL, 0, CTL_ZERO_BYTES, stream);
    a.ph_lo = 0; a.ph_hi = NPH;
    void* kargs[] = {&a};
    hipError_t e = hipLaunchCooperativeKernel((const void*)mk_fwd, dim3(grid), dim3(512), kargs, LDS_BYTES, stream);
    if (e != hipSuccess) fprintf(stderr, "cooperative launch failed: %s (grid %d)\n", hipGetErrorString(e), grid);
#else
    for (int ph = 0; ph < NPH; ++ph) for (int rep = 0; rep < 1 + ((MK_REP_MASK >> ph) & 1); ++rep) { a.ph_lo = ph; a.ph_hi = ph + 1; hipLaunchKernelGGL(mk_fwd, dim3(grid), dim3(512), LDS_BYTES, stream, a); }
#endif
}
```

```cpp
#include <hip/hip_runtime.h>
#include <hip/hip_cooperative_groups.h>
#include <cstdio>
#include <cstdint>
#include <cmath>
__device__ __forceinline__ int my_tid() { int t = threadIdx.x; asm volatile("" : "+v"(t)); return t; }
namespace pg8 {
#define PG8_LAS __attribute__((address_space(3)))
typedef unsigned short bf16_t;
typedef short bf16x8 __attribute__((ext_vector_type(8)));
typedef float f32x4 __attribute__((ext_vector_type(4)));
typedef unsigned u32x4 __attribute__((ext_vector_type(4)));
constexpr int BM = 256, BK = 64, HALF = 128, HTB = HALF * BK * 2  , STAGE_BYTES = 8 * HTB, NXCD = 8, WGM = 8;

__host__ __device__ __forceinline__ int lds_byte(int r, int c) { const int st = (r >> 4) * 2 + (c >> 5), rr = r & 15, cc = c & 31, ob = rr * 64 + cc * 2; return st * 1024 + (ob ^ (((ob >> 9) & 1) << 5)); }
__host__ __device__ __forceinline__ void stage_rc(int b, int& R, int& C) { const int st = b / 1024, sb = b % 1024, swz = sb ^ (((sb >> 9) & 1) << 5); R = (st >> 1) * 16 + swz / 64; C = (st & 1) * 32 + (swz % 64) / 2; }
__host__ __device__ __forceinline__ int perm32(int rho) { const int n = rho >> 4, i = rho & 15; return 8 * (i >> 2) + 4 * n + (i & 3); }

struct Unit { int pm, pn, ko, nt; };
struct Gemm { const bf16_t* A; const bf16_t* Bt; int M, N, K; };

struct StaticOrder {
    int nM, nN, nwg, G, c, ntk;
    __host__ __device__ void init(int M, int N, int G_, int c_, int K_) { nM = M / BM; nN = N / BM; nwg = nM * nN; G = G_; c = c_; ntk = K_ / BK; }
    __host__ __device__ bool next(int i, Unit& u) const {
        const long L = (long)i * G + c; if (L >= nwg) return false;
        int wgid = (int)L; { const int q = nwg / NXCD, r = nwg % NXCD, xcd = wgid % NXCD, off = wgid / NXCD; wgid = (xcd < r ? xcd * (q + 1) : r * (q + 1) + (xcd - r) * q) + off; }
        const int nig = WGM * nN, gid = wgid / nig, fm = gid * WGM, gsz = (nM - fm) < WGM ? (nM - fm) : WGM;
        u.pm = fm + ((wgid % nig) % gsz); u.pn = (wgid % nig) / gsz; u.ko = 0; u.nt = ntk; return true;
    }
    __device__ __forceinline__ void a_ready(const Unit&) const {}
    __device__ __forceinline__ void done(const Unit&) const {}
};

__device__ __forceinline__ unsigned cvt_pk_bf16(float lo, float hi) { unsigned r; asm volatile("v_cvt_pk_bf16_f32 %0, %1, %2" : "=v"(r) : "v"(lo), "v"(hi)); return r; }
typedef float f32x2 __attribute__((ext_vector_type(2)));
template <class Epi, class Sched, bool ALIGN_EPI = false, bool SP2 = false>
__device__ __forceinline__ void gemm_phase(PG8_LAS unsigned char* lds, const Gemm g, const Sched& S, const Epi& E) {
    const int tid = my_tid(), wid = __builtin_amdgcn_readfirstlane(tid >> 6), lane = tid & 63, wr = wid >> 2, wc = wid & 3, fr = lane & 15, fq = lane >> 4;
    const int K = g.K;
    unsigned voffA[2], voffB[2];
#pragma unroll
    for (int i = 0; i < 2; ++i) { int R, C; stage_rc(tid * 16 + i * 8192, R, C); const int Rb = Epi::PERM ? ((R & ~31) + perm32(R & 31)) : R;
        voffA[i] = (unsigned)(R * K + C) * 2u; voffB[i] = (unsigned)(Rb * K + C) * 2u; }
    const size_t kstep = (size_t)(BK * 2);
    const size_t hstep = (size_t)HALF * K * 2;
    const size_t tstep = 2 * hstep;
    const unsigned ldsw = (unsigned)wid * 1024u;
    const int aoff = lds_byte(wr * 64 + fr, fq * 8), boff = lds_byte(wc * 32 + fr, fq * 8);
#define PG8_SA(b, h) (((b) * 2 + (h)) * HTB)
#define PG8_SB(b, h) ((4 + (b) * 2 + (h)) * HTB)
#define PG8_STAGE(bufoff, gbase, voff) do { _Pragma("unroll") for (int _i = 0; _i < 2; ++_i) \
        __builtin_amdgcn_global_load_lds((const unsigned*)((const char*)(gbase) + (voff)[_i]), (PG8_LAS unsigned*)(lds + (bufoff) + ldsw + _i * 8192), 16, 0, 0); } while (0)
#define PG8_LDA(dst, b, h) do { _Pragma("unroll") for (int m = 0; m < 4; ++m) _Pragma("unroll") for (int k = 0; k < 2; ++k) dst[m][k] = *(const PG8_LAS bf16x8*)(lds + PG8_SA(b, h) + aoff + m * 2048 + k * 1024); } while (0)
#define PG8_LDB(dst, b, h) do { _Pragma("unroll") for (int n = 0; n < 2; ++n) _Pragma("unroll") for (int k = 0; k < 2; ++k) dst[n][k] = *(const PG8_LAS bf16x8*)(lds + PG8_SB(b, h) + boff + n * 2048 + k * 1024); } while (0)
#define PG8_MMA(ai, bj, At, Bt) do { __builtin_amdgcn_s_setprio(1); _Pragma("unroll") for (int m = 0; m < 4; ++m) _Pragma("unroll") for (int n = 0; n < 2; ++n) _Pragma("unroll") for (int k = 0; k < 2; ++k) \
        acc[ai][bj][m][n] = __builtin_amdgcn_mfma_f32_16x16x32_bf16(Bt[n][k], At[m][k], acc[ai][bj][m][n], 0, 0, 0); __builtin_amdgcn_s_setprio(0); } while (0)
#define PG8_WAIT_V(n) asm volatile("s_waitcnt vmcnt(" #n ")" ::: "memory")
#define PG8_WAIT_L(n) asm volatile("s_waitcnt lgkmcnt(" #n ")" ::: "memory")
#define PG8_BAR __builtin_amdgcn_s_barrier()
#define PG8_SCHED __builtin_amdgcn_sched_barrier(0)
    Unit cur, nxt; int ui = 0;
    if (!S.next(0, cur)) return;
    f32x4 acc[2][2][4][2];
#pragma unroll
    for (int a = 0; a < 2; ++a)
#pragma unroll
        for (int b = 0; b < 2; ++b)
#pragma unroll
            for (int m = 0; m < 4; ++m)
#pragma unroll
                for (int n = 0; n < 2; ++n) acc[a][b][m][n] = (f32x4){0.f, 0.f, 0.f, 0.f};
    bf16x8 At[4][2], B0[2][2], B1[2][2];
    const char* cA = (const char*)g.A + (size_t)cur.pm * tstep + (size_t)cur.ko * 2; const char* cB = (const char*)g.Bt + (size_t)cur.pn * tstep + (size_t)cur.ko * 2;
    S.a_ready(cur);
    if constexpr (SP2) {
        PG8_STAGE(PG8_SB(0, 0), cB, voffB); PG8_STAGE(PG8_SB(0, 1), cB + hstep, voffB); PG8_STAGE(PG8_SA(0, 0), cA, voffA); PG8_STAGE(PG8_SA(0, 1), cA + hstep, voffA);
        if (wr == 1) PG8_BAR;
        PG8_WAIT_V(2); PG8_BAR;
        PG8_STAGE(PG8_SB(1, 0), cB + kstep, voffB); PG8_STAGE(PG8_SA(1, 0), cA + kstep, voffA); PG8_STAGE(PG8_SB(1, 1), cB + hstep + kstep, voffB);
        PG8_WAIT_V(6); PG8_BAR;
    } else {
        PG8_STAGE(PG8_SB(0, 0), cB, voffB); PG8_STAGE(PG8_SA(0, 0), cA, voffA); PG8_STAGE(PG8_SB(0, 1), cB + hstep, voffB); PG8_STAGE(PG8_SA(0, 1), cA + hstep, voffA);
        if (wr == 1) PG8_BAR;
        PG8_WAIT_V(4); PG8_BAR;
        PG8_STAGE(PG8_SB(1, 0), cB + kstep, voffB); PG8_STAGE(PG8_SA(1, 0), cA + kstep, voffA); PG8_STAGE(PG8_SB(1, 1), cB + hstep + kstep, voffB);
        PG8_WAIT_V(6); PG8_BAR;
    }
    for (;;) {
        const bool has_next = S.next(ui + 1, nxt);
        const char* nA = has_next ? (const char*)g.A + (size_t)nxt.pm * tstep + (size_t)nxt.ko * 2 : cA; const char* nB = has_next ? (const char*)g.Bt + (size_t)nxt.pn * tstep + (size_t)nxt.ko * 2 : cB;
        const int nt = cur.nt;
        for (int t = 0; t < nt; t += 2) {
            const bool last = (t == nt - 2);
            const char* a1 = cA + (size_t)(t + 1) * kstep;
            const char* a2 = last ? nA : cA + (size_t)(t + 2) * kstep; const char* b2 = last ? nB : cB + (size_t)(t + 2) * kstep;
            const char* a3 = a2 + kstep; const char* b3 = b2 + kstep;
            if (last && has_next) S.a_ready(nxt);
            if constexpr (SP2) {
            PG8_LDB(B0, 0, 0); PG8_LDB(B1, 0, 1); PG8_SCHED; PG8_LDA(At, 0, 0); PG8_STAGE(PG8_SA(1, 1), a1 + hstep, voffA);
            PG8_WAIT_V(8); PG8_WAIT_L(0); PG8_BAR; PG8_MMA(0, 0, At, B0); PG8_MMA(0, 1, At, B1); PG8_BAR; PG8_SCHED;
            PG8_LDA(At, 0, 1); PG8_STAGE(PG8_SB(0, 0), b2, voffB); PG8_STAGE(PG8_SB(0, 1), b2 + hstep, voffB); PG8_STAGE(PG8_SA(0, 0), a2, voffA);
            PG8_WAIT_V(8); PG8_WAIT_L(0); PG8_BAR; PG8_MMA(1, 0, At, B0); PG8_MMA(1, 1, At, B1); PG8_BAR; PG8_SCHED;
            PG8_LDB(B0, 1, 0); PG8_LDB(B1, 1, 1); PG8_SCHED; PG8_LDA(At, 1, 0); PG8_STAGE(PG8_SA(0, 1), a2 + hstep, voffA);
            PG8_WAIT_V(8); PG8_WAIT_L(0); PG8_BAR; PG8_MMA(0, 0, At, B0); PG8_MMA(0, 1, At, B1); PG8_BAR; PG8_SCHED;
            PG8_LDA(At, 1, 1); PG8_STAGE(PG8_SB(1, 0), b3, voffB); PG8_STAGE(PG8_SB(1, 1), b3 + hstep, voffB); PG8_STAGE(PG8_SA(1, 0), a3, voffA);
            PG8_WAIT_V(8); PG8_WAIT_L(0); PG8_BAR; PG8_MMA(1, 0, At, B0); PG8_MMA(1, 1, At, B1); PG8_BAR; PG8_SCHED;
            } else {
            PG8_LDB(B0, 0, 0); PG8_SCHED; PG8_LDA(At, 0, 0); PG8_STAGE(PG8_SA(1, 1), a1 + hstep, voffA);
            PG8_WAIT_L(8); PG8_BAR; PG8_WAIT_L(0); PG8_MMA(0, 0, At, B0); PG8_BAR; PG8_SCHED;
            PG8_LDB(B1, 0, 1); PG8_STAGE(PG8_SB(0, 0), b2, voffB);
            PG8_BAR; PG8_WAIT_L(0); PG8_MMA(0, 1, At, B1); PG8_BAR;
            PG8_LDA(At, 0, 1); PG8_STAGE(PG8_SA(0, 0), a2, voffA);
            PG8_BAR; PG8_WAIT_L(0); PG8_MMA(1, 0, At, B0); PG8_BAR; PG8_SCHED;
            PG8_STAGE(PG8_SB(0, 1), b2 + hstep, voffB);
            PG8_WAIT_V(6); PG8_BAR; PG8_MMA(1, 1, At, B1); PG8_BAR;
            PG8_LDB(B0, 1, 0); PG8_SCHED; PG8_LDA(At, 1, 0); PG8_STAGE(PG8_SA(0, 1), a2 + hstep, voffA);
            PG8_WAIT_L(8); PG8_BAR; PG8_WAIT_L(0); PG8_MMA(0, 0, At, B0); PG8_BAR; PG8_SCHED;
            PG8_LDB(B1, 1, 1); PG8_STAGE(PG8_SB(1, 0), b3, voffB);
            PG8_BAR; PG8_WAIT_L(0); PG8_MMA(0, 1, At, B1); PG8_BAR;
            PG8_LDA(At, 1, 1); PG8_STAGE(PG8_SA(1, 0), a3, voffA);
            PG8_BAR; PG8_WAIT_L(0); PG8_MMA(1, 0, At, B0); PG8_BAR; PG8_SCHED;
            PG8_STAGE(PG8_SB(1, 1), b3 + hstep, voffB);
            PG8_WAIT_V(6); PG8_BAR; PG8_MMA(1, 1, At, B1); PG8_BAR;
            }
        }
        if constexpr (ALIGN_EPI) { if (wr == 0) PG8_BAR; }
        if constexpr (!Epi::AFTER_DRAIN) { E(acc, cur, wr, wc, fr, fq); S.done(cur); }
        if (!has_next) break;
#pragma unroll
        for (int a = 0; a < 2; ++a)
#pragma unroll
            for (int b = 0; b < 2; ++b)
#pragma unroll
                for (int m = 0; m < 4; ++m)
#pragma unroll
                    for (int n = 0; n < 2; ++n) acc[a][b][m][n] = (f32x4){0.f, 0.f, 0.f, 0.f};
        cur = nxt; cA = nA; cB = nB; ++ui;
        if constexpr (ALIGN_EPI) { if (wr == 1) PG8_BAR; }
    }
    PG8_WAIT_V(0);
    if constexpr (!ALIGN_EPI) { if (wr == 0) PG8_BAR; }
    PG8_BAR;
    if constexpr (Epi::AFTER_DRAIN) { E.fused(acc, cur, wr, wc, fr, fq, lds, wid, lane); S.done(cur); }
#undef PG8_SA
#undef PG8_SB
#undef PG8_STAGE
#undef PG8_LDA
#undef PG8_LDB
#undef PG8_MMA
#undef PG8_WAIT_V
#undef PG8_WAIT_L
#undef PG8_BAR
#undef PG8_SCHED
}
}

#ifndef MK_REP_MASK
#define MK_REP_MASK 0
#endif
#ifndef MK_ONE_LAUNCH
#define MK_ONE_LAUNCH 1
#endif
#define LAS __attribute__((address_space(3)))
typedef unsigned short bf16;
typedef float f32x4 __attribute__((ext_vector_type(4)));
typedef unsigned u32x4 __attribute__((ext_vector_type(4)));
typedef unsigned u32x2 __attribute__((ext_vector_type(2)));
constexpr int D = 1024, NB = 8, SEQ = 2048, NMETA = 16, TP = SEQ + NMETA, DB = 128, DS = 4;
constexpr int NH = 8, DTMP = 1792, DIN = 2816, DFF = 3072;
constexpr int R_SAMPLE = NB * SEQ, R_META = R_SAMPLE + DB * DS, R_END = R_META + NMETA, MP = 17152, M_MAIN = 16896;
constexpr float EPS = 1e-6f, GN_EPS = 64e-5f;
constexpr int NPH = 12;
constexpr int LDS_BYTES = 147456;
enum { I_XP = 0, I_XS, I_STS, I_SWKV, I_SLC, I_SLH, I_SFC, I_META, I_N1G, I_WIN, I_MU, I_W0, I_WUP, I_A0, I_AUP, I_GUP, I_KK, I_KA, I_RK,
       I_GNG, I_GNB, I_LCW, I_LCB, I_LWA, I_LBA, I_LWX, I_LBX, I_LAM, I_LOG, I_WOUT, I_N2G, I_FUP, I_FGATE, I_FCW, I_FCB, I_FDOWN, I_NFG, N_IN };
constexpr size_t O_YP = 0, O_YS = 16777216, O_PSHIFT = 17301504, O_PWKV = 17315840, O_PLC = 17577984, O_PLH = 17590272, O_PFC = 17594368,
                 O_SSHIFT = 17643520, O_SWKV = 17872896, O_SLC = 22067200, O_SLH = 22263808, O_SFC = 22329344, O_END = 23115776;
constexpr size_t MiB = 1u << 20;
constexpr size_t WS_CTL = 0, CTL_ZERO_BYTES = 65536;
constexpr size_t WS_SSQ1 = 1 * MiB, WS_SSQ2 = WS_SSQ1 + (size_t)MP * 16 * 4;
constexpr size_t WS_WUP = 4 * MiB, WS_WGATE = 10 * MiB, WS_WDOWN = 16 * MiB;
constexpr size_t WS_X1B = 22 * MiB, WS_UP = WS_X1B + (size_t)MP * D * 2, WS_HID = WS_UP + (size_t)MP * DFF * 2;
constexpr size_t WS_U = 22 * MiB;
constexpr size_t WS_XN = 115 * MiB, WS_WIN = WS_XN + (size_t)MP * D * 2;
constexpr size_t WS_AP = 190 * MiB, WS_XC = 199 * MiB, WS_BA = 216 * MiB, WS_BB = 217 * MiB, WS_GB = 220 * MiB;
constexpr size_t WS_REC = 115 * MiB, WS_LRU = 182 * MiB, WS_Y = 220 * MiB, WS_MIX = 115 * MiB;
static_assert(WS_SSQ2 + (size_t)MP * 16 * 4 <= WS_WUP, "ssq");
static_assert(WS_HID + (size_t)M_MAIN * DFF * 2 <= 256 * MiB, "hid");
static_assert(WS_U + (size_t)MP * DIN * 2 <= WS_XN, "u");
static_assert(WS_WIN + (size_t)DIN * D * 2 <= WS_LRU, "win");
static_assert(WS_AP + (size_t)MP * 256 * 2 <= WS_XC && WS_XC + (size_t)MP * 512 * 2 <= WS_BA, "ap/xc");
static_assert(WS_GB + (size_t)MP * 1024 * 2 <= 256 * MiB, "gb");
static_assert(WS_REC + (size_t)R_END * 4096 <= WS_LRU && WS_LRU + (size_t)R_END * 2048 <= WS_BA, "rec/lru");
static_assert(WS_Y + (size_t)R_END * 2048 <= 256 * MiB, "y");
constexpr size_t DO_GA = 0, DO_LTOT = (size_t)MP * 1536 * 2, DO_CARRY = DO_LTOT + 513 * 2 * 512 * 4, DO_BON = DO_CARRY + 8 * 64 * 512 * 4, DO_WOUT = O_SFC * 4;
static_assert(DO_BON + (size_t)R_END * 8 * 4 <= O_PSHIFT * 4, "d_out scratch");

struct Args { const float* in[N_IN]; float* out; unsigned char* ws; int ph_lo, ph_hi; };

__device__ __forceinline__ float bf2f(bf16 h) { return __uint_as_float(((unsigned)h) << 16); }
__device__ __forceinline__ unsigned f2bf(float f) { unsigned u = __float_as_uint(f); return (u + 0x7fffu + ((u >> 16) & 1u)) >> 16; }
typedef float f32x2_t __attribute__((ext_vector_type(2))); typedef __bf16 bf16x2_t __attribute__((ext_vector_type(2)));
__device__ __forceinline__ unsigned pk2(float lo, float hi) { const f32x2_t v = {lo, hi}; const bf16x2_t b = __builtin_convertvector(v, bf16x2_t); return __builtin_bit_cast(unsigned, b); }
__device__ __forceinline__ float lo16(unsigned w) { return __uint_as_float(w << 16); }
__device__ __forceinline__ float hi16(unsigned w) { return __uint_as_float(w & 0xffff0000u); }
__device__ __forceinline__ float sigm(float x) { return __builtin_amdgcn_rcpf(1.f + __builtin_amdgcn_exp2f(-1.4426950409f * x)); }
__device__ __forceinline__ float softplus_(float z) { return fmaxf(z, 0.f) + log1pf(__expf(-fabsf(z))); }
__device__ __forceinline__ float gelu_tanh(float x) { const float t = x * (-2.3022082f + -0.10294324f * (x * x)); return x * __builtin_amdgcn_rcpf(1.f + __builtin_amdgcn_exp2f(t)); }
__device__ __forceinline__ float tanh_(float x) { const float e = __builtin_amdgcn_exp2f(2.8853900818f * x); return 1.f - 2.f * __builtin_amdgcn_rcpf(e + 1.f); }
__device__ __forceinline__ float wave_sum(float v) {
#pragma unroll
    for (int o = 1; o < 64; o <<= 1) v += __shfl_xor(v, o);
    return v;
}
template <int CTRL> __device__ __forceinline__ float dpp_f(float x) { return __int_as_float(__builtin_amdgcn_update_dpp(0, __float_as_int(x), CTRL, 0xF, 0xF, true)); }
__device__ __forceinline__ float allsum16(float x) { x += dpp_f<0xB1>(x); x += dpp_f<0x4E>(x); x += dpp_f<0x141>(x); x += dpp_f<0x140>(x); return x; }

struct RowInfo { int kind, b, t; };
__device__ __forceinline__ RowInfo row_info(int row) {
    RowInfo r;
    if (row < R_SAMPLE) { r.kind = 0; r.b = row >> 11; r.t = (row & 2047) + NMETA; }
    else if (row < R_META) { r.kind = 1; r.b = (row - R_SAMPLE) >> 2; r.t = (row - R_SAMPLE) & 3; }
    else if (row < R_END) { r.kind = 2; r.b = 0; r.t = row - R_META; }
    else { r.kind = 3; r.b = 0; r.t = 0; }
    return r;
}
__device__ __forceinline__ int prompt_row(int b, int t) { return t < NMETA ? R_META + t : b * SEQ + t - NMETA; }
__device__ __forceinline__ int row_back(const RowInfo& ri, int row, int j) {
    const int tt = ri.t - j; if (tt < 0) return -1;
    if (ri.kind == 1) return row - j;
    return prompt_row(ri.b, tt);
}
__device__ __forceinline__ void unpack8(const u32x4 w, float (&f)[8]) {
    f[0] = lo16(w.x); f[1] = hi16(w.x); f[2] = lo16(w.y); f[3] = hi16(w.y); f[4] = lo16(w.z); f[5] = hi16(w.z); f[6] = lo16(w.w); f[7] = hi16(w.w);
}
__device__ __forceinline__ void ld8f(const float* p, float (&f)[8]) { const f32x4 a = *(const f32x4*)p, b = *(const f32x4*)(p + 4); f[0] = a.x; f[1] = a.y; f[2] = a.z; f[3] = a.w; f[4] = b.x; f[5] = b.y; f[6] = b.z; f[7] = b.w; }
__device__ __forceinline__ u32x4 pack8(const float (&o)[8]) { u32x4 w; w.x = pk2(o[0], o[1]); w.y = pk2(o[2], o[3]); w.z = pk2(o[4], o[5]); w.w = pk2(o[6], o[7]); return w; }
__device__ __forceinline__ float row_rs(const float* ssq, int row) {
    const f32x4* p = (const f32x4*)(ssq + (size_t)row * 16); const f32x4 a = p[0], b = p[1], c = p[2], d = p[3];
    const float s = ((a.x + a.y) + (a.z + a.w)) + ((b.x + b.y) + (b.z + b.w)) + ((c.x + c.y) + (c.z + c.w)) + ((d.x + d.y) + (d.z + d.w));
    return __builtin_amdgcn_rsqf(s * (1.f / 1024.f) + EPS);
}

#define EPI_ROW(ai, m) (u.pm * 256 + (ai) * 128 + wr * 64 + (m) * 16 + fr)
#define EPI_COL(bj) (u.pn * 256 + (bj) * 128 + wc * 32 + 8 * fq)
struct EpiX1 {
    static constexpr bool PERM = true, AFTER_DRAIN = false;
    const float* __restrict__ xp; const float* __restrict__ xs; const float* __restrict__ meta; float* __restrict__ x1; bf16* __restrict__ x1b; float* __restrict__ ssq;
    __device__ __forceinline__ void operator()(const f32x4 (&acc)[2][2][4][2], const pg8::Unit& u, int wr, int wc, int fr, int fq) const {
#pragma unroll
        for (int ai = 0; ai < 2; ++ai)
#pragma unroll
            for (int m = 0; m < 4; ++m) {
                const int row = EPI_ROW(ai, m);
                const float* res = row < R_SAMPLE ? xp + (size_t)row * D : row < R_META ? xs + (size_t)(row - R_SAMPLE) * D : row < R_END ? meta + (size_t)(row - R_META) * D : nullptr;
                float s = 0.f;
#pragma unroll
                for (int bj = 0; bj < 2; ++bj) {
                    const int col = EPI_COL(bj);
                    f32x4 v0 = acc[ai][bj][m][0], v1 = acc[ai][bj][m][1];
                    if (res) { v0 += *(const f32x4*)(res + col); v1 += *(const f32x4*)(res + col + 4); }
                    if (row >= R_SAMPLE && row < M_MAIN) { *(f32x4*)(x1 + (size_t)row * D + col) = v0; *(f32x4*)(x1 + (size_t)row * D + col + 4) = v1; }
                    u32x4 w; w.x = pk2(v0.x, v0.y); w.y = pk2(v0.z, v0.w); w.z = pk2(v1.x, v1.y); w.w = pk2(v1.z, v1.w);
                    *(u32x4*)(x1b + (size_t)row * D + col) = w;
                    s += (v0.x * v0.x + v0.y * v0.y) + (v0.z * v0.z + v0.w * v0.w) + (v1.x * v1.x + v1.y * v1.y) + (v1.z * v1.z + v1.w * v1.w);
                }
                s += __shfl_xor(s, 16); s += __shfl_xor(s, 32);
                if (fq == 0) ssq[(size_t)row * 16 + u.pn * 4 + wc] = s;
            }
    }
};
struct EpiUp {
    static constexpr bool PERM = true, AFTER_DRAIN = false;
    const float* __restrict__ ssq; bf16* __restrict__ up; float* __restrict__ pffn; float* __restrict__ sffn;
    __device__ __forceinline__ void operator()(const f32x4 (&acc)[2][2][4][2], const pg8::Unit& u, int wr, int wc, int fr, int fq) const {
#pragma unroll
        for (int ai = 0; ai < 2; ++ai)
#pragma unroll
            for (int m = 0; m < 4; ++m) {
                const int row = EPI_ROW(ai, m);
                const float rs = row_rs(ssq, row);
                const RowInfo ri = row_info(row);
                float* st = nullptr;
                if (ri.kind == 0 && ri.t >= TP - 2) st = pffn + ((size_t)ri.b * 2 + (ri.t - (TP - 2))) * DFF;
                else if (ri.kind == 1 && ri.t >= 2) st = sffn + ((size_t)ri.b * 2 + (ri.t - 2)) * DFF;
#pragma unroll
                for (int bj = 0; bj < 2; ++bj) {
                    const int col = EPI_COL(bj);
                    const f32x4 v0 = acc[ai][bj][m][0] * rs, v1 = acc[ai][bj][m][1] * rs;
                    u32x4 w; w.x = pk2(v0.x, v0.y); w.y = pk2(v0.z, v0.w); w.z = pk2(v1.x, v1.y); w.w = pk2(v1.z, v1.w);
                    *(u32x4*)(up + (size_t)row * DFF + col) = w;
                    if (st) { *(f32x4*)(st + col) = v0; *(f32x4*)(st + col + 4) = v1; }
                }
            }
    }
};
struct EpiGate {
    static constexpr bool PERM = true, AFTER_DRAIN = false;
    const float* ssq; const bf16* up; const float* stf; const float* cw; const float* cb; bf16* hid;
    __device__ __forceinline__ void operator()(const f32x4 (&acc)[2][2][4][2], const pg8::Unit& u, int wr, int wc, int fr, int fq) const {
#pragma unroll
        for (int ai = 0; ai < 2; ++ai)
#pragma unroll
            for (int m = 0; m < 4; ++m) {
                const int row = EPI_ROW(ai, m);
                const float rs = row_rs(ssq, row);
                const RowInfo ri = row_info(row);
                const int r1 = row_back(ri, row, 1), r2 = row_back(ri, row, 2);
#pragma unroll
                for (int bj = 0; bj < 2; ++bj) {
                    const int col = EPI_COL(bj);
                    float g[8], u0[8], p1[8], p2[8];
                    { const f32x4 v0 = acc[ai][bj][m][0] * rs, v1 = acc[ai][bj][m][1] * rs; g[0] = v0.x; g[1] = v0.y; g[2] = v0.z; g[3] = v0.w; g[4] = v1.x; g[5] = v1.y; g[6] = v1.z; g[7] = v1.w; }
                    unpack8(*(const u32x4*)(up + (size_t)row * DFF + col), u0);
                    if (r1 >= 0) unpack8(*(const u32x4*)(up + (size_t)r1 * DFF + col), p1);
                    else if (ri.kind == 1) { const float* s = stf + ((size_t)ri.b * 2 + (1 + ri.t)) * DFF + col; const f32x4 a = *(const f32x4*)s, b = *(const f32x4*)(s + 4);
                        p1[0] = a.x; p1[1] = a.y; p1[2] = a.z; p1[3] = a.w; p1[4] = b.x; p1[5] = b.y; p1[6] = b.z; p1[7] = b.w; }
                    else {
#pragma unroll
                        for (int i = 0; i < 8; ++i) p1[i] = 0.f; }
                    if (r2 >= 0) unpack8(*(const u32x4*)(up + (size_t)r2 * DFF + col), p2);
                    else if (ri.kind == 1) { const float* s = stf + ((size_t)ri.b * 2 + ri.t) * DFF + col; const f32x4 a = *(const f32x4*)s, b = *(const f32x4*)(s + 4);
                        p2[0] = a.x; p2[1] = a.y; p2[2] = a.z; p2[3] = a.w; p2[4] = b.x; p2[5] = b.y; p2[6] = b.z; p2[7] = b.w; }
                    else {
#pragma unroll
                        for (int i = 0; i < 8; ++i) p2[i] = 0.f; }
                    float o[8];
#pragma unroll
                    for (int h = 0; h < 2; ++h) {
                        const f32x4 w0 = *(const f32x4*)(cw + col + 4 * h), w1 = *(const f32x4*)(cw + DFF + col + 4 * h), w2 = *(const f32x4*)(cw + 2 * DFF + col + 4 * h), bb = *(const f32x4*)(cb + col + 4 * h);
#pragma unroll
                        for (int i = 0; i < 4; ++i) { const int e = 4 * h + i; const float c = bb[i] + w0[i] * p2[e] + w1[i] * p1[e] + w2[i] * u0[e]; o[e] = gelu_tanh(c) * g[e]; }
                    }
                    u32x4 w; w.x = pk2(o[0], o[1]); w.y = pk2(o[2], o[3]); w.z = pk2(o[4], o[5]); w.w = pk2(o[6], o[7]);
                    *(u32x4*)(hid + (size_t)row * DFF + col) = w;
                }
            }
    }
};
struct EpiDown {
    static constexpr bool PERM = true, AFTER_DRAIN = false;
    float* __restrict__ x; const bf16* __restrict__ x1b;
    __device__ __forceinline__ void operator()(const f32x4 (&acc)[2][2][4][2], const pg8::Unit& u, int wr, int wc, int fr, int fq) const {
        const bool part = u.nt != DFF / 64;
#pragma unroll
        for (int ai = 0; ai < 2; ++ai)
#pragma unroll
            for (int m = 0; m < 4; ++m) {
                const int row = EPI_ROW(ai, m);
#pragma unroll
                for (int bj = 0; bj < 2; ++bj) {
                    const int col = EPI_COL(bj);
                    float* p = x + (size_t)row * D + col;
                    if (part) {
#pragma unroll
                        for (int i = 0; i < 4; ++i) { unsafeAtomicAdd(p + i, acc[ai][bj][m][0][i]); unsafeAtomicAdd(p + 4 + i, acc[ai][bj][m][1][i]); }
                    } else {
                        float r8[8]; unpack8(*(const u32x4*)(x1b + (size_t)row * D + col), r8);
                        const f32x4 v0 = acc[ai][bj][m][0] + (f32x4){r8[0], r8[1], r8[2], r8[3]}, v1 = acc[ai][bj][m][1] + (f32x4){r8[4], r8[5], r8[6], r8[7]};
                        *(f32x4*)p = v0; *(f32x4*)(p + 4) = v1;
                    }
                }
            }
    }
};
struct DownOrder {
    pg8::StaticOrder base; int G, c;
    __device__ void init(int G_, int c_) { base.init(R_SAMPLE, D, G_, c_, DFF); G = G_; c = c_; }
    __device__ bool next(int i, pg8::Unit& u) const {
        const int nb = (256 - c + G - 1) / G;
        if (i < nb) return base.next(i, u);
        const int j = (i - nb) * G + c; if (j >= 48) return false;
        u.pm = 64 + j / 24; u.pn = (j / 6) % 4; u.ko = (j % 6) * 512; u.nt = 8; return true;
    }
    __device__ __forceinline__ void a_ready(const pg8::Unit&) const {}
    __device__ __forceinline__ void done(const pg8::Unit&) const {}
};
struct EpiStash {
    static constexpr bool PERM = true, AFTER_DRAIN = false;
    const float* __restrict__ ssq; bf16* __restrict__ hid;
    __device__ __forceinline__ void operator()(const f32x4 (&acc)[2][2][4][2], const pg8::Unit& u, int wr, int wc, int fr, int fq) const {
#pragma unroll
        for (int ai = 0; ai < 2; ++ai)
#pragma unroll
            for (int m = 0; m < 4; ++m) {
                const int row = EPI_ROW(ai, m);
                const float rs = row_rs(ssq, row);
#pragma unroll
                for (int bj = 0; bj < 2; ++bj) {
                    const int col = EPI_COL(bj);
                    const f32x4 v0 = acc[ai][bj][m][0] * rs, v1 = acc[ai][bj][m][1] * rs;
                    u32x4 w; w.x = pk2(v0.x, v0.y); w.y = pk2(v0.z, v0.w); w.z = pk2(v1.x, v1.y); w.w = pk2(v1.z, v1.w);
                    *(u32x4*)(hid + (size_t)row * DFF + col) = w;
                }
            }
    }
};
struct TailOrder {
    int G, c;
    __device__ bool next(int i, pg8::Unit& u) const {
        const int j = i * G + c - (G == 256 ? 36 : 0); if (j < 0 || j >= 24) return false;
        u.pm = 64 + j / 12; u.pn = j % 12; u.ko = 0; u.nt = D / 64; return true;
    }
    __device__ __forceinline__ void a_ready(const pg8::Unit&) const {}
    __device__ __forceinline__ void done(const pg8::Unit&) const {}
};
struct EpiPlain {
    static constexpr bool PERM = true, AFTER_DRAIN = false;
    bf16* O; int ldc;
    __device__ __forceinline__ void operator()(const f32x4 (&acc)[2][2][4][2], const pg8::Unit& u, int wr, int wc, int fr, int fq) const {
#pragma unroll
        for (int ai = 0; ai < 2; ++ai)
#pragma unroll
            for (int m = 0; m < 4; ++m) {
                const int row = EPI_ROW(ai, m);
#pragma unroll
                for (int bj = 0; bj < 2; ++bj) {
                    const int col = EPI_COL(bj);
                    const f32x4 v0 = acc[ai][bj][m][0], v1 = acc[ai][bj][m][1];
                    u32x4 w; w.x = pk2(v0.x, v0.y); w.y = pk2(v0.z, v0.w); w.z = pk2(v1.x, v1.y); w.w = pk2(v1.z, v1.w);
                    *(u32x4*)(O + (size_t)row * ldc + col) = w;
                }
            }
    }
};

#define XB_TMO      128
#define XB_XCNT(j)  (256  + 64 * (j))
#define XB_XSUB(j)  (1280 + 64 * (j))
#define XB_XGEN(j)  (2304 + 64 * (j))
#define XB_TOP      3328
#define XB_TOPGEN   3392
#define XCD_BAR_WORDS 3456
#define XB_SPIN_CAP (1u << 22)
__device__ __forceinline__ unsigned xb_ld(unsigned* p)              { return __hip_atomic_load(p, __ATOMIC_RELAXED, __HIP_MEMORY_SCOPE_AGENT); }
__device__ __forceinline__ unsigned xb_add(unsigned* p, unsigned v) { return __hip_atomic_fetch_add(p, v, __ATOMIC_RELAXED, __HIP_MEMORY_SCOPE_AGENT); }
__device__ __forceinline__ unsigned xb_xcc_id() { return (unsigned)__builtin_amdgcn_s_getreg((3 << 11) | 20) & 0xFu; }
#define XB_SPIN(cond, bar) do { unsigned _sp = 0; while (cond) { __builtin_amdgcn_s_sleep(1); \
    if ((++_sp & 255u) == 0u) { if (xb_ld(&(bar)[XB_TMO])) break; if (_sp > XB_SPIN_CAP) { atomicAdd(&(bar)[XB_TMO], 1u); break; } } } } while (0)
struct XcdBarrier { unsigned* bar; unsigned x; volatile LAS unsigned* st; };
__device__ __forceinline__ XcdBarrier xcd_barrier_post(unsigned* bar, volatile LAS unsigned* st) {
    XcdBarrier b; b.bar = bar; b.x = xb_xcc_id(); b.st = st;
    if (threadIdx.x == 0) (void)xb_add(&bar[XB_XCNT(b.x)], 1u);
    return b;
}
__device__ __forceinline__ void xcd_barrier_complete(unsigned* bar, unsigned x, unsigned& nloc, unsigned& nx) {
    const unsigned G = gridDim.x * gridDim.y * gridDim.z;
    unsigned sum, cnt, mine, sp = 0u;
    for (;;) {
        sum = 0u; cnt = 0u; mine = 0u;
#pragma unroll
        for (unsigned j = 0; j < 16; ++j) { const unsigned c = xb_ld(&bar[XB_XCNT(j)]); sum += c; cnt += (c > 0u) ? 1u : 0u; mine = (j == x) ? c : mine; }
        if (sum == G) break;
        __builtin_amdgcn_s_sleep(1);
        if ((++sp & 255u) == 0u) { if (xb_ld(&bar[XB_TMO])) break; if (sp > XB_SPIN_CAP) { atomicAdd(&bar[XB_TMO], 1u); break; } }
    }
    nloc = mine > 0u ? mine : 1u; nx = cnt > 0u ? cnt : 1u;
}
__device__ __forceinline__ void xcd_barrier(const XcdBarrier& b) {
    asm volatile("s_waitcnt vmcnt(0)" ::: "memory");
    __syncthreads();
    if (threadIdx.x == 0) {
        unsigned* bar = b.bar;
        __builtin_amdgcn_s_waitcnt(0);
        unsigned nloc = b.st[0], nx = b.st[1];
        if (nloc == 0u) { xcd_barrier_complete(bar, b.x, nloc, nx); b.st[0] = nloc; b.st[1] = nx; }
        const unsigned old = xb_add(&bar[XB_XSUB(b.x)], 1u);
        const unsigned gen = old / nloc;
        if (old + 1u == (gen + 1u) * nloc) {
            __builtin_amdgcn_fence(__ATOMIC_RELEASE, "agent");
            asm volatile("s_waitcnt vmcnt(0)" ::: "memory");
            const unsigned og = xb_add(&bar[XB_TOP], 1u);
            const unsigned tg = og / nx;
            if (og + 1u == (tg + 1u) * nx) xb_add(&bar[XB_TOPGEN], 1u);
            else XB_SPIN(xb_ld(&bar[XB_TOPGEN]) == tg, bar);
            __builtin_amdgcn_fence(__ATOMIC_ACQUIRE, "agent");
            xb_add(&bar[XB_XGEN(b.x)], 1u);
            asm volatile("s_waitcnt vmcnt(0)" ::: "memory");
        } else {
            XB_SPIN(xb_ld(&bar[XB_XGEN(b.x)]) == gen, bar);
            __builtin_amdgcn_fence(__ATOMIC_ACQUIRE, "agent");
            asm volatile("s_waitcnt vmcnt(0)" ::: "memory");
        }
    }
    __syncthreads();
}

__device__ __forceinline__ void p0_transpose_item(const float* W, int K, int N, bf16* WT, const float* ksc, LAS float* scr, int item, int lane) {
    const int nblk = N / 32, kb = item / nblk, nb = item % nblk, k0 = 64 * kb, n0 = 32 * nb;
#pragma unroll
    for (int i = 0; i < 32; ++i) { const int kk = 2 * i + (lane >> 5); float v = W[(size_t)(k0 + kk) * N + n0 + (lane & 31)]; if (ksc) v *= ksc[k0 + kk]; scr[kk * 33 + (lane & 31)] = v; }
    asm volatile("s_waitcnt lgkmcnt(0)" ::: "memory");
    const int c = lane & 7;
#pragma unroll
    for (int j = 0; j < 4; ++j) { const int n = (lane >> 3) + 8 * j; const LAS float* s = scr + (8 * c) * 33 + n;
        u32x4 o; o.x = pk2(s[0 * 33], s[1 * 33]); o.y = pk2(s[2 * 33], s[3 * 33]); o.z = pk2(s[4 * 33], s[5 * 33]); o.w = pk2(s[6 * 33], s[7 * 33]);
        *(u32x4*)(WT + (size_t)(n0 + n) * K + k0 + 8 * c) = o; }
    asm volatile("s_waitcnt lgkmcnt(0)" ::: "memory");
}
__device__ __forceinline__ void phase_p0(const Args& A, LAS unsigned char* lds, int G) {
    const int tid = my_tid(), lane = tid & 63, wave = tid >> 6;
    LAS float* scr = (LAS float*)(lds + wave * 16384);
    const int gw = blockIdx.x * 8 + wave, NGW = G * 8;
    unsigned char* ws = A.ws;
    constexpr int I_IN = 16 * 88, I_OUT = 16 * 32, I_UPI = 16 * 96, I_DN = 48 * 32, NIT = I_IN + I_OUT + 2 * I_UPI + I_DN;
    for (int it = gw; it < NIT; it += NGW) {
        int r = it;
        if (r < I_IN) { p0_transpose_item(A.in[I_WIN], D, DIN, (bf16*)(ws + WS_WIN), nullptr, scr, r, lane); continue; } r -= I_IN;
        if (r < I_OUT) { p0_transpose_item(A.in[I_WOUT], D, D, (bf16*)((unsigned char*)A.out + DO_WOUT), nullptr, scr, r, lane); continue; } r -= I_OUT;
        if (r < I_UPI) { p0_transpose_item(A.in[I_FUP], D, DFF, (bf16*)(ws + WS_WUP), A.in[I_N2G], scr, r, lane); continue; } r -= I_UPI;
        if (r < I_UPI) { p0_transpose_item(A.in[I_FGATE], D, DFF, (bf16*)(ws + WS_WGATE), A.in[I_N2G], scr, r, lane); continue; } r -= I_UPI;
        p0_transpose_item(A.in[I_FDOWN], DFF, D, (bf16*)(ws + WS_WDOWN), nullptr, scr, r, lane);
    }
    const int gt = blockIdx.x * 512 + tid, NGT = G * 512;
    { bf16* BA = (bf16*)(ws + WS_BA); const float* wup = A.in[I_WUP]; const float* aup = A.in[I_AUP]; const float* gup = A.in[I_GUP];
      for (int e = gt; e < 1536 * 256; e += NGT) { const int n = e >> 8, k = e & 255; float v = 0.f;
          if (n < 512) { if (k < 64) v = wup[k * 512 + n]; }
          else if (n < 1024) { if (k >= 64 && k < 128) v = aup[(k - 64) * 512 + n - 512]; }
          else { if (k >= 128) v = gup[(k - 128) * 512 + n - 1024]; }
          BA[e] = (bf16)f2bf(v); } }
    { bf16* BB = (bf16*)(ws + WS_BB); const float* wa = A.in[I_LWA]; const float* wx = A.in[I_LWX];
      for (int e = gt; e < 1024 * 512; e += NGT) { const int n = e >> 9, k = e & 511, nn = n & 511, h = nn >> 6, j = nn & 63; float v = 0.f;
          if ((k >> 6) == h) { const float* Wm = n < 512 ? wa : wx; v = Wm[(h * 64 + (k & 63)) * 64 + j]; }
          BB[e] = (bf16)f2bf(v); } }
    bf16* XN = (bf16*)(ws + WS_XN); const float* g1 = A.in[I_N1G];
    f32x4 gv[4];
#pragma unroll
    for (int j = 0; j < 4; ++j) gv[j] = ((const f32x4*)g1)[lane + 64 * j];
#pragma unroll 2
    for (int row = gw; row < MP; row += NGW) {
        const float* src = row < R_SAMPLE ? A.in[I_XP] + (size_t)row * D : row < R_META ? A.in[I_XS] + (size_t)(row - R_SAMPLE) * D : row < R_END ? A.in[I_META] + (size_t)(row - R_META) * D : nullptr;
        u32x2* o = (u32x2*)(XN + (size_t)row * D);
        if (!src) {
#pragma unroll
            for (int j = 0; j < 4; ++j) o[lane + 64 * j] = (u32x2){0u, 0u};
            continue; }
        f32x4 v[4]; float s = 0.f;
#pragma unroll
        for (int j = 0; j < 4; ++j) { v[j] = ((const f32x4*)src)[lane + 64 * j]; s += (v[j].x * v[j].x + v[j].y * v[j].y) + (v[j].z * v[j].z + v[j].w * v[j].w); }
        const float rs = __builtin_amdgcn_rsqf(wave_sum(s) * (1.f / D) + EPS);
#pragma unroll
        for (int j = 0; j < 4; ++j) { const f32x4 g = gv[j];
            o[lane + 64 * j] = (u32x2){pk2(v[j].x * rs * g.x, v[j].y * rs * g.y), pk2(v[j].z * rs * g.z, v[j].w * rs * g.w)}; }
    }
}

__device__ __forceinline__ void phase_e1(const Args& A, int G) {
    const int tid = my_tid(), lane = tid & 63, wave = tid >> 6;
    const int gw = blockIdx.x * 8 + wave, NGW = G * 8;
    unsigned char* ws = A.ws;
    const bf16* __restrict__ U = (const bf16*)(ws + WS_U); bf16* __restrict__ AP = (bf16*)(ws + WS_AP); bf16* __restrict__ XC = (bf16*)(ws + WS_XC);
    const float* mu = A.in[I_MU]; const float* sts = A.in[I_STS]; const float* slc = A.in[I_SLC]; const float* lcw = A.in[I_LCW]; const float* lcb = A.in[I_LCB];
#pragma unroll 4
    for (int row = gw; row < MP; row += NGW) {
        bf16* ap = AP + (size_t)row * 256; bf16* xc = XC + (size_t)row * 512;
        const RowInfo ri = row_info(row);
        if (ri.kind == 3) { ((u32x2*)ap)[lane] = (u32x2){0u, 0u}; ((u32x4*)xc)[lane] = (u32x4){0u, 0u, 0u, 0u}; continue; }
        const bf16* urow = U + (size_t)row * DIN;
        const int r1 = row_back(ri, row, 1);
        {
            const int c0 = 1536 + 4 * lane;
            const u32x2 uw = *(const u32x2*)(urow + c0);
            float u[4] = {lo16(uw.x), hi16(uw.x), lo16(uw.y), hi16(uw.y)}, p[4];
            if (r1 >= 0) { const u32x2 pw = *(const u32x2*)(U + (size_t)r1 * DIN + c0); p[0] = lo16(pw.x); p[1] = hi16(pw.x); p[2] = lo16(pw.y); p[3] = hi16(pw.y); }
            else if (ri.kind == 1) { const f32x4 pv = *(const f32x4*)(sts + (size_t)ri.b * DTMP + c0); p[0] = pv.x; p[1] = pv.y; p[2] = pv.z; p[3] = pv.w; }
            else { p[0] = p[1] = p[2] = p[3] = 0.f; }
            const f32x4 m4 = *(const f32x4*)(mu + c0);
            float o[4];
#pragma unroll
            for (int i = 0; i < 4; ++i) { const float um = u[i] + (p[i] - u[i]) * m4[i]; o[i] = lane < 16 ? tanh_(um) : lane < 32 ? um : sigm(um); }
            ((u32x2*)ap)[lane] = (u32x2){pk2(o[0], o[1]), pk2(o[2], o[3])};
        }
        {
            const int c = 8 * lane;
            float acc[8], cur[8];
            { const f32x4 b0 = *(const f32x4*)(lcb + c), b1 = *(const f32x4*)(lcb + c + 4); acc[0] = b0.x; acc[1] = b0.y; acc[2] = b0.z; acc[3] = b0.w; acc[4] = b1.x; acc[5] = b1.y; acc[6] = b1.z; acc[7] = b1.w; }
#pragma unroll
            for (int j = 0; j < 4; ++j) {
                float val[8];
                const int rj = (j == 3) ? row : row_back(ri, row, 3 - j);
                if (rj >= 0) unpack8(*(const u32x4*)(U + (size_t)rj * DIN + DTMP + c), val);
                else if (ri.kind == 1) { const float* s = slc + ((size_t)ri.b * 3 + (ri.t + j)) * 512 + c; const f32x4 a = *(const f32x4*)s, b = *(const f32x4*)(s + 4);
                    val[0] = a.x; val[1] = a.y; val[2] = a.z; val[3] = a.w; val[4] = b.x; val[5] = b.y; val[6] = b.z; val[7] = b.w; }
                else {
#pragma unroll
                    for (int i = 0; i < 8; ++i) val[i] = 0.f; }
                const f32x4 w0 = *(const f32x4*)(lcw + j * 512 + c), w1 = *(const f32x4*)(lcw + j * 512 + c + 4);
#pragma unroll
                for (int i = 0; i < 4; ++i) { acc[i] += w0[i] * val[i]; acc[4 + i] += w1[i] * val[4 + i]; }
                if (j == 3) {
#pragma unroll
                    for (int i = 0; i < 8; ++i) cur[i] = val[i]; }
            }
            u32x4 w; w.x = pk2(acc[0], acc[1]); w.y = pk2(acc[2], acc[3]); w.z = pk2(acc[4], acc[5]); w.w = pk2(acc[6], acc[7]);
            ((u32x4*)xc)[lane] = w;
            float* lco = nullptr;
            if (ri.kind == 0 && ri.t >= TP - 3) lco = A.out + O_PLC + ((size_t)ri.b * 3 + (ri.t - (TP - 3))) * 512 + c;
            else if (ri.kind == 1 && ri.t >= 1) lco = A.out + O_SLC + ((size_t)ri.b * 3 + (ri.t - 1)) * 512 + c;
            if (lco) { *(f32x4*)lco = (f32x4){cur[0], cur[1], cur[2], cur[3]}; *(f32x4*)(lco + 4) = (f32x4){cur[4], cur[5], cur[6], cur[7]}; }
        }
        float* sho = nullptr;
        if (ri.kind == 0 && ri.t == TP - 1) sho = A.out + O_PSHIFT + (size_t)ri.b * DTMP;
        else if (ri.kind == 1 && ri.t == DS - 1) sho = A.out + O_SSHIFT + (size_t)ri.b * DTMP;
        if (sho) for (int i = lane; i < DTMP; i += 64) sho[i] = bf2f(urow[i]);
    }
}

__device__ __forceinline__ float sum8(float x) { x += dpp_f<0xB1>(x); x += dpp_f<0x4E>(x); x += dpp_f<0x141>(x); return x; }
__device__ __forceinline__ void phase_e2(const Args& A, int G) {
    const int tid = my_tid(), lane = tid & 63, wave = tid >> 6;
    unsigned char* ws = A.ws;
    const bf16* __restrict__ U = (const bf16*)(ws + WS_U); const bf16* __restrict__ GB = (const bf16*)(ws + WS_GB); const bf16* __restrict__ GA = (const bf16*)((unsigned char*)A.out + DO_GA);
    bf16* __restrict__ REC = (bf16*)(ws + WS_REC); bf16* __restrict__ LRU = (bf16*)(ws + WS_LRU);
    float* __restrict__ LTOT = (float*)((unsigned char*)A.out + DO_LTOT); float* __restrict__ BON = (float*)((unsigned char*)A.out + DO_BON);
    const float* mu = A.in[I_MU]; const float* sts = A.in[I_STS]; const float* slc = A.in[I_SLC]; const float* slh = A.in[I_SLH];
    for (int unit = blockIdx.x; unit < 513 + DB; unit += G) {
        int row0, ntok, kind;
        if (unit < 512) { row0 = unit * 32; ntok = 32; kind = 0; } else if (unit == 512) { row0 = R_META; ntok = 16; kind = 2; } else { row0 = R_SAMPLE + (unit - 513) * 4; ntok = 4; kind = 1; }
        const int c = tid;
        const float sp = softplus_(-A.in[I_LAM][c]);
        const float cw0 = A.in[I_LCW][c], cw1 = A.in[I_LCW][512 + c], cw2 = A.in[I_LCW][1024 + c], cw3 = A.in[I_LCW][1536 + c], cbias = A.in[I_LCB][c];
        const float ba_ = A.in[I_LBA][c], bx_ = A.in[I_LBX][c];
        float l1 = 0.f, l2 = 0.f, l3 = 0.f, H = 0.f, P = 1.f;
        if (kind == 0) { const RowInfo ri0 = row_info(row0);
            l1 = bf2f(U[(size_t)row_back(ri0, row0, 1) * DIN + DTMP + c]); l2 = bf2f(U[(size_t)row_back(ri0, row0, 2) * DIN + DTMP + c]); l3 = bf2f(U[(size_t)row_back(ri0, row0, 3) * DIN + DTMP + c]); }
        else if (kind == 1) { const int b = unit - 513; l3 = slc[((size_t)b * 3 + 0) * 512 + c]; l2 = slc[((size_t)b * 3 + 1) * 512 + c]; l1 = slc[((size_t)b * 3 + 2) * 512 + c]; H = slh[(size_t)b * 512 + c]; }
#pragma unroll 4
        for (int j = 0; j < ntok; ++j) {
            const int row = row0 + j;
            const float l0 = bf2f(U[(size_t)row * DIN + DTMP + c]);
            const float xc = cbias + cw0 * l3 + cw1 * l2 + cw2 * l1 + cw3 * l0;
            l3 = l2; l2 = l1; l1 = l0;
            const float ra = bf2f(GB[(size_t)row * 1024 + c]) + ba_, ix = bf2f(GB[(size_t)row * 1024 + 512 + c]) + bx_;
            const float rg = sigm(ra), ig = sigm(ix);
            const float la = -8.f * rg * sp, a = __builtin_amdgcn_exp2f(1.4426950409f * la);
            float mult = __builtin_amdgcn_sqrtf(fmaxf(1.f - __builtin_amdgcn_exp2f(2.8853900818f * la), 0.f)); if (kind == 2 && j == 0) mult = 1.f;
            H = a * H + xc * ig * mult; P = P * a;
            LRU[(size_t)row * 1024 + c] = (bf16)f2bf(H); LRU[(size_t)row * 1024 + 512 + c] = (bf16)f2bf(kind == 1 ? 0.f : P);
        }
        if (kind == 1) A.out[O_SLH + (size_t)(unit - 513) * 512 + c] = H;
        else { LTOT[((size_t)unit * 2 + 0) * 512 + c] = P; LTOT[((size_t)unit * 2 + 1) * 512 + c] = H; }
    }
    {
        const int c = 8 * lane, h = lane >> 3, gw = blockIdx.x * 8 + wave, NGW = G * 8;
        float mr[8], mk[8], w0[8], a0[8], kkw[8], kaw[8], rkw[8];
        ld8f(mu + c, mr); ld8f(mu + 512 + c, mk); ld8f(A.in[I_W0] + c, w0); ld8f(A.in[I_A0] + c, a0); ld8f(A.in[I_KK] + c, kkw); ld8f(A.in[I_KA] + c, kaw); ld8f(A.in[I_RK] + c, rkw);
#pragma unroll 2
        for (int row = gw; row < R_END; row += NGW) {
            const RowInfo ri = row_info(row); const int r1 = row_back(ri, row, 1);
            const bf16* ur = U + (size_t)row * DIN;
            float u_r[8], u_k[8], p_r[8], p_k[8], wp[8], ap[8];
            unpack8(*(const u32x4*)(ur + c), u_r); unpack8(*(const u32x4*)(ur + 512 + c), u_k);
            unpack8(*(const u32x4*)(GA + (size_t)row * 1536 + c), wp); unpack8(*(const u32x4*)(GA + (size_t)row * 1536 + 512 + c), ap);
            if (r1 >= 0) { unpack8(*(const u32x4*)(U + (size_t)r1 * DIN + c), p_r); unpack8(*(const u32x4*)(U + (size_t)r1 * DIN + 512 + c), p_k); }
            else if (ri.kind == 1) { ld8f(sts + (size_t)ri.b * DTMP + c, p_r); ld8f(sts + (size_t)ri.b * DTMP + 512 + c, p_k); }
            else {
#pragma unroll
                for (int i = 0; i < 8; ++i) { p_r[i] = 0.f; p_k[i] = 0.f; } }
            float av[8], xv[8], kk[8], kp[8], ss = 0.f, bs = 0.f;
#pragma unroll
            for (int i = 0; i < 8; ++i) {
                const float um_r = u_r[i] + (p_r[i] - u_r[i]) * mr[i], um_k = u_k[i] + (p_k[i] - u_k[i]) * mk[i];
                const float z = -(wp[i] + w0[i]);
                const float w_log = -(fmaxf(z, 0.f) + __logf(1.f + __expf(-fabsf(z)))) - 0.5f;
                const float e = __builtin_amdgcn_exp2f(1.4426950409f * w_log); xv[i] = 1.f - __builtin_amdgcn_exp2f(-1.4426950409f * e);
                av[i] = sigm(ap[i] + a0[i]);
                kk[i] = um_k * kkw[i]; ss += kk[i] * kk[i];
                kp[i] = um_k * (1.f + (av[i] - 1.f) * kaw[i]);
                bs += um_r * kp[i] * rkw[i];
            }
            ss = sum8(ss); bs = sum8(bs);
            const float rn = __builtin_amdgcn_rsqf(fmaxf(ss, 1e-24f));
#pragma unroll
            for (int i = 0; i < 8; ++i) kk[i] *= rn;
            bf16* rec = REC + ((size_t)row * 8 + h) * 256 + (lane & 7) * 8;
            *(u32x4*)rec = pack8(av); *(u32x4*)(rec + 64) = pack8(xv); *(u32x4*)(rec + 128) = pack8(kk); *(u32x4*)(rec + 192) = pack8(kp);
            if ((lane & 7) == 0) BON[(size_t)row * 8 + h] = bs;
        }
    }
}

struct Raw { bf16 a, x, kk, kp, ur, uv, pr, pv; };
__device__ __forceinline__ void m2_load(Raw (&raw)[8], const bf16* REC, const bf16* U, int b, int h, int t0, int ns, int k, int sub) {
#pragma unroll
    for (int i = 0; i < 8; ++i) {
        const int s = sub + 4 * i;
        raw[i].a = 0; raw[i].x = 0; raw[i].kk = 0; raw[i].kp = 0; raw[i].ur = 0; raw[i].uv = 0; raw[i].pr = 0; raw[i].pv = 0;
        if (s < ns) {
            const int t = t0 + s, row = prompt_row(b, t);
            const bf16* rec = REC + ((size_t)row * 8 + h) * 256;
            raw[i].a = rec[k]; raw[i].x = rec[64 + k]; raw[i].kk = rec[128 + k]; raw[i].kp = rec[192 + k];
            const bf16* ur = U + (size_t)row * DIN + h * 64 + k; raw[i].ur = ur[0]; raw[i].uv = ur[1024];
            if (t > 0) { const bf16* pr = U + (size_t)prompt_row(b, t - 1) * DIN + h * 64 + k; raw[i].pr = pr[0]; raw[i].pv = pr[1024]; }
        }
    }
}
__device__ __forceinline__ void m2_store(const Raw (&raw)[8], LAS float* buf, float mu_r, float mu_v, int k, int sub, int ns) {
#pragma unroll
    for (int i = 0; i < 8; ++i) {
        const int s = sub + 4 * i;
        if (s < ns) {
            LAS float* p = buf + s * 384;
            const float a = bf2f(raw[i].a), kk = bf2f(raw[i].kk), ur = bf2f(raw[i].ur), uv = bf2f(raw[i].uv);
            p[k] = kk; p[64 + k] = 1.f - bf2f(raw[i].x); p[128 + k] = -(kk * a); p[192 + k] = bf2f(raw[i].kp);
            p[256 + k] = ur + (bf2f(raw[i].pr) - ur) * mu_r; p[320 + k] = uv + (bf2f(raw[i].pv) - uv) * mu_v;
        }
    }
}
typedef float f32x2 __attribute__((ext_vector_type(2)));
struct StepOps { f32x4 kk, dd, nka, kp, r; float v; };
__device__ __forceinline__ void ops_load(StepOps& o, const LAS float* p, int ks, int vrow) {
    o.kk = *(const LAS f32x4*)(p + 4 * ks); o.dd = *(const LAS f32x4*)(p + 64 + 4 * ks); o.nka = *(const LAS f32x4*)(p + 128 + 4 * ks);
    o.kp = *(const LAS f32x4*)(p + 192 + 4 * ks); o.r = *(const LAS f32x4*)(p + 256 + 4 * ks); o.v = p[320 + vrow];
}
__device__ __forceinline__ float dot4(const f32x4 a, const f32x4 b) { f32x2 t = a.xy * b.xy; t = a.zw * b.zw + t; return t.x + t.y; }
__device__ __forceinline__ void scan_step2(f32x4& S, const StepOps& o, float& yp) {
    float d = dot4(S, o.kk);
    d += dpp_f<0xB1>(d); yp += dpp_f<0xB1>(yp); d += dpp_f<0x4E>(d); yp += dpp_f<0x4E>(yp);
    d += dpp_f<0x141>(d); yp += dpp_f<0x141>(yp); d += dpp_f<0x140>(d); yp += dpp_f<0x140>(yp);
    S = S * o.dd + d * o.nka + o.v * o.kp;
}
__device__ __forceinline__ float scan_step(f32x4& S, const StepOps& o) {
    float d = dot4(S, o.kk); d = allsum16(d);
    S = S * o.dd + d * o.nka + o.v * o.kp;
    float y = dot4(S, o.r); return allsum16(y);
}
__device__ __forceinline__ void sample_load(int task, int rl, int ks, f32x4& S, StepOps (&o)[DS], const bf16* __restrict__ REC, const bf16* __restrict__ U, const float* __restrict__ swkv, const float* __restrict__ sts, const float* __restrict__ mu) {
    const int bh = task >> 4, rg = task & 15, b = bh >> 3, h = bh & 7, v = 4 * rg + rl;
    S = *(const f32x4*)(swkv + ((size_t)bh * 64 + v) * 64 + 4 * ks);
    const f32x4 mr4 = *(const f32x4*)(mu + h * 64 + 4 * ks); const float mv = mu[1024 + h * 64 + v];
#pragma unroll
    for (int t = 0; t < DS; ++t) {
        const int row = R_SAMPLE + 4 * b + t;
        const bf16* rec = REC + ((size_t)row * 8 + h) * 256 + 4 * ks;
        const u32x2 wa = *(const u32x2*)rec, wx = *(const u32x2*)(rec + 64), wk = *(const u32x2*)(rec + 128), wp = *(const u32x2*)(rec + 192);
        const f32x4 a4 = (f32x4){lo16(wa.x), hi16(wa.x), lo16(wa.y), hi16(wa.y)};
        o[t].dd = 1.f - (f32x4){lo16(wx.x), hi16(wx.x), lo16(wx.y), hi16(wx.y)};
        o[t].kk = (f32x4){lo16(wk.x), hi16(wk.x), lo16(wk.y), hi16(wk.y)}; o[t].kp = (f32x4){lo16(wp.x), hi16(wp.x), lo16(wp.y), hi16(wp.y)};
        const u32x2 wr_ = *(const u32x2*)(U + (size_t)row * DIN + h * 64 + 4 * ks);
        const f32x4 ur4 = (f32x4){lo16(wr_.x), hi16(wr_.x), lo16(wr_.y), hi16(wr_.y)};
        const float uv = bf2f(U[(size_t)row * DIN + 1024 + h * 64 + v]);
        f32x4 pr4; float pv;
        if (t > 0) { const u32x2 w = *(const u32x2*)(U + (size_t)(row - 1) * DIN + h * 64 + 4 * ks); pr4 = (f32x4){lo16(w.x), hi16(w.x), lo16(w.y), hi16(w.y)}; pv = bf2f(U[(size_t)(row - 1) * DIN + 1024 + h * 64 + v]); }
        else { pr4 = *(const f32x4*)(sts + (size_t)b * DTMP + h * 64 + 4 * ks); pv = sts[(size_t)b * DTMP + 1024 + h * 64 + v]; }
        o[t].r = ur4 + (pr4 - ur4) * mr4; o[t].v = uv + (pv - uv) * mv; o[t].nka = -(o[t].kk * a4);
    }
}
__device__ __forceinline__ void sample_finish(int task, int rl, int ks, f32x4 S, const StepOps (&o)[DS], float* __restrict__ Y, float* __restrict__ out) {
    const int bh = task >> 4, rg = task & 15, b = bh >> 3, h = bh & 7, v = 4 * rg + rl;
#pragma unroll
    for (int t = 0; t < DS; ++t) { const float y = scan_step(S, o[t]); if (ks == 0) Y[(size_t)(R_SAMPLE + 4 * b + t) * 512 + h * 64 + v] = y; }
    *(f32x4*)(out + O_SWKV + ((size_t)bh * 64 + v) * 64 + 4 * ks) = S;
}
__device__ __forceinline__ void phase_m2(const Args& A, LAS unsigned char* lds, int G) {
    const int tid = my_tid(), lane = tid & 63, wave = tid >> 6;
    unsigned char* ws = A.ws;
    const bf16* __restrict__ U = (const bf16*)(ws + WS_U); const bf16* __restrict__ REC = (const bf16*)(ws + WS_REC); float* __restrict__ Y = (float*)(ws + WS_Y);
    const float* LTOT = (const float*)((unsigned char*)A.out + DO_LTOT); float* CARRY = (float*)((unsigned char*)A.out + DO_CARRY);
    const float* mu = A.in[I_MU];
    for (int b = blockIdx.x; b < NB; b += G) {
        const int c = tid; float carry = LTOT[((size_t)512 * 2 + 1) * 512 + c];
        float Pv[64], Hv[64];
#pragma unroll
        for (int i = 0; i < 64; ++i) { const int un = b * 64 + i; Pv[i] = LTOT[((size_t)un * 2 + 0) * 512 + c]; Hv[i] = LTOT[((size_t)un * 2 + 1) * 512 + c]; }
#pragma unroll
        for (int i = 0; i < 64; ++i) { CARRY[((size_t)b * 64 + i) * 512 + c] = carry; carry = Pv[i] * carry + Hv[i]; }
        A.out[O_PLH + (size_t)b * 512 + c] = carry;
    }
    const int ks = lane & 15, rl = lane >> 4;
    for (int item = blockIdx.x; item < 256; item += G) {
        const int bh = item >> 2, q = item & 3, b = bh >> 3, h = bh & 7;
        int k = tid & 63, sub = (tid >> 6) & 3;
        asm volatile("" : "+v"(k), "+v"(sub));
        const float mu_r = mu[h * 64 + k], mu_v = mu[1024 + h * 64 + k];
        const int wv = wave & 3, vrow = 16 * q + 4 * wv + rl;
        f32x4 S = (f32x4){0.f, 0.f, 0.f, 0.f};
        const bool first_item = item == (int)blockIdx.x;
        Raw raw[8];
        LAS float* buf0 = (LAS float*)lds; LAS float* buf1 = (LAS float*)(lds + 50688); LAS float* ybuf = (LAS float*)(lds + 101376) + wv * 132;
        __syncthreads();
        if (wave >= 4) { m2_load(raw, REC, U, b, h, 0, 16, k, sub); m2_store(raw, buf0, mu_r, mu_v, k, sub, 16); m2_load(raw, REC, U, b, h, 16, 32, k, sub); }
        __syncthreads();
        for (int blk = 0; blk < 65; ++blk) {
            const int t0 = blk == 0 ? 0 : 16 + 32 * (blk - 1), ns = blk == 0 ? 16 : 32;
            if (wave >= 4) {
                const int jt = blk >> 2; int task = (int)blockIdx.x * 4 + (wave - 4) + G * 4 * jt;
                asm volatile("" : "+v"(task));
                const bool do_task = first_item && (blk & 3) == 0 && jt < 16 && task < DB * NH * 16;
                f32x4 Sc; StepOps oc[DS];
                if (do_task) sample_load(task, rl, ks, Sc, oc, REC, U, A.in[I_SWKV], A.in[I_STS], mu);
                if (blk + 1 < 65) m2_store(raw, (blk & 1) ? buf0 : buf1, mu_r, mu_v, k, sub, 32);
                if (blk + 2 < 65) m2_load(raw, REC, U, b, h, 16 + 32 * (blk + 1), 32, k, sub);
                if (do_task) sample_finish(task, rl, ks, Sc, oc, Y, A.out);
            } else {
                const LAS float* buf = (blk & 1) ? buf1 : buf0;
                StepOps oa, ob; ops_load(oa, buf, ks, vrow);
                float yp = 0.f;
                for (int s = 0; s < ns; s += 2) {
                    ops_load(ob, buf + (s + 1) * 384, ks, vrow);
                    scan_step2(S, oa, yp); ybuf[s * 4 + rl] = yp; yp = dot4(S, oa.r);
                    ops_load(oa, buf + (s + 2) * 384, ks, vrow);
                    scan_step2(S, ob, yp); ybuf[(s + 1) * 4 + rl] = yp; yp = dot4(S, ob.r);
                }
                yp = allsum16(yp); ybuf[ns * 4 + rl] = yp;
                if (ks < ns) Y[(size_t)prompt_row(b, t0 + ks) * 512 + h * 64 + vrow] = ybuf[(ks + 1) * 4 + rl];
                if (ks + 16 < ns) Y[(size_t)prompt_row(b, t0 + ks + 16) * 512 + h * 64 + vrow] = ybuf[(ks + 17) * 4 + rl];
            }
            __syncthreads();
        }
        if (wave < 4) *(f32x4*)(A.out + O_PWKV + ((size_t)(b * 8 + h) * 64 + vrow) * 64 + 4 * ks) = S;
    }
    for (int task = G * 4 * 16 + blockIdx.x * 8 + wave; task < DB * NH * 16; task += G * 8) {
        f32x4 Sc; StepOps oc[DS];
        sample_load(task, rl, ks, Sc, oc, REC, U, A.in[I_SWKV], A.in[I_STS], mu);
        sample_finish(task, rl, ks, Sc, oc, Y, A.out);
    }
}

__device__ __forceinline__ void phase_m3(const Args& A, int G) {
    const int tid = my_tid(), lane = tid & 63, wave = tid >> 6;
    const int gw = blockIdx.x * 8 + wave, NGW = G * 8;
    unsigned char* ws = A.ws;
    const bf16* __restrict__ U = (const bf16*)(ws + WS_U); const bf16* __restrict__ GA = (const bf16*)((unsigned char*)A.out + DO_GA); const bf16* __restrict__ LRU = (const bf16*)(ws + WS_LRU);
    const float* __restrict__ Y = (const float*)(ws + WS_Y); const float* __restrict__ CARRY = (const float*)((unsigned char*)A.out + DO_CARRY); const float* __restrict__ BON = (const float*)((unsigned char*)A.out + DO_BON);
    bf16* __restrict__ MIX = (bf16*)(ws + WS_MIX);
    const float* sts = A.in[I_STS];
    const int c = 8 * lane, h = lane >> 3;
    float mv[8], gg[8], gb[8], og[8];
    ld8f(A.in[I_MU] + 1024 + c, mv); ld8f(A.in[I_GNG] + c, gg); ld8f(A.in[I_GNB] + c, gb); ld8f(A.in[I_LOG] + c, og);
#pragma unroll 3
    for (int row = gw; row < MP; row += NGW) {
        bf16* mo = MIX + (size_t)row * D;
        const RowInfo ri = row_info(row);
        if (ri.kind == 3) { ((u32x4*)mo)[lane] = (u32x4){0u, 0u, 0u, 0u}; ((u32x4*)mo)[64 + lane] = (u32x4){0u, 0u, 0u, 0u}; continue; }
        const int r1 = row_back(ri, row, 1);
        float y[8], uv[8], pv[8], g[8], hv[8], pp[8], gt[8], cr[8];
        ld8f(Y + (size_t)row * 512 + c, y);
        unpack8(*(const u32x4*)(U + (size_t)row * DIN + 1024 + c), uv);
        unpack8(*(const u32x4*)(GA + (size_t)row * 1536 + 1024 + c), g);
        unpack8(*(const u32x4*)(LRU + (size_t)row * 1024 + c), hv); unpack8(*(const u32x4*)(LRU + (size_t)row * 1024 + 512 + c), pp);
        unpack8(*(const u32x4*)(U + (size_t)row * DIN + DTMP + 512 + c), gt);
        const float bon = BON[(size_t)row * 8 + h];
        if (r1 >= 0) unpack8(*(const u32x4*)(U + (size_t)r1 * DIN + 1024 + c), pv);
        else if (ri.kind == 1) ld8f(sts + (size_t)ri.b * DTMP + 1024 + c, pv);
        else {
#pragma unroll
            for (int i = 0; i < 8; ++i) pv[i] = 0.f; }
        if (ri.kind == 0) ld8f(CARRY + ((size_t)ri.b * 64 + ((row & 2047) >> 5)) * 512 + c, cr);
        else {
#pragma unroll
            for (int i = 0; i < 8; ++i) cr[i] = 0.f; }
        float s = 0.f;
#pragma unroll
        for (int i = 0; i < 8; ++i) s += y[i];
        const float mean = sum8(s) * (1.f / 64.f);
        float q = 0.f;
#pragma unroll
        for (int i = 0; i < 8; ++i) { y[i] -= mean; q += y[i] * y[i]; }
        const float rstd = __builtin_amdgcn_rsqf(sum8(q) * (1.f / 64.f) + GN_EPS);
        float o[8];
#pragma unroll
        for (int i = 0; i < 8; ++i) { const float vv = uv[i] + (pv[i] - uv[i]) * mv[i]; o[i] = (y[i] * rstd * gg[i] + gb[i] + bon * vv) * g[i]; }
        *(u32x4*)(mo + c) = pack8(o);
        float z[8], s2 = 0.f;
#pragma unroll
        for (int i = 0; i < 8; ++i) { z[i] = (hv[i] + pp[i] * cr[i]) * gelu_tanh(gt[i]); s2 += z[i] * z[i]; }
        const float rs = __builtin_amdgcn_rsqf(wave_sum(s2) * (1.f / 512.f) + EPS);
#pragma unroll
        for (int i = 0; i < 8; ++i) o[i] = z[i] * rs * og[i];
        *(u32x4*)(mo + 512 + c) = pack8(o);
    }
}

__device__ __forceinline__ void phase_final(const Args& A, int G) {
    const int tid = my_tid(), lane = tid & 63, wave = tid >> 6;
    const int gw = blockIdx.x * 8 + wave, NGW = G * 8;
    const float* gf = A.in[I_NFG];
    f32x4 g[4];
#pragma unroll
    for (int j = 0; j < 4; ++j) g[j] = ((const f32x4*)gf)[lane + 64 * j];
    for (int row = gw; row < M_MAIN; row += NGW) {
        f32x4* p = (f32x4*)(A.out + (size_t)row * D);
        f32x4 v[4]; float s = 0.f;
#pragma unroll
        for (int j = 0; j < 4; ++j) { v[j] = p[lane + 64 * j]; s += (v[j].x * v[j].x + v[j].y * v[j].y) + (v[j].z * v[j].z + v[j].w * v[j].w); }
        const float rs = __builtin_amdgcn_rsqf(wave_sum(s) * (1.f / D) + EPS);
#pragma unroll
        for (int j = 0; j < 4; ++j) p[lane + 64 * j] = v[j] * rs * g[j];
    }
}

__device__ __forceinline__ void phase_gate_fix(const Args& A, int G) {
    const int tid = my_tid(), gt = blockIdx.x * 512 + tid, NGT = G * 512;
    const bf16* __restrict__ up = (const bf16*)(A.ws + WS_UP); bf16* hid = (bf16*)(A.ws + WS_HID);
    const float* __restrict__ stf = A.in[I_SFC]; const float* __restrict__ cw = A.in[I_FCW]; const float* __restrict__ cb = A.in[I_FCB];
    for (int g = gt; g < DB * DS * (DFF / 8); g += NGT) {
        const int row = R_SAMPLE + g / (DFF / 8), col = (g % (DFF / 8)) * 8, t = row & 3, sb = (row - R_SAMPLE) >> 2;
        float gs[8], u0[8], p1[8], p2[8], w0[8], w1[8], w2[8], bb[8], o[8];
        unpack8(*(const u32x4*)(hid + (size_t)row * DFF + col), gs); unpack8(*(const u32x4*)(up + (size_t)row * DFF + col), u0);
        if (t >= 1) unpack8(*(const u32x4*)(up + (size_t)(row - 1) * DFF + col), p1); else ld8f(stf + ((size_t)sb * 2 + 1) * DFF + col, p1);
        if (t >= 2) unpack8(*(const u32x4*)(up + (size_t)(row - 2) * DFF + col), p2); else ld8f(stf + ((size_t)sb * 2 + t) * DFF + col, p2);
        ld8f(cw + col, w0); ld8f(cw + DFF + col, w1); ld8f(cw + 2 * DFF + col, w2); ld8f(cb + col, bb);
#pragma unroll
        for (int e = 0; e < 8; ++e) o[e] = gelu_tanh(bb[e] + w0[e] * p2[e] + w1[e] * p1[e] + w2[e] * u0[e]) * gs[e];
        *(u32x4*)(hid + (size_t)row * DFF + col) = pack8(o);
    }
}

namespace cg = cooperative_groups;
__global__ void __launch_bounds__(512, 2) mk_fwd(Args args) {
    extern __shared__ __attribute__((aligned(16))) unsigned char lds_raw[];
    LAS unsigned char* lds = (LAS unsigned char*)lds_raw;
    const int G = gridDim.x, tid = threadIdx.x;
    volatile LAS unsigned* MISC = (volatile LAS unsigned*)(lds + 131072 + 320);
    if (tid < 64) ((LAS unsigned*)(lds + 131072))[tid + 64] = 0u, ((LAS unsigned*)(lds + 131072))[tid] = 0u;
    __syncthreads();
    const int lo = args.ph_lo, hi = args.ph_hi;
    XcdBarrier bar; bar.bar = (unsigned*)(args.ws + WS_CTL) + 4096; bar.x = 0; bar.st = nullptr;
    if (hi - lo > 1) bar = xcd_barrier_post((unsigned*)(args.ws + WS_CTL) + 4096, MISC + 8);
    if (lo < 0) cg::this_grid().sync();
#define IN(k) (lo <= (k) && (k) < hi)
#define SEAM(k) do { if (IN(k) && IN((k) + 1)) xcd_barrier(bar); } while (0)
    unsigned char* ws = args.ws; unsigned char* ob = (unsigned char*)args.out;
    if (IN(0)) { phase_p0(args, lds, G); } SEAM(0);
    if (IN(1)) { pg8::Gemm g{(const bf16*)(ws + WS_XN), (const bf16*)(ws + WS_WIN), MP, DIN, D}; pg8::StaticOrder S; S.init(MP, DIN, G, (int)blockIdx.x, D);
        EpiPlain E{(bf16*)(ws + WS_U), DIN}; pg8::gemm_phase<EpiPlain, pg8::StaticOrder, true, true>(lds, g, S, E); } SEAM(1);
    if (IN(2)) { phase_e1(args, G); } SEAM(2);
    if (IN(3)) {
        { pg8::Gemm g{(const bf16*)(ws + WS_AP), (const bf16*)(ws + WS_BA), MP, 1536, 256}; pg8::StaticOrder S; S.init(MP, 1536, G, (int)blockIdx.x, 256);
          EpiPlain E{(bf16*)(ob + DO_GA), 1536}; pg8::gemm_phase<EpiPlain, pg8::StaticOrder, true, true>(lds, g, S, E); }
        { pg8::Gemm g{(const bf16*)(ws + WS_XC), (const bf16*)(ws + WS_BB), MP, 1024, 512}; pg8::StaticOrder S; S.init(MP, 1024, G, (int)((blockIdx.x + 96u) % (unsigned)G), 512);
          EpiPlain E{(bf16*)(ws + WS_GB), 1024}; pg8::gemm_phase<EpiPlain, pg8::StaticOrder, true, true>(lds, g, S, E); }
    } SEAM(3);
    if (IN(4)) { phase_e2(args, G); } SEAM(4);
    if (IN(5)) { phase_m2(args, lds, G); } SEAM(5);
    if (IN(6)) { phase_m3(args, G); } SEAM(6);
    if (IN(7)) { pg8::Gemm g{(const bf16*)(ws + WS_MIX), (const bf16*)(ob + DO_WOUT), MP, D, D}; pg8::StaticOrder S; S.init(MP, D, G, (int)blockIdx.x, D);
        EpiX1 E{args.in[I_XP], args.in[I_XS], args.in[I_META], args.out, (bf16*)(ws + WS_X1B), (float*)(ws + WS_SSQ1)};
        pg8::gemm_phase<EpiX1, pg8::StaticOrder, true, true>(lds, g, S, E); } SEAM(7);
    if (IN(8)) { pg8::Gemm g{(const bf16*)(ws + WS_X1B), (const bf16*)(ws + WS_WUP), MP, DFF, D}; pg8::StaticOrder S; S.init(MP, DFF, G, (int)blockIdx.x, D);
        EpiUp E{(const float*)(ws + WS_SSQ1), (bf16*)(ws + WS_UP), args.out + O_PFC, args.out + O_SFC};
        pg8::gemm_phase<EpiUp, pg8::StaticOrder, true, true>(lds, g, S, E);
        { pg8::Gemm g2{(const bf16*)(ws + WS_X1B), (const bf16*)(ws + WS_WGATE), MP, DFF, D}; TailOrder S2{G, (int)blockIdx.x};
          EpiStash E2{(const float*)(ws + WS_SSQ1), (bf16*)(ws + WS_HID)}; pg8::gemm_phase<EpiStash, TailOrder, true, true>(lds, g2, S2, E2); } } SEAM(8);
    if (IN(9)) { pg8::Gemm g{(const bf16*)(ws + WS_X1B), (const bf16*)(ws + WS_WGATE), R_SAMPLE, DFF, D}; pg8::StaticOrder S; S.init(R_SAMPLE, DFF, G, (int)blockIdx.x, D);
        EpiGate E{(const float*)(ws + WS_SSQ1), (const bf16*)(ws + WS_UP), args.in[I_SFC], args.in[I_FCW], args.in[I_FCB], (bf16*)(ws + WS_HID)};
        pg8::gemm_phase<EpiGate, pg8::StaticOrder, true, true>(lds, g, S, E); phase_gate_fix(args, G); } SEAM(9);
    if (IN(10)) { pg8::Gemm g{(const bf16*)(ws + WS_HID), (const bf16*)(ws + WS_WDOWN), M_MAIN, D, DFF}; DownOrder S; S.init(G, (int)blockIdx.x);
        EpiDown E{args.out, (const bf16*)(ws + WS_X1B)};
        pg8::gemm_phase<EpiDown, DownOrder, true, true>(lds, g, S, E); } SEAM(10);
    if (IN(11)) { phase_final(args, G); }
#undef IN
#undef SEAM
}

extern "C" void kernel_launch(void* const* d_in, const int* in_sizes, int n_in, void* d_out, int out_size, void* d_ws, size_t ws_size, hipStream_t stream) {
    static int grid = 0;
    if (grid == 0) {
        if (n_in != N_IN || (size_t)out_size != O_END || ws_size < 256 * MiB) { fprintf(stderr, "kernel_launch: unexpected shapes n_in %d out %d ws %zu\n", n_in, out_size, ws_size); grid = -1; return; }
        int dev = 0, cus = 0, per_cu = 0;
        (void)hipGetDevice(&dev); (void)hipDeviceGetAttribute(&cus, hipDeviceAttributeMultiprocessorCount, dev);
        if (hipFuncSetAttribute((const void*)mk_fwd, hipFuncAttributeMaxDynamicSharedMemorySize, LDS_BYTES) != hipSuccess) { fprintf(stderr, "kernel_launch: hipFuncSetAttribute failed\n"); grid = -1; return; }
        if (hipOccupancyMaxActiveBlocksPerMultiprocessor(&per_cu, (const void*)mk_fwd, 512, LDS_BYTES) != hipSuccess || per_cu < 1) per_cu = 1;
        (void)hipGetLastError();
        grid = cus > 0 ? cus : 256;
    }
    if (grid < 0) return;
    Args a{};
    for (int i = 0; i < N_IN; ++i) a.in[i] = (const float*)d_in[i];
    a.out = (float*)d_out; a.ws = (unsigned char*)d_ws;
#if MK_ONE_LAUNCH
    (void)hipMemsetAsync((char*)d_ws + WS_CTL, 0, CTL_ZERO_BYTES, stream);
    a.ph_lo = 0; a.ph_hi = NPH;
    void* kargs[] = {&a};
    hipError_t e = hipLaunchCooperativeKernel((const void*)mk_fwd, dim3(grid), dim3(512), kargs, LDS_BYTES, stream);
    if (e != hipSuccess) fprintf(stderr, "cooperative launch failed: %s (grid %d)\n", hipGetErrorString(e), grid);
#else
    for (int ph = 0; ph < NPH; ++ph) for (int rep = 0; rep < 1 + ((MK_REP_MASK >> ph) & 1); ++rep) { a.ph_lo = ph; a.ph_hi = ph + 1; hipLaunchKernelGGL(mk_fwd, dim3(grid), dim3(512), LDS_BYTES, stream, a); }
#endif
}
```

```cpp
#include <hip/hip_runtime.h>
#include <hip/hip_cooperative_groups.h>
#include <cstdio>
#include <cstdint>
#include <cmath>
__device__ __forceinline__ int my_tid() { int t = threadIdx.x; asm volatile("" : "+v"(t)); return t; }
namespace pg8 {
#define PG8_LAS __attribute__((address_space(3)))
typedef unsigned short bf16_t;
typedef short bf16x8 __attribute__((ext_vector_type(8)));
typedef float f32x4 __attribute__((ext_vector_type(4)));
typedef unsigned u32x4 __attribute__((ext_vector_type(4)));
constexpr int BM = 256, BK = 64, HALF = 128, HTB = HALF * BK * 2  , STAGE_BYTES = 8 * HTB, NXCD = 8, WGM = 8;

__host__ __device__ __forceinline__ int lds_byte(int r, int c) { const int st = (r >> 4) * 2 + (c >> 5), rr = r & 15, cc = c & 31, ob = rr * 64 + cc * 2; return st * 1024 + (ob ^ (((ob >> 9) & 1) << 5)); }
__host__ __device__ __forceinline__ void stage_rc(int b, int& R, int& C) { const int st = b / 1024, sb = b % 1024, swz = sb ^ (((sb >> 9) & 1) << 5); R = (st >> 1) * 16 + swz / 64; C = (st & 1) * 32 + (swz % 64) / 2; }
__host__ __device__ __forceinline__ int perm32(int rho) { const int n = rho >> 4, i = rho & 15; return 8 * (i >> 2) + 4 * n + (i & 3); }

struct Unit { int pm, pn, ko, nt; };
struct Gemm { const bf16_t* A; const bf16_t* Bt; int M, N, K; };

struct StaticOrder {
    int nM, nN, nwg, G, c, ntk;
    __host__ __device__ void init(int M, int N, int G_, int c_, int K_) { nM = M / BM; nN = N / BM; nwg = nM * nN; G = G_; c = c_; ntk = K_ / BK; }
    __host__ __device__ bool next(int i, Unit& u) const {
        const long L = (long)i * G + c; if (L >= nwg) return false;
        int wgid = (int)L; { const int q = nwg / NXCD, r = nwg % NXCD, xcd = wgid % NXCD, off = wgid / NXCD; wgid = (xcd < r ? xcd * (q + 1) : r * (q + 1) + (xcd - r) * q) + off; }
        const int nig = WGM * nN, gid = wgid / nig, fm = gid * WGM, gsz = (nM - fm) < WGM ? (nM - fm) : WGM;
        u.pm = fm + ((wgid % nig) % gsz); u.pn = (wgid % nig) / gsz; u.ko = 0; u.nt = ntk; return true;
    }
    __device__ __forceinline__ void a_ready(const Unit&) const {}
    __device__ __forceinline__ void done(const Unit&) const {}
};

__device__ __forceinline__ unsigned cvt_pk_bf16(float lo, float hi) { unsigned r; asm volatile("v_cvt_pk_bf16_f32 %0, %1, %2" : "=v"(r) : "v"(lo), "v"(hi)); return r; }
typedef float f32x2 __attribute__((ext_vector_type(2)));
template <class Epi, class Sched, bool ALIGN_EPI = false, bool SP2 = false>
__device__ __forceinline__ void gemm_phase(PG8_LAS unsigned char* lds, const Gemm g, const Sched& S, const Epi& E) {
    const int tid = my_tid(), wid = __builtin_amdgcn_readfirstlane(tid >> 6), lane = tid & 63, wr = wid >> 2, wc = wid & 3, fr = lane & 15, fq = lane >> 4;
    const int K = g.K;
    unsigned voffA[2], voffB[2];
#pragma unroll
    for (int i = 0; i < 2; ++i) { int R, C; stage_rc(tid * 16 + i * 8192, R, C); const int Rb = Epi::PERM ? ((R & ~31) + perm32(R & 31)) : R;
        voffA[i] = (unsigned)(R * K + C) * 2u; voffB[i] = (unsigned)(Rb * K + C) * 2u; }
    const size_t kstep = (size_t)(BK * 2);
    const size_t hstep = (size_t)HALF * K * 2;
    const size_t tstep = 2 * hstep;
    const unsigned ldsw = (unsigned)wid * 1024u;
    const int aoff = lds_byte(wr * 64 + fr, fq * 8), boff = lds_byte(wc * 32 + fr, fq * 8);
#define PG8_SA(b, h) (((b) * 2 + (h)) * HTB)
#define PG8_SB(b, h) ((4 + (b) * 2 + (h)) * HTB)
#define PG8_STAGE(bufoff, gbase, voff) do { _Pragma("unroll") for (int _i = 0; _i < 2; ++_i) \
        __builtin_amdgcn_global_load_lds((const unsigned*)((const char*)(gbase) + (voff)[_i]), (PG8_LAS unsigned*)(lds + (bufoff) + ldsw + _i * 8192), 16, 0, 0); } while (0)
#define PG8_LDA(dst, b, h) do { _Pragma("unroll") for (int m = 0; m < 4; ++m) _Pragma("unroll") for (int k = 0; k < 2; ++k) dst[m][k] = *(const PG8_LAS bf16x8*)(lds + PG8_SA(b, h) + aoff + m * 2048 + k * 1024); } while (0)
#define PG8_LDB(dst, b, h) do { _Pragma("unroll") for (int n = 0; n < 2; ++n) _Pragma("unroll") for (int k = 0; k < 2; ++k) dst[n][k] = *(const PG8_LAS bf16x8*)(lds + PG8_SB(b, h) + boff + n * 2048 + k * 1024); } while (0)
#define PG8_MMA(ai, bj, At, Bt) do { __builtin_amdgcn_s_setprio(1); _Pragma("unroll") for (int m = 0; m < 4; ++m) _Pragma("unroll") for (int n = 0; n < 2; ++n) _Pragma("unroll") for (int k = 0; k < 2; ++k) \
        acc[ai][bj][m][n] = __builtin_amdgcn_mfma_f32_16x16x32_bf16(Bt[n][k], At[m][k], acc[ai][bj][m][n], 0, 0, 0); __builtin_amdgcn_s_setprio(0); } while (0)
#define PG8_WAIT_V(n) asm volatile("s_waitcnt vmcnt(" #n ")" ::: "memory")
#define PG8_WAIT_L(n) asm volatile("s_waitcnt lgkmcnt(" #n ")" ::: "memory")
#define PG8_BAR __builtin_amdgcn_s_barrier()
#define PG8_SCHED __builtin_amdgcn_sched_barrier(0)
    Unit cur, nxt; int ui = 0;
    if (!S.next(0, cur)) return;
    f32x4 acc[2][2][4][2];
#pragma unroll
    for (int a = 0; a < 2; ++a)
#pragma unroll
        for (int b = 0; b < 2; ++b)
#pragma unroll
            for (int m = 0; m < 4; ++m)
#pragma unroll
                for (int n = 0; n < 2; ++n) acc[a][b][m][n] = (f32x4){0.f, 0.f, 0.f, 0.f};
    bf16x8 At[4][2], B0[2][2], B1[2][2];
    const char* cA = (const char*)g.A + (size_t)cur.pm * tstep + (size_t)cur.ko * 2; const char* cB = (const char*)g.Bt + (size_t)cur.pn * tstep + (size_t)cur.ko * 2;
    S.a_ready(cur);
    if constexpr (SP2) {
        PG8_STAGE(PG8_SB(0, 0), cB, voffB); PG8_STAGE(PG8_SB(0, 1), cB + hstep, voffB); PG8_STAGE(PG8_SA(0, 0), cA, voffA); PG8_STAGE(PG8_SA(0, 1), cA + hstep, voffA);
        if (wr == 1) PG8_BAR;
        PG8_WAIT_V(2); PG8_BAR;
        PG8_STAGE(PG8_SB(1, 0), cB + kstep, voffB); PG8_STAGE(PG8_SA(1, 0), cA + kstep, voffA); PG8_STAGE(PG8_SB(1, 1), cB + hstep + kstep, voffB);
        PG8_WAIT_V(6); PG8_BAR;
    } else {
        PG8_STAGE(PG8_SB(0, 0), cB, voffB); PG8_STAGE(PG8_SA(0, 0), cA, voffA); PG8_STAGE(PG8_SB(0, 1), cB + hstep, voffB); PG8_STAGE(PG8_SA(0, 1), cA + hstep, voffA);
        if (wr == 1) PG8_BAR;
        PG8_WAIT_V(4); PG8_BAR;
        PG8_STAGE(PG8_SB(1, 0), cB + kstep, voffB); PG8_STAGE(PG8_SA(1, 0), cA + kstep, voffA); PG8_STAGE(PG8_SB(1, 1), cB + hstep + kstep, voffB);
        PG8_WAIT_V(6); PG8_BAR;
    }
    for (;;) {
        const bool has_next = S.next(ui + 1, nxt);
        const char* nA = has_next ? (const char*)g.A + (size_t)nxt.pm * tstep + (size_t)nxt.ko * 2 : cA; const char* nB = has_next ? (const char*)g.Bt + (size_t)nxt.pn * tstep + (size_t)nxt.ko * 2 : cB;
        const int nt = cur.nt;
        for (int t = 0; t < nt; t += 2) {
            const bool last = (t == nt - 2);
            const char* a1 = cA + (size_t)(t + 1) * kstep;
            const char* a2 = last ? nA : cA + (size_t)(t + 2) * kstep; const char* b2 = last ? nB : cB + (size_t)(t + 2) * kstep;
            const char* a3 = a2 + kstep; const char* b3 = b2 + kstep;
            if (last && has_next) S.a_ready(nxt);
            if constexpr (SP2) {
            PG8_LDB(B0, 0, 0); PG8_LDB(B1, 0, 1); PG8_SCHED; PG8_LDA(At, 0, 0); PG8_STAGE(PG8_SA(1, 1), a1 + hstep, voffA);
            PG8_WAIT_V(8); PG8_WAIT_L(0); PG8_BAR; PG8_MMA(0, 0, At, B0); PG8_MMA(0, 1, At, B1); PG8_BAR; PG8_SCHED;
            PG8_LDA(At, 0, 1); PG8_STAGE(PG8_SB(0, 0), b2, voffB); PG8_STAGE(PG8_SB(0, 1), b2 + hstep, voffB); PG8_STAGE(PG8_SA(0, 0), a2, voffA);
            PG8_WAIT_V(8); PG8_WAIT_L(0); PG8_BAR; PG8_MMA(1, 0, At, B0); PG8_MMA(1, 1, At, B1); PG8_BAR; PG8_SCHED;
            PG8_LDB(B0, 1, 0); PG8_LDB(B1, 1, 1); PG8_SCHED; PG8_LDA(At, 1, 0); PG8_STAGE(PG8_SA(0, 1), a2 + hstep, voffA);
            PG8_WAIT_V(8); PG8_WAIT_L(0); PG8_BAR; PG8_MMA(0, 0, At, B0); PG8_MMA(0, 1, At, B1); PG8_BAR; PG8_SCHED;
            PG8_LDA(At, 1, 1); PG8_STAGE(PG8_SB(1, 0), b3, voffB); PG8_STAGE(PG8_SB(1, 1), b3 + hstep, voffB); PG8_STAGE(PG8_SA(1, 0), a3, voffA);
            PG8_WAIT_V(8); PG8_WAIT_L(0); PG8_BAR; PG8_MMA(1, 0, At, B0); PG8_MMA(1, 1, At, B1); PG8_BAR; PG8_SCHED;
            } else {
            PG8_LDB(B0, 0, 0); PG8_SCHED; PG8_LDA(At, 0, 0); PG8_STAGE(PG8_SA(1, 1), a1 + hstep, voffA);
            PG8_WAIT_L(8); PG8_BAR; PG8_WAIT_L(0); PG8_MMA(0, 0, At, B0); PG8_BAR; PG8_SCHED;
            PG8_LDB(B1, 0, 1); PG8_STAGE(PG8_SB(0, 0), b2, voffB);
            PG8_BAR; PG8_WAIT_L(0); PG8_MMA(0, 1, At, B1); PG8_BAR;
            PG8_LDA(At, 0, 1); PG8_STAGE(PG8_SA(0, 0), a2, voffA);
            PG8_BAR; PG8_WAIT_L(0); PG8_MMA(1, 0, At, B0); PG8_BAR; PG8_SCHED;
            PG8_STAGE(PG8_SB(0, 1), b2 + hstep, voffB);
            PG8_WAIT_V(6); PG8_BAR; PG8_MMA(1, 1, At, B1); PG8_BAR;
            PG8_LDB(B0, 1, 0); PG8_SCHED; PG8_LDA(At, 1, 0); PG8_STAGE(PG8_SA(0, 1), a2 + hstep, voffA);
            PG8_WAIT_L(8); PG8_BAR; PG8_WAIT_L(0); PG8_MMA(0, 0, At, B0); PG8_BAR; PG8_SCHED;
            PG8_LDB(B1, 1, 1); PG8_STAGE(PG8_SB(1, 0), b3, voffB);
            PG8_BAR; PG8_WAIT_L(0); PG8_MMA(0, 1, At, B1); PG8_BAR;
            PG8_LDA(At, 1, 1); PG8_STAGE(PG8_SA(1, 0), a3, voffA);
            PG8_BAR; PG8_WAIT_L(0); PG8_MMA(1, 0, At, B0); PG8_BAR; PG8_SCHED;
            PG8_STAGE(PG8_SB(1, 1), b3 + hstep, voffB);
            PG8_WAIT_V(6); PG8_BAR; PG8_MMA(1, 1, At, B1); PG8_BAR;
            }
        }
        if constexpr (ALIGN_EPI) { if (wr == 0) PG8_BAR; }
        if constexpr (!Epi::AFTER_DRAIN) { E(acc, cur, wr, wc, fr, fq); S.done(cur); }
        if (!has_next) break;
#pragma unroll
        for (int a = 0; a < 2; ++a)
#pragma unroll
            for (int b = 0; b < 2; ++b)
#pragma unroll
                for (int m = 0; m < 4; ++m)
#pragma unroll
                    for (int n = 0; n < 2; ++n) acc[a][b][m][n] = (f32x4){0.f, 0.f, 0.f, 0.f};
        cur = nxt; cA = nA; cB = nB; ++ui;
        if constexpr (ALIGN_EPI) { if (wr == 1) PG8_BAR; }
    }
    PG8_WAIT_V(0);
    if constexpr (!ALIGN_EPI) { if (wr == 0) PG8_BAR; }
    PG8_BAR;
    if constexpr (Epi::AFTER_DRAIN) { E.fused(acc, cur, wr, wc, fr, fq, lds, wid, lane); S.done(cur); }
#undef PG8_SA
#undef PG8_SB
#undef PG8_STAGE
#undef PG8_LDA
#undef PG8_LDB
#undef PG8_MMA
#undef PG8_WAIT_V
#undef PG8_WAIT_L
#undef PG8_BAR
#undef PG8_SCHED
}
}

#ifndef MK_REP_MASK
#define MK_REP_MASK 0
#endif
#ifndef MK_ONE_LAUNCH
#define MK_ONE_LAUNCH 1
#endif
#define LAS __attribute__((address_space(3)))
typedef unsigned short bf16;
typedef float f32x4 __attribute__((ext_vector_type(4)));
typedef unsigned u32x4 __attribute__((ext_vector_type(4)));
typedef unsigned u32x2 __attribute__((ext_vector_type(2)));
constexpr int D = 1024, NB = 8, SEQ = 2048, NMETA = 16, TP = SEQ + NMETA, DB = 128, DS = 4;
constexpr int NH = 8, DTMP = 1792, DIN = 2816, DFF = 3072;
constexpr int R_SAMPLE = NB * SEQ, R_META = R_SAMPLE + DB * DS, R_END = R_META + NMETA, MP = 17152, M_MAIN = 16896;
constexpr float EPS = 1e-6f, GN_EPS = 64e-5f;
constexpr int NPH = 12;
constexpr int LDS_BYTES = 147456;
enum { I_XP = 0, I_XS, I_STS, I_SWKV, I_SLC, I_SLH, I_SFC, I_META, I_N1G, I_WIN, I_MU, I_W0, I_WUP, I_A0, I_AUP, I_GUP, I_KK, I_KA, I_RK,
       I_GNG, I_GNB, I_LCW, I_LCB, I_LWA, I_LBA, I_LWX, I_LBX, I_LAM, I_LOG, I_WOUT, I_N2G, I_FUP, I_FGATE, I_FCW, I_FCB, I_FDOWN, I_NFG, N_IN };
constexpr size_t O_YP = 0, O_YS = 16777216, O_PSHIFT = 17301504, O_PWKV = 17315840, O_PLC = 17577984, O_PLH = 17590272, O_PFC = 17594368,
                 O_SSHIFT = 17643520, O_SWKV = 17872896, O_SLC = 22067200, O_SLH = 22263808, O_SFC = 22329344, O_END = 23115776;
constexpr size_t MiB = 1u << 20;
constexpr size_t WS_CTL = 0, CTL_ZERO_BYTES = 65536;
constexpr size_t WS_SSQ1 = 1 * MiB, WS_SSQ2 = WS_SSQ1 + (size_t)MP * 16 * 4;
constexpr size_t WS_WUP = 4 * MiB, WS_WGATE = 10 * MiB, WS_WDOWN = 16 * MiB;
constexpr size_t WS_X1B = 22 * MiB, WS_UP = WS_X1B + (size_t)MP * D * 2, WS_HID = WS_UP + (size_t)MP * DFF * 2;
constexpr size_t WS_U = 22 * MiB;
constexpr size_t WS_XN = 115 * MiB, WS_WIN = WS_XN + (size_t)MP * D * 2;
constexpr size_t WS_AP = 190 * MiB, WS_XC = 199 * MiB, WS_BA = 216 * MiB, WS_BB = 217 * MiB, WS_GB = 220 * MiB;
constexpr size_t WS_REC = 115 * MiB, WS_LRU = 182 * MiB, WS_Y = 220 * MiB, WS_MIX = 115 * MiB;
static_assert(WS_SSQ2 + (size_t)MP * 16 * 4 <= WS_WUP, "ssq");
static_assert(WS_HID + (size_t)M_MAIN * DFF * 2 <= 256 * MiB, "hid");
static_assert(WS_U + (size_t)MP * DIN * 2 <= WS_XN, "u");
static_assert(WS_WIN + (size_t)DIN * D * 2 <= WS_LRU, "win");
static_assert(WS_AP + (size_t)MP * 256 * 2 <= WS_XC && WS_XC + (size_t)MP * 512 * 2 <= WS_BA, "ap/xc");
static_assert(WS_GB + (size_t)MP * 1024 * 2 <= 256 * MiB, "gb");
static_assert(WS_REC + (size_t)R_END * 4096 <= WS_LRU && WS_LRU + (size_t)R_END * 2048 <= WS_BA, "rec/lru");
static_assert(WS_Y + (size_t)R_END * 2048 <= 256 * MiB, "y");
constexpr size_t DO_GA = 0, DO_LTOT = (size_t)MP * 1536 * 2, DO_CARRY = DO_LTOT + 513 * 2 * 512 * 4, DO_BON = DO_CARRY + 8 * 64 * 512 * 4, DO_WOUT = O_SFC * 4;
static_assert(DO_BON + (size_t)R_END * 8 * 4 <= O_PSHIFT * 4, "d_out scratch");

struct Args { const float* in[N_IN]; float* out; unsigned char* ws; int ph_lo, ph_hi; };

__device__ __forceinline__ float bf2f(bf16 h) { return __uint_as_float(((unsigned)h) << 16); }
__device__ __forceinline__ unsigned f2bf(float f) { unsigned u = __float_as_uint(f); return (u + 0x7fffu + ((u >> 16) & 1u)) >> 16; }
typedef float f32x2_t __attribute__((ext_vector_type(2))); typedef __bf16 bf16x2_t __attribute__((ext_vector_type(2)));
__device__ __forceinline__ unsigned pk2(float lo, float hi) { const f32x2_t v = {lo, hi}; const bf16x2_t b = __builtin_convertvector(v, bf16x2_t); return __builtin_bit_cast(unsigned, b); }
__device__ __forceinline__ float lo16(unsigned w) { return __uint_as_float(w << 16); }
__device__ __forceinline__ float hi16(unsigned w) { return __uint_as_float(w & 0xffff0000u); }
__device__ __forceinline__ float sigm(float x) { return __builtin_amdgcn_rcpf(1.f + __builtin_amdgcn_exp2f(-1.4426950409f * x)); }
__device__ __forceinline__ float softplus_(float z) { return fmaxf(z, 0.f) + log1pf(__expf(-fabsf(z))); }
__device__ __forceinline__ float gelu_tanh(float x) { const float t = x * (-2.3022082f + -0.10294324f * (x * x)); return x * __builtin_amdgcn_rcpf(1.f + __builtin_amdgcn_exp2f(t)); }
__device__ __forceinline__ float tanh_(float x) { const float e = __builtin_amdgcn_exp2f(2.8853900818f * x); return 1.f - 2.f * __builtin_amdgcn_rcpf(e + 1.f); }
__device__ __forceinline__ float wave_sum(float v) {
#pragma unroll
    for (int o = 1; o < 64; o <<= 1) v += __shfl_xor(v, o);
    return v;
}
template <int CTRL> __device__ __forceinline__ float dpp_f(float x) { return __int_as_float(__builtin_amdgcn_update_dpp(0, __float_as_int(x), CTRL, 0xF, 0xF, true)); }
__device__ __forceinline__ float allsum16(float x) { x += dpp_f<0xB1>(x); x += dpp_f<0x4E>(x); x += dpp_f<0x141>(x); x += dpp_f<0x140>(x); return x; }

struct RowInfo { int kind, b, t; };
__device__ __forceinline__ RowInfo row_info(int row) {
    RowInfo r;
    if (row < R_SAMPLE) { r.kind = 0; r.b = row >> 11; r.t = (row & 2047) + NMETA; }
    else if (row < R_META) { r.kind = 1; r.b = (row - R_SAMPLE) >> 2; r.t = (row - R_SAMPLE) & 3; }
    else if (row < R_END) { r.kind = 2; r.b = 0; r.t = row - R_META; }
    else { r.kind = 3; r.b = 0; r.t = 0; }
    return r;
}
__device__ __forceinline__ int prompt_row(int b, int t) { return t < NMETA ? R_META + t : b * SEQ + t - NMETA; }
__device__ __forceinline__ int row_back(const RowInfo& ri, int row, int j) {
    const int tt = ri.t - j; if (tt < 0) return -1;
    if (ri.kind == 1) return row - j;
    return prompt_row(ri.b, tt);
}
__device__ __forceinline__ void unpack8(const u32x4 w, float (&f)[8]) {
    f[0] = lo16(w.x); f[1] = hi16(w.x); f[2] = lo16(w.y); f[3] = hi16(w.y); f[4] = lo16(w.z); f[5] = hi16(w.z); f[6] = lo16(w.w); f[7] = hi16(w.w);
}
__device__ __forceinline__ void ld8f(const float* p, float (&f)[8]) { const f32x4 a = *(const f32x4*)p, b = *(const f32x4*)(p + 4); f[0] = a.x; f[1] = a.y; f[2] = a.z; f[3] = a.w; f[4] = b.x; f[5] = b.y; f[6] = b.z; f[7] = b.w; }
__device__ __forceinline__ u32x4 pack8(const float (&o)[8]) { u32x4 w; w.x = pk2(o[0], o[1]); w.y = pk2(o[2], o[3]); w.z = pk2(o[4], o[5]); w.w = pk2(o[6], o[7]); return w; }
__device__ __forceinline__ float row_rs(const float* ssq, int row) {
    const f32x4* p = (const f32x4*)(ssq + (size_t)row * 16); const f32x4 a = p[0], b = p[1], c = p[2], d = p[3];
    const float s = ((a.x + a.y) + (a.z + a.w)) + ((b.x + b.y) + (b.z + b.w)) + ((c.x + c.y) + (c.z + c.w)) + ((d.x + d.y) + (d.z + d.w));
    return __builtin_amdgcn_rsqf(s * (1.f / 1024.f) + EPS);
}

#define EPI_ROW(ai, m) (u.pm * 256 + (ai) * 128 + wr * 64 + (m) * 16 + fr)
#define EPI_COL(bj) (u.pn * 256 + (bj) * 128 + wc * 32 + 8 * fq)
struct EpiX1 {
    static constexpr bool PERM = true, AFTER_DRAIN = false;
    const float* __restrict__ xp; const float* __restrict__ xs; const float* __restrict__ meta; float* __restrict__ x1; bf16* __restrict__ x1b; float* __restrict__ ssq;
    __device__ __forceinline__ void operator()(const f32x4 (&acc)[2][2][4][2], const pg8::Unit& u, int wr, int wc, int fr, int fq) const {
#pragma unroll
        for (int ai = 0; ai < 2; ++ai)
#pragma unroll
            for (int m = 0; m < 4; ++m) {
                const int row = EPI_ROW(ai, m);
                const float* res = row < R_SAMPLE ? xp + (size_t)row * D : row < R_META ? xs + (size_t)(row - R_SAMPLE) * D : row < R_END ? meta + (size_t)(row - R_META) * D : nullptr;
                float s = 0.f;
#pragma unroll
                for (int bj = 0; bj < 2; ++bj) {
                    const int col = EPI_COL(bj);
                    f32x4 v0 = acc[ai][bj][m][0], v1 = acc[ai][bj][m][1];
                    if (res) { v0 += *(const f32x4*)(res + col); v1 += *(const f32x4*)(res + col + 4); }
                    if (row >= R_SAMPLE && row < M_MAIN) { *(f32x4*)(x1 + (size_t)row * D + col) = v0; *(f32x4*)(x1 + (size_t)row * D + col + 4) = v1; }
                    u32x4 w; w.x = pk2(v0.x, v0.y); w.y = pk2(v0.z, v0.w); w.z = pk2(v1.x, v1.y); w.w = pk2(v1.z, v1.w);
                    *(u32x4*)(x1b + (size_t)row * D + col) = w;
                    s += (v0.x * v0.x + v0.y * v0.y) + (v0.z * v0.z + v0.w * v0.w) + (v1.x * v1.x + v1.y * v1.y) + (v1.z * v1.z + v1.w * v1.w);
                }
                s += __shfl_xor(s, 16); s += __shfl_xor(s, 32);
                if (fq == 0) ssq[(size_t)row * 16 + u.pn * 4 + wc] = s;
            }
    }
};
struct EpiUp {
    static constexpr bool PERM = true, AFTER_DRAIN = false;
    const float* __restrict__ ssq; bf16* __restrict__ up; float* __restrict__ pffn; float* __restrict__ sffn;
    __device__ __forceinline__ void operator()(const f32x4 (&acc)[2][2][4][2], const pg8::Unit& u, int wr, int wc, int fr, int fq) const {
#pragma unroll
        for (int ai = 0; ai < 2; ++ai)
#pragma unroll
            for (int m = 0; m < 4; ++m) {
                const int row = EPI_ROW(ai, m);
                const float rs = row_rs(ssq, row);
                const RowInfo ri = row_info(row);
                float* st = nullptr;
                if (ri.kind == 0 && ri.t >= TP - 2) st = pffn + ((size_t)ri.b * 2 + (ri.t - (TP - 2))) * DFF;
                else if (ri.kind == 1 && ri.t >= 2) st = sffn + ((size_t)ri.b * 2 + (ri.t - 2)) * DFF;
#pragma unroll
                for (int bj = 0; bj < 2; ++bj) {
                    const int col = EPI_COL(bj);
                    const f32x4 v0 = acc[ai][bj][m][0] * rs, v1 = acc[ai][bj][m][1] * rs;
                    u32x4 w; w.x = pk2(v0.x, v0.y); w.y = pk2(v0.z, v0.w); w.z = pk2(v1.x, v1.y); w.w = pk2(v1.z, v1.w);
                    *(u32x4*)(up + (size_t)row * DFF + col) = w;
                    if (st) { *(f32x4*)(st + col) = v0; *(f32x4*)(st + col + 4) = v1; }
                }
            }
    }
};
struct EpiGate {
    static constexpr bool PERM = true, AFTER_DRAIN = false;
    const float* ssq; const bf16* up; const float* stf; const float* cw; const float* cb; bf16* hid;
    __device__ __forceinline__ void operator()(const f32x4 (&acc)[2][2][4][2], const pg8::Unit& u, int wr, int wc, int fr, int fq) const {
#pragma unroll
        for (int ai = 0; ai < 2; ++ai)
#pragma unroll
            for (int m = 0; m < 4; ++m) {
                const int row = EPI_ROW(ai, m);
                const float rs = row_rs(ssq, row);
                const RowInfo ri = row_info(row);
                const int r1 = row_back(ri, row, 1), r2 = row_back(ri, row, 2);
#pragma unroll
                for (int bj = 0; bj < 2; ++bj) {
                    const int col = EPI_COL(bj);
                    float g[8], u0[8], p1[8], p2[8];
                    { const f32x4 v0 = acc[ai][bj][m][0] * rs, v1 = acc[ai][bj][m][1] * rs; g[0] = v0.x; g[1] = v0.y; g[2] = v0.z; g[3] = v0.w; g[4] = v1.x; g[5] = v1.y; g[6] = v1.z; g[7] = v1.w; }
                    unpack8(*(const u32x4*)(up + (size_t)row * DFF + col), u0);
                    if (r1 >= 0) unpack8(*(const u32x4*)(up + (size_t)r1 * DFF + col), p1);
                    else if (ri.kind == 1) { const float* s = stf + ((size_t)ri.b * 2 + (1 + ri.t)) * DFF + col; const f32x4 a = *(const f32x4*)s, b = *(const f32x4*)(s + 4);
                        p1[0] = a.x; p1[1] = a.y; p1[2] = a.z; p1[3] = a.w; p1[4] = b.x; p1[5] = b.y; p1[6] = b.z; p1[7] = b.w; }
                    else {
#pragma unroll
                        for (int i = 0; i < 8; ++i) p1[i] = 0.f; }
                    if (r2 >= 0) unpack8(*(const u32x4*)(up + (size_t)r2 * DFF + col), p2);
                    else if (ri.kind == 1) { const float* s = stf + ((size_t)ri.b * 2 + ri.t) * DFF + col; const f32x4 a = *(const f32x4*)s, b = *(const f32x4*)(s + 4);
                        p2[0] = a.x; p2[1] = a.y; p2[2] = a.z; p2[3] = a.w; p2[4] = b.x; p2[5] = b.y; p2[6] = b.z; p2[7] = b.w; }
                    else {
#pragma unroll
                        for (int i = 0; i < 8; ++i) p2[i] = 0.f; }
                    float o[8];
#pragma unroll
                    for (int h = 0; h < 2; ++h) {
                        const f32x4 w0 = *(const f32x4*)(cw + col + 4 * h), w1 = *(const f32x4*)(cw + DFF + col + 4 * h), w2 = *(const f32x4*)(cw + 2 * DFF + col + 4 * h), bb = *(const f32x4*)(cb + col + 4 * h);
#pragma unroll
                        for (int i = 0; i < 4; ++i) { const int e = 4 * h + i; const float c = bb[i] + w0[i] * p2[e] + w1[i] * p1[e] + w2[i] * u0[e]; o[e] = gelu_tanh(c) * g[e]; }
                    }
                    u32x4 w; w.x = pk2(o[0], o[1]); w.y = pk2(o[2], o[3]); w.z = pk2(o[4], o[5]); w.w = pk2(o[6], o[7]);
                    *(u32x4*)(hid + (size_t)row * DFF + col) = w;
                }
            }
    }
};
struct EpiDown {
    static constexpr bool PERM = true, AFTER_DRAIN = false;
    float* __restrict__ x; const bf16* __restrict__ x1b;
    __device__ __forceinline__ void operator()(const f32x4 (&acc)[2][2][4][2], const pg8::Unit& u, int wr, int wc, int fr, int fq) const {
        const bool part = u.nt != DFF / 64;
#pragma unroll
        for (int ai = 0; ai < 2; ++ai)
#pragma unroll
            for (int m = 0; m < 4; ++m) {
                const int row = EPI_ROW(ai, m);
#pragma unroll
                for (int bj = 0; bj < 2; ++bj) {
                    const int col = EPI_COL(bj);
                    float* p = x + (size_t)row * D + col;
                    if (part) {
#pragma unroll
                        for (int i = 0; i < 4; ++i) { unsafeAtomicAdd(p + i, acc[ai][bj][m][0][i]); unsafeAtomicAdd(p + 4 + i, acc[ai][bj][m][1][i]); }
                    } else {
                        float r8[8]; unpack8(*(const u32x4*)(x1b + (size_t)row * D + col), r8);
                        const f32x4 v0 = acc[ai][bj][m][0] + (f32x4){r8[0], r8[1], r8[2], r8[3]}, v1 = acc[ai][bj][m][1] + (f32x4){r8[4], r8[5], r8[6], r8[7]};
                        *(f32x4*)p = v0; *(f32x4*)(p + 4) = v1;
                    }
                }
            }
    }
};
struct DownOrder {
    pg8::StaticOrder base; int G, c;
    __device__ void init(int G_, int c_) { base.init(R_SAMPLE, D, G_, c_, DFF); G = G_; c = c_; }
    __device__ bool next(int i, pg8::Unit& u) const {
        const int nb = (256 - c + G - 1) / G;
        if (i < nb) return base.next(i, u);
        const int j = (i - nb) * G + c; if (j >= 48) return false;
        u.pm = 64 + j / 24; u.pn = (j / 6) % 4; u.ko = (j % 6) * 512; u.nt = 8; return true;
    }
    __device__ __forceinline__ void a_ready(const pg8::Unit&) const {}
    __device__ __forceinline__ void done(const pg8::Unit&) const {}
};
struct EpiStash {
    static constexpr bool PERM = true, AFTER_DRAIN = false;
    const float* __restrict__ ssq; bf16* __restrict__ hid;
    __device__ __forceinline__ void operator()(const f32x4 (&acc)[2][2][4][2], const pg8::Unit& u, int wr, int wc, int fr, int fq) const {
#pragma unroll
        for (int ai = 0; ai < 2; ++ai)
#pragma unroll
            for (int m = 0; m < 4; ++m) {
                const int row = EPI_ROW(ai, m);
                const float rs = row_rs(ssq, row);
#pragma unroll
                for (int bj = 0; bj < 2; ++bj) {
                    const int col = EPI_COL(bj);
                    const f32x4 v0 = acc[ai][bj][m][0] * rs, v1 = acc[ai][bj][m][1] * rs;
                    u32x4 w; w.x = pk2(v0.x, v0.y); w.y = pk2(v0.z, v0.w); w.z = pk2(v1.x, v1.y); w.w = pk2(v1.z, v1.w);
                    *(u32x4*)(hid + (size_t)row * DFF + col) = w;
                }
            }
    }
};
struct TailOrder {
    int G, c;
    __device__ bool next(int i, pg8::Unit& u) const {
        const int j = i * G + c - (G == 256 ? 36 : 0); if (j < 0 || j >= 24) return false;
        u.pm = 64 + j / 12; u.pn = j % 12; u.ko = 0; u.nt = D / 64; return true;
    }
    __device__ __forceinline__ void a_ready(const pg8::Unit&) const {}
    __device__ __forceinline__ void done(const pg8::Unit&) const {}
};
struct EpiPlain {
    static constexpr bool PERM = true, AFTER_DRAIN = false;
    bf16* O; int ldc;
    __device__ __forceinline__ void operator()(const f32x4 (&acc)[2][2][4][2], const pg8::Unit& u, int wr, int wc, int fr, int fq) const {
#pragma unroll
        for (int ai = 0; ai < 2; ++ai)
#pragma unroll
            for (int m = 0; m < 4; ++m) {
                const int row = EPI_ROW(ai, m);
#pragma unroll
                for (int bj = 0; bj < 2; ++bj) {
                    const int col = EPI_COL(bj);
                    const f32x4 v0 = acc[ai][bj][m][0], v1 = acc[ai][bj][m][1];
                    u32x4 w; w.x = pk2(v0.x, v0.y); w.y = pk2(v0.z, v0.w); w.z = pk2(v1.x, v1.y); w.w = pk2(v1.z, v1.w);
                    *(u32x4*)(O + (size_t)row * ldc + col) = w;
                }
            }
    }
};

#define XB_TMO      128
#define XB_XCNT(j)  (256  + 64 * (j))
#define XB_XSUB(j)  (1280 + 64 * (j))
#define XB_XGEN(j)  (2304 + 64 * (j))
#define XB_TOP      3328
#define XB_TOPGEN   3392
#define XCD_BAR_WORDS 3456
#define XB_SPIN_CAP (1u << 22)
__device__ __forceinline__ unsigned xb_ld(unsigned* p)              { return __hip_atomic_load(p, __ATOMIC_RELAXED, __HIP_MEMORY_SCOPE_AGENT); }
__device__ __forceinline__ unsigned xb_add(unsigned* p, unsigned v) { return __hip_atomic_fetch_add(p, v, __ATOMIC_RELAXED, __HIP_MEMORY_SCOPE_AGENT); }
__device__ __forceinline__ unsigned xb_xcc_id() { return (unsigned)__builtin_amdgcn_s_getreg((3 << 11) | 20) & 0xFu; }
#define XB_SPIN(cond, bar) do { unsigned _sp = 0; while (cond) { __builtin_amdgcn_s_sleep(1); \
    if ((++_sp & 255u) == 0u) { if (xb_ld(&(bar)[XB_TMO])) break; if (_sp > XB_SPIN_CAP) { atomicAdd(&(bar)[XB_TMO], 1u); break; } } } } while (0)
struct XcdBarrier { unsigned* bar; unsigned x; volatile LAS unsigned* st; };
__device__ __forceinline__ XcdBarrier xcd_barrier_post(unsigned* bar, volatile LAS unsigned* st) {
    XcdBarrier b; b.bar = bar; b.x = xb_xcc_id(); b.st = st;
    if (threadIdx.x == 0) (void)xb_add(&bar[XB_XCNT(b.x)], 1u);
    return b;
}
__device__ __forceinline__ void xcd_barrier_complete(unsigned* bar, unsigned x, unsigned& nloc, unsigned& nx) {
    const unsigned G = gridDim.x * gridDim.y * gridDim.z;
    unsigned sum, cnt, mine, sp = 0u;
    for (;;) {
        sum = 0u; cnt = 0u; mine = 0u;
#pragma unroll
        for (unsigned j = 0; j < 16; ++j) { const unsigned c = xb_ld(&bar[XB_XCNT(j)]); sum += c; cnt += (c > 0u) ? 1u : 0u; mine = (j == x) ? c : mine; }
        if (sum == G) break;
        __builtin_amdgcn_s_sleep(1);
        if ((++sp & 255u) == 0u) { if (xb_ld(&bar[XB_TMO])) break; if (sp > XB_SPIN_CAP) { atomicAdd(&bar[XB_TMO], 1u); break; } }
    }
    nloc = mine > 0u ? mine : 1u; nx = cnt > 0u ? cnt : 1u;
}
__device__ __forceinline__ void xcd_barrier(const XcdBarrier& b) {
    asm volatile("s_waitcnt vmcnt(0)" ::: "memory");
    __syncthreads();
    if (threadIdx.x == 0) {
        unsigned* bar = b.bar;
        __builtin_amdgcn_s_waitcnt(0);
        unsigned nloc = b.st[0], nx = b.st[1];
        if (nloc == 0u) { xcd_barrier_complete(bar, b.x, nloc, nx); b.st[0] = nloc; b.st[1] = nx; }
        const unsigned old = xb_add(&bar[XB_XSUB(b.x)], 1u);
        const unsigned gen = old / nloc;
        if (old + 1u == (gen + 1u) * nloc) {
            __builtin_amdgcn_fence(__ATOMIC_RELEASE, "agent");
            asm volatile("s_waitcnt vmcnt(0)" ::: "memory");
            const unsigned og = xb_add(&bar[XB_TOP], 1u);
            const unsigned tg = og / nx;
            if (og + 1u == (tg + 1u) * nx) xb_add(&bar[XB_TOPGEN], 1u);
            else XB_SPIN(xb_ld(&bar[XB_TOPGEN]) == tg, bar);
            __builtin_amdgcn_fence(__ATOMIC_ACQUIRE, "agent");
            xb_add(&bar[XB_XGEN(b.x)], 1u);
            asm volatile("s_waitcnt vmcnt(0)" ::: "memory");
        } else {
            XB_SPIN(xb_ld(&bar[XB_XGEN(b.x)]) == gen, bar);
            __builtin_amdgcn_fence(__ATOMIC_ACQUIRE, "agent");
            asm volatile("s_waitcnt vmcnt(0)" ::: "memory");
        }
    }
    __syncthreads();
}

__device__ __forceinline__ void p0_transpose_item(const float* W, int K, int N, bf16* WT, const float* ksc, LAS float* scr, int item, int lane) {
    const int nblk = N / 32, kb = item / nblk, nb = item % nblk, k0 = 64 * kb, n0 = 32 * nb;
#pragma unroll
    for (int i = 0; i < 32; ++i) { const int kk = 2 * i + (lane >> 5); float v = W[(size_t)(k0 + kk) * N + n0 + (lane & 31)]; if (ksc) v *= ksc[k0 + kk]; scr[kk * 33 + (lane & 31)] = v; }
    asm volatile("s_waitcnt lgkmcnt(0)" ::: "memory");
    const int c = lane & 7;
#pragma unroll
    for (int j = 0; j < 4; ++j) { const int n = (lane >> 3) + 8 * j; const LAS float* s = scr + (8 * c) * 33 + n;
        u32x4 o; o.x = pk2(s[0 * 33], s[1 * 33]); o.y = pk2(s[2 * 33], s[3 * 33]); o.z = pk2(s[4 * 33], s[5 * 33]); o.w = pk2(s[6 * 33], s[7 * 33]);
        *(u32x4*)(WT + (size_t)(n0 + n) * K + k0 + 8 * c) = o; }
    asm volatile("s_waitcnt lgkmcnt(0)" ::: "memory");
}
__device__ __forceinline__ void ffn_weight_transposes(const Args& A, LAS unsigned char* lds, int gw, int NGW) {
    const int lane = my_tid() & 63, wave = (my_tid() >> 6);
    LAS float* scr = (LAS float*)(lds + wave * 16384);
    unsigned char* ws = A.ws;
    constexpr int I_UPI = 16 * 96, I_DN = 48 * 32;
    for (int it = gw; it < 2 * I_UPI + I_DN; it += NGW) {
        int r = it;
        if (r < I_UPI) { p0_transpose_item(A.in[I_FUP], D, DFF, (bf16*)(ws + WS_WUP), A.in[I_N2G], scr, r, lane); continue; } r -= I_UPI;
        if (r < I_UPI) { p0_transpose_item(A.in[I_FGATE], D, DFF, (bf16*)(ws + WS_WGATE), A.in[I_N2G], scr, r, lane); continue; } r -= I_UPI;
        p0_transpose_item(A.in[I_FDOWN], DFF, D, (bf16*)(ws + WS_WDOWN), nullptr, scr, r, lane);
    }
}
__device__ __forceinline__ void phase_p0(const Args& A, LAS unsigned char* lds, int G) {
    const int tid = my_tid(), lane = tid & 63, wave = tid >> 6;
    LAS float* scr = (LAS float*)(lds + wave * 16384);
    const int gw = blockIdx.x * 8 + wave, NGW = G * 8;
    unsigned char* ws = A.ws;
    constexpr int I_IN = 16 * 88, I_OUT = 16 * 32;
    for (int it = gw; it < I_IN + I_OUT; it += NGW) {
        if (it < I_IN) p0_transpose_item(A.in[I_WIN], D, DIN, (bf16*)(ws + WS_WIN), nullptr, scr, it, lane);
        else p0_transpose_item(A.in[I_WOUT], D, D, (bf16*)((unsigned char*)A.out + DO_WOUT), nullptr, scr, it - I_IN, lane);
    }
    if (G <= 12) ffn_weight_transposes(A, lds, gw, NGW);
    const int gt = blockIdx.x * 512 + tid, NGT = G * 512;
    { bf16* BA = (bf16*)(ws + WS_BA); const float* wup = A.in[I_WUP]; const float* aup = A.in[I_AUP]; const float* gup = A.in[I_GUP];
      for (int e = gt; e < 1536 * 256; e += NGT) { const int n = e >> 8, k = e & 255; float v = 0.f;
          if (n < 512) { if (k < 64) v = wup[k * 512 + n]; }
          else if (n < 1024) { if (k >= 64 && k < 128) v = aup[(k - 64) * 512 + n - 512]; }
          else { if (k >= 128) v = gup[(k - 128) * 512 + n - 1024]; }
          BA[e] = (bf16)f2bf(v); } }
    { bf16* BB = (bf16*)(ws + WS_BB); const float* wa = A.in[I_LWA]; const float* wx = A.in[I_LWX];
      for (int e = gt; e < 1024 * 512; e += NGT) { const int n = e >> 9, k = e & 511, nn = n & 511, h = nn >> 6, j = nn & 63; float v = 0.f;
          if ((k >> 6) == h) { const float* Wm = n < 512 ? wa : wx; v = Wm[(h * 64 + (k & 63)) * 64 + j]; }
          BB[e] = (bf16)f2bf(v); } }
    bf16* XN = (bf16*)(ws + WS_XN); const float* g1 = A.in[I_N1G];
    f32x4 gv[4];
#pragma unroll
    for (int j = 0; j < 4; ++j) gv[j] = ((const f32x4*)g1)[lane + 64 * j];
#pragma unroll 2
    for (int row = gw; row < MP; row += NGW) {
        const float* src = row < R_SAMPLE ? A.in[I_XP] + (size_t)row * D : row < R_META ? A.in[I_XS] + (size_t)(row - R_SAMPLE) * D : row < R_END ? A.in[I_META] + (size_t)(row - R_META) * D : nullptr;
        u32x2* o = (u32x2*)(XN + (size_t)row * D);
        if (!src) {
#pragma unroll
            for (int j = 0; j < 4; ++j) o[lane + 64 * j] = (u32x2){0u, 0u};
            continue; }
        f32x4 v[4]; float s = 0.f;
#pragma unroll
        for (int j = 0; j < 4; ++j) { v[j] = ((const f32x4*)src)[lane + 64 * j]; s += (v[j].x * v[j].x + v[j].y * v[j].y) + (v[j].z * v[j].z + v[j].w * v[j].w); }
        const float rs = __builtin_amdgcn_rsqf(wave_sum(s) * (1.f / D) + EPS);
#pragma unroll
        for (int j = 0; j < 4; ++j) { const f32x4 g = gv[j];
            o[lane + 64 * j] = (u32x2){pk2(v[j].x * rs * g.x, v[j].y * rs * g.y), pk2(v[j].z * rs * g.z, v[j].w * rs * g.w)}; }
    }
}

__device__ __forceinline__ void phase_e1(const Args& A, int G) {
    const int tid = my_tid(), lane = tid & 63, wave = tid >> 6;
    const int gw = blockIdx.x * 8 + wave, NGW = G * 8;
    unsigned char* ws = A.ws;
    const bf16* __restrict__ U = (const bf16*)(ws + WS_U); bf16* __restrict__ AP = (bf16*)(ws + WS_AP); bf16* __restrict__ XC = (bf16*)(ws + WS_XC);
    const float* mu = A.in[I_MU]; const float* sts = A.in[I_STS]; const float* slc = A.in[I_SLC]; const float* lcw = A.in[I_LCW]; const float* lcb = A.in[I_LCB];
#pragma unroll 4
    for (int row = gw; row < MP; row += NGW) {
        bf16* ap = AP + (size_t)row * 256; bf16* xc = XC + (size_t)row * 512;
        const RowInfo ri = row_info(row);
        if (ri.kind == 3) { ((u32x2*)ap)[lane] = (u32x2){0u, 0u}; ((u32x4*)xc)[lane] = (u32x4){0u, 0u, 0u, 0u}; continue; }
        const bf16* urow = U + (size_t)row * DIN;
        const int r1 = row_back(ri, row, 1);
        {
            const int c0 = 1536 + 4 * lane;
            const u32x2 uw = *(const u32x2*)(urow + c0);
            float u[4] = {lo16(uw.x), hi16(uw.x), lo16(uw.y), hi16(uw.y)}, p[4];
            if (r1 >= 0) { const u32x2 pw = *(const u32x2*)(U + (size_t)r1 * DIN + c0); p[0] = lo16(pw.x); p[1] = hi16(pw.x); p[2] = lo16(pw.y); p[3] = hi16(pw.y); }
            else if (ri.kind == 1) { const f32x4 pv = *(const f32x4*)(sts + (size_t)ri.b * DTMP + c0); p[0] = pv.x; p[1] = pv.y; p[2] = pv.z; p[3] = pv.w; }
            else { p[0] = p[1] = p[2] = p[3] = 0.f; }
            const f32x4 m4 = *(const f32x4*)(mu + c0);
            float o[4];
#pragma unroll
            for (int i = 0; i < 4; ++i) { const float um = u[i] + (p[i] - u[i]) * m4[i]; o[i] = lane < 16 ? tanh_(um) : lane < 32 ? um : sigm(um); }
            ((u32x2*)ap)[lane] = (u32x2){pk2(o[0], o[1]), pk2(o[2], o[3])};
        }
        {
            const int c = 8 * lane;
            float acc[8], cur[8];
            { const f32x4 b0 = *(const f32x4*)(lcb + c), b1 = *(const f32x4*)(lcb + c + 4); acc[0] = b0.x; acc[1] = b0.y; acc[2] = b0.z; acc[3] = b0.w; acc[4] = b1.x; acc[5] = b1.y; acc[6] = b1.z; acc[7] = b1.w; }
#pragma unroll
            for (int j = 0; j < 4; ++j) {
                float val[8];
                const int rj = (j == 3) ? row : row_back(ri, row, 3 - j);
                if (rj >= 0) unpack8(*(const u32x4*)(U + (size_t)rj * DIN + DTMP + c), val);
                else if (ri.kind == 1) { const float* s = slc + ((size_t)ri.b * 3 + (ri.t + j)) * 512 + c; const f32x4 a = *(const f32x4*)s, b = *(const f32x4*)(s + 4);
                    val[0] = a.x; val[1] = a.y; val[2] = a.z; val[3] = a.w; val[4] = b.x; val[5] = b.y; val[6] = b.z; val[7] = b.w; }
                else {
#pragma unroll
                    for (int i = 0; i < 8; ++i) val[i] = 0.f; }
                const f32x4 w0 = *(const f32x4*)(lcw + j * 512 + c), w1 = *(const f32x4*)(lcw + j * 512 + c + 4);
#pragma unroll
                for (int i = 0; i < 4; ++i) { acc[i] += w0[i] * val[i]; acc[4 + i] += w1[i] * val[4 + i]; }
                if (j == 3) {
#pragma unroll
                    for (int i = 0; i < 8; ++i) cur[i] = val[i]; }
            }
            u32x4 w; w.x = pk2(acc[0], acc[1]); w.y = pk2(acc[2], acc[3]); w.z = pk2(acc[4], acc[5]); w.w = pk2(acc[6], acc[7]);
            ((u32x4*)xc)[lane] = w;
            float* lco = nullptr;
            if (ri.kind == 0 && ri.t >= TP - 3) lco = A.out + O_PLC + ((size_t)ri.b * 3 + (ri.t - (TP - 3))) * 512 + c;
            else if (ri.kind == 1 && ri.t >= 1) lco = A.out + O_SLC + ((size_t)ri.b * 3 + (ri.t - 1)) * 512 + c;
            if (lco) { *(f32x4*)lco = (f32x4){cur[0], cur[1], cur[2], cur[3]}; *(f32x4*)(lco + 4) = (f32x4){cur[4], cur[5], cur[6], cur[7]}; }
        }
        float* sho = nullptr;
        if (ri.kind == 0 && ri.t == TP - 1) sho = A.out + O_PSHIFT + (size_t)ri.b * DTMP;
        else if (ri.kind == 1 && ri.t == DS - 1) sho = A.out + O_SSHIFT + (size_t)ri.b * DTMP;
        if (sho) for (int i = lane; i < DTMP; i += 64) sho[i] = bf2f(urow[i]);
    }
}

__device__ __forceinline__ float sum8(float x) { x += dpp_f<0xB1>(x); x += dpp_f<0x4E>(x); x += dpp_f<0x141>(x); return x; }
__device__ __forceinline__ void phase_e2(const Args& A, int G) {
    const int tid = my_tid(), lane = tid & 63, wave = tid >> 6;
    unsigned char* ws = A.ws;
    const bf16* __restrict__ U = (const bf16*)(ws + WS_U); const bf16* __restrict__ GB = (const bf16*)(ws + WS_GB); const bf16* __restrict__ GA = (const bf16*)((unsigned char*)A.out + DO_GA);
    bf16* __restrict__ REC = (bf16*)(ws + WS_REC); bf16* __restrict__ LRU = (bf16*)(ws + WS_LRU);
    float* __restrict__ LTOT = (float*)((unsigned char*)A.out + DO_LTOT); float* __restrict__ BON = (float*)((unsigned char*)A.out + DO_BON);
    const float* mu = A.in[I_MU]; const float* sts = A.in[I_STS]; const float* slc = A.in[I_SLC]; const float* slh = A.in[I_SLH];
    for (int unit = blockIdx.x; unit < 513 + DB; unit += G) {
        int row0, ntok, kind;
        if (unit < 512) { row0 = unit * 32; ntok = 32; kind = 0; } else if (unit == 512) { row0 = R_META; ntok = 16; kind = 2; } else { row0 = R_SAMPLE + (unit - 513) * 4; ntok = 4; kind = 1; }
        const int c = tid;
        const float sp = softplus_(-A.in[I_LAM][c]);
        const float cw0 = A.in[I_LCW][c], cw1 = A.in[I_LCW][512 + c], cw2 = A.in[I_LCW][1024 + c], cw3 = A.in[I_LCW][1536 + c], cbias = A.in[I_LCB][c];
        const float ba_ = A.in[I_LBA][c], bx_ = A.in[I_LBX][c];
        float l1 = 0.f, l2 = 0.f, l3 = 0.f, H = 0.f, P = 1.f;
        if (kind == 0) { const RowInfo ri0 = row_info(row0);
            l1 = bf2f(U[(size_t)row_back(ri0, row0, 1) * DIN + DTMP + c]); l2 = bf2f(U[(size_t)row_back(ri0, row0, 2) * DIN + DTMP + c]); l3 = bf2f(U[(size_t)row_back(ri0, row0, 3) * DIN + DTMP + c]); }
        else if (kind == 1) { const int b = unit - 513; l3 = slc[((size_t)b * 3 + 0) * 512 + c]; l2 = slc[((size_t)b * 3 + 1) * 512 + c]; l1 = slc[((size_t)b * 3 + 2) * 512 + c]; H = slh[(size_t)b * 512 + c]; }
#pragma unroll 4
        for (int j = 0; j < ntok; ++j) {
            const int row = row0 + j;
            const float l0 = bf2f(U[(size_t)row * DIN + DTMP + c]);
            const float xc = cbias + cw0 * l3 + cw1 * l2 + cw2 * l1 + cw3 * l0;
            l3 = l2; l2 = l1; l1 = l0;
            const float ra = bf2f(GB[(size_t)row * 1024 + c]) + ba_, ix = bf2f(GB[(size_t)row * 1024 + 512 + c]) + bx_;
            const float rg = sigm(ra), ig = sigm(ix);
            const float la = -8.f * rg * sp, a = __builtin_amdgcn_exp2f(1.4426950409f * la);
            float mult = __builtin_amdgcn_sqrtf(fmaxf(1.f - __builtin_amdgcn_exp2f(2.8853900818f * la), 0.f)); if (kind == 2 && j == 0) mult = 1.f;
            H = a * H + xc * ig * mult; P = P * a;
            LRU[(size_t)row * 1024 + c] = (bf16)f2bf(H); LRU[(size_t)row * 1024 + 512 + c] = (bf16)f2bf(kind == 1 ? 0.f : P);
        }
        if (kind == 1) A.out[O_SLH + (size_t)(unit - 513) * 512 + c] = H;
        else { LTOT[((size_t)unit * 2 + 0) * 512 + c] = P; LTOT[((size_t)unit * 2 + 1) * 512 + c] = H; }
    }
    {
        const int c = 8 * lane, h = lane >> 3, gw = blockIdx.x * 8 + wave, NGW = G * 8;
        float mr[8], mk[8], w0[8], a0[8], kkw[8], kaw[8], rkw[8];
        ld8f(mu + c, mr); ld8f(mu + 512 + c, mk); ld8f(A.in[I_W0] + c, w0); ld8f(A.in[I_A0] + c, a0); ld8f(A.in[I_KK] + c, kkw); ld8f(A.in[I_KA] + c, kaw); ld8f(A.in[I_RK] + c, rkw);
#pragma unroll 2
        for (int row = gw; row < R_END; row += NGW) {
            const RowInfo ri = row_info(row); const int r1 = row_back(ri, row, 1);
            const bf16* ur = U + (size_t)row * DIN;
            float u_r[8], u_k[8], p_r[8], p_k[8], wp[8], ap[8];
            unpack8(*(const u32x4*)(ur + c), u_r); unpack8(*(const u32x4*)(ur + 512 + c), u_k);
            unpack8(*(const u32x4*)(GA + (size_t)row * 1536 + c), wp); unpack8(*(const u32x4*)(GA + (size_t)row * 1536 + 512 + c), ap);
            if (r1 >= 0) { unpack8(*(const u32x4*)(U + (size_t)r1 * DIN + c), p_r); unpack8(*(const u32x4*)(U + (size_t)r1 * DIN + 512 + c), p_k); }
            else if (ri.kind == 1) { ld8f(sts + (size_t)ri.b * DTMP + c, p_r); ld8f(sts + (size_t)ri.b * DTMP + 512 + c, p_k); }
            else {
#pragma unroll
                for (int i = 0; i < 8; ++i) { p_r[i] = 0.f; p_k[i] = 0.f; } }
            float av[8], xv[8], kk[8], kp[8], ss = 0.f, bs = 0.f;
#pragma unroll
            for (int i = 0; i < 8; ++i) {
                const float um_r = u_r[i] + (p_r[i] - u_r[i]) * mr[i], um_k = u_k[i] + (p_k[i] - u_k[i]) * mk[i];
                const float z = -(wp[i] + w0[i]);
                const float w_log = -(fmaxf(z, 0.f) + __logf(1.f + __expf(-fabsf(z)))) - 0.5f;
                const float e = __builtin_amdgcn_exp2f(1.4426950409f * w_log); xv[i] = 1.f - __builtin_amdgcn_exp2f(-1.4426950409f * e);
                av[i] = sigm(ap[i] + a0[i]);
                kk[i] = um_k * kkw[i]; ss += kk[i] * kk[i];
                kp[i] = um_k * (1.f + (av[i] - 1.f) * kaw[i]);
                bs += um_r * kp[i] * rkw[i];
            }
            ss = sum8(ss); bs = sum8(bs);
            const float rn = __builtin_amdgcn_rsqf(fmaxf(ss, 1e-24f));
#pragma unroll
            for (int i = 0; i < 8; ++i) kk[i] *= rn;
            bf16* rec = REC + ((size_t)row * 8 + h) * 256 + (lane & 7) * 8;
            *(u32x4*)rec = pack8(av); *(u32x4*)(rec + 64) = pack8(xv); *(u32x4*)(rec + 128) = pack8(kk); *(u32x4*)(rec + 192) = pack8(kp);
            if ((lane & 7) == 0) BON[(size_t)row * 8 + h] = bs;
        }
    }
}

struct Raw { bf16 a, x, kk, kp, ur, uv, pr, pv; };
__device__ __forceinline__ void m2_load(Raw (&raw)[8], const bf16* REC, const bf16* U, int b, int h, int t0, int ns, int k, int sub) {
#pragma unroll
    for (int i = 0; i < 8; ++i) {
        const int s = sub + 4 * i;
        raw[i].a = 0; raw[i].x = 0; raw[i].kk = 0; raw[i].kp = 0; raw[i].ur = 0; raw[i].uv = 0; raw[i].pr = 0; raw[i].pv = 0;
        if (s < ns) {
            const int t = t0 + s, row = prompt_row(b, t);
            const bf16* rec = REC + ((size_t)row * 8 + h) * 256;
            raw[i].a = rec[k]; raw[i].x = rec[64 + k]; raw[i].kk = rec[128 + k]; raw[i].kp = rec[192 + k];
            const bf16* ur = U + (size_t)row * DIN + h * 64 + k; raw[i].ur = ur[0]; raw[i].uv = ur[1024];
            if (t > 0) { const bf16* pr = U + (size_t)prompt_row(b, t - 1) * DIN + h * 64 + k; raw[i].pr = pr[0]; raw[i].pv = pr[1024]; }
        }
    }
}
__device__ __forceinline__ void m2_store(const Raw (&raw)[8], LAS float* buf, float mu_r, float mu_v, int k, int sub, int ns) {
#pragma unroll
    for (int i = 0; i < 8; ++i) {
        const int s = sub + 4 * i;
        if (s < ns) {
            LAS float* p = buf + s * 384;
            const float a = bf2f(raw[i].a), kk = bf2f(raw[i].kk), ur = bf2f(raw[i].ur), uv = bf2f(raw[i].uv);
            p[k] = kk; p[64 + k] = 1.f - bf2f(raw[i].x); p[128 + k] = -(kk * a); p[192 + k] = bf2f(raw[i].kp);
            p[256 + k] = ur + (bf2f(raw[i].pr) - ur) * mu_r; p[320 + k] = uv + (bf2f(raw[i].pv) - uv) * mu_v;
        }
    }
}
typedef float f32x2 __attribute__((ext_vector_type(2)));
struct StepOps { f32x4 kk, dd, nka, kp, r; float v; };
__device__ __forceinline__ void ops_load(StepOps& o, const LAS float* p, int ks, int vrow) {
    o.kk = *(const LAS f32x4*)(p + 4 * ks); o.dd = *(const LAS f32x4*)(p + 64 + 4 * ks); o.nka = *(const LAS f32x4*)(p + 128 + 4 * ks);
    o.kp = *(const LAS f32x4*)(p + 192 + 4 * ks); o.r = *(const LAS f32x4*)(p + 256 + 4 * ks); o.v = p[320 + vrow];
}
__device__ __forceinline__ float dot4(const f32x4 a, const f32x4 b) { f32x2 t = a.xy * b.xy; t = a.zw * b.zw + t; return t.x + t.y; }
__device__ __forceinline__ void scan_step2(f32x4& S, const StepOps& o, float& yp) {
    float d = dot4(S, o.kk);
    d += dpp_f<0xB1>(d); yp += dpp_f<0xB1>(yp); d += dpp_f<0x4E>(d); yp += dpp_f<0x4E>(yp);
    d += dpp_f<0x141>(d); yp += dpp_f<0x141>(yp); d += dpp_f<0x140>(d); yp += dpp_f<0x140>(yp);
    S = S * o.dd + d * o.nka + o.v * o.kp;
}
__device__ __forceinline__ float scan_step(f32x4& S, const StepOps& o) {
    float d = dot4(S, o.kk); d = allsum16(d);
    S = S * o.dd + d * o.nka + o.v * o.kp;
    float y = dot4(S, o.r); return allsum16(y);
}
__device__ __forceinline__ void sample_load(int task, int rl, int ks, f32x4& S, StepOps (&o)[DS], const bf16* __restrict__ REC, const bf16* __restrict__ U, const float* __restrict__ swkv, const float* __restrict__ sts, const float* __restrict__ mu) {
    const int bh = task >> 4, rg = task & 15, b = bh >> 3, h = bh & 7, v = 4 * rg + rl;
    S = *(const f32x4*)(swkv + ((size_t)bh * 64 + v) * 64 + 4 * ks);
    const f32x4 mr4 = *(const f32x4*)(mu + h * 64 + 4 * ks); const float mv = mu[1024 + h * 64 + v];
#pragma unroll
    for (int t = 0; t < DS; ++t) {
        const int row = R_SAMPLE + 4 * b + t;
        const bf16* rec = REC + ((size_t)row * 8 + h) * 256 + 4 * ks;
        const u32x2 wa = *(const u32x2*)rec, wx = *(const u32x2*)(rec + 64), wk = *(const u32x2*)(rec + 128), wp = *(const u32x2*)(rec + 192);
        const f32x4 a4 = (f32x4){lo16(wa.x), hi16(wa.x), lo16(wa.y), hi16(wa.y)};
        o[t].dd = 1.f - (f32x4){lo16(wx.x), hi16(wx.x), lo16(wx.y), hi16(wx.y)};
        o[t].kk = (f32x4){lo16(wk.x), hi16(wk.x), lo16(wk.y), hi16(wk.y)}; o[t].kp = (f32x4){lo16(wp.x), hi16(wp.x), lo16(wp.y), hi16(wp.y)};
        const u32x2 wr_ = *(const u32x2*)(U + (size_t)row * DIN + h * 64 + 4 * ks);
        const f32x4 ur4 = (f32x4){lo16(wr_.x), hi16(wr_.x), lo16(wr_.y), hi16(wr_.y)};
        const float uv = bf2f(U[(size_t)row * DIN + 1024 + h * 64 + v]);
        f32x4 pr4; float pv;
        if (t > 0) { const u32x2 w = *(const u32x2*)(U + (size_t)(row - 1) * DIN + h * 64 + 4 * ks); pr4 = (f32x4){lo16(w.x), hi16(w.x), lo16(w.y), hi16(w.y)}; pv = bf2f(U[(size_t)(row - 1) * DIN + 1024 + h * 64 + v]); }
        else { pr4 = *(const f32x4*)(sts + (size_t)b * DTMP + h * 64 + 4 * ks); pv = sts[(size_t)b * DTMP + 1024 + h * 64 + v]; }
        o[t].r = ur4 + (pr4 - ur4) * mr4; o[t].v = uv + (pv - uv) * mv; o[t].nka = -(o[t].kk * a4);
    }
}
__device__ __forceinline__ void sample_finish(int task, int rl, int ks, f32x4 S, const StepOps (&o)[DS], float* __restrict__ Y, float* __restrict__ out) {
    const int bh = task >> 4, rg = task & 15, b = bh >> 3, h = bh & 7, v = 4 * rg + rl;
#pragma unroll
    for (int t = 0; t < DS; ++t) { const float y = scan_step(S, o[t]); if (ks == 0) Y[(size_t)(R_SAMPLE + 4 * b + t) * 512 + h * 64 + v] = y; }
    *(f32x4*)(out + O_SWKV + ((size_t)bh * 64 + v) * 64 + 4 * ks) = S;
}
__device__ __forceinline__ void phase_m2(const Args& A, LAS unsigned char* lds, int G) {
    const int tid = my_tid(), lane = tid & 63, wave = tid >> 6;
    unsigned char* ws = A.ws;
    const bf16* __restrict__ U = (const bf16*)(ws + WS_U); const bf16* __restrict__ REC = (const bf16*)(ws + WS_REC); float* __restrict__ Y = (float*)(ws + WS_Y);
    const float* LTOT = (const float*)((unsigned char*)A.out + DO_LTOT); float* CARRY = (float*)((unsigned char*)A.out + DO_CARRY);
    const float* mu = A.in[I_MU];
    for (int b = blockIdx.x; b < NB; b += G) {
        const int c = tid; float carry = LTOT[((size_t)512 * 2 + 1) * 512 + c];
        float Pv[64], Hv[64];
#pragma unroll
        for (int i = 0; i < 64; ++i) { const int un = b * 64 + i; Pv[i] = LTOT[((size_t)un * 2 + 0) * 512 + c]; Hv[i] = LTOT[((size_t)un * 2 + 1) * 512 + c]; }
#pragma unroll
        for (int i = 0; i < 64; ++i) { CARRY[((size_t)b * 64 + i) * 512 + c] = carry; carry = Pv[i] * carry + Hv[i]; }
        A.out[O_PLH + (size_t)b * 512 + c] = carry;
    }
    const int ks = lane & 15, rl = lane >> 4;
    for (int item = blockIdx.x; item < 256; item += G) {
        const int bh = item >> 2, q = item & 3, b = bh >> 3, h = bh & 7;
        int k = tid & 63, sub = (tid >> 6) & 3;
        asm volatile("" : "+v"(k), "+v"(sub));
        const float mu_r = mu[h * 64 + k], mu_v = mu[1024 + h * 64 + k];
        const int wv = wave & 3, vrow = 16 * q + 4 * wv + rl;
        f32x4 S = (f32x4){0.f, 0.f, 0.f, 0.f};
        const bool first_item = item == (int)blockIdx.x;
        Raw raw[8];
        LAS float* buf0 = (LAS float*)lds; LAS float* buf1 = (LAS float*)(lds + 50688); LAS float* ybuf = (LAS float*)(lds + 101376) + wv * 132;
        __syncthreads();
        if (wave >= 4) { m2_load(raw, REC, U, b, h, 0, 16, k, sub); m2_store(raw, buf0, mu_r, mu_v, k, sub, 16); m2_load(raw, REC, U, b, h, 16, 32, k, sub); }
        __syncthreads();
        for (int blk = 0; blk < 65; ++blk) {
            const int t0 = blk == 0 ? 0 : 16 + 32 * (blk - 1), ns = blk == 0 ? 16 : 32;
            if (wave >= 4) {
                const int jt = blk >> 2; int task = (int)blockIdx.x * 4 + (wave - 4) + G * 4 * jt;
                asm volatile("" : "+v"(task));
                const bool do_task = first_item && (blk & 3) == 0 && jt < 16 && task < DB * NH * 16;
                f32x4 Sc; StepOps oc[DS];
                if (do_task) sample_load(task, rl, ks, Sc, oc, REC, U, A.in[I_SWKV], A.in[I_STS], mu);
                if (blk + 1 < 65) m2_store(raw, (blk & 1) ? buf0 : buf1, mu_r, mu_v, k, sub, 32);
                if (blk + 2 < 65) m2_load(raw, REC, U, b, h, 16 + 32 * (blk + 1), 32, k, sub);
                if (do_task) sample_finish(task, rl, ks, Sc, oc, Y, A.out);
            } else {
                const LAS float* buf = (blk & 1) ? buf1 : buf0;
                StepOps oa, ob; ops_load(oa, buf, ks, vrow);
                float yp = 0.f;
                for (int s = 0; s < ns; s += 2) {
                    ops_load(ob, buf + (s + 1) * 384, ks, vrow);
                    scan_step2(S, oa, yp); ybuf[s * 4 + rl] = yp; yp = dot4(S, oa.r);
                    ops_load(oa, buf + (s + 2) * 384, ks, vrow);
                    scan_step2(S, ob, yp); ybuf[(s + 1) * 4 + rl] = yp; yp = dot4(S, ob.r);
                }
                yp = allsum16(yp); ybuf[ns * 4 + rl] = yp;
                if (ks < ns) Y[(size_t)prompt_row(b, t0 + ks) * 512 + h * 64 + vrow] = ybuf[(ks + 1) * 4 + rl];
                if (ks + 16 < ns) Y[(size_t)prompt_row(b, t0 + ks + 16) * 512 + h * 64 + vrow] = ybuf[(ks + 17) * 4 + rl];
            }
            __syncthreads();
        }
        if (wave < 4) *(f32x4*)(A.out + O_PWKV + ((size_t)(b * 8 + h) * 64 + vrow) * 64 + 4 * ks) = S;
    }
    for (int task = G * 4 * 16 + blockIdx.x * 8 + wave; task < DB * NH * 16; task += G * 8) {
        f32x4 Sc; StepOps oc[DS];
        sample_load(task, rl, ks, Sc, oc, REC, U, A.in[I_SWKV], A.in[I_STS], mu);
        sample_finish(task, rl, ks, Sc, oc, Y, A.out);
    }
}

__device__ __forceinline__ void phase_m3(const Args& A, int G) {
    const int tid = my_tid(), lane = tid & 63, wave = tid >> 6;
    const int gw = blockIdx.x * 8 + wave, NGW = G * 8;
    unsigned char* ws = A.ws;
    const bf16* __restrict__ U = (const bf16*)(ws + WS_U); const bf16* __restrict__ GA = (const bf16*)((unsigned char*)A.out + DO_GA); const bf16* __restrict__ LRU = (const bf16*)(ws + WS_LRU);
    const float* __restrict__ Y = (const float*)(ws + WS_Y); const float* __restrict__ CARRY = (const float*)((unsigned char*)A.out + DO_CARRY); const float* __restrict__ BON = (const float*)((unsigned char*)A.out + DO_BON);
    bf16* __restrict__ MIX = (bf16*)(ws + WS_MIX);
    const float* sts = A.in[I_STS];
    const int c = 8 * lane, h = lane >> 3;
    float mv[8], gg[8], gb[8], og[8];
    ld8f(A.in[I_MU] + 1024 + c, mv); ld8f(A.in[I_GNG] + c, gg); ld8f(A.in[I_GNB] + c, gb); ld8f(A.in[I_LOG] + c, og);
#pragma unroll 3
    for (int row = gw; row < MP; row += NGW) {
        bf16* mo = MIX + (size_t)row * D;
        const RowInfo ri = row_info(row);
        if (ri.kind == 3) { ((u32x4*)mo)[lane] = (u32x4){0u, 0u, 0u, 0u}; ((u32x4*)mo)[64 + lane] = (u32x4){0u, 0u, 0u, 0u}; continue; }
        const int r1 = row_back(ri, row, 1);
        float y[8], uv[8], pv[8], g[8], hv[8], pp[8], gt[8], cr[8];
        ld8f(Y + (size_t)row * 512 + c, y);
        unpack8(*(const u32x4*)(U + (size_t)row * DIN + 1024 + c), uv);
        unpack8(*(const u32x4*)(GA + (size_t)row * 1536 + 1024 + c), g);
        unpack8(*(const u32x4*)(LRU + (size_t)row * 1024 + c), hv); unpack8(*(const u32x4*)(LRU + (size_t)row * 1024 + 512 + c), pp);
        unpack8(*(const u32x4*)(U + (size_t)row * DIN + DTMP + 512 + c), gt);
        const float bon = BON[(size_t)row * 8 + h];
        if (r1 >= 0) unpack8(*(const u32x4*)(U + (size_t)r1 * DIN + 1024 + c), pv);
        else if (ri.kind == 1) ld8f(sts + (size_t)ri.b * DTMP + 1024 + c, pv);
        else {
#pragma unroll
            for (int i = 0; i < 8; ++i) pv[i] = 0.f; }
        if (ri.kind == 0) ld8f(CARRY + ((size_t)ri.b * 64 + ((row & 2047) >> 5)) * 512 + c, cr);
        else {
#pragma unroll
            for (int i = 0; i < 8; ++i) cr[i] = 0.f; }
        float s = 0.f;
#pragma unroll
        for (int i = 0; i < 8; ++i) s += y[i];
        const float mean = sum8(s) * (1.f / 64.f);
        float q = 0.f;
#pragma unroll
        for (int i = 0; i < 8; ++i) { y[i] -= mean; q += y[i] * y[i]; }
        const float rstd = __builtin_amdgcn_rsqf(sum8(q) * (1.f / 64.f) + GN_EPS);
        float o[8];
#pragma unroll
        for (int i = 0; i < 8; ++i) { const float vv = uv[i] + (pv[i] - uv[i]) * mv[i]; o[i] = (y[i] * rstd * gg[i] + gb[i] + bon * vv) * g[i]; }
        *(u32x4*)(mo + c) = pack8(o);
        float z[8], s2 = 0.f;
#pragma unroll
        for (int i = 0; i < 8; ++i) { z[i] = (hv[i] + pp[i] * cr[i]) * gelu_tanh(gt[i]); s2 += z[i] * z[i]; }
        const float rs = __builtin_amdgcn_rsqf(wave_sum(s2) * (1.f / 512.f) + EPS);
#pragma unroll
        for (int i = 0; i < 8; ++i) o[i] = z[i] * rs * og[i];
        *(u32x4*)(mo + 512 + c) = pack8(o);
    }
}

__device__ __forceinline__ void phase_final(const Args& A, int G) {
    const int tid = my_tid(), lane = tid & 63, wave = tid >> 6;
    const int gw = blockIdx.x * 8 + wave, NGW = G * 8;
    const float* gf = A.in[I_NFG];
    f32x4 g[4];
#pragma unroll
    for (int j = 0; j < 4; ++j) g[j] = ((const f32x4*)gf)[lane + 64 * j];
    for (int row = gw; row < M_MAIN; row += NGW) {
        f32x4* p = (f32x4*)(A.out + (size_t)row * D);
        f32x4 v[4]; float s = 0.f;
#pragma unroll
        for (int j = 0; j < 4; ++j) { v[j] = p[lane + 64 * j]; s += (v[j].x * v[j].x + v[j].y * v[j].y) + (v[j].z * v[j].z + v[j].w * v[j].w); }
        const float rs = __builtin_amdgcn_rsqf(wave_sum(s) * (1.f / D) + EPS);
#pragma unroll
        for (int j = 0; j < 4; ++j) p[lane + 64 * j] = v[j] * rs * g[j];
    }
}

__device__ __forceinline__ void phase_gate_fix(const Args& A, int G) {
    const int tid = my_tid(), gt = blockIdx.x * 512 + tid, NGT = G * 512;
    const bf16* __restrict__ up = (const bf16*)(A.ws + WS_UP); bf16* hid = (bf16*)(A.ws + WS_HID);
    const float* __restrict__ stf = A.in[I_SFC]; const float* __restrict__ cw = A.in[I_FCW]; const float* __restrict__ cb = A.in[I_FCB];
    for (int g = gt; g < DB * DS * (DFF / 8); g += NGT) {
        const int row = R_SAMPLE + g / (DFF / 8), col = (g % (DFF / 8)) * 8, t = row & 3, sb = (row - R_SAMPLE) >> 2;
        float gs[8], u0[8], p1[8], p2[8], w0[8], w1[8], w2[8], bb[8], o[8];
        unpack8(*(const u32x4*)(hid + (size_t)row * DFF + col), gs); unpack8(*(const u32x4*)(up + (size_t)row * DFF + col), u0);
        if (t >= 1) unpack8(*(const u32x4*)(up + (size_t)(row - 1) * DFF + col), p1); else ld8f(stf + ((size_t)sb * 2 + 1) * DFF + col, p1);
        if (t >= 2) unpack8(*(const u32x4*)(up + (size_t)(row - 2) * DFF + col), p2); else ld8f(stf + ((size_t)sb * 2 + t) * DFF + col, p2);
        ld8f(cw + col, w0); ld8f(cw + DFF + col, w1); ld8f(cw + 2 * DFF + col, w2); ld8f(cb + col, bb);
#pragma unroll
        for (int e = 0; e < 8; ++e) o[e] = gelu_tanh(bb[e] + w0[e] * p2[e] + w1[e] * p1[e] + w2[e] * u0[e]) * gs[e];
        *(u32x4*)(hid + (size_t)row * DFF + col) = pack8(o);
    }
}

namespace cg = cooperative_groups;
__global__ void __launch_bounds__(512, 2) mk_fwd(Args args) {
    extern __shared__ __attribute__((aligned(16))) unsigned char lds_raw[];
    LAS unsigned char* lds = (LAS unsigned char*)lds_raw;
    const int G = gridDim.x, tid = threadIdx.x;
    volatile LAS unsigned* MISC = (volatile LAS unsigned*)(lds + 131072 + 320);
    if (tid < 64) ((LAS unsigned*)(lds + 131072))[tid + 64] = 0u, ((LAS unsigned*)(lds + 131072))[tid] = 0u;
    __syncthreads();
    const int lo = args.ph_lo, hi = args.ph_hi;
    XcdBarrier bar; bar.bar = (unsigned*)(args.ws + WS_CTL) + 4096; bar.x = 0; bar.st = nullptr;
    if (hi - lo > 1) bar = xcd_barrier_post((unsigned*)(args.ws + WS_CTL) + 4096, MISC + 8);
    if (lo < 0) cg::this_grid().sync();
#define IN(k) (lo <= (k) && (k) < hi)
#define SEAM(k) do { if (IN(k) && IN((k) + 1)) xcd_barrier(bar); } while (0)
    unsigned char* ws = args.ws; unsigned char* ob = (unsigned char*)args.out;
    if (IN(0)) { phase_p0(args, lds, G); } SEAM(0);
    if (IN(1)) { pg8::Gemm g{(const bf16*)(ws + WS_XN), (const bf16*)(ws + WS_WIN), MP, DIN, D}; pg8::StaticOrder S; S.init(MP, DIN, G, (int)blockIdx.x, D);
        EpiPlain E{(bf16*)(ws + WS_U), DIN}; pg8::gemm_phase<EpiPlain, pg8::StaticOrder, true, true>(lds, g, S, E); } SEAM(1);
    if (IN(2)) { phase_e1(args, G); } SEAM(2);
    if (IN(3)) {
        { pg8::Gemm g{(const bf16*)(ws + WS_AP), (const bf16*)(ws + WS_BA), MP, 1536, 256}; pg8::StaticOrder S; S.init(MP, 1536, G, (int)blockIdx.x, 256);
          EpiPlain E{(bf16*)(ob + DO_GA), 1536}; pg8::gemm_phase<EpiPlain, pg8::StaticOrder, true, true>(lds, g, S, E); }
        { pg8::Gemm g{(const bf16*)(ws + WS_XC), (const bf16*)(ws + WS_BB), MP, 1024, 512}; pg8::StaticOrder S; S.init(MP, 1024, G, (int)((blockIdx.x + 96u) % (unsigned)G), 512);
          EpiPlain E{(bf16*)(ws + WS_GB), 1024}; pg8::gemm_phase<EpiPlain, pg8::StaticOrder, true, true>(lds, g, S, E); }
    } SEAM(3);
    if (IN(4)) { phase_e2(args, G); } SEAM(4);
    if (IN(5)) { phase_m2(args, lds, G); } SEAM(5);
    if (IN(6)) { phase_m3(args, G); } SEAM(6);
    if (IN(7)) { pg8::Gemm g{(const bf16*)(ws + WS_MIX), (const bf16*)(ob + DO_WOUT), MP, D, D}; pg8::StaticOrder S; S.init(MP, D, G, (int)blockIdx.x, D);
        EpiX1 E{args.in[I_XP], args.in[I_XS], args.in[I_META], args.out, (bf16*)(ws + WS_X1B), (float*)(ws + WS_SSQ1)};
        pg8::gemm_phase<EpiX1, pg8::StaticOrder, true, true>(lds, g, S, E);
        if (G > 12 && (int)blockIdx.x >= 12) { __syncthreads(); ffn_weight_transposes(args, lds, ((int)blockIdx.x - 12) * 8 + (my_tid() >> 6), (G - 12) * 8); } } SEAM(7);
    if (IN(8)) { pg8::Gemm g{(const bf16*)(ws + WS_X1B), (const bf16*)(ws + WS_WUP), MP, DFF, D}; pg8::StaticOrder S; S.init(MP, DFF, G, (int)blockIdx.x, D);
        EpiUp E{(const float*)(ws + WS_SSQ1), (bf16*)(ws + WS_UP), args.out + O_PFC, args.out + O_SFC};
        pg8::gemm_phase<EpiUp, pg8::StaticOrder, true, true>(lds, g, S, E);
        { pg8::Gemm g2{(const bf16*)(ws + WS_X1B), (const bf16*)(ws + WS_WGATE), MP, DFF, D}; TailOrder S2{G, (int)blockIdx.x};
          EpiStash E2{(const float*)(ws + WS_SSQ1), (bf16*)(ws + WS_HID)}; pg8::gemm_phase<EpiStash, TailOrder, true, true>(lds, g2, S2, E2); } } SEAM(8);
    if (IN(9)) { pg8::Gemm g{(const bf16*)(ws + WS_X1B), (const bf16*)(ws + WS_WGATE), R_SAMPLE, DFF, D}; pg8::StaticOrder S; S.init(R_SAMPLE, DFF, G, (int)blockIdx.x, D);
        EpiGate E{(const float*)(ws + WS_SSQ1), (const bf16*)(ws + WS_UP), args.in[I_SFC], args.in[I_FCW], args.in[I_FCB], (bf16*)(ws + WS_HID)};
        pg8::gemm_phase<EpiGate, pg8::StaticOrder, true, true>(lds, g, S, E); phase_gate_fix(args, G); } SEAM(9);
    if (IN(10)) { pg8::Gemm g{(const bf16*)(ws + WS_HID), (const bf16*)(ws + WS_WDOWN), M_MAIN, D, DFF}; DownOrder S; S.init(G, (int)blockIdx.x);
        EpiDown E{args.out, (const bf16*)(ws + WS_X1B)};
        pg8::gemm_phase<EpiDown, DownOrder, true, true>(lds, g, S, E); } SEAM(10);
    if (IN(11)) { phase_final(args, G); }
#undef IN
#undef SEAM
}

extern "C" void kernel_launch(void* const* d_in, const int* in_sizes, int n_in, void* d_out, int out_size, void* d_ws, size_t ws_size, hipStream_t stream) {
    static int grid = 0;
    if (grid == 0) {
        if (n_in != N_IN || (size_t)out_size != O_END || ws_size < 256 * MiB) { fprintf(stderr, "kernel_launch: unexpected shapes n_in %d out %d ws %zu\n", n_in, out_size, ws_size); grid = -1; return; }
        int dev = 0, cus = 0, per_cu = 0;
        (void)hipGetDevice(&dev); (void)hipDeviceGetAttribute(&cus, hipDeviceAttributeMultiprocessorCount, dev);
        if (hipFuncSetAttribute((const void*)mk_fwd, hipFuncAttributeMaxDynamicSharedMemorySize, LDS_BYTES) != hipSuccess) { fprintf(stderr, "kernel_launch: hipFuncSetAttribute failed\n"); grid = -1; return; }
        if (hipOccupancyMaxActiveBlocksPerMultiprocessor(&per_cu, (const void*)mk_fwd, 512, LDS_BYTES) != hipSuccess || per_cu < 1) per_cu = 1;
        (void)hipGetLastError();
        grid = cus > 0 ? cus : 256;
    }
    if (grid < 0) return;
    Args a{};
    for (int i = 0; i < N_IN; ++i) a.in[i] = (const float*)d_in[i];
    a.out = (float*)d_out; a.ws = (unsigned char*)d_ws;
#if MK_ONE_LAUNCH
    (void)hipMemsetAsync((char*)d_ws + WS_CTL, 0, CTL_ZERO_BYTES, stream);
    a.ph_lo = 0; a.ph_hi = NPH;
    void* kargs[] = {&a};
    hipError_t e = hipLaunchCooperativeKernel((const void*)mk_fwd, dim3(grid), dim3(512), kargs, LDS_BYTES, stream);
    if (e != hipSuccess) fprintf(stderr, "cooperative launch failed: %s (grid %d)\n", hipGetErrorString(e), grid);
#else
    for (int ph = 0; ph < NPH; ++ph) for (int rep = 0; rep < 1 + ((MK_REP_MASK >> ph) & 1); ++rep) { a.ph_lo = ph; a.ph_hi = ph + 1; hipLaunchKernelGGL(mk_fwd, dim3(grid), dim3(512), LDS_BYTES, stream, a); }
#endif
}
```
